# Optimizing an MI355X kernel written in HIP

```python
import math
import jax, jax.numpy as jnp
from jax import lax
import numpy as np

D_MODEL = 4096
BATCH = 4
SEQ = 4096
DEPTH = 1

NORM_EPS = 1e-6
GLA_HEADS = 16
GLA_DK = 64
GLA_DV = 128
GLA_KEY_W = GLA_HEADS * GLA_DK
GLA_VAL_W = GLA_HEADS * GLA_DV
GLA_GATE_RANK = 16
GLA_TAU = 16.0
GLA_CHUNK = 64
NSA_HEADS = 16
NSA_KV_HEADS = 4
NSA_GROUP = NSA_HEADS // NSA_KV_HEADS
NSA_DIM = 128
NSA_Q_W = NSA_HEADS * NSA_DIM
NSA_KV_W = NSA_KV_HEADS * NSA_DIM
CMP_BLOCK = 32
CMP_STRIDE = 16
PHI_HIDDEN = 128
SEL_BLOCK = 64
SEL_TOPK = 16
SEL_LOCAL = 2
SEL_QUERY_BLOCK = 32
WINDOW = 512
WIN_QUERY_BLOCK = 128
REL_BUCKETS = 32
REL_MAX_DIST = 128
D_FF = 4 * D_MODEL

NEG_INF = -1e30
FORCE_SCORE = 1e4

IN_SPLITS = (GLA_KEY_W, GLA_KEY_W, GLA_VAL_W, GLA_GATE_RANK, GLA_VAL_W,
             NSA_Q_W, NSA_KV_W, NSA_KV_W, NSA_KV_W, NSA_KV_W, NSA_KV_W, NSA_KV_W, 3 * NSA_HEADS,
             D_MODEL, D_MODEL)
D_IN_PROJ = sum(IN_SPLITS)
SPLIT_POINTS = [int(v) for v in np.cumsum(IN_SPLITS)[:-1]]

kernel_name = 'hybrid_gla_nsa_gated_block'


def _rmsnorm(x, g):
    xf = x.astype(jnp.float32)
    y = xf * lax.rsqrt(jnp.mean(xf * xf, axis=-1, keepdims=True) + NORM_EPS)
    return (y * g.astype(jnp.float32)).astype(x.dtype)


def _rel_bucket(dist):
    n = jnp.maximum(dist, 0)
    max_exact = REL_BUCKETS // 2
    nf = jnp.maximum(n, max_exact).astype(jnp.float32)
    large = max_exact + (jnp.log(nf / max_exact) / math.log(REL_MAX_DIST / max_exact)
                         * (REL_BUCKETS - max_exact)).astype(jnp.int32)
    large = jnp.minimum(large, REL_BUCKETS - 1)
    return jnp.where(n < max_exact, n, large)


def _masked_softmax(logits, valid):
    p = jax.nn.softmax(jnp.where(valid, logits, NEG_INF), axis=-1)
    return jnp.where(valid, p, 0.0)


def _cmp_to_sel_matrix(n_c, n_s):
    m_mat = np.zeros((n_c, n_s), np.float32)
    j = np.arange(n_s)
    for m in range(SEL_BLOCK // CMP_STRIDE):
        for n in range(CMP_BLOCK // CMP_STRIDE):
            c = (SEL_BLOCK // CMP_STRIDE) * j + m - n
            ok = (c >= 0) & (c < n_c)
            np.add.at(m_mat, (c[ok], j[ok]), 1.0)
    return jnp.asarray(m_mat)


def _gla_mixer(q, k, v, a_lr, r, w_alpha2, b_alpha, norm_g):
    B, S, _ = q.shape
    N, C, H = S // GLA_CHUNK, GLA_CHUNK, GLA_HEADS

    def chunks(t, d):
        return t.reshape(B, N, C, H, d).transpose(0, 3, 1, 2, 4)

    log_a = jax.nn.log_sigmoid((a_lr @ w_alpha2 + b_alpha).astype(jnp.float32)) / GLA_TAU
    bcum = jnp.cumsum(chunks(log_a, GLA_DK), axis=3)
    qc = chunks(q, GLA_DK).astype(jnp.float32) * (GLA_DK ** -0.5)
    kc = chunks(k, GLA_DK).astype(jnp.float32)
    vc = chunks(v, GLA_DV).astype(jnp.float32)
    qe = qc * jnp.exp(bcum)
    ke = kc * jnp.exp(-bcum)
    kd = kc * jnp.exp(bcum[:, :, :, -1:, :] - bcum)
    causal = jnp.asarray(np.tril(np.ones((C, C), dtype=bool)))
    attn = jnp.where(causal, jnp.einsum('bhncd,bhnsd->bhncs', qe, ke), 0.0)
    o_intra = jnp.einsum('bhncs,bhnse->bhnce', attn, vc)
    kv = jnp.einsum('bhnsd,bhnse->bhnde', kd, vc)
    decay = jnp.exp(bcum[:, :, :, -1, :])

    def step(state, inp):
        dec, kv_n = inp
        return dec[..., None] * state + kv_n, state

    init = jnp.zeros((B, H, GLA_DK, GLA_DV), jnp.float32)
    _, prev = lax.scan(step, init, (jnp.moveaxis(decay, 2, 0), jnp.moveaxis(kv, 2, 0)))
    o_inter = jnp.einsum('bhncd,nbhde->bhnce', qe, prev)
    o = (o_intra + o_inter).transpose(0, 2, 3, 1, 4).reshape(B, S, H, GLA_DV)
    o = _rmsnorm(o, norm_g)
    return (o.reshape(B, S, GLA_VAL_W) * jax.nn.silu(r.astype(jnp.float32))).astype(q.dtype)


def _nsa_mixer(q, k_cmp, v_cmp, k_sel, v_sel, k_win, v_win, gate_logits,
               pos_k, pos_v, phi_k_w1, phi_k_w2, phi_v_w1, phi_v_w2, rel_table):
    B, S, _ = q.shape
    G, R, d = NSA_KV_HEADS, NSA_GROUP, NSA_DIM
    scale = d ** -0.5
    q5 = q.reshape(B, S, G, R, d)
    k_cmp, v_cmp, k_sel, v_sel, k_win, v_win = [t.reshape(B, S, G, d) for t in
                                                 (k_cmp, v_cmp, k_sel, v_sel, k_win, v_win)]
    table_gr = rel_table.astype(jnp.float32).reshape(REL_BUCKETS, G, R)
    pos_t = jnp.arange(S, dtype=jnp.int32)

    n_c = (S - CMP_BLOCK) // CMP_STRIDE + 1
    blk_idx = np.arange(n_c)[:, None] * CMP_STRIDE + np.arange(CMP_BLOCK)[None, :]

    def compress(t, pos, w1, w2):
        blocks = t[:, blk_idx] + pos[None, None, :, None, :]
        flat = blocks.transpose(0, 1, 3, 2, 4).reshape(B, n_c, G, CMP_BLOCK * d)
        return jax.nn.relu(flat @ w1) @ w2

    kc = compress(k_cmp, pos_k, phi_k_w1, phi_k_w2)
    vc = compress(v_cmp, pos_v, phi_v_w1, phi_v_w2)
    cmp_end = jnp.arange(n_c, dtype=jnp.int32) * CMP_STRIDE + (CMP_BLOCK - 1)
    dist_c = pos_t[:, None] - cmp_end[None, :]
    bias_c = table_gr[_rel_bucket(dist_c)].transpose(2, 3, 0, 1)
    logits_c = jnp.einsum('bsgrd,bcgd->bgrsc', q5, kc).astype(jnp.float32) * scale + bias_c
    p_c = _masked_softmax(logits_c, dist_c >= 0)
    o_cmp = jnp.einsum('bgrsc,bcgd->bsgrd', p_c.astype(vc.dtype), vc)

    n_s = S // SEL_BLOCK
    top_n = min(SEL_TOPK, n_s)
    imp = jnp.einsum('bgrsc,cj->bgsj', p_c, _cmp_to_sel_matrix(n_c, n_s))
    blk = jnp.arange(n_s, dtype=jnp.int32)
    cur = pos_t // SEL_BLOCK
    forced = (blk[None, :] == 0) | ((blk[None, :] <= cur[:, None]) &
                                     (blk[None, :] > cur[:, None] - SEL_LOCAL))
    reachable = blk[None, :] * SEL_BLOCK <= pos_t[:, None]
    score = jnp.where(forced, FORCE_SCORE, jnp.where(reachable, imp, -FORCE_SCORE))
    _, sel_idx = lax.top_k(score, top_n)
    ks_blk = k_sel.reshape(B, n_s, SEL_BLOCK, G, d).transpose(0, 3, 1, 2, 4)
    vs_blk = v_sel.reshape(B, n_s, SEL_BLOCK, G, d).transpose(0, 3, 1, 2, 4)
    b_ix = jnp.arange(B)[:, None, None, None]
    g_ix = jnp.arange(G)[None, :, None, None]
    n_key = top_n * SEL_BLOCK
    QS = SEL_QUERY_BLOCK

    def sel_chunk(i):
        q0 = i * QS
        qb = lax.dynamic_slice_in_dim(q5, q0, QS, axis=1)
        idx = lax.dynamic_slice_in_dim(sel_idx, q0, QS, axis=2)
        kg = ks_blk[b_ix, g_ix, idx].reshape(B, G, QS, n_key, d)
        vg = vs_blk[b_ix, g_ix, idx].reshape(B, G, QS, n_key, d)
        kpos = (idx[..., None] * SEL_BLOCK + jnp.arange(SEL_BLOCK, dtype=jnp.int32)).reshape(B, G, QS, n_key)
        dist = (q0 + jnp.arange(QS, dtype=jnp.int32))[None, None, :, None] - kpos
        bias = table_gr[_rel_bucket(dist), g_ix].transpose(0, 1, 4, 2, 3)
        logits = jnp.einsum('bqgrd,bgqkd->bgrqk', qb, kg).astype(jnp.float32) * scale + bias
        p = _masked_softmax(logits, (dist >= 0)[:, :, None])
        return jnp.einsum('bgrqk,bgqkd->bqgrd', p.astype(vg.dtype), vg)

    o_sel = lax.map(sel_chunk, jnp.arange(S // QS, dtype=jnp.int32))
    o_sel = jnp.moveaxis(o_sel, 0, 1).reshape(B, S, G, R, d)

    QB = WIN_QUERY_BLOCK
    span = QB + WINDOW
    pad = ((0, 0), (WINDOW, 0), (0, 0), (0, 0))
    kw_pad = jnp.pad(k_win, pad)
    vw_pad = jnp.pad(v_win, pad)

    def win_block(i):
        s0 = i * QB
        qb = lax.dynamic_slice_in_dim(q5, s0, QB, axis=1)
        kb = lax.dynamic_slice_in_dim(kw_pad, s0, span, axis=1)
        vb = lax.dynamic_slice_in_dim(vw_pad, s0, span, axis=1)
        tq = s0 + jnp.arange(QB, dtype=jnp.int32)
        kpos = s0 - WINDOW + jnp.arange(span, dtype=jnp.int32)
        dist = tq[:, None] - kpos[None, :]
        valid = (dist >= 0) & (dist < WINDOW) & (kpos[None, :] >= 0)
        bias = table_gr[_rel_bucket(dist)].transpose(2, 3, 0, 1)
        logits = jnp.einsum('bqgrd,bkgd->bgrqk', qb, kb).astype(jnp.float32) * scale + bias
        p = _masked_softmax(logits, valid)
        return jnp.einsum('bgrqk,bkgd->bqgrd', p.astype(vb.dtype), vb)

    o_win = lax.map(win_block, jnp.arange(S // QB, dtype=jnp.int32))
    o_win = jnp.moveaxis(o_win, 0, 1).reshape(B, S, G, R, d)

    gates = jax.nn.sigmoid(gate_logits.astype(jnp.float32)).reshape(B, S, G, R, 3)
    o = gates[..., 0:1] * o_cmp + gates[..., 1:2] * o_sel + gates[..., 2:3] * o_win
    return o.reshape(B, S, NSA_Q_W).astype(q.dtype)


def setup_inputs(seed: int = 0) -> dict:
    key = jax.random.key(seed)
    ks = jax.random.split(key, 22)
    f32 = jnp.float32
    L = DEPTH

    def nrm(k, shape, scale):
        return jax.random.normal(k, shape, f32) * scale

    def gain(k, shape):
        return 1.0 + nrm(k, shape, 0.02)

    return {
        'x': nrm(ks[0], (BATCH, SEQ, D_MODEL), 1.0),
        'g_mix_norm': gain(ks[1], (L, D_MODEL)),
        'w_in': nrm(ks[2], (L, D_MODEL, D_IN_PROJ), D_MODEL ** -0.5),
        'w_alpha2': nrm(ks[3], (L, GLA_GATE_RANK, GLA_KEY_W), GLA_GATE_RANK ** -0.5),
        'b_alpha': nrm(ks[4], (L, GLA_KEY_W), 0.1),
        'gla_norm_g': gain(ks[5], (L, GLA_HEADS, GLA_DV)),
        'cmp_pos_k': nrm(ks[6], (L, CMP_BLOCK, NSA_DIM), 0.02),
        'cmp_pos_v': nrm(ks[7], (L, CMP_BLOCK, NSA_DIM), 0.02),
        'phi_k_w1': nrm(ks[8], (L, CMP_BLOCK * NSA_DIM, PHI_HIDDEN), (CMP_BLOCK * NSA_DIM) ** -0.5),
        'phi_k_w2': nrm(ks[9], (L, PHI_HIDDEN, NSA_DIM), PHI_HIDDEN ** -0.5),
        'phi_v_w1': nrm(ks[10], (L, CMP_BLOCK * NSA_DIM, PHI_HIDDEN), (CMP_BLOCK * NSA_DIM) ** -0.5),
        'phi_v_w2': nrm(ks[11], (L, PHI_HIDDEN, NSA_DIM), PHI_HIDDEN ** -0.5),
        'rel_bias_table': nrm(ks[12], (REL_BUCKETS, NSA_HEADS), 0.5),
        'w_gla_proj': nrm(ks[13], (L, GLA_VAL_W, D_MODEL), GLA_VAL_W ** -0.5),
        'w_nsa_proj': nrm(ks[14], (L, NSA_Q_W, D_MODEL), NSA_Q_W ** -0.5),
        'w_out': nrm(ks[15], (L, D_MODEL, D_MODEL), D_MODEL ** -0.5),
        'g_mlp_norm': gain(ks[16], (L, D_MODEL)),
        'w_up': nrm(ks[17], (L, D_MODEL, D_FF), D_MODEL ** -0.5),
        'w_down': nrm(ks[18], (L, D_FF, D_MODEL), D_FF ** -0.5),
        'g_final_norm': gain(ks[19], (D_MODEL,)),
    }


def reference(x, g_mix_norm, w_in, w_alpha2, b_alpha, gla_norm_g, cmp_pos_k, cmp_pos_v,
              phi_k_w1, phi_k_w2, phi_v_w1, phi_v_w2, rel_bias_table, w_gla_proj, w_nsa_proj,
              w_out, g_mlp_norm, w_up, w_down, g_final_norm):
    for l in range(DEPTH):
        h = _rmsnorm(x, g_mix_norm[l])
        u = h @ w_in[l]
        (gq, gk, gv, ga, gr, nq, kc, vc, ksl, vsl, kw, vw, ng, m_gla, m_nsa) = jnp.split(u, SPLIT_POINTS, axis=-1)
        o_gla = _gla_mixer(gq, gk, gv, ga, gr, w_alpha2[l], b_alpha[l], gla_norm_g[l])
        o_nsa = _nsa_mixer(nq, kc, vc, ksl, vsl, kw, vw, ng, cmp_pos_k[l], cmp_pos_v[l],
                           phi_k_w1[l], phi_k_w2[l], phi_v_w1[l], phi_v_w2[l], rel_bias_table)
        mix = (jax.nn.sigmoid(m_gla) * (o_gla @ w_gla_proj[l])
               + jax.nn.sigmoid(m_nsa) * (o_nsa @ w_nsa_proj[l]))
        x = x + mix @ w_out[l]
        h = _rmsnorm(x, g_mlp_norm[l])
        x = x + jnp.square(jax.nn.relu(h @ w_up[l])) @ w_down[l]
    return _rmsnorm(x, g_final_norm)
```

```cpp
#include <hip/hip_runtime.h>
#include <cstdio>
#include <cstdint>
#ifndef MK_N_LAUNCHES
#define MK_N_LAUNCHES 1
#endif
#ifndef NSA_SB
#define NSA_SB()
#endif
namespace pg8 {
#define PG8_LAS __attribute__((address_space(3)))
typedef unsigned short bf16_t;
typedef short bf16x8 __attribute__((ext_vector_type(8)));
typedef float f32x4 __attribute__((ext_vector_type(4)));
typedef unsigned u32x4 __attribute__((ext_vector_type(4)));
constexpr int BM = 256, BK = 64, HALF = 128, HTB = HALF * BK * 2  , STAGE_BYTES = 8 * HTB, NXCD = 8, WGM = 8;

__host__ __device__ __forceinline__ int lds_byte(int r, int c) { const int st = (r >> 4) * 2 + (c >> 5), rr = r & 15, cc = c & 31, ob = rr * 64 + cc * 2; return st * 1024 + (ob ^ (((ob >> 9) & 1) << 5)); }
__host__ __device__ __forceinline__ void stage_rc(int b, int& R, int& C) { const int st = b / 1024, sb = b % 1024, swz = sb ^ (((sb >> 9) & 1) << 5); R = (st >> 1) * 16 + swz / 64; C = (st & 1) * 32 + (swz % 64) / 2; }
__host__ __device__ __forceinline__ int perm32(int rho) { const int n = rho >> 4, i = rho & 15; return 8 * (i >> 2) + 4 * n + (i & 3); }

struct Unit { int pm, pn; };
struct Gemm { const bf16_t* A; const bf16_t* Bt; int M, N, K; };

struct StaticOrder {
    int nM, nN, nwg, G, c;
    __host__ __device__ void init(int M, int N, int G_, int c_) { nM = M / BM; nN = N / BM; nwg = nM * nN; G = G_; c = c_; }
    __host__ __device__ bool next(int i, Unit& u) const {
        const long L = (long)i * G + c; if (L >= nwg) return false;
        int wgid = (int)L; { const int q = nwg / NXCD, r = nwg % NXCD, xcd = wgid % NXCD, off = wgid / NXCD; wgid = (xcd < r ? xcd * (q + 1) : r * (q + 1) + (xcd - r) * q) + off; }
        const int nig = WGM * nN, gid = wgid / nig, fm = gid * WGM, gsz = (nM - fm) < WGM ? (nM - fm) : WGM;
        u.pm = fm + ((wgid % nig) % gsz); u.pn = (wgid % nig) / gsz; return true;
    }
    __device__ __forceinline__ void a_ready(const Unit&) const {}
    __device__ __forceinline__ void done(const Unit&) const {}
};
struct LateOrder : StaticOrder {
    int nlate, cut, nfull;
    __host__ __device__ void init2(int M, int N, int G_, int c_, int nlate_, int cut_) { init(M, N, G_, c_); nlate = nlate_; cut = cut_; nfull = nwg / G_; }
    __host__ __device__ bool next(int i, Unit& u) const {
        long L;
        if (c < nlate) { if (i >= nfull - cut) return false; L = (long)i * G + c; }
        else if (i < nfull) L = (long)i * G + c;
        else { const int e = c - nlate; if (i > nfull || e >= nlate * cut) return false; L = (long)(nfull - cut + e / nlate) * G + (e % nlate); }
        int wgid = (int)L; { const int q = nwg / NXCD, r = nwg % NXCD, xcd = wgid % NXCD, off = wgid / NXCD; wgid = (xcd < r ? xcd * (q + 1) : r * (q + 1) + (xcd - r) * q) + off; }
        const int nig = WGM * nN, gid = wgid / nig, fm = gid * WGM, gsz = (nM - fm) < WGM ? (nM - fm) : WGM;
        u.pm = fm + ((wgid % nig) % gsz); u.pn = (wgid % nig) / gsz; return true;
    }
};


__device__ __forceinline__ unsigned cvt_pk_bf16(float lo, float hi) { unsigned r; asm volatile("v_cvt_pk_bf16_f32 %0, %1, %2" : "=v"(r) : "v"(lo), "v"(hi)); return r; }
typedef float f32x2 __attribute__((ext_vector_type(2)));
__device__ __forceinline__ float sigmoid_f(float x) { return __builtin_amdgcn_rcpf(1.0f + __expf(-x)); }
__device__ __forceinline__ float bf_lo(unsigned w) { return __uint_as_float(w << 16); }
__device__ __forceinline__ float bf_hi(unsigned w) { return __uint_as_float(w & 0xffff0000u); }

struct EpiU {
    static constexpr bool PERM = true, AFTER_DRAIN = false;
    bf16_t* O; int ldc; int pn_off; float scl; bool remap;
    __device__ __forceinline__ void operator()(const f32x4 (&acc)[2][2][4][2], const Unit& u, int wr, int wc, int fr, int fq) const {
        const int ct = (remap && u.pn == 44) ? 76 : u.pn + pn_off;
        const int row0 = u.pm * BM + wr * 64 + fr, col0 = ct * BM + wc * 32 + 8 * fq;
        const int mode = (ct >= 16 && ct < 24) ? 1 : ((ct >= 44 && ct < 76) ? 2 : (ct == 76 ? 3 : 0));
#pragma unroll
        for (int ai = 0; ai < 2; ++ai)
#pragma unroll
            for (int m = 0; m < 4; ++m) { bf16_t* rowp = O + (size_t)(row0 + ai * HALF + m * 16) * ldc + col0;
#pragma unroll
                for (int bj = 0; bj < 2; ++bj) { f32x4 v0 = acc[ai][bj][m][0] * scl, v1 = acc[ai][bj][m][1] * scl;
                    if (mode == 1) {
#pragma unroll
                        for (int j = 0; j < 4; ++j) { v0[j] = v0[j] * sigmoid_f(v0[j]); v1[j] = v1[j] * sigmoid_f(v1[j]); } }
                    else if (mode == 2 || (mode == 3 && (bj * HALF + wc * 32 + 8 * fq) >= 16)) {
#pragma unroll
                        for (int j = 0; j < 4; ++j) { v0[j] = sigmoid_f(v0[j]); v1[j] = sigmoid_f(v1[j]); } }
                    u32x4 w; w.x = cvt_pk_bf16(v0[0], v0[1]); w.y = cvt_pk_bf16(v0[2], v0[3]); w.z = cvt_pk_bf16(v1[0], v1[1]); w.w = cvt_pk_bf16(v1[2], v1[3]);
                    *(u32x4*)(rowp + bj * HALF) = w; } }
    }
};
template <int ACT> struct EpiAct {
    static constexpr bool PERM = true, AFTER_DRAIN = false;
    bf16_t* O; int ldc;
    __device__ __forceinline__ void operator()(const f32x4 (&acc)[2][2][4][2], const Unit& u, int wr, int wc, int fr, int fq) const {
        const int row0 = u.pm * BM + wr * 64 + fr, col0 = u.pn * BM + wc * 32 + 8 * fq;
#pragma unroll
        for (int ai = 0; ai < 2; ++ai)
#pragma unroll
            for (int m = 0; m < 4; ++m) { bf16_t* rowp = O + (size_t)(row0 + ai * HALF + m * 16) * ldc + col0;
#pragma unroll
                for (int bj = 0; bj < 2; ++bj) { f32x4 v0 = acc[ai][bj][m][0], v1 = acc[ai][bj][m][1];
                    if (ACT >= 1) {
#pragma unroll
                        for (int j = 0; j < 4; ++j) { v0[j] = fmaxf(v0[j], 0.f); v1[j] = fmaxf(v1[j], 0.f); if (ACT == 2) { v0[j] *= v0[j]; v1[j] *= v1[j]; } } }
                    u32x4 w; w.x = cvt_pk_bf16(v0[0], v0[1]); w.y = cvt_pk_bf16(v0[2], v0[3]); w.z = cvt_pk_bf16(v1[0], v1[1]); w.w = cvt_pk_bf16(v1[2], v1[3]);
                    *(u32x4*)(rowp + bj * HALF) = w; } }
    }
};
template <bool ACCUM> struct EpiMix {
    static constexpr bool PERM = true, AFTER_DRAIN = false;
    bf16_t* O; int ldc; const bf16_t* Gt; int ldg;
    __device__ __forceinline__ void operator()(const f32x4 (&acc)[2][2][4][2], const Unit& u, int wr, int wc, int fr, int fq) const {
        const int row0 = u.pm * BM + wr * 64 + fr, col0 = u.pn * BM + wc * 32 + 8 * fq;
#pragma unroll
        for (int ai = 0; ai < 2; ++ai)
#pragma unroll
            for (int m = 0; m < 4; ++m) { const size_t r = (size_t)(row0 + ai * HALF + m * 16); bf16_t* rowp = O + r * ldc + col0; const bf16_t* gp = Gt + r * ldg + col0;
#pragma unroll
                for (int bj = 0; bj < 2; ++bj) { f32x4 v0 = acc[ai][bj][m][0], v1 = acc[ai][bj][m][1];
                    const u32x4 gw = *(const u32x4*)(gp + bj * HALF);
                    v0[0] *= bf_lo(gw.x); v0[1] *= bf_hi(gw.x); v0[2] *= bf_lo(gw.y); v0[3] *= bf_hi(gw.y); v1[0] *= bf_lo(gw.z); v1[1] *= bf_hi(gw.z); v1[2] *= bf_lo(gw.w); v1[3] *= bf_hi(gw.w);
                    if (ACCUM) { const u32x4 ow = *(const u32x4*)(rowp + bj * HALF);
                        v0[0] += bf_lo(ow.x); v0[1] += bf_hi(ow.x); v0[2] += bf_lo(ow.y); v0[3] += bf_hi(ow.y); v1[0] += bf_lo(ow.z); v1[1] += bf_hi(ow.z); v1[2] += bf_lo(ow.w); v1[3] += bf_hi(ow.w); }
                    u32x4 w; w.x = cvt_pk_bf16(v0[0], v0[1]); w.y = cvt_pk_bf16(v0[2], v0[3]); w.z = cvt_pk_bf16(v1[0], v1[1]); w.w = cvt_pk_bf16(v1[2], v1[3]);
                    *(u32x4*)(rowp + bj * HALF) = w; } }
    }
};
struct EpiRes {
    static constexpr bool PERM = false, AFTER_DRAIN = false;
    const float* base; float* out; int ldc;
    __device__ __forceinline__ void operator()(const f32x4 (&acc)[2][2][4][2], const Unit& u, int wr, int wc, int fr, int fq) const {
        const int row0 = u.pm * BM + wr * 64 + fr, col0 = u.pn * BM + wc * 32 + 4 * fq;
#pragma unroll
        for (int ai = 0; ai < 2; ++ai)
#pragma unroll
            for (int m = 0; m < 4; ++m) { const size_t off = (size_t)(row0 + ai * HALF + m * 16) * ldc + col0;
#pragma unroll
                for (int bj = 0; bj < 2; ++bj)
#pragma unroll
                    for (int n = 0; n < 2; ++n) { const f32x4 bs = *(const f32x4*)(base + off + bj * HALF + n * 16); *(f32x4*)(out + off + bj * HALF + n * 16) = bs + acc[ai][bj][m][n]; } }
    }
};
struct EpiResN {
    static constexpr bool PERM = false, AFTER_DRAIN = false;
    const float* base; float* out; int ldc; const float* gain; bf16_t* XB; float* RS;
    __device__ __forceinline__ void operator()(const f32x4 (&acc)[2][2][4][2], const Unit& u, int wr, int wc, int fr, int fq) const {
        const int row0 = u.pm * BM + wr * 64 + fr, col0 = u.pn * BM + wc * 32 + 4 * fq;
        f32x4 gv[2][2];
#pragma unroll
        for (int bj = 0; bj < 2; ++bj)
#pragma unroll
            for (int n = 0; n < 2; ++n) gv[bj][n] = *(const f32x4*)(gain + col0 + bj * HALF + n * 16);
#pragma unroll
        for (int ai = 0; ai < 2; ++ai)
#pragma unroll
            for (int m = 0; m < 4; ++m) { const int row = row0 + ai * HALF + m * 16; const size_t off = (size_t)row * ldc + col0; float ss = 0.f;
#pragma unroll
                for (int bj = 0; bj < 2; ++bj)
#pragma unroll
                    for (int n = 0; n < 2; ++n) { const f32x4 bs = *(const f32x4*)(base + off + bj * HALF + n * 16); const f32x4 v = bs + acc[ai][bj][m][n]; *(f32x4*)(out + off + bj * HALF + n * 16) = v;
                        ss += (v[0] * v[0] + v[1] * v[1]) + (v[2] * v[2] + v[3] * v[3]);
                        const f32x4 w = v * gv[bj][n]; unsigned long long pk = (unsigned long long)cvt_pk_bf16(w[0], w[1]) | ((unsigned long long)cvt_pk_bf16(w[2], w[3]) << 32);
                        *(unsigned long long*)(XB + off + bj * HALF + n * 16) = pk; }
                ss += __shfl_xor(ss, 16); ss += __shfl_xor(ss, 32);
                if (fq == 0) RS[(size_t)row * 64 + u.pn * 4 + wc] = ss; }
    }
};
struct EpiRelu2R {
    static constexpr bool PERM = true, AFTER_DRAIN = false;
    bf16_t* O; int ldc; const float* rs2;
    __device__ __forceinline__ void operator()(const f32x4 (&acc)[2][2][4][2], const Unit& u, int wr, int wc, int fr, int fq) const {
        const int row0 = u.pm * BM + wr * 64 + fr, col0 = u.pn * BM + wc * 32 + 8 * fq;
#pragma unroll
        for (int ai = 0; ai < 2; ++ai)
#pragma unroll
            for (int m = 0; m < 4; ++m) { const int row = row0 + ai * HALF + m * 16; bf16_t* rowp = O + (size_t)row * ldc + col0; const float r2 = rs2[row];
#pragma unroll
                for (int bj = 0; bj < 2; ++bj) { f32x4 v0 = acc[ai][bj][m][0], v1 = acc[ai][bj][m][1];
#pragma unroll
                    for (int j = 0; j < 4; ++j) { v0[j] = fmaxf(v0[j], 0.f); v1[j] = fmaxf(v1[j], 0.f); v0[j] = v0[j] * v0[j] * r2; v1[j] = v1[j] * v1[j] * r2; }
                    u32x4 w; w.x = cvt_pk_bf16(v0[0], v0[1]); w.y = cvt_pk_bf16(v0[2], v0[3]); w.z = cvt_pk_bf16(v1[0], v1[1]); w.w = cvt_pk_bf16(v1[2], v1[3]);
                    *(u32x4*)(rowp + bj * HALF) = w; } }
    }
};


typedef int v8i_t __attribute__((ext_vector_type(8)));
template <class Epi, class Sched, bool ALIGN_EPI = false, bool SP2 = false, bool F8 = false, bool HALFSEL = false>
__device__ __forceinline__ void gemm_phase(PG8_LAS unsigned char* lds, const Gemm g, const Sched& S, const Epi& E, const int wid_in) {
    int lane_; asm volatile("v_mbcnt_lo_u32_b32 %0, -1, 0\n\tv_mbcnt_hi_u32_b32 %0, -1, %0" : "=v"(lane_));
    const int wid = wid_in, lane = lane_, tid = wid * 64 + lane, wr = wid >> 2, wc = wid & 3, fr = lane & 15, fq = lane >> 4;
    const int K = g.K, nt = K / BK;
    unsigned voffA[2], voffB[2];
#pragma unroll
    for (int i = 0; i < 2; ++i) { int R, C; stage_rc(tid * 16 + i * 8192, R, C); const int Rb = Epi::PERM ? ((R & ~31) + perm32(R & 31)) : R;
        voffA[i] = (unsigned)(R * K + C) * 2u; voffB[i] = (unsigned)(Rb * K + C) * 2u; }
    const size_t kstep = (size_t)(BK * 2);
    const size_t hstep = (size_t)HALF * K * 2;
    const size_t tstep = 2 * hstep;
    const unsigned ldsw = (unsigned)wid * 1024u;
    const int aoff = lds_byte(wr * 64 + fr, fq * 8), boff = lds_byte(wc * 32 + fr, fq * 8);
#define PG8_SA(b, h) (((b) * 2 + (h)) * HTB)
#define PG8_SB(b, h) ((4 + (b) * 2 + (h)) * HTB)
#define PG8_STAGE(bufoff, gbase, voff) do { _Pragma("unroll") for (int _i = 0; _i < 2; ++_i) \
        __builtin_amdgcn_global_load_lds((const unsigned*)((const char*)(gbase) + (voff)[_i]), (PG8_LAS unsigned*)(lds + (bufoff) + ldsw + _i * 8192), 16, 0, 0); } while (0)
#define PG8_LDA(dst, b, h) do { _Pragma("unroll") for (int m = 0; m < 4; ++m) { if constexpr (F8) { dst##8[m] = __builtin_bit_cast(v8i_t, __builtin_shufflevector(*(const PG8_LAS bf16x8*)(lds + PG8_SA(b, h) + aoff + m * 2048), *(const PG8_LAS bf16x8*)(lds + PG8_SA(b, h) + aoff + m * 2048 + 1024), 0, 1, 2, 3, 4, 5, 6, 7, 8, 9, 10, 11, 12, 13, 14, 15)); } \
        else { _Pragma("unroll") for (int k = 0; k < 2; ++k) dst[m][k] = *(const PG8_LAS bf16x8*)(lds + PG8_SA(b, h) + aoff + m * 2048 + k * 1024); } } } while (0)
#define PG8_LDB(dst, b, h) do { _Pragma("unroll") for (int n = 0; n < 2; ++n) { if constexpr (F8) { dst##8[n] = __builtin_bit_cast(v8i_t, __builtin_shufflevector(*(const PG8_LAS bf16x8*)(lds + PG8_SB(b, h) + boff + n * 2048), *(const PG8_LAS bf16x8*)(lds + PG8_SB(b, h) + boff + n * 2048 + 1024), 0, 1, 2, 3, 4, 5, 6, 7, 8, 9, 10, 11, 12, 13, 14, 15)); } \
        else { _Pragma("unroll") for (int k = 0; k < 2; ++k) dst[n][k] = *(const PG8_LAS bf16x8*)(lds + PG8_SB(b, h) + boff + n * 2048 + k * 1024); } } } while (0)
#define PG8_MMA(ai, bj, At, Bt) do { if (HALFSEL && !((bjm >> (bj)) & 1)) break; __builtin_amdgcn_s_setprio(1); _Pragma("unroll") for (int m = 0; m < 4; ++m) _Pragma("unroll") for (int n = 0; n < 2; ++n) { \
        if constexpr (F8) { asm volatile("v_mfma_f32_16x16x128_f8f6f4 %0, %1, %2, %0" : "+v"(acc[ai][bj][m][n]) : "v"(Bt##8[n]), "v"(At##8[m])); } \
        else { _Pragma("unroll") for (int k = 0; k < 2; ++k) acc[ai][bj][m][n] = __builtin_amdgcn_mfma_f32_16x16x32_bf16(Bt[n][k], At[m][k], acc[ai][bj][m][n], 0, 0, 0); } } __builtin_amdgcn_s_setprio(0); } while (0)
#define PG8_WAIT_V(n) asm volatile("s_waitcnt vmcnt(" #n ")" ::: "memory")
#define PG8_WAIT_L(n) asm volatile("s_waitcnt lgkmcnt(" #n ")" ::: "memory")
#define PG8_BAR __builtin_amdgcn_s_barrier()
#define PG8_SCHED __builtin_amdgcn_sched_barrier(0)
    Unit cur, nxt; int ui = 0;
    if (!S.next(0, cur)) return;
    f32x4 acc[2][2][4][2];
#pragma unroll
    for (int a = 0; a < 2; ++a)
#pragma unroll
        for (int b = 0; b < 2; ++b)
#pragma unroll
            for (int m = 0; m < 4; ++m)
#pragma unroll
                for (int n = 0; n < 2; ++n) acc[a][b][m][n] = (f32x4){0.f, 0.f, 0.f, 0.f};
    bf16x8 At[4][2], B0[2][2], B1[2][2]; v8i_t At8[4], B08[2], B18[2]; (void)At; (void)B0; (void)B1; (void)At8; (void)B08; (void)B18;
    const char* cA = (const char*)g.A + (size_t)cur.pm * tstep; const char* cB = (const char*)g.Bt + (size_t)cur.pn * tstep;
    S.a_ready(cur);
    if constexpr (SP2) {
        PG8_STAGE(PG8_SB(0, 0), cB, voffB); PG8_STAGE(PG8_SB(0, 1), cB + hstep, voffB); PG8_STAGE(PG8_SA(0, 0), cA, voffA); PG8_STAGE(PG8_SA(0, 1), cA + hstep, voffA);
        if (wr == 1) PG8_BAR;
        PG8_WAIT_V(2); PG8_BAR;
        PG8_STAGE(PG8_SB(1, 0), cB + kstep, voffB); PG8_STAGE(PG8_SA(1, 0), cA + kstep, voffA); PG8_STAGE(PG8_SB(1, 1), cB + hstep + kstep, voffB);
        PG8_WAIT_V(6); PG8_BAR;
    } else {
        PG8_STAGE(PG8_SB(0, 0), cB, voffB); PG8_STAGE(PG8_SA(0, 0), cA, voffA); PG8_STAGE(PG8_SB(0, 1), cB + hstep, voffB); PG8_STAGE(PG8_SA(0, 1), cA + hstep, voffA);
        if (wr == 1) PG8_BAR;
        PG8_WAIT_V(4); PG8_BAR;
        PG8_STAGE(PG8_SB(1, 0), cB + kstep, voffB); PG8_STAGE(PG8_SA(1, 0), cA + kstep, voffA); PG8_STAGE(PG8_SB(1, 1), cB + hstep + kstep, voffB);
        PG8_WAIT_V(6); PG8_BAR;
    }
    for (;;) {
        const int bjm = HALFSEL ? ((2 * cur.pm < g.M / BM) ? 1 : 2) : 3; (void)bjm;
        const bool has_next = S.next(ui + 1, nxt);
        const char* nA = has_next ? (const char*)g.A + (size_t)nxt.pm * tstep : cA; const char* nB = has_next ? (const char*)g.Bt + (size_t)nxt.pn * tstep : cB;
        for (int t = 0; t < nt; t += 2) {
            const bool last = (t == nt - 2);
            const char* a1 = cA + (size_t)(t + 1) * kstep;
            const char* a2 = last ? nA : cA + (size_t)(t + 2) * kstep; const char* b2 = last ? nB : cB + (size_t)(t + 2) * kstep;
            const char* a3 = a2 + kstep; const char* b3 = b2 + kstep;
            if (last && has_next) S.a_ready(nxt);
            if constexpr (SP2) {
            PG8_LDB(B0, 0, 0); PG8_LDB(B1, 0, 1); PG8_SCHED; PG8_LDA(At, 0, 0); PG8_STAGE(PG8_SA(1, 1), a1 + hstep, voffA);
            PG8_WAIT_V(8); PG8_WAIT_L(0); PG8_BAR; PG8_MMA(0, 0, At, B0); PG8_MMA(0, 1, At, B1); PG8_BAR; PG8_SCHED;
            PG8_LDA(At, 0, 1); PG8_STAGE(PG8_SB(0, 0), b2, voffB); PG8_STAGE(PG8_SB(0, 1), b2 + hstep, voffB); PG8_STAGE(PG8_SA(0, 0), a2, voffA);
            PG8_WAIT_V(8); PG8_WAIT_L(0); PG8_BAR; PG8_MMA(1, 0, At, B0); PG8_MMA(1, 1, At, B1); PG8_BAR; PG8_SCHED;
            PG8_LDB(B0, 1, 0); PG8_LDB(B1, 1, 1); PG8_SCHED; PG8_LDA(At, 1, 0); PG8_STAGE(PG8_SA(0, 1), a2 + hstep, voffA);
            PG8_WAIT_V(8); PG8_WAIT_L(0); PG8_BAR; PG8_MMA(0, 0, At, B0); PG8_MMA(0, 1, At, B1); PG8_BAR; PG8_SCHED;
            PG8_LDA(At, 1, 1); PG8_STAGE(PG8_SB(1, 0), b3, voffB); PG8_STAGE(PG8_SB(1, 1), b3 + hstep, voffB); PG8_STAGE(PG8_SA(1, 0), a3, voffA);
            PG8_WAIT_V(8); PG8_WAIT_L(0); PG8_BAR; PG8_MMA(1, 0, At, B0); PG8_MMA(1, 1, At, B1); PG8_BAR; PG8_SCHED;
            } else {
            PG8_LDB(B0, 0, 0); PG8_SCHED; PG8_LDA(At, 0, 0); PG8_STAGE(PG8_SA(1, 1), a1 + hstep, voffA);
            PG8_WAIT_L(8); PG8_BAR; PG8_WAIT_L(0); PG8_MMA(0, 0, At, B0); PG8_BAR; PG8_SCHED;
            PG8_LDB(B1, 0, 1); PG8_STAGE(PG8_SB(0, 0), b2, voffB);
            PG8_BAR; PG8_WAIT_L(0); PG8_MMA(0, 1, At, B1); PG8_BAR;
            PG8_LDA(At, 0, 1); PG8_STAGE(PG8_SA(0, 0), a2, voffA);
            PG8_BAR; PG8_WAIT_L(0); PG8_MMA(1, 0, At, B0); PG8_BAR; PG8_SCHED;
            PG8_STAGE(PG8_SB(0, 1), b2 + hstep, voffB);
            PG8_WAIT_V(6); PG8_BAR; PG8_MMA(1, 1, At, B1); PG8_BAR;
            PG8_LDB(B0, 1, 0); PG8_SCHED; PG8_LDA(At, 1, 0); PG8_STAGE(PG8_SA(0, 1), a2 + hstep, voffA);
            PG8_WAIT_L(8); PG8_BAR; PG8_WAIT_L(0); PG8_MMA(0, 0, At, B0); PG8_BAR; PG8_SCHED;
            PG8_LDB(B1, 1, 1); PG8_STAGE(PG8_SB(1, 0), b3, voffB);
            PG8_BAR; PG8_WAIT_L(0); PG8_MMA(0, 1, At, B1); PG8_BAR;
            PG8_LDA(At, 1, 1); PG8_STAGE(PG8_SA(1, 0), a3, voffA);
            PG8_BAR; PG8_WAIT_L(0); PG8_MMA(1, 0, At, B0); PG8_BAR; PG8_SCHED;
            PG8_STAGE(PG8_SB(1, 1), b3 + hstep, voffB);
            PG8_WAIT_V(6); PG8_BAR; PG8_MMA(1, 1, At, B1); PG8_BAR;
            }
        }
        if constexpr (ALIGN_EPI) { if (wr == 0) PG8_BAR; }
        if constexpr (F8) {
            asm volatile("s_nop 15\n\ts_nop 15\n\ts_nop 7" : "+v"(acc[0][0][0][0]), "+v"(acc[0][0][0][1]), "+v"(acc[0][0][1][0]), "+v"(acc[0][0][1][1]), "+v"(acc[0][0][2][0]), "+v"(acc[0][0][2][1]), "+v"(acc[0][0][3][0]), "+v"(acc[0][0][3][1]), "+v"(acc[0][1][0][0]), "+v"(acc[0][1][0][1]), "+v"(acc[0][1][1][0]), "+v"(acc[0][1][1][1]), "+v"(acc[0][1][2][0]), "+v"(acc[0][1][2][1]), "+v"(acc[0][1][3][0]), "+v"(acc[0][1][3][1]));
            asm volatile("s_nop 0" : "+v"(acc[1][0][0][0]), "+v"(acc[1][0][0][1]), "+v"(acc[1][0][1][0]), "+v"(acc[1][0][1][1]), "+v"(acc[1][0][2][0]), "+v"(acc[1][0][2][1]), "+v"(acc[1][0][3][0]), "+v"(acc[1][0][3][1]), "+v"(acc[1][1][0][0]), "+v"(acc[1][1][0][1]), "+v"(acc[1][1][1][0]), "+v"(acc[1][1][1][1]), "+v"(acc[1][1][2][0]), "+v"(acc[1][1][2][1]), "+v"(acc[1][1][3][0]), "+v"(acc[1][1][3][1])); }
        if constexpr (!Epi::AFTER_DRAIN) { E(acc, cur, wr, wc, fr, fq); S.done(cur); }
        if (!has_next) break;
#pragma unroll
        for (int a = 0; a < 2; ++a)
#pragma unroll
            for (int b = 0; b < 2; ++b)
#pragma unroll
                for (int m = 0; m < 4; ++m)
#pragma unroll
                    for (int n = 0; n < 2; ++n) acc[a][b][m][n] = (f32x4){0.f, 0.f, 0.f, 0.f};
        cur = nxt; cA = nA; cB = nB; ++ui;
        if constexpr (ALIGN_EPI) { if (wr == 1) PG8_BAR; }
    }
    PG8_WAIT_V(0);
    if constexpr (!ALIGN_EPI) { if (wr == 0) PG8_BAR; }
    PG8_BAR;
    if constexpr (Epi::AFTER_DRAIN) { E.fused(acc, cur, wr, wc, fr, fq, lds, wid, lane); S.done(cur); }
#undef PG8_SA
#undef PG8_SB
#undef PG8_STAGE
#undef PG8_LDA
#undef PG8_LDB
#undef PG8_MMA
#undef PG8_WAIT_V
#undef PG8_WAIT_L
#undef PG8_BAR
#undef PG8_SCHED
}
}

constexpr int NWAVES = 8;
constexpr int N_LAUNCHES = MK_N_LAUNCHES;
constexpr int NPHASE = 12;
constexpr int BATCH = 4, SEQ = 4096, M = BATCH * SEQ, D = 4096, FF = 16384;
constexpr int NIN = 19520, LDU = 19712;
constexpr int GLA_H = 16, GLA_DK = 64, GLA_DV = 128;
constexpr int NSA_G = 4, NSA_R = 4, NSA_D = 128;
constexpr float NORM_EPS = 1e-6f;
constexpr int U_GQ = 0, U_GK = 1024, U_GV = 2048, U_GR = 4096, U_NQ = 6144, U_KC = 8192, U_VC = 8704, U_KSL = 9216, U_VSL = 9728, U_KW = 10240, U_VW = 10752,
              U_MG = 11264, U_MN = 15360, U_GA = 19456, U_NG = 19472;
__host__ __device__ __forceinline__ int orig_col(int n) {
    if (n < 4096) return n;
    if (n < 6144) return n - 4096 + 4112;
    if (n < 11264) return n - 6144 + 6160;
    if (n < 19456) return n - 11264 + 11328;
    if (n < 19472) return n - 19456 + 4096;
    if (n < 19520) return n - 19472 + 11280;
    return -1;
}
constexpr size_t MiB = 1u << 20;
constexpr size_t WS_CTL = 0, CTL_ZERO_BYTES = 1 * MiB;
constexpr size_t WS_W1C = 1 * MiB;
constexpr size_t WS_W2B = 3 * MiB;
constexpr size_t WS_HC = 4 * MiB;
constexpr size_t WS_OC = 8 * MiB;
constexpr size_t WS_RS = 12 * MiB;
constexpr size_t WS_RS2 = 3 * MiB + 256 * 1024;
constexpr size_t WS_U = 16 * MiB;
constexpr size_t WS_R2 = 632 * MiB;
constexpr size_t WS_WIN = WS_R2;
constexpr size_t WS_H = WS_R2 + 154 * MiB;
constexpr size_t WS_OGLA = WS_R2;
constexpr size_t WS_ONSA = WS_R2 + 64 * MiB;
constexpr size_t WS_MIX = WS_R2 + 128 * MiB;
constexpr size_t WS_ACMP = WS_R2 + 128 * MiB;
constexpr size_t WS_H2 = WS_R2;
constexpr size_t WS_WDOWN = WS_R2 + 128 * MiB;
constexpr size_t WS_WGLA = 914 * MiB, WS_WNSA = 930 * MiB, WS_WOUT = 946 * MiB, WS_WUP = 978 * MiB, WS_H8 = 1106 * MiB, WS_END = 1170 * MiB;
#ifndef GATE_FP8
#define GATE_FP8 1
#endif
constexpr int NB16 = GATE_FP8 ? 11520 : LDU;
constexpr int NG8 = 8192;
constexpr size_t WS_WG8 = WS_R2 + 90 * MiB;
constexpr int CW_TMO = 0, CW_BAR = 4096;
constexpr int RING_BYTES = 155648, LDSCTL_OFF = RING_BYTES, MISC_OFF = LDSCTL_OFF + 320, LDS_BYTES = 157696;

#define GAS __attribute__((address_space(1)))
#define LAS __attribute__((address_space(3)))
typedef unsigned short bf16;
typedef unsigned v4u __attribute__((ext_vector_type(4)));
typedef unsigned v2u __attribute__((ext_vector_type(2)));
typedef float f32x4 __attribute__((ext_vector_type(4)));
typedef GAS unsigned gu32;
#define RLX_AGENT __ATOMIC_RELAXED, __HIP_MEMORY_SCOPE_AGENT
#define LDS_WAIT() asm volatile("s_waitcnt lgkmcnt(0)" ::: "memory")
#define VM_WAIT() asm volatile("s_waitcnt vmcnt(0)" ::: "memory")
__device__ __forceinline__ unsigned f2bf(float f) { unsigned u = __builtin_bit_cast(unsigned, f); return (u + 0x7fffu + ((u >> 16) & 1u)) >> 16; }
__device__ __forceinline__ unsigned pk2(float lo, float hi) { return f2bf(lo) | (f2bf(hi) << 16); }
__device__ __forceinline__ float bfl(unsigned w) { return __uint_as_float(w << 16); }
__device__ __forceinline__ float bfh(unsigned w) { return __uint_as_float(w & 0xffff0000u); }

struct Args { const float* in[20]; float* out; unsigned char* ws; int ph_lo, ph_hi; };
typedef const __attribute__((address_space(4))) Args* KArgs;
__device__ __forceinline__ KArgs fresh_args() { KArgs p = (KArgs)__builtin_amdgcn_kernarg_segment_ptr(); asm volatile("" : "+s"(p)); return p; }
#define AIN ap->in
#define XB_TMO      128
#define XB_XCNT(j)  (256  + 64 * (j))
#define XB_XSUB(j)  (1280 + 64 * (j))
#define XB_XGEN(j)  (2304 + 64 * (j))
#define XB_TOP      3328
#define XB_TOPGEN   3392
#define XCD_BAR_WORDS 3456
#define XB_SPIN_CAP (1u << 22)
__device__ __forceinline__ unsigned xb_ld(unsigned* p)              { return __hip_atomic_load(p, __ATOMIC_RELAXED, __HIP_MEMORY_SCOPE_AGENT); }
__device__ __forceinline__ unsigned xb_add(unsigned* p, unsigned v) { return __hip_atomic_fetch_add(p, v, __ATOMIC_RELAXED, __HIP_MEMORY_SCOPE_AGENT); }
__device__ __forceinline__ unsigned xb_xcc_id() { return (unsigned)__builtin_amdgcn_s_getreg((3 << 11) | 20) & 0xFu; }
#define XB_SPIN(cond, bar) do { unsigned _sp = 0; while (cond) { __builtin_amdgcn_s_sleep(1); \
    if ((++_sp & 255u) == 0u) { if (xb_ld(&(bar)[XB_TMO])) break; if (_sp > XB_SPIN_CAP) { atomicAdd(&(bar)[XB_TMO], 1u); break; } } } } while (0)

struct XcdBarrier {
    unsigned* bar; unsigned x;
    volatile LAS unsigned* st;
};

__device__ __forceinline__ XcdBarrier xcd_barrier_post(unsigned* bar, volatile LAS unsigned* st) {
    XcdBarrier b; b.bar = bar; b.x = xb_xcc_id(); b.st = st;
    if (threadIdx.x == 0) (void)xb_add(&bar[XB_XCNT(b.x)], 1u);
    return b;
}
__device__ __forceinline__ void xcd_barrier_complete(unsigned* bar, unsigned x, unsigned& nloc, unsigned& nx) {
    const unsigned G = gridDim.x * gridDim.y * gridDim.z;
    unsigned sum, cnt, mine, sp = 0u;
    for (;;) {
        sum = 0u; cnt = 0u; mine = 0u;
#pragma unroll
        for (unsigned j = 0; j < 16; ++j) { const unsigned c = xb_ld(&bar[XB_XCNT(j)]); sum += c; cnt += (c > 0u) ? 1u : 0u; mine = (j == x) ? c : mine; }
        if (sum == G) break;
        __builtin_amdgcn_s_sleep(1);
        if ((++sp & 255u) == 0u) { if (xb_ld(&bar[XB_TMO])) break; if (sp > XB_SPIN_CAP) { atomicAdd(&bar[XB_TMO], 1u); break; } }
    }
    nloc = mine > 0u ? mine : 1u; nx = cnt > 0u ? cnt : 1u;
}

__device__ __forceinline__ void xcd_barrier(const XcdBarrier& b, const int wave) {
    int lane_; asm volatile("v_mbcnt_lo_u32_b32 %0, -1, 0\n\tv_mbcnt_hi_u32_b32 %0, -1, %0" : "=v"(lane_)); const bool is_t0 = (wave == 0) && (lane_ == 0);
    asm volatile("s_waitcnt vmcnt(0)" ::: "memory");
    __syncthreads();
    if (is_t0) {
        unsigned* bar = b.bar;
        __builtin_amdgcn_s_waitcnt(0);
        unsigned nloc = b.st[0], nx = b.st[1];
        if (nloc == 0u) { xcd_barrier_complete(bar, b.x, nloc, nx); b.st[0] = nloc; b.st[1] = nx; }
        const unsigned old = xb_add(&bar[XB_XSUB(b.x)], 1u);
        const unsigned gen = old / nloc;
        if (old + 1u == (gen + 1u) * nloc) {
            __builtin_amdgcn_fence(__ATOMIC_RELEASE, "agent");
            asm volatile("s_waitcnt vmcnt(0)" ::: "memory");
            const unsigned og = xb_add(&bar[XB_TOP], 1u);
            const unsigned tg = og / nx;
            if (og + 1u == (tg + 1u) * nx) xb_add(&bar[XB_TOPGEN], 1u);
            else XB_SPIN(xb_ld(&bar[XB_TOPGEN]) == tg, bar);
            __builtin_amdgcn_fence(__ATOMIC_ACQUIRE, "agent");
            xb_add(&bar[XB_XGEN(b.x)], 1u);
            asm volatile("s_waitcnt vmcnt(0)" ::: "memory");
        } else {
            XB_SPIN(xb_ld(&bar[XB_XGEN(b.x)]) == gen, bar);
            __builtin_amdgcn_fence(__ATOMIC_ACQUIRE, "agent");
            asm volatile("s_waitcnt vmcnt(0)" ::: "memory");
        }
    }
    __syncthreads();
}

struct Frame {
    LAS unsigned char* lds;
    volatile LAS unsigned* MISC;
    int tid, lane, wave, G, blk;
};
__device__ __forceinline__ float wave_sum(float v) {
#pragma unroll
    for (int o = 1; o < 64; o <<= 1) v += __shfl_xor(v, o);
    return v;
}
__device__ __forceinline__ float wave_max(float v) {
#pragma unroll
    for (int o = 1; o < 64; o <<= 1) v = fmaxf(v, __shfl_xor(v, o));
    return v;
}
__device__ const unsigned char REL_LUT[128] = {0,1,2,3,4,5,6,7,8,9,10,11,12,13,14,15,16,16,16,17,17,18,18,18,19,19,19,20,20,20,20,21,21,21,21,22,22,22,22,22,23,23,23,23,23,23,24,24,24,24,24,24,25,25,25,25,25,25,25,
    26,26,26,26,26,26,26,26,27,27,27,27,27,27,27,27,27,27,28,28,28,28,28,28,28,28,28,28,29,29,29,29,29,29,29,29,29,29,29,29,30,30,30,30,30,30,30,30,30,30,30,30,30,30,31,31,31,31,31,31,31,31,31,31,31,31,31,31,31};

__device__ __forceinline__ float fp8_rt(float v) { const int p = __builtin_amdgcn_cvt_pk_fp8_f32(v, v, 0, false); return __builtin_amdgcn_cvt_f32_fp8(p, 0); }
__device__ __forceinline__ unsigned pk4_fp8(float a, float b, float c, float d) { int p = __builtin_amdgcn_cvt_pk_fp8_f32(a, b, 0, false); p = __builtin_amdgcn_cvt_pk_fp8_f32(c, d, p, true); return (unsigned)p; }
__device__ __forceinline__ void transpose_item_fp8(const float* W, int K, int ldw, unsigned char* WT8, int dst_row0, int src_col, int k0, LAS float* scr, int lane, float mul) {
#pragma unroll 8
    for (int i = 0; i < 32; ++i) { const int kk = 2 * i + (lane >> 5); scr[kk * 33 + (lane & 31)] = W[(size_t)(k0 + kk) * ldw + src_col] * mul; }
    LDS_WAIT(); asm volatile("" ::: "memory");
    const int c = lane & 7;
#pragma unroll
    for (int j = 0; j < 4; ++j) { const int n = (lane >> 3) + 8 * j; const LAS float* s = scr + (8 * c) * 33 + n;
        v2u o; o.x = pk4_fp8(s[0 * 33], s[1 * 33], s[2 * 33], s[3 * 33]); o.y = pk4_fp8(s[4 * 33], s[5 * 33], s[6 * 33], s[7 * 33]);
        *(GAS v2u*)(WT8 + (size_t)(dst_row0 + n) * K + k0 + 8 * c) = o; }
    LDS_WAIT(); asm volatile("" ::: "memory");
}
__device__ __forceinline__ void transpose_item(const float* W, int K, int ldw, bf16* WT, int dst_row0, int src_col, int k0, LAS float* scr, int lane, bool q8 = false) {
#pragma unroll 8
    for (int i = 0; i < 32; ++i) { const int kk = 2 * i + (lane >> 5); float wv = src_col >= 0 ? W[(size_t)(k0 + kk) * ldw + src_col] : 0.f; if (q8) wv = fp8_rt(wv * 64.f) * (1.f / 64.f); scr[kk * 33 + (lane & 31)] = wv; }
    LDS_WAIT(); asm volatile("" ::: "memory");
    const int c = lane & 7;
#pragma unroll
    for (int j = 0; j < 4; ++j) { const int n = (lane >> 3) + 8 * j; const LAS float* s = scr + (8 * c) * 33 + n;
        v4u o; o.x = pk2(s[0 * 33], s[1 * 33]); o.y = pk2(s[2 * 33], s[3 * 33]); o.z = pk2(s[4 * 33], s[5 * 33]); o.w = pk2(s[6 * 33], s[7 * 33]);
        *(GAS v4u*)(WT + (size_t)(dst_row0 + n) * K + k0 + 8 * c) = o; }
    LDS_WAIT(); asm volatile("" ::: "memory");
}
__device__ __forceinline__ void transpose_plain(const float* W, int K, int N, bf16* WT, int row_off, int item, LAS float* scr, int lane) {
    const int nblk = N / 32, kb = item / nblk, nb = item % nblk;
    transpose_item(W, K, N, WT, row_off + 32 * nb, 32 * nb + (lane & 31), 64 * kb, scr, lane);
}
__device__ __forceinline__ void rms_row_to_bf16(const float* xrow, const float* gain, bf16* orow, int lane, bool q8 = false, unsigned char* o8row = nullptr) {
    const GAS f32x4* xr = (const GAS f32x4*)xrow + lane; const GAS f32x4* gr = (const GAS f32x4*)gain + lane;
    f32x4 v[16]; float s = 0.f;
#pragma unroll
    for (int j = 0; j < 16; ++j) { v[j] = xr[64 * j]; s += (v[j].x * v[j].x + v[j].y * v[j].y) + (v[j].z * v[j].z + v[j].w * v[j].w); }
    const float rstd = 1.f / sqrtf(wave_sum(s) * (1.f / D) + NORM_EPS);
    GAS v2u* o8 = (GAS v2u*)orow + lane;
#pragma unroll
    for (int j = 0; j < 16; ++j) { const f32x4 g = gr[64 * j]; float a0 = v[j].x * rstd * g.x, a1 = v[j].y * rstd * g.y, a2 = v[j].z * rstd * g.z, a3 = v[j].w * rstd * g.w;
        if (q8) { a0 = fp8_rt(a0); a1 = fp8_rt(a1); a2 = fp8_rt(a2); a3 = fp8_rt(a3); }
        v2u o; o.x = pk2(a0, a1); o.y = pk2(a2, a3); o8[64 * j] = o;
        if (o8row) ((GAS unsigned*)o8row)[lane + 64 * j] = pk4_fp8(a0, a1, a2, a3); }
}
__device__ __forceinline__ void rms_row_inplace(float* xrow, const float* gain, int lane) {
    GAS f32x4* xr = (GAS f32x4*)xrow + lane; const GAS f32x4* gr = (const GAS f32x4*)gain + lane;
    f32x4 v[16]; float s = 0.f;
#pragma unroll
    for (int j = 0; j < 16; ++j) { v[j] = xr[64 * j]; s += (v[j].x * v[j].x + v[j].y * v[j].y) + (v[j].z * v[j].z + v[j].w * v[j].w); }
    const float rstd = 1.f / sqrtf(wave_sum(s) * (1.f / D) + NORM_EPS);
#pragma unroll
    for (int j = 0; j < 16; ++j) { const f32x4 g = gr[64 * j]; xr[64 * j] = (f32x4){v[j].x * rstd * g.x, v[j].y * rstd * g.y, v[j].z * rstd * g.z, v[j].w * rstd * g.w}; }
}

#ifndef FP8_EMU_W
#define FP8_EMU_W false
#endif
#ifndef FP8_EMU_H
#define FP8_EMU_H false
#endif
__device__ __forceinline__ void rms_rows(Frame& F, const float* X, const float* gain, bf16* H, unsigned char* H8, float* OUT, const int gw, const int NGW) {
    f32x4 v[16];
    if (gw < M) { const GAS f32x4* xr = (const GAS f32x4*)(X + (size_t)gw * D) + F.lane;
#pragma unroll
        for (int j = 0; j < 16; ++j) v[j] = xr[64 * j]; }
    for (int m = gw; m < M; m += NGW) { f32x4 vn[16]; const bool has = m + NGW < M;
        if (has) { const GAS f32x4* xr = (const GAS f32x4*)(X + (size_t)(m + NGW) * D) + F.lane;
#pragma unroll
            for (int j = 0; j < 16; ++j) vn[j] = xr[64 * j]; }
        float ssum = 0.f;
#pragma unroll
        for (int j = 0; j < 16; ++j) ssum += (v[j].x * v[j].x + v[j].y * v[j].y) + (v[j].z * v[j].z + v[j].w * v[j].w);
        const float rstd = 1.f / sqrtf(wave_sum(ssum) * (1.f / D) + NORM_EPS);
        const GAS f32x4* gr = (const GAS f32x4*)gain + F.lane;
#pragma unroll
        for (int j = 0; j < 16; ++j) { const f32x4 g = gr[64 * j]; const float a0 = v[j].x * rstd * g.x, a1 = v[j].y * rstd * g.y, a2 = v[j].z * rstd * g.z, a3 = v[j].w * rstd * g.w;
            if (OUT) ((GAS f32x4*)(OUT + (size_t)m * D) + F.lane)[64 * j] = (f32x4){a0, a1, a2, a3};
            if (H) { v2u o; o.x = pk2(a0, a1); o.y = pk2(a2, a3); ((GAS v2u*)(H + (size_t)m * D) + F.lane)[64 * j] = o; }
            if (H8) ((GAS unsigned*)(H8 + (size_t)m * D))[F.lane + 64 * j] = pk4_fp8(a0, a1, a2, a3); }
        if (has) {
#pragma unroll
            for (int j = 0; j < 16; ++j) v[j] = vn[j]; } }
}
struct TD { const float* W; unsigned char* WT; int K, ldw, drow, k0, scol, f8; };
template <class Dec> __device__ __forceinline__ void transpose_stream(Frame& F, const Dec& decode, const int NITEMS, LAS float* scr, const int gw, const int NGW) {
    float tv[32];
    if (gw < NITEMS) { const TD d = decode(gw);
#pragma unroll
        for (int i = 0; i < 32; ++i) tv[i] = d.scol >= 0 ? d.W[(size_t)(d.k0 + 2 * i + (F.lane >> 5)) * d.ldw + d.scol] : 0.f; }
    for (int it = gw; it < NITEMS; it += NGW) {
        const TD d = decode(it); const bool has = it + NGW < NITEMS; float tn[32];
        if (has) { const TD e = decode(it + NGW);
#pragma unroll
            for (int i = 0; i < 32; ++i) tn[i] = e.scol >= 0 ? e.W[(size_t)(e.k0 + 2 * i + (F.lane >> 5)) * e.ldw + e.scol] : 0.f; }
        const float mul = d.f8 ? 64.f : 1.f;
#pragma unroll
        for (int i = 0; i < 32; ++i) scr[(2 * i + (F.lane >> 5)) * 33 + (F.lane & 31)] = tv[i] * mul;
        LDS_WAIT(); asm volatile("" ::: "memory");
        const int c = F.lane & 7;
#pragma unroll
        for (int j = 0; j < 4; ++j) { const int n = (F.lane >> 3) + 8 * j; const LAS float* sp = scr + (8 * c) * 33 + n;
            if (d.f8) { v2u o; o.x = pk4_fp8(sp[0 * 33], sp[1 * 33], sp[2 * 33], sp[3 * 33]); o.y = pk4_fp8(sp[4 * 33], sp[5 * 33], sp[6 * 33], sp[7 * 33]); *(GAS v2u*)(d.WT + (size_t)(d.drow + n) * d.K + d.k0 + 8 * c) = o; }
            else { v4u o; o.x = pk2(sp[0 * 33], sp[1 * 33]); o.y = pk2(sp[2 * 33], sp[3 * 33]); o.z = pk2(sp[4 * 33], sp[5 * 33]); o.w = pk2(sp[6 * 33], sp[7 * 33]); *(GAS v4u*)((bf16*)d.WT + (size_t)(d.drow + n) * d.K + d.k0 + 8 * c) = o; } }
        LDS_WAIT(); asm volatile("" ::: "memory");
        if (has) {
#pragma unroll
            for (int i = 0; i < 32; ++i) tv[i] = tn[i]; }
    }
}
__device__ __forceinline__ void p0_prologue(Frame& F, KArgs ap) {
    unsigned char* ws_ = ap->ws;
    LAS float* scr = (LAS float*)(F.lds + F.wave * 16384);
    const int gw = F.blk * NWAVES + F.wave, NGW = F.G * NWAVES;
    bf16* WinT = (bf16*)(ws_ + WS_WIN); bf16* WglaT = (bf16*)(ws_ + WS_WGLA); bf16* WnsaT = (bf16*)(ws_ + WS_WNSA); bf16* WoutT = (bf16*)(ws_ + WS_WOUT); bf16* WupT = (bf16*)(ws_ + WS_WUP);
    bf16* W1cT = (bf16*)(ws_ + WS_W1C); bf16* W2bT = (bf16*)(ws_ + WS_W2B);
    constexpr int I_IN = (D / 64) * (NB16 / 32), I_G8 = GATE_FP8 ? (D / 64) * (NG8 / 32) : 0, I_GLA = (2048 / 64) * (D / 32), I_NSA = I_GLA, I_OUT = (D / 64) * (D / 32), I_UP = (D / 64) * (FF / 32), I_PHI = (4096 / 64) * (128 / 32);
    constexpr int NITEMS = I_IN + I_G8 + I_GLA + I_NSA + I_OUT + I_UP + 2 * I_PHI;
    auto decode = [&](int it) -> TD { TD d; int r = it; d.f8 = 0;
        if (r < I_IN) { const int nblk = NB16 / 32, kb = r / nblk, nb = r % nblk; const int ucol = (!GATE_FP8 || 32 * nb < 11264) ? 32 * nb : 32 * nb - 11264 + 19456;
            d.W = AIN[2]; d.WT = (unsigned char*)WinT; d.K = D; d.ldw = NIN; d.drow = 32 * nb; d.k0 = 64 * kb; d.scol = orig_col(ucol + (F.lane & 31)); return d; } r -= I_IN;
        if (r < I_G8) { const int nblk = NG8 / 32, kb = r / nblk, nb = r % nblk;
            d.W = AIN[2]; d.WT = ws_ + WS_WG8; d.K = D; d.ldw = NIN; d.drow = 32 * nb; d.k0 = 64 * kb; d.scol = orig_col(11264 + 32 * nb + (F.lane & 31)); d.f8 = 1; return d; } r -= I_G8;
        const float* W; bf16* WT; int K, N, roff = 0;
        if (r < I_GLA) { W = AIN[13]; WT = WglaT; K = 2048; N = D; } else if ((r -= I_GLA) < I_NSA) { W = AIN[14]; WT = WnsaT; K = 2048; N = D; } else if ((r -= I_NSA) < I_OUT) { W = AIN[15]; WT = WoutT; K = D; N = D; }
        else if ((r -= I_OUT) < I_UP) { W = AIN[17]; WT = WupT; K = D; N = FF; } else if ((r -= I_UP) < I_PHI) { W = AIN[8]; WT = W1cT; K = 4096; N = 128; } else { r -= I_PHI; W = AIN[10]; WT = W1cT; K = 4096; N = 128; roff = 128; }
        const int nblk = N / 32, kb = r / nblk, nb = r % nblk;
        d.W = W; d.WT = (unsigned char*)WT; d.K = K; d.ldw = N; d.drow = roff + 32 * nb; d.k0 = 64 * kb; d.scol = 32 * nb + (F.lane & 31); return d; };
    transpose_stream(F, decode, NITEMS, scr, gw, NGW);
    for (int i = gw * 64 + F.lane; i < 256 * 256; i += NGW * 64) { const int n = i >> 8, k = i & 255; float v = 0.f;
        if (n < 128 && k < 128) v = AIN[9][k * 128 + n]; else if (n >= 128 && k >= 128) v = AIN[11][(k - 128) * 128 + (n - 128)];
        W2bT[i] = (bf16)f2bf(v); }
    bf16* H = (bf16*)(ws_ + WS_H);
    rms_rows(F, AIN[0], AIN[1], H, GATE_FP8 ? ws_ + WS_H8 : nullptr, nullptr, gw, NGW);
}
__device__ __forceinline__ void p2_im2col(Frame& F, KArgs ap, int row_lo = 0, int row_hi = 8192, int gw_in = -1, int ngw_in = 0) {
    unsigned char* ws_ = ap->ws;
    const int gw = gw_in >= 0 ? gw_in : F.blk * NWAVES + F.wave, NGW = gw_in >= 0 ? ngw_in : F.G * NWAVES;
    const bf16* U = (const bf16*)(ws_ + WS_U); bf16* A = (bf16*)(ws_ + WS_ACMP);
    const int tq = F.lane >> 4, dc = (F.lane & 15) * 8;
    for (int row = row_lo + gw; row < row_hi; row += NGW) {
        const int kv = row >> 12, bg = (row >> 8) & 15, c = row & 255, b = bg >> 2, g = bg & 3;
        const float* pos = AIN[6 + kv]; const int ucol = (kv ? U_VC : U_KC) + g * 128 + dc;
#pragma unroll
        for (int i = 0; i < 8; ++i) { const int t = 4 * i + tq; v4u o = (v4u){0u, 0u, 0u, 0u};
            if (c < 255) { const v4u w = *(const GAS v4u*)(U + (size_t)(b * SEQ + 16 * c + t) * LDU + ucol);
                const f32x4 p0 = *(const GAS f32x4*)(pos + t * 128 + dc), p1 = *(const GAS f32x4*)(pos + t * 128 + dc + 4);
                o.x = pk2(bfl(w.x) + p0.x, bfh(w.x) + p0.y); o.y = pk2(bfl(w.y) + p0.z, bfh(w.y) + p0.w); o.z = pk2(bfl(w.z) + p1.x, bfh(w.z) + p1.y); o.w = pk2(bfl(w.w) + p1.z, bfh(w.w) + p1.w); }
            *(GAS v4u*)(A + (size_t)row * 4096 + t * 128 + dc) = o; }
    }
}
__device__ __forceinline__ void gla_chain(Frame& F, KArgs ap, int bh) {
    unsigned char* ws_ = ap->ws;
    const int b = bh >> 4, h = bh & 15, tid = F.tid, lane = F.lane, wave = F.wave;
    LAS float* A = (LAS float*)F.lds; LAS float* Kf = A + 4096; LAS float* Qf = Kf + 4096; LAS float* V = Qf + 4096; LAS float* O = V + 8192; LAS float* W2 = O + 8192; LAS float* Bal = W2 + 1024;
    const bf16* U = (const bf16*)(ws_ + WS_U); bf16* OG = (bf16*)(ws_ + WS_OGLA);
    for (int i = tid; i < 1024; i += 512) W2[i] = AIN[3][(i >> 6) * 1024 + h * 64 + (i & 63)];
    if (tid < 64) Bal[tid] = AIN[4][h * 64 + tid];
    const int grp = tid & 3, e = tid >> 2;
    float st[16];
#pragma unroll
    for (int j = 0; j < 16; ++j) st[j] = 0.f;
    const float g0 = AIN[5][h * 128 + 2 * lane], g1 = AIN[5][h * 128 + 2 * lane + 1];
    __syncthreads();
    for (int n = 0; n < 64; ++n) {
        const size_t tok0 = (size_t)b * SEQ + n * 64;
        { const int t = tid >> 3, dd = (tid & 7) * 8; const bf16* ur = U + (tok0 + t) * LDU;
          const v4u a0 = *(const GAS v4u*)(ur + U_GA), a1 = *(const GAS v4u*)(ur + U_GA + 8);
          float alr[16]; alr[0] = bfl(a0.x); alr[1] = bfh(a0.x); alr[2] = bfl(a0.y); alr[3] = bfh(a0.y); alr[4] = bfl(a0.z); alr[5] = bfh(a0.z); alr[6] = bfl(a0.w); alr[7] = bfh(a0.w);
          alr[8] = bfl(a1.x); alr[9] = bfh(a1.x); alr[10] = bfl(a1.y); alr[11] = bfh(a1.y); alr[12] = bfl(a1.z); alr[13] = bfh(a1.z); alr[14] = bfl(a1.w); alr[15] = bfh(a1.w);
#pragma unroll
          for (int j = 0; j < 8; ++j) { const int d = dd + j; float pre = Bal[d];
#pragma unroll
              for (int i = 0; i < 16; ++i) pre += alr[i] * W2[i * 64 + d];
              const float ls = fminf(pre, 0.f) - log1pf(expf(-fabsf(pre)));
              A[t * 64 + d] = expf(ls * (1.f / 16.f)); }
          const v4u qw = *(const GAS v4u*)(ur + U_GQ + h * 64 + dd), kw = *(const GAS v4u*)(ur + U_GK + h * 64 + dd);
          LAS float* qd = Qf + t * 64 + dd; LAS float* kd = Kf + t * 64 + dd;
          qd[0] = bfl(qw.x) * 0.125f; qd[1] = bfh(qw.x) * 0.125f; qd[2] = bfl(qw.y) * 0.125f; qd[3] = bfh(qw.y) * 0.125f; qd[4] = bfl(qw.z) * 0.125f; qd[5] = bfh(qw.z) * 0.125f; qd[6] = bfl(qw.w) * 0.125f; qd[7] = bfh(qw.w) * 0.125f;
          kd[0] = bfl(kw.x); kd[1] = bfh(kw.x); kd[2] = bfl(kw.y); kd[3] = bfh(kw.y); kd[4] = bfl(kw.z); kd[5] = bfh(kw.z); kd[6] = bfl(kw.w); kd[7] = bfh(kw.w);
          const int e0 = (tid & 7) * 16; const v4u v0 = *(const GAS v4u*)(ur + U_GV + h * 128 + e0), v1 = *(const GAS v4u*)(ur + U_GV + h * 128 + e0 + 8);
          LAS float* vd = V + t * 128 + e0;
          vd[0] = bfl(v0.x); vd[1] = bfh(v0.x); vd[2] = bfl(v0.y); vd[3] = bfh(v0.y); vd[4] = bfl(v0.z); vd[5] = bfh(v0.z); vd[6] = bfl(v0.w); vd[7] = bfh(v0.w);
          vd[8] = bfl(v1.x); vd[9] = bfh(v1.x); vd[10] = bfl(v1.y); vd[11] = bfh(v1.y); vd[12] = bfl(v1.z); vd[13] = bfh(v1.z); vd[14] = bfl(v1.w); vd[15] = bfh(v1.w); }
        __syncthreads();
        for (int t = 0; t < 64; ++t) {
            const LAS f32x4* ap = (const LAS f32x4*)(A + t * 64 + grp * 16); const LAS f32x4* kp = (const LAS f32x4*)(Kf + t * 64 + grp * 16); const LAS f32x4* qp = (const LAS f32x4*)(Qf + t * 64 + grp * 16);
            const float v = V[t * 128 + e]; float o = 0.f;
#pragma unroll
            for (int j4 = 0; j4 < 4; ++j4) { const f32x4 a = ap[j4], k = kp[j4], q = qp[j4];
                st[4 * j4 + 0] = a.x * st[4 * j4 + 0] + k.x * v; st[4 * j4 + 1] = a.y * st[4 * j4 + 1] + k.y * v; st[4 * j4 + 2] = a.z * st[4 * j4 + 2] + k.z * v; st[4 * j4 + 3] = a.w * st[4 * j4 + 3] + k.w * v;
                o += q.x * st[4 * j4 + 0] + q.y * st[4 * j4 + 1] + q.z * st[4 * j4 + 2] + q.w * st[4 * j4 + 3]; }
            o += __shfl_xor(o, 1); o += __shfl_xor(o, 2);
            if (grp == 0) O[t * 128 + e] = o;
        }
        __syncthreads();
#pragma unroll 2
        for (int i = 0; i < 8; ++i) { const int t = wave * 8 + i; const float o0 = O[t * 128 + 2 * lane], o1 = O[t * 128 + 2 * lane + 1];
            const float rstd = 1.f / sqrtf(wave_sum(o0 * o0 + o1 * o1) * (1.f / 128.f) + NORM_EPS);
            const unsigned rw = *(const GAS unsigned*)(U + (tok0 + t) * LDU + U_GR + h * 128 + 2 * lane);
            *(GAS unsigned*)(OG + (tok0 + t) * 2048 + h * 128 + 2 * lane) = pk2(o0 * rstd * g0 * bfl(rw), o1 * rstd * g1 * bfh(rw)); }
    }
    __syncthreads();
}

__device__ __forceinline__ void qk4(const bf16* krow, const LAS float* qs, float (&sc)[4]) {
#pragma unroll
    for (int r = 0; r < 4; ++r) sc[r] = 0.f;
#pragma unroll 4
    for (int d8 = 0; d8 < 16; ++d8) { const v4u w = *(const GAS v4u*)(krow + 8 * d8);
        const float k0 = bfl(w.x), k1 = bfh(w.x), k2 = bfl(w.y), k3 = bfh(w.y), k4 = bfl(w.z), k5 = bfh(w.z), k6 = bfl(w.w), k7 = bfh(w.w);
#pragma unroll
        for (int r = 0; r < 4; ++r) { const f32x4 qa = *(const LAS f32x4*)(qs + r * 128 + 8 * d8), qb = *(const LAS f32x4*)(qs + r * 128 + 8 * d8 + 4);
            sc[r] += (k0 * qa.x + k1 * qa.y) + (k2 * qa.z + k3 * qa.w) + (k4 * qb.x + k5 * qb.y) + (k6 * qb.z + k7 * qb.w); } }
}
__device__ __forceinline__ void pv4(const bf16* vbase, size_t vstride, const LAS float* pT, int nk, int lane, float (&o)[4][2]) {
#pragma unroll 4
    for (int key = 0; key < nk; ++key) { const unsigned w = *(const GAS unsigned*)(vbase + (size_t)key * vstride + 2 * lane); const float v0 = bfl(w), v1 = bfh(w);
        const f32x4 p = *(const LAS f32x4*)(pT + 4 * key);
        o[0][0] += p.x * v0; o[0][1] += p.x * v1; o[1][0] += p.y * v0; o[1][1] += p.y * v1; o[2][0] += p.z * v0; o[2][1] += p.z * v1; o[3][0] += p.w * v0; o[3][1] += p.w * v1; }
}
__device__ __forceinline__ void attend64(const bf16* Ub, int kb, bool valid, int dist, int koff, int voff, const LAS float* qs, LAS float* pT, const LAS float* bias, float (&m)[4], float (&l)[4], float (&o)[4][2], int lane) {
    float sc[4]; qk4(Ub + (size_t)(kb + lane) * LDU + koff, qs, sc);
    const int dd = dist < 0 ? 0 : (dist > 127 ? 127 : dist); const int bk = REL_LUT[dd];
    const f32x4 bv = *(const LAS f32x4*)(bias + 4 * bk);
    float p[4];
#pragma unroll
    for (int r = 0; r < 4; ++r) { const float x = sc[r] + bv[r]; const float bm = wave_max(valid ? x : -1e30f); const float mn = fmaxf(m[r], bm); const float al = __expf(m[r] - mn);
        p[r] = valid ? __expf(x - mn) : 0.f; l[r] = l[r] * al + wave_sum(p[r]); o[r][0] *= al; o[r][1] *= al; m[r] = mn; }
    asm volatile("" ::: "memory");
    *(LAS f32x4*)(pT + 4 * lane) = (f32x4){p[0], p[1], p[2], p[3]};
    LDS_WAIT(); __builtin_amdgcn_wave_barrier(); asm volatile("" ::: "memory");
    pv4(Ub + (size_t)kb * LDU + voff, LDU, pT, 64, lane, o);
    asm volatile("" ::: "memory");
}
__device__ __forceinline__ void nsa_item(Frame& F, KArgs ap, int item, LAS float* wl) {
    unsigned char* ws_ = ap->ws;
    const int lane = F.lane; const int s = item & (SEQ - 1), g = (item >> 12) & 3, b = item >> 14;
    LAS float* qs = wl; LAS float* pT = wl + 512; LAS float* bias = wl + 512 + 1024;
    const bf16* U = (const bf16*)(ws_ + WS_U); const bf16* Ub = U + (size_t)b * SEQ * LDU; const bf16* OC = (const bf16*)(ws_ + WS_OC);
    const size_t tok = (size_t)b * SEQ + s; const float scale = 0.08838834764831845f;
    asm volatile("" ::: "memory");
#pragma unroll
    for (int r = 0; r < 4; ++r) { const unsigned w = *(const GAS unsigned*)(U + tok * LDU + U_NQ + (g * 4 + r) * 128 + 2 * lane); qs[r * 128 + 2 * lane] = bfl(w) * scale; qs[r * 128 + 2 * lane + 1] = bfh(w) * scale; }
    for (int i = lane; i < 128; i += 64) bias[i] = AIN[12][(i >> 2) * 16 + g * 4 + (i & 3)];
    LDS_WAIT(); __builtin_amdgcn_wave_barrier(); asm volatile("" ::: "memory");
    float sc[4][4];
    const bf16* kc = OC + (size_t)((b * 4 + g) * 256) * 256; const bf16* vc = OC + (size_t)(4096 + (b * 4 + g) * 256) * 256 + 128;
    float mx[4] = {-1e30f, -1e30f, -1e30f, -1e30f};
#pragma unroll
    for (int i = 0; i < 4; ++i) { const int c = 64 * i + lane; qk4(kc + (size_t)c * 256, qs, sc[i]); const int dist = s - (16 * c + 31); const bool valid = (c < 255) && dist >= 0;
        const int dd = dist < 0 ? 0 : (dist > 127 ? 127 : dist); const f32x4 bv = *(const LAS f32x4*)(bias + 4 * REL_LUT[dd]);
#pragma unroll
        for (int r = 0; r < 4; ++r) { sc[i][r] = valid ? sc[i][r] + bv[r] : -1e30f; mx[r] = fmaxf(mx[r], sc[i][r]); } }
    float inv[4];
#pragma unroll
    for (int r = 0; r < 4; ++r) { mx[r] = wave_max(mx[r]); float sum = 0.f;
#pragma unroll
        for (int i = 0; i < 4; ++i) { sc[i][r] = sc[i][r] > -1e29f ? __expf(sc[i][r] - mx[r]) : 0.f; sum += sc[i][r]; }
        sum = wave_sum(sum); inv[r] = sum > 0.f ? 1.f / sum : 0.f; }
#pragma unroll
    for (int i = 0; i < 4; ++i) *(LAS f32x4*)(pT + 4 * (64 * i + lane)) = (f32x4){sc[i][0] * inv[0], sc[i][1] * inv[1], sc[i][2] * inv[2], sc[i][3] * inv[3]};
    LDS_WAIT(); __builtin_amdgcn_wave_barrier(); asm volatile("" ::: "memory");
    float ocmp[4][2];
#pragma unroll
    for (int r = 0; r < 4; ++r) { ocmp[r][0] = 0.f; ocmp[r][1] = 0.f; }
    const int nvalid = s >= 31 ? ((s - 31) >> 4) + 1 : 0;
    pv4(vc, 256, pT, nvalid, lane, ocmp);
    float imp = 0.f;
#pragma unroll
    for (int dc = -1; dc <= 3; ++dc) { const int c = 4 * lane + dc; if (c >= 0 && c < 255) { const f32x4 p = *(const LAS f32x4*)(pT + 4 * c); const float w = (dc == -1 || dc == 3) ? 1.f : 2.f; imp += w * ((p.x + p.y) + (p.z + p.w)); } }
    const int cur = s >> 6; const bool forced = (lane == 0) || (lane <= cur && lane > cur - 2); const bool reach = lane <= cur;
    const float score = forced ? 1e4f : (reach ? imp : -1e4f);
    int rank = 0;
#pragma unroll
    for (int jp = 0; jp < 64; ++jp) { const float sj = __int_as_float(__builtin_amdgcn_readlane(__float_as_int(score), jp)); rank += (sj > score || (sj == score && jp < lane)) ? 1 : 0; }
    unsigned long long mask = __ballot(rank < 16 && reach);
    asm volatile("" ::: "memory");
    float ms[4], ls[4], osel[4][2];
#pragma unroll
    for (int r = 0; r < 4; ++r) { ms[r] = -1e30f; ls[r] = 0.f; osel[r][0] = 0.f; osel[r][1] = 0.f; }
    while (mask) { const int j = __builtin_ctzll(mask); mask &= mask - 1; const int kpos = 64 * j + lane;
        attend64(Ub, 64 * j, kpos <= s, s - kpos, U_KSL + g * 128, U_VSL + g * 128, qs, pT, bias, ms, ls, osel, lane); }
    float mw[4], lw[4], owin[4][2];
#pragma unroll
    for (int r = 0; r < 4; ++r) { mw[r] = -1e30f; lw[r] = 0.f; owin[r][0] = 0.f; owin[r][1] = 0.f; }
    const int lo = s - 511 > 0 ? s - 511 : 0;
    for (int kb = lo & ~63; kb <= s; kb += 64) { const int kpos = kb + lane;
        attend64(Ub, kb, kpos >= lo && kpos <= s, s - kpos, U_KW + g * 128, U_VW + g * 128, qs, pT, bias, mw, lw, owin, lane); }
    bf16* ON = (bf16*)(ws_ + WS_ONSA);
#pragma unroll
    for (int r = 0; r < 4; ++r) { const bf16* gp = U + tok * LDU + U_NG + (g * 4 + r) * 3;
        const float g0 = __uint_as_float((unsigned)gp[0] << 16), g1 = __uint_as_float((unsigned)gp[1] << 16), g2 = __uint_as_float((unsigned)gp[2] << 16);
        const float is = g1 / ls[r], iw = g2 / lw[r];
        *(GAS unsigned*)(ON + tok * 2048 + (g * 4 + r) * 128 + 2 * lane) = pk2(g0 * ocmp[r][0] + is * osel[r][0] + iw * owin[r][0], g0 * ocmp[r][1] + is * osel[r][1] + iw * owin[r][1]); }
    asm volatile("" ::: "memory");
}
#ifndef NSA_SB2
#define NSA_SB2()
#endif
#ifndef NSA_SB
#define NSA_SB() __builtin_amdgcn_sched_barrier(0)
#endif
typedef short bf16x8_t __attribute__((ext_vector_type(8)));
typedef short s16x4_t __attribute__((ext_vector_type(4)));
constexpr int NT_ROWB = 288;
constexpr int NT_TILEB = 64 * NT_ROWB;
constexpr int NL_K = 0, NL_V = 2 * NT_TILEB, NL_Q = 4 * NT_TILEB, NL_BIAS = NL_Q + 256 * NT_ROWB, NL_SELM = NL_BIAS + 2048, NL_WUN = NL_SELM + 512, NL_END = NL_WUN + 64, NL_IMP = NL_K;
static_assert(NL_END <= RING_BYTES, "NSA LDS map");
__device__ __forceinline__ s16x4_t tr_rd(LAS const unsigned char* p) { return __builtin_bit_cast(s16x4_t, __builtin_amdgcn_ds_read_tr16_b64_v4i16((LAS s16x4_t*)p)); }
__device__ __forceinline__ unsigned cvtpk(float lo, float hi) { unsigned r; asm volatile("v_cvt_pk_bf16_f32 %0, %1, %2" : "=v"(r) : "v"(lo), "v"(hi)); return r; }

struct NsaTileSrc { const unsigned char* k; const unsigned char* v; unsigned stride; };
struct NsaRegs { v4u k0, k1, v0, v1; };
__device__ __forceinline__ void nsa_ld(const NsaTileSrc& s, int tid_in, NsaRegs& r) {
    int tid = tid_in; asm volatile("" : "+v"(tid));
    const int row = tid >> 4, c16 = (tid & 15) * 16;
    r.k0 = *(const GAS v4u*)(s.k + (size_t)row * s.stride + c16); r.k1 = *(const GAS v4u*)(s.k + (size_t)(row + 32) * s.stride + c16);
    r.v0 = *(const GAS v4u*)(s.v + (size_t)row * s.stride + c16); r.v1 = *(const GAS v4u*)(s.v + (size_t)(row + 32) * s.stride + c16);
}
__device__ __forceinline__ void nsa_st(LAS unsigned char* lds, int buf, int tid_in, const NsaRegs& r) {
    int tid = tid_in; asm volatile("" : "+v"(tid));
    const int row = tid >> 4, c16 = (tid & 15) * 16; LAS unsigned char* kb = lds + NL_K + buf * NT_TILEB + row * NT_ROWB + c16; LAS unsigned char* vb = lds + NL_V + buf * NT_TILEB + row * NT_ROWB + c16;
    *(LAS v4u*)kb = r.k0; *(LAS v4u*)(kb + 32 * NT_ROWB) = r.k1; *(LAS v4u*)vb = r.v0; *(LAS v4u*)(vb + 32 * NT_ROWB) = r.v1;
}
struct NsaAcc { f32x4 o[8][2]; float m[2], l[2]; };
template <int BR>
__device__ __forceinline__ void nsa_tile(LAS const unsigned char* lds, int buf, int wave, NsaAcc& A, f32x4 (&imp)[4][2], int pos0, const int (&qpos)[2], const bool (&selbit)[2], bool far, bool FAST, int rhead, int lane_in, bool pre, const NsaTileSrc& nsrc, int tid, NsaRegs& R) {
    int lane = lane_in; asm volatile("" : "+v"(lane));
    const int n = lane & 15, g = lane >> 4;
    if (BR != 0 && pre) nsa_ld(nsrc, tid, R);
    LAS const unsigned char* kb = lds + NL_K + buf * NT_TILEB + n * NT_ROWB + g * 16;
    LAS const unsigned char* qb = lds + NL_Q + (32 * wave + n) * NT_ROWB + g * 16;
    const bool act0 = (BR != 1) || (__builtin_amdgcn_ballot_w64(selbit[0]) != 0ull), act1 = (BR != 1) || (__builtin_amdgcn_ballot_w64(selbit[1]) != 0ull);
    f32x4 s[4][2];
#pragma unroll
    for (int kt = 0; kt < 4; ++kt) { s[kt][0] = (f32x4){0.f, 0.f, 0.f, 0.f}; s[kt][1] = (f32x4){0.f, 0.f, 0.f, 0.f}; }
#pragma unroll
    for (int ks = 0; ks < 4; ++ks) { bf16x8_t kf[4];
        const bf16x8_t q0 = *(LAS const bf16x8_t*)(qb + ks * 64), q1 = *(LAS const bf16x8_t*)(qb + 16 * NT_ROWB + ks * 64);
#pragma unroll
        for (int kt = 0; kt < 4; ++kt) kf[kt] = *(LAS const bf16x8_t*)(kb + kt * 16 * NT_ROWB + ks * 64);
#pragma unroll
        for (int kt = 0; kt < 4; ++kt) {
            if (act0) s[kt][0] = __builtin_amdgcn_mfma_f32_16x16x32_bf16(kf[kt], q0, s[kt][0], 0, 0, 0);
            if (act1) s[kt][1] = __builtin_amdgcn_mfma_f32_16x16x32_bf16(kf[kt], q1, s[kt][1], 0, 0, 0); }
        NSA_SB(); }
    const float C1 = 0.08838834764831845f * 1.4426950408889634f;
    LAS const float* bl = (LAS const float*)(lds + NL_BIAS) + rhead * 128;
    const float bfar = bl[127];
    bf16x8_t pf[2][2];
#pragma unroll
    for (int t = 0; t < 2; ++t) {
        NSA_SB2();
        if (!(t == 0 ? act0 : act1)) { pf[0][t] = (bf16x8_t){0, 0, 0, 0, 0, 0, 0, 0}; pf[1][t] = pf[0][t]; continue; }
        float x[4][4]; bool vld[4][4]; float mx = -1e30f; float ps = 0.f; float p[4][4]; float mn, al;
        if (FAST) {
            const bool rv = (BR == 1) ? selbit[t] : true;
            float m0 = fmaxf(fmaxf(s[0][t][0], s[0][t][1]), fmaxf(s[0][t][2], s[0][t][3]));
#pragma unroll
            for (int kt = 1; kt < 4; ++kt) m0 = fmaxf(m0, fmaxf(fmaxf(s[kt][t][0], s[kt][t][1]), fmaxf(s[kt][t][2], s[kt][t][3])));
            mx = rv ? m0 * C1 + bfar : -1e30f;
            mx = fmaxf(mx, __shfl_xor(mx, 16)); mx = fmaxf(mx, __shfl_xor(mx, 32));
            mn = fmaxf(A.m[t], mx); al = __builtin_amdgcn_exp2f(A.m[t] - mn); A.m[t] = mn;
            const float sh = bfar - mn;
#pragma unroll
            for (int kt = 0; kt < 4; ++kt)
#pragma unroll
                for (int i = 0; i < 4; ++i) { const float e = __builtin_amdgcn_exp2f(s[kt][t][i] * C1 + sh); p[kt][i] = rv ? e : 0.f; ps += p[kt][i]; }
        } else {
#pragma unroll
        for (int kt = 0; kt < 4; ++kt)
#pragma unroll
            for (int i = 0; i < 4; ++i) { const int kk = 16 * kt + 4 * g + i; int dist; bool v;
                if (BR == 0) { const int c = pos0 + kk; dist = qpos[t] - (16 * c + 31); v = dist >= 0 && c < 255; }
                else if (BR == 1) { dist = qpos[t] - (pos0 + kk); v = dist >= 0 && selbit[t]; }
                else { dist = qpos[t] - (pos0 + kk); v = dist >= 0 && dist < 512; }
                float b2 = bfar; if (!far) { const int dd = dist < 0 ? 0 : (dist > 127 ? 127 : dist); b2 = bl[dd]; }
                x[kt][i] = s[kt][t][i] * C1 + b2; vld[kt][i] = v; mx = fmaxf(mx, v ? x[kt][i] : -1e30f); }
        mx = fmaxf(mx, __shfl_xor(mx, 16)); mx = fmaxf(mx, __shfl_xor(mx, 32));
        mn = fmaxf(A.m[t], mx); al = __builtin_amdgcn_exp2f(A.m[t] - mn); A.m[t] = mn;
#pragma unroll
        for (int kt = 0; kt < 4; ++kt)
#pragma unroll
            for (int i = 0; i < 4; ++i) { p[kt][i] = vld[kt][i] ? __builtin_amdgcn_exp2f(x[kt][i] - mn) : 0.f; ps += p[kt][i]; }
        }
        A.l[t] = A.l[t] * al + ps;
        if (__builtin_amdgcn_ballot_w64(al != 1.0f) != 0ull) {
#pragma unroll
            for (int dt = 0; dt < 8; ++dt) A.o[dt][t] *= al;
            if (BR == 0) {
#pragma unroll
                for (int jt = 0; jt < 4; ++jt) imp[jt][t] *= al; } }
#pragma unroll
        for (int k2 = 0; k2 < 2; ++k2) { v4u w; w.x = cvtpk(p[2 * k2][0], p[2 * k2][1]); w.y = cvtpk(p[2 * k2][2], p[2 * k2][3]); w.z = cvtpk(p[2 * k2 + 1][0], p[2 * k2 + 1][1]); w.w = cvtpk(p[2 * k2 + 1][2], p[2 * k2 + 1][3]);
            pf[k2][t] = __builtin_bit_cast(bf16x8_t, w); }
    }
    NSA_SB2();
    if (BR == 0 && pre) nsa_ld(nsrc, tid, R);
    NSA_SB2();
    LAS const unsigned char* vb = lds + NL_V + buf * NT_TILEB + (4 * g + (n >> 2)) * NT_ROWB + (n & 3) * 8;
#pragma unroll
    for (int k2 = 0; k2 < 2; ++k2)
#pragma unroll
        for (int d4 = 0; d4 < 2; ++d4) { bf16x8_t vf[4];
#pragma unroll
            for (int q = 0; q < 4; ++q) { const int dt = 4 * d4 + q; const s16x4_t lo = tr_rd(vb + (32 * k2) * NT_ROWB + dt * 32), hi = tr_rd(vb + (32 * k2 + 16) * NT_ROWB + dt * 32);
                vf[q] = __builtin_shufflevector(lo, hi, 0, 1, 2, 3, 4, 5, 6, 7); }
#pragma unroll
            for (int q = 0; q < 4; ++q) { const int dt = 4 * d4 + q;
                if (act0) A.o[dt][0] = __builtin_amdgcn_mfma_f32_16x16x32_bf16(vf[q], pf[k2][0], A.o[dt][0], 0, 0, 0);
                if (act1) A.o[dt][1] = __builtin_amdgcn_mfma_f32_16x16x32_bf16(vf[q], pf[k2][1], A.o[dt][1], 0, 0, 0); }
            NSA_SB(); }
    if (BR == 0) {
#pragma unroll
        for (int jt = 0; jt < 4; ++jt) { if (16 * jt > (pos0 >> 2) + 16 || 16 * jt + 15 < (pos0 >> 2)) continue;
            const int jb = 16 * jt + n;
#pragma unroll
            for (int k2 = 0; k2 < 2; ++k2) { unsigned short e[8];
#pragma unroll
                for (int q = 0; q < 8; ++q) { const int c = pos0 + 32 * k2 + (q < 4 ? 4 * g + q : 16 + 4 * g + (q - 4)); const int dz = c - 4 * jb;
                    e[q] = (c < 255) ? ((dz == -1 || dz == 3) ? 0x3F80 : ((dz >= 0 && dz <= 2) ? 0x4000 : 0)) : 0; }
                v4u w; w.x = e[0] | ((unsigned)e[1] << 16); w.y = e[2] | ((unsigned)e[3] << 16); w.z = e[4] | ((unsigned)e[5] << 16); w.w = e[6] | ((unsigned)e[7] << 16);
                const bf16x8_t mf = __builtin_bit_cast(bf16x8_t, w);
                imp[jt][0] = __builtin_amdgcn_mfma_f32_16x16x32_bf16(mf, pf[k2][0], imp[jt][0], 0, 0, 0);
                imp[jt][1] = __builtin_amdgcn_mfma_f32_16x16x32_bf16(mf, pf[k2][1], imp[jt][1], 0, 0, 0); } }
    }
}
template <bool ACCUM>
__device__ __forceinline__ void nsa_flush(NsaAcc& A, bf16* ON, const bf16* U, int b, int q0, int gk, int wave, int br, int lane_in) {
    int lane = lane_in; asm volatile("" : "+v"(lane)); const int n = lane & 15, g = lane >> 4, rhead = n & 3;
#pragma unroll
    for (int t = 0; t < 2; ++t) { float l = A.l[t]; l += __shfl_xor(l, 16); l += __shfl_xor(l, 32); A.l[t] = l;
        const size_t tok = (size_t)b * SEQ + q0 + ((32 * wave + 16 * t + n) >> 2);
        const float gate = __uint_as_float((unsigned)U[tok * LDU + U_NG + (gk * 4 + rhead) * 3 + br] << 16); const float sc = l > 0.f ? gate / l : 0.f;
        bf16* orow_t = ON + tok * 2048 + (gk * 4 + rhead) * 128;
#pragma unroll
        for (int dt = 0; dt < 8; ++dt) { GAS v2u* p = (GAS v2u*)(orow_t + 16 * dt + 4 * g); f32x4 v = A.o[dt][t] * sc;
            if (ACCUM) { const v2u w = *p; v[0] += bfl(w.x); v[1] += bfh(w.x); v[2] += bfl(w.y); v[3] += bfh(w.y); }
            v2u w; w.x = cvtpk(v[0], v[1]); w.y = cvtpk(v[2], v[3]); *p = w; } }
}
__device__ __forceinline__ void nsa_acc_reset(NsaAcc& A) {
#pragma unroll
    for (int t = 0; t < 2; ++t) { A.m[t] = -1e30f; A.l[t] = 0.f;
#pragma unroll
        for (int dt = 0; dt < 8; ++dt) A.o[dt][t] = (f32x4){0.f, 0.f, 0.f, 0.f}; }
}
__device__ __forceinline__ void nsa_wg_item(Frame& F, KArgs ap, int item, size_t on_off) {
    unsigned char* ws_ = ap->ws;
    const int qt = item & 63, gk = (item >> 6) & 3, b = item >> 8;
    int lane = F.lane; asm volatile("" : "+v"(lane));
    const int wave = F.wave, tid = wave * 64 + lane, n = lane & 15, g = lane >> 4;
    LAS unsigned char* lds = F.lds;
    const bf16* U = (const bf16*)(ws_ + WS_U); const bf16* OC = (const bf16*)(ws_ + WS_OC); bf16* ON = (bf16*)(ws_ + on_off);
    const int q0 = 64 * qt, rhead = n & 3;
    int qpos[2];
#pragma unroll
    for (int t = 0; t < 2; ++t) qpos[t] = q0 + ((32 * wave + 16 * t + n) >> 2);
#pragma unroll
    for (int i = 0; i < 8; ++i) { const int cid = tid + 512 * i, row = cid >> 4, c16 = cid & 15;
        const v4u w = *(const GAS v4u*)(U + ((size_t)b * SEQ + q0 + (row >> 2)) * LDU + U_NQ + (gk * 4 + (row & 3)) * 128 + c16 * 8);
        *(LAS v4u*)(lds + NL_Q + row * NT_ROWB + c16 * 16) = w; }
    { LAS float* bl = (LAS float*)(lds + NL_BIAS); const int r = tid >> 7, dd = tid & 127; bl[tid] = ap->in[12][REL_LUT[dd] * 16 + gk * 4 + r] * 1.4426950408889634f; }
    NsaAcc A; f32x4 imp[4][2]; NsaRegs R; const bool nosel[2] = {true, true};
    nsa_acc_reset(A);
#pragma unroll
    for (int jt = 0; jt < 4; ++jt) { imp[jt][0] = (f32x4){0.f, 0.f, 0.f, 0.f}; imp[jt][1] = (f32x4){0.f, 0.f, 0.f, 0.f}; }
    { const unsigned char* kbase = (const unsigned char*)(OC + (size_t)((b * 4 + gk) * 256) * 256); const unsigned char* vbase = (const unsigned char*)(OC + (size_t)(4096 + (b * 4 + gk) * 256) * 256 + 128);
      const int ntile = (q0 + 63 >= 31) ? (((q0 + 63 - 31) >> 4) >> 6) + 1 : 0;
      NsaTileSrc src{kbase, vbase, 512u};
      if (ntile > 0) { nsa_ld(src, tid, R); nsa_st(lds, 0, tid, R); }
      __syncthreads();
      for (int i = 0; i < ntile; ++i) {
          const NsaTileSrc s2{kbase + (size_t)(i + 1) * 64 * 512, vbase + (size_t)(i + 1) * 64 * 512, 512u};
          const bool far = (q0 - (16 * (64 * i + 63) + 31)) >= 128;
          nsa_tile<0>(lds, i & 1, wave, A, imp, 64 * i, qpos, nosel, far, far, rhead, lane, i + 1 < ntile, s2, tid, R);
          if (i + 1 < ntile) nsa_st(lds, (i + 1) & 1, tid, R);
          __syncthreads();
      }
      nsa_flush<false>(A, ON, U, b, q0, gk, wave, 0, lane);
    }
    unsigned long long mymask[2];
    { LAS float* ib = (LAS float*)(lds + NL_IMP) + wave * 512;
#pragma unroll
      for (int t = 0; t < 2; ++t) { const float inv = A.l[t] > 0.f ? 1.f / A.l[t] : 0.f;
#pragma unroll
          for (int jt = 0; jt < 4; ++jt) { f32x4 v = imp[jt][t] * inv;
#pragma unroll
              for (int i = 0; i < 4; ++i) { v[i] += __shfl_xor(v[i], 1); v[i] += __shfl_xor(v[i], 2); }
              if (rhead == 0) *(LAS f32x4*)(ib + (4 * t + (n >> 2)) * 64 + 16 * jt + 4 * g) = v; } }
      LDS_WAIT(); __builtin_amdgcn_wave_barrier(); asm volatile("" ::: "memory");
      const int qw = lane >> 3, js = lane & 7; const int cur = qt;
      unsigned lo = 0u, hi = 0u;
      if (cur < 16) { const unsigned long long all = (cur >= 63) ? ~0ull : ((1ull << (cur + 1)) - 1ull); lo = (unsigned)all; hi = (unsigned)(all >> 32); }
      else {
          float sc[64];
#pragma unroll
          for (int j4 = 0; j4 < 16; ++j4) { const f32x4 v = *(LAS const f32x4*)(ib + qw * 64 + 4 * j4);
#pragma unroll
              for (int i = 0; i < 4; ++i) { const int j = 4 * j4 + i; const bool forced = (j == 0) || (j <= cur && j > cur - 2); sc[j] = forced ? 1e4f : (j <= cur ? v[i] : -1e4f); } }
#pragma unroll
          for (int k = 0; k < 8; ++k) { const int j = js + 8 * k; const bool forced = (j == 0) || (j <= cur && j > cur - 2); const float mine = forced ? 1e4f : (j <= cur ? ib[qw * 64 + j] : -1e4f);
              int rank = 0;
#pragma unroll
              for (int jp = 0; jp < 64; ++jp) rank += (sc[jp] > mine || (sc[jp] == mine && jp < j)) ? 1 : 0;
              const bool sel = rank < 16 && j <= cur;
              if (k < 4) lo |= sel ? (1u << (js + 8 * k)) : 0u; else hi |= sel ? (1u << (js + 8 * (k - 4))) : 0u; }
          lo |= __shfl_xor(lo, 1); lo |= __shfl_xor(lo, 2); lo |= __shfl_xor(lo, 4); hi |= __shfl_xor(hi, 1); hi |= __shfl_xor(hi, 2); hi |= __shfl_xor(hi, 4);
      }
      LAS unsigned* sm = (LAS unsigned*)(lds + NL_SELM) + wave * 16;
      if (js == 0) { sm[2 * qw] = lo; sm[2 * qw + 1] = hi; }
      unsigned ulo = lo, uhi = hi;
      ulo |= __shfl_xor(ulo, 8); ulo |= __shfl_xor(ulo, 16); ulo |= __shfl_xor(ulo, 32); uhi |= __shfl_xor(uhi, 8); uhi |= __shfl_xor(uhi, 16); uhi |= __shfl_xor(uhi, 32);
      LAS unsigned* wu = (LAS unsigned*)(lds + NL_WUN);
      if (lane == 0) { wu[2 * wave] = ulo; wu[2 * wave + 1] = uhi; }
      LDS_WAIT(); __builtin_amdgcn_wave_barrier(); asm volatile("" ::: "memory");
#pragma unroll
      for (int t = 0; t < 2; ++t) { const int qi = 4 * t + (n >> 2); mymask[t] = (unsigned long long)sm[2 * qi] | ((unsigned long long)sm[2 * qi + 1] << 32); }
    }
    __syncthreads();
    unsigned long long wgmask = 0ull, wvmask;
    { LAS const unsigned* wu = (LAS const unsigned*)(lds + NL_WUN);
#pragma unroll
      for (int w = 0; w < 8; ++w) wgmask |= (unsigned long long)wu[2 * w] | ((unsigned long long)wu[2 * w + 1] << 32);
      wvmask = (unsigned long long)wu[2 * wave] | ((unsigned long long)wu[2 * wave + 1] << 32);
      wgmask = ((unsigned long long)__builtin_amdgcn_readfirstlane((unsigned)(wgmask >> 32)) << 32) | (unsigned)__builtin_amdgcn_readfirstlane((unsigned)wgmask);
      wvmask = ((unsigned long long)__builtin_amdgcn_readfirstlane((unsigned)(wvmask >> 32)) << 32) | (unsigned)__builtin_amdgcn_readfirstlane((unsigned)wvmask); }
    nsa_acc_reset(A);
    { const unsigned char* kbase = (const unsigned char*)(U + (size_t)b * SEQ * LDU + U_KSL + gk * 128); const unsigned char* vbase = (const unsigned char*)(U + (size_t)b * SEQ * LDU + U_VSL + gk * 128);
      unsigned long long rem = wgmask; int j = __builtin_ctzll(rem); rem &= rem - 1;
      { NsaTileSrc src{kbase + (size_t)j * 64 * LDU * 2, vbase + (size_t)j * 64 * LDU * 2, (unsigned)(LDU * 2)}; nsa_ld(src, tid, R); nsa_st(lds, 0, tid, R); }
      __syncthreads();
      for (int i = 0;; ++i) {
          const bool more = rem != 0ull; int jn = 0;
          if (more) { jn = __builtin_ctzll(rem); rem &= rem - 1; }
          const NsaTileSrc s2{kbase + (size_t)jn * 64 * LDU * 2, vbase + (size_t)jn * 64 * LDU * 2, (unsigned)(LDU * 2)};
          if ((wvmask >> j) & 1ull) { const bool sb[2] = {(bool)((mymask[0] >> j) & 1ull), (bool)((mymask[1] >> j) & 1ull)}; const bool far = (q0 - (64 * j + 63)) >= 128;
              nsa_tile<1>(lds, i & 1, wave, A, imp, 64 * j, qpos, sb, far, far, rhead, lane, more, s2, tid, R); }
          else if (more) nsa_ld(s2, tid, R);
          if (more) nsa_st(lds, (i + 1) & 1, tid, R);
          __syncthreads();
          if (!more) break;
          j = jn;
      }
      nsa_flush<true>(A, ON, U, b, q0, gk, wave, 1, lane);
    }
    nsa_acc_reset(A);
    { const unsigned char* kbase = (const unsigned char*)(U + (size_t)b * SEQ * LDU + U_KW + gk * 128); const unsigned char* vbase = (const unsigned char*)(U + (size_t)b * SEQ * LDU + U_VW + gk * 128);
      const int j0 = qt >= 8 ? qt - 8 : 0, ntile = qt - j0 + 1;
      { NsaTileSrc src{kbase + (size_t)j0 * 64 * LDU * 2, vbase + (size_t)j0 * 64 * LDU * 2, (unsigned)(LDU * 2)}; nsa_ld(src, tid, R); nsa_st(lds, 0, tid, R); }
      __syncthreads();
      for (int i = 0; i < ntile; ++i) { const int j = j0 + i;
          const NsaTileSrc s2{kbase + (size_t)(j + 1) * 64 * LDU * 2, vbase + (size_t)(j + 1) * 64 * LDU * 2, (unsigned)(LDU * 2)};
          const bool far = (q0 - (64 * j + 63)) >= 128;
          nsa_tile<2>(lds, i & 1, wave, A, imp, 64 * j, qpos, nosel, far, far && j > qt - 8, rhead, lane, i + 1 < ntile, s2, tid, R);
          if (i + 1 < ntile) nsa_st(lds, (i + 1) & 1, tid, R);
          __syncthreads();
      }
      nsa_flush<true>(A, ON, U, b, q0, gk, wave, 2, lane);
    }
    __syncthreads();
}

constexpr int GP = 288;
constexpr int GL_QE = 0, GL_KE = 64 * GP, GL_KD = 2 * 64 * GP, GL_V = 3 * 64 * GP, GL_ST = 4 * 64 * GP, GL_W2 = GL_ST + 128 * GP, GL_BAL = GL_W2 + 4096, GL_ALR = GL_BAL + 256, GL_WT = GL_ALR + 4096,
              GL_DEC = GL_WT + 2048, GL_SSQ = GL_DEC + 256, GL_END = GL_SSQ + 512;
static_assert(GL_END <= RING_BYTES, "GLA LDS map");
__device__ __forceinline__ bf16x8_t tr2(LAS const unsigned char* p) { const s16x4_t lo = tr_rd(p), hi = tr_rd(p + 16 * GP); return __builtin_shufflevector(lo, hi, 0, 1, 2, 3, 4, 5, 6, 7); }
__device__ __forceinline__ void gla_chain_mfma(Frame& F, KArgs ap, int bh, size_t og_off = WS_OGLA) {
    unsigned char* ws_ = ap->ws;
    const int b = bh >> 4, h = bh & 15;
    int lane = F.lane; asm volatile("" : "+v"(lane));
    const int wave = F.wave, tid = wave * 64 + lane, n = lane & 15, g = lane >> 4;
    LAS unsigned char* lds = F.lds;
    const bf16* U = (const bf16*)(ws_ + WS_U); bf16* OG = (bf16*)(ws_ + og_off);
    LAS float* W2 = (LAS float*)(lds + GL_W2); LAS float* Bal = (LAS float*)(lds + GL_BAL); LAS float* ALR = (LAS float*)(lds + GL_ALR); LAS float* WT = (LAS float*)(lds + GL_WT);
    LAS float* DEC = (LAS float*)(lds + GL_DEC); LAS float* SSQ = (LAS float*)(lds + GL_SSQ);
    for (int i = tid; i < 1024; i += 512) W2[i] = ap->in[3][(i >> 6) * 1024 + h * 64 + (i & 63)];
    if (tid < 64) Bal[tid] = ap->in[4][h * 64 + tid];
    for (int i = tid; i < 128 * GP / 4; i += 512) ((LAS unsigned*)(lds + GL_ST))[i] = 0u;
    const int tt = wave & 3, eh = wave >> 2;
    f32x4 Sr[4];
#pragma unroll
    for (int el = 0; el < 4; ++el) Sr[el] = (f32x4){0.f, 0.f, 0.f, 0.f};
    f32x4 gain[4];
#pragma unroll
    for (int el = 0; el < 4; ++el) gain[el] = *(const GAS f32x4*)(ap->in[5] + h * 128 + 16 * (4 * eh + el) + 4 * g);
    __syncthreads();
    float w2r[16];
#pragma unroll
    for (int j = 0; j < 16; ++j) w2r[j] = W2[j * 64 + lane];
    const float balr = Bal[lane];
    const int st_t = tid >> 3, st_p = tid & 7;
    unsigned p_aw; v4u p_q, p_k, p_v0, p_v1; v2u p_r[4];
#define GLA_LOAD(cc) do { const size_t tk = (size_t)b * SEQ + (cc) * 64; const bf16* ur = U + (tk + st_t) * LDU; \
        p_aw = *(const GAS unsigned*)(ur + U_GA + 2 * st_p); p_q = *(const GAS v4u*)(ur + U_GQ + h * 64 + st_p * 8); p_k = *(const GAS v4u*)(ur + U_GK + h * 64 + st_p * 8); \
        p_v0 = *(const GAS v4u*)(ur + U_GV + h * 128 + st_p * 16); p_v1 = *(const GAS v4u*)(ur + U_GV + h * 128 + st_p * 16 + 8); \
        _Pragma("unroll") for (int el = 0; el < 4; ++el) p_r[el] = *(const GAS v2u*)(U + (tk + 16 * tt + n) * LDU + U_GR + h * 128 + 16 * (4 * eh + el) + 4 * g); } while (0)
    GLA_LOAD(0);
    for (int c = 0; c < 64; ++c) {
        const size_t tok0 = (size_t)b * SEQ + c * 64;
        ALR[st_t * 16 + 2 * st_p] = bfl(p_aw); ALR[st_t * 16 + 2 * st_p + 1] = bfh(p_aw);
        *(LAS v4u*)(lds + GL_V + st_t * GP + st_p * 32) = p_v0; *(LAS v4u*)(lds + GL_V + st_t * GP + st_p * 32 + 16) = p_v1;
        *(LAS v4u*)(lds + GL_QE + st_t * GP + st_p * 16) = p_q; *(LAS v4u*)(lds + GL_KE + st_t * GP + st_p * 16) = p_k;
        v2u rcur[4];
#pragma unroll
        for (int el = 0; el < 4; ++el) rcur[el] = p_r[el];
        if (c + 1 < 64) GLA_LOAD(c + 1);
        __syncthreads();
        float bc[8]; float run = 0.f;
#pragma unroll
        for (int i = 0; i < 8; ++i) { const LAS f32x4* ar = (const LAS f32x4*)(ALR + (8 * wave + i) * 16); float pre = balr;
#pragma unroll
            for (int j4 = 0; j4 < 4; ++j4) { const f32x4 a = ar[j4]; pre += a.x * w2r[4 * j4] + a.y * w2r[4 * j4 + 1] + a.z * w2r[4 * j4 + 2] + a.w * w2r[4 * j4 + 3]; }
            const float ls = fminf(pre, 0.f) - __logf(1.f + __expf(-fabsf(pre)));
            run += ls * (1.f / 16.f); bc[i] = run; }
        WT[wave * 64 + lane] = run;
        __syncthreads();
        float off = 0.f, tot = 0.f; float qv[8], kv[8];
#pragma unroll
        for (int i = 0; i < 8; ++i) { const int t = 8 * wave + i; qv[i] = __uint_as_float((unsigned)*(LAS const unsigned short*)(lds + GL_QE + t * GP + 2 * lane) << 16); kv[i] = __uint_as_float((unsigned)*(LAS const unsigned short*)(lds + GL_KE + t * GP + 2 * lane) << 16); }
#pragma unroll
        for (int s = 0; s < 8; ++s) { const float wv = WT[s * 64 + lane]; tot += wv; off += (s < wave) ? wv : 0.f; }
#pragma unroll
        for (int i = 0; i < 8; ++i) { const float bcum = bc[i] + off; const int t = 8 * wave + i;
            *(LAS unsigned short*)(lds + GL_QE + t * GP + 2 * lane) = (unsigned short)f2bf(qv[i] * 0.125f * __expf(bcum));
            *(LAS unsigned short*)(lds + GL_KE + t * GP + 2 * lane) = (unsigned short)f2bf(kv[i] * __expf(-bcum));
            *(LAS unsigned short*)(lds + GL_KD + t * GP + 2 * lane) = (unsigned short)f2bf(kv[i] * __expf(tot - bcum)); }
        if (wave == 0) DEC[lane] = __expf(tot);
        __syncthreads();
        f32x4 at[4]; bf16x8_t qfr[2];
#pragma unroll
        for (int st = 0; st < 4; ++st) at[st] = (f32x4){0.f, 0.f, 0.f, 0.f};
#pragma unroll
        for (int ks = 0; ks < 2; ++ks) { qfr[ks] = *(LAS const bf16x8_t*)(lds + GL_QE + (16 * tt + n) * GP + 64 * ks + 16 * g);
#pragma unroll
            for (int st = 0; st < 4; ++st) if (st <= tt) { const bf16x8_t kf = *(LAS const bf16x8_t*)(lds + GL_KE + (16 * st + n) * GP + 64 * ks + 16 * g);
                at[st] = __builtin_amdgcn_mfma_f32_16x16x32_bf16(kf, qfr[ks], at[st], 0, 0, 0); } }
#pragma unroll
        for (int st = 0; st < 4; ++st) if (st == tt) {
#pragma unroll
            for (int i = 0; i < 4; ++i) if (4 * g + i > n) at[st][i] = 0.f; }
        bf16x8_t pf[2];
#pragma unroll
        for (int k2 = 0; k2 < 2; ++k2) { v4u w; w.x = cvtpk(at[2 * k2][0], at[2 * k2][1]); w.y = cvtpk(at[2 * k2][2], at[2 * k2][3]); w.z = cvtpk(at[2 * k2 + 1][0], at[2 * k2 + 1][1]); w.w = cvtpk(at[2 * k2 + 1][2], at[2 * k2 + 1][3]);
            pf[k2] = __builtin_bit_cast(bf16x8_t, w); }
        f32x4 o[4];
#pragma unroll
        for (int el = 0; el < 4; ++el) o[el] = (f32x4){0.f, 0.f, 0.f, 0.f};
        const float dec = DEC[16 * tt + n];
#pragma unroll
        for (int el = 0; el < 4; ++el) Sr[el] *= dec;
        LAS const unsigned char* trb = lds + (4 * g + (n >> 2)) * GP + (n & 3) * 8;
#pragma unroll
        for (int k2 = 0; k2 < 2; ++k2) { const bf16x8_t kdf = tr2(trb + GL_KD + 32 * k2 * GP + 32 * tt);
#pragma unroll
            for (int el = 0; el < 4; ++el) { const bf16x8_t vf = tr2(trb + GL_V + 32 * k2 * GP + 32 * (4 * eh + el));
                if (2 * k2 <= tt) o[el] = __builtin_amdgcn_mfma_f32_16x16x32_bf16(vf, pf[k2], o[el], 0, 0, 0);
                Sr[el] = __builtin_amdgcn_mfma_f32_16x16x32_bf16(vf, kdf, Sr[el], 0, 0, 0); } }
#pragma unroll
        for (int ks = 0; ks < 2; ++ks)
#pragma unroll
            for (int el = 0; el < 4; ++el) { const bf16x8_t sf = *(LAS const bf16x8_t*)(lds + GL_ST + (16 * (4 * eh + el) + n) * GP + 64 * ks + 16 * g);
                o[el] = __builtin_amdgcn_mfma_f32_16x16x32_bf16(sf, qfr[ks], o[el], 0, 0, 0); }
        float ss = 0.f;
#pragma unroll
        for (int el = 0; el < 4; ++el) ss += (o[el][0] * o[el][0] + o[el][1] * o[el][1]) + (o[el][2] * o[el][2] + o[el][3] * o[el][3]);
        ss += __shfl_xor(ss, 16); ss += __shfl_xor(ss, 32);
        if (g == 0) SSQ[(16 * tt + n) * 2 + eh] = ss;
        __syncthreads();
#pragma unroll
        for (int el = 0; el < 4; ++el)
#pragma unroll
            for (int i = 0; i < 4; ++i) *(LAS unsigned short*)(lds + GL_ST + (16 * (4 * eh + el) + 4 * g + i) * GP + 2 * (16 * tt + n)) = (unsigned short)f2bf(Sr[el][i]);
        const int t = 16 * tt + n; const float rstd = 1.f / sqrtf((SSQ[2 * t] + SSQ[2 * t + 1]) * (1.f / 128.f) + NORM_EPS);
#pragma unroll
        for (int el = 0; el < 4; ++el) { const int e0 = 16 * (4 * eh + el) + 4 * g; const v2u rw = rcur[el];
            v2u ow; ow.x = cvtpk(o[el][0] * rstd * gain[el][0] * bfl(rw.x), o[el][1] * rstd * gain[el][1] * bfh(rw.x)); ow.y = cvtpk(o[el][2] * rstd * gain[el][2] * bfl(rw.y), o[el][3] * rstd * gain[el][3] * bfh(rw.y));
            *(GAS v2u*)(OG + (tok0 + t) * 2048 + h * 128 + e0) = ow; }
    }
    __syncthreads();
#undef GLA_LOAD
}
constexpr size_t WS_KD = WS_R2 + 192 * MiB;
constexpr size_t WS_DEC = WS_R2 + 224 * MiB;
constexpr int GQ_ALR = 0, GQ_WT = 4096, GQ_QRAW = 8192, GQ_KRAW = GQ_QRAW + 64 * GP, GQ_QE = GQ_KRAW + 64 * GP, GQ_KE = GQ_QE + 64 * GP, GQ_KD = GQ_KE + 64 * GP, GQ_END = GQ_KD + 64 * GP;
static_assert(GQ_END <= RING_BYTES, "GLA pre-pass LDS map");
__device__ __forceinline__ void gla_pre_items(Frame& F, KArgs ap, int it0, int nw) {
    unsigned char* ws_ = ap->ws;
    int lane = F.lane; asm volatile("" : "+v"(lane));
    const int wave = F.wave, tid = wave * 64 + lane, st_t = tid >> 3, st_p = tid & 7;
    LAS unsigned char* lds = F.lds; LAS float* ALR = (LAS float*)(lds + GQ_ALR); LAS float* WT = (LAS float*)(lds + GQ_WT);
    bf16* U = (bf16*)(ws_ + WS_U); bf16* KD = (bf16*)(ws_ + WS_KD); float* DEC = (float*)(ws_ + WS_DEC);
    const int h = it0 & 15, slot = it0 >> 4, ns = (nw - h + 15) >> 4;
    float w2r[16];
#pragma unroll
    for (int j = 0; j < 16; ++j) w2r[j] = ap->in[3][j * 1024 + h * 64 + lane];
    const float balr = ap->in[4][h * 64 + lane];
    unsigned p_aw; v4u p_q, p_k;
#define GLA_PLOAD(px) do { const bf16* ur = U + ((size_t)((px) >> 6) * SEQ + ((px) & 63) * 64 + st_t) * LDU; \
        p_aw = *(const GAS unsigned*)(ur + U_GA + 2 * st_p); p_q = *(const GAS v4u*)(ur + U_GQ + h * 64 + st_p * 8); p_k = *(const GAS v4u*)(ur + U_GK + h * 64 + st_p * 8); } while (0)
    if (slot < 256) GLA_PLOAD(slot);
    for (int pr = slot; pr < 256; pr += ns) {
        const int b = pr >> 6, c = pr & 63, bh = b * 16 + h; const size_t tok0 = (size_t)b * SEQ + c * 64;
        ALR[st_t * 16 + 2 * st_p] = bfl(p_aw); ALR[st_t * 16 + 2 * st_p + 1] = bfh(p_aw);
        *(LAS v4u*)(lds + GQ_QRAW + st_t * GP + st_p * 16) = p_q; *(LAS v4u*)(lds + GQ_KRAW + st_t * GP + st_p * 16) = p_k;
        if (pr + ns < 256) GLA_PLOAD(pr + ns);
        __syncthreads();
        float bc[8]; float run = 0.f;
#pragma unroll
        for (int i = 0; i < 8; ++i) { const LAS f32x4* ar = (const LAS f32x4*)(ALR + (8 * wave + i) * 16); float pre = balr;
#pragma unroll
            for (int j4 = 0; j4 < 4; ++j4) { const f32x4 a = ar[j4]; pre += a.x * w2r[4 * j4] + a.y * w2r[4 * j4 + 1] + a.z * w2r[4 * j4 + 2] + a.w * w2r[4 * j4 + 3]; }
            const float ls = fminf(pre, 0.f) - __logf(1.f + __expf(-fabsf(pre)));
            run += ls * (1.f / 16.f); bc[i] = run; }
        WT[wave * 64 + lane] = run;
        __syncthreads();
        float off = 0.f, tot = 0.f;
#pragma unroll
        for (int s = 0; s < 8; ++s) { const float wv = WT[s * 64 + lane]; tot += wv; off += (s < wave) ? wv : 0.f; }
#pragma unroll
        for (int i = 0; i < 8; ++i) { const float bcum = bc[i] + off; const int t = 8 * wave + i;
            const float qv = __uint_as_float((unsigned)*(LAS const unsigned short*)(lds + GQ_QRAW + t * GP + 2 * lane) << 16), kv = __uint_as_float((unsigned)*(LAS const unsigned short*)(lds + GQ_KRAW + t * GP + 2 * lane) << 16);
            const unsigned wq = cvtpk(qv * 0.125f * __expf(bcum), kv * __expf(-bcum)); const unsigned wk = cvtpk(kv * __expf(tot - bcum), 0.f);
            *(LAS unsigned short*)(lds + GQ_QE + t * GP + 2 * lane) = (unsigned short)wq; *(LAS unsigned short*)(lds + GQ_KE + t * GP + 2 * lane) = (unsigned short)(wq >> 16);
            *(LAS unsigned short*)(lds + GQ_KD + t * GP + 2 * lane) = (unsigned short)wk; }
        if (wave == 0) DEC[(size_t)(bh * 64 + c) * 64 + lane] = __expf(tot);
        __syncthreads();
        { const v4u a = *(LAS const v4u*)(lds + GQ_QE + st_t * GP + st_p * 16), k2 = *(LAS const v4u*)(lds + GQ_KE + st_t * GP + st_p * 16), k3 = *(LAS const v4u*)(lds + GQ_KD + st_t * GP + st_p * 16);
          bf16* ur = U + (tok0 + st_t) * LDU; *(GAS v4u*)(ur + U_GQ + h * 64 + st_p * 8) = a; *(GAS v4u*)(ur + U_GK + h * 64 + st_p * 8) = k2; *(GAS v4u*)(KD + (tok0 + st_t) * 1024 + h * 64 + st_p * 8) = k3; }
    }
    __syncthreads();
#undef GLA_PLOAD
}
__device__ __forceinline__ void gla_chain_mfma2(Frame& F, KArgs ap, int bh) {
    unsigned char* ws_ = ap->ws;
    const int b = bh >> 4, h = bh & 15;
    int lane = F.lane; asm volatile("" : "+v"(lane));
    const int wave = F.wave, tid = wave * 64 + lane, n = lane & 15, g = lane >> 4;
    LAS unsigned char* lds = F.lds;
    const bf16* U = (const bf16*)(ws_ + WS_U); const bf16* KDg = (const bf16*)(ws_ + WS_KD); const float* DECg = (const float*)(ws_ + WS_DEC); bf16* OG = (bf16*)(ws_ + WS_OGLA);
    LAS float* DEC = (LAS float*)(lds + GL_DEC); LAS float* SSQ = (LAS float*)(lds + GL_SSQ);
    for (int i = tid; i < 128 * GP / 4; i += 512) ((LAS unsigned*)(lds + GL_ST))[i] = 0u;
    const int tt = wave & 3, eh = wave >> 2;
    f32x4 Sr[4];
#pragma unroll
    for (int el = 0; el < 4; ++el) Sr[el] = (f32x4){0.f, 0.f, 0.f, 0.f};
    f32x4 gain[4];
#pragma unroll
    for (int el = 0; el < 4; ++el) gain[el] = *(const GAS f32x4*)(ap->in[5] + h * 128 + 16 * (4 * eh + el) + 4 * g);
    const int st_t = tid >> 3, st_p = tid & 7;
    v4u p_q, p_k, p_kd, p_v0, p_v1; v2u p_r[4]; float p_dec;
#define GLA_LOAD2(cc) do { const size_t tk = (size_t)b * SEQ + (cc) * 64; const bf16* ur = U + (tk + st_t) * LDU; \
        p_q = *(const GAS v4u*)(ur + U_GQ + h * 64 + st_p * 8); p_k = *(const GAS v4u*)(ur + U_GK + h * 64 + st_p * 8); p_kd = *(const GAS v4u*)(KDg + (tk + st_t) * 1024 + h * 64 + st_p * 8); \
        p_v0 = *(const GAS v4u*)(ur + U_GV + h * 128 + st_p * 16); p_v1 = *(const GAS v4u*)(ur + U_GV + h * 128 + st_p * 16 + 8); \
        p_dec = DECg[(size_t)(bh * 64 + (cc)) * 64 + (tid & 63)]; \
        _Pragma("unroll") for (int el = 0; el < 4; ++el) p_r[el] = *(const GAS v2u*)(U + (tk + 16 * tt + n) * LDU + U_GR + h * 128 + 16 * (4 * eh + el) + 4 * g); } while (0)
    GLA_LOAD2(0);
    __syncthreads();
    for (int c = 0; c < 64; ++c) {
        const size_t tok0 = (size_t)b * SEQ + c * 64;
        *(LAS v4u*)(lds + GL_V + st_t * GP + st_p * 32) = p_v0; *(LAS v4u*)(lds + GL_V + st_t * GP + st_p * 32 + 16) = p_v1;
        *(LAS v4u*)(lds + GL_QE + st_t * GP + st_p * 16) = p_q; *(LAS v4u*)(lds + GL_KE + st_t * GP + st_p * 16) = p_k; *(LAS v4u*)(lds + GL_KD + st_t * GP + st_p * 16) = p_kd;
        if (wave == 0) DEC[lane] = p_dec;
        v2u rcur[4];
#pragma unroll
        for (int el = 0; el < 4; ++el) rcur[el] = p_r[el];
        if (c + 1 < 64) GLA_LOAD2(c + 1);
        __syncthreads();
        f32x4 at[4]; bf16x8_t qfr[2];
#pragma unroll
        for (int st = 0; st < 4; ++st) at[st] = (f32x4){0.f, 0.f, 0.f, 0.f};
#pragma unroll
        for (int ks = 0; ks < 2; ++ks) { qfr[ks] = *(LAS const bf16x8_t*)(lds + GL_QE + (16 * tt + n) * GP + 64 * ks + 16 * g);
#pragma unroll
            for (int st = 0; st < 4; ++st) if (st <= tt) { const bf16x8_t kf = *(LAS const bf16x8_t*)(lds + GL_KE + (16 * st + n) * GP + 64 * ks + 16 * g);
                at[st] = __builtin_amdgcn_mfma_f32_16x16x32_bf16(kf, qfr[ks], at[st], 0, 0, 0); } }
#pragma unroll
        for (int st = 0; st < 4; ++st) if (st == tt) {
#pragma unroll
            for (int i = 0; i < 4; ++i) if (4 * g + i > n) at[st][i] = 0.f; }
        bf16x8_t pf[2];
#pragma unroll
        for (int k2 = 0; k2 < 2; ++k2) { v4u w; w.x = cvtpk(at[2 * k2][0], at[2 * k2][1]); w.y = cvtpk(at[2 * k2][2], at[2 * k2][3]); w.z = cvtpk(at[2 * k2 + 1][0], at[2 * k2 + 1][1]); w.w = cvtpk(at[2 * k2 + 1][2], at[2 * k2 + 1][3]);
            pf[k2] = __builtin_bit_cast(bf16x8_t, w); }
        f32x4 o[4];
#pragma unroll
        for (int el = 0; el < 4; ++el) o[el] = (f32x4){0.f, 0.f, 0.f, 0.f};
        const float dec = DEC[16 * tt + n];
#pragma unroll
        for (int el = 0; el < 4; ++el) Sr[el] *= dec;
        LAS const unsigned char* trb = lds + (4 * g + (n >> 2)) * GP + (n & 3) * 8;
#pragma unroll
        for (int k2 = 0; k2 < 2; ++k2) { const bf16x8_t kdf = tr2(trb + GL_KD + 32 * k2 * GP + 32 * tt);
#pragma unroll
            for (int el = 0; el < 4; ++el) { const bf16x8_t vf = tr2(trb + GL_V + 32 * k2 * GP + 32 * (4 * eh + el));
                if (2 * k2 <= tt) o[el] = __builtin_amdgcn_mfma_f32_16x16x32_bf16(vf, pf[k2], o[el], 0, 0, 0);
                Sr[el] = __builtin_amdgcn_mfma_f32_16x16x32_bf16(vf, kdf, Sr[el], 0, 0, 0); } }
#pragma unroll
        for (int ks = 0; ks < 2; ++ks)
#pragma unroll
            for (int el = 0; el < 4; ++el) { const bf16x8_t sf = *(LAS const bf16x8_t*)(lds + GL_ST + (16 * (4 * eh + el) + n) * GP + 64 * ks + 16 * g);
                o[el] = __builtin_amdgcn_mfma_f32_16x16x32_bf16(sf, qfr[ks], o[el], 0, 0, 0); }
        float ss = 0.f;
#pragma unroll
        for (int el = 0; el < 4; ++el) ss += (o[el][0] * o[el][0] + o[el][1] * o[el][1]) + (o[el][2] * o[el][2] + o[el][3] * o[el][3]);
        ss += __shfl_xor(ss, 16); ss += __shfl_xor(ss, 32);
        if (g == 0) SSQ[(16 * tt + n) * 2 + eh] = ss;
        __syncthreads();
#pragma unroll
        for (int el = 0; el < 4; ++el) { const unsigned w0 = cvtpk(Sr[el][0], Sr[el][1]), w1 = cvtpk(Sr[el][2], Sr[el][3]); LAS unsigned char* sp = lds + GL_ST + (16 * (4 * eh + el) + 4 * g) * GP + 2 * (16 * tt + n);
            *(LAS unsigned short*)(sp) = (unsigned short)w0; *(LAS unsigned short*)(sp + GP) = (unsigned short)(w0 >> 16); *(LAS unsigned short*)(sp + 2 * GP) = (unsigned short)w1; *(LAS unsigned short*)(sp + 3 * GP) = (unsigned short)(w1 >> 16); }
        const int t = 16 * tt + n; const float rstd = 1.f / sqrtf((SSQ[2 * t] + SSQ[2 * t + 1]) * (1.f / 128.f) + NORM_EPS);
#pragma unroll
        for (int el = 0; el < 4; ++el) { const int e0 = 16 * (4 * eh + el) + 4 * g; const v2u rw = rcur[el];
            v2u ow; ow.x = cvtpk(o[el][0] * rstd * gain[el][0] * bfl(rw.x), o[el][1] * rstd * gain[el][1] * bfh(rw.x)); ow.y = cvtpk(o[el][2] * rstd * gain[el][2] * bfl(rw.y), o[el][3] * rstd * gain[el][3] * bfh(rw.y));
            *(GAS v2u*)(OG + (tok0 + t) * 2048 + h * 128 + e0) = ow; }
    }
    __syncthreads();
#undef GLA_LOAD2
}
__device__ __forceinline__ void nsa_wg_all(Frame& F, KArgs ap, int w, int nw, size_t on_off) {
    for (int k = 0;; ++k) { const int idx = (k & 1) ? k * nw + (nw - 1 - w) : k * nw + w; if (k * nw >= 1024) break; if (idx >= 1024) continue;
        const int qt = 63 - (idx >> 4), bg = idx & 15; nsa_wg_item(F, ap, ((bg >> 2) << 8) | ((bg & 3) << 6) | qt, on_off); }
}
constexpr int CW_QHEAD = 3072;
__device__ __forceinline__ void nsa_wg_queue(Frame& F, KArgs ap, size_t on_off, int hq) {
    unsigned* head = (unsigned*)(ap->ws + WS_CTL) + CW_QHEAD + hq; volatile LAS unsigned* slot = F.MISC + 16;
    for (;;) {
        if (F.tid == 0) slot[0] = __hip_atomic_fetch_add(head, 1u, __ATOMIC_RELAXED, __HIP_MEMORY_SCOPE_AGENT);
        __syncthreads();
        const int idx = (int)slot[0];
        __syncthreads();
        if (idx >= 1024) break;
        const int qt = 63 - (idx >> 4), bg = idx & 15; nsa_wg_item(F, ap, ((bg >> 2) << 8) | ((bg & 3) << 6) | qt, on_off);
    }
}
#ifndef GLA_IMPL
#define GLA_IMPL 2
#endif
#if GLA_IMPL == 0
#define GLA_CHAIN gla_chain
#elif GLA_IMPL == 1
#define GLA_CHAIN gla_chain_mfma
#else
#define GLA_CHAIN gla_chain_mfma2
#endif
#ifndef NSA_IMPL
#define NSA_IMPL 2
#endif
__device__ __forceinline__ void p5_mixers(Frame& F, KArgs ap, int rep = 0) {
    const int nG = F.G >= 128 ? 64 : (F.G >= 8 ? F.G / 4 : 1);
#if NSA_IMPL == 2
    if (F.blk < nG) { for (int bh = F.blk; bh < BATCH * GLA_H; bh += nG) GLA_CHAIN(F, ap, bh); }
    nsa_wg_queue(F, ap, WS_ONSA, 64 * rep);
#else
    if (F.blk < nG) { for (int bh = F.blk; bh < BATCH * GLA_H; bh += nG) GLA_CHAIN(F, ap, bh); }
    else if (F.G > nG) {
#if NSA_IMPL == 0
        LAS float* wl = (LAS float*)F.lds + F.wave * 2048;
        const int nw = (F.G - nG) * NWAVES; for (int it = (F.blk - nG) * NWAVES + F.wave; it < BATCH * NSA_G * SEQ; it += nw) nsa_item(F, ap, it, wl);
#else
        nsa_wg_all(F, ap, F.blk - nG, F.G - nG, WS_ONSA);
#endif
    }
#endif
}

#if defined(NSA_CHECK)
#define CHECK_AMP NSA_CHECK
#elif defined(GLA_CHECK)
#define CHECK_AMP GLA_CHECK
#endif
#ifndef PHM
#define PHM 0xFFF
#endif
__global__ void __launch_bounds__(NWAVES * 64, 2) hybrid_fwd(Args args) {
    extern __shared__ __attribute__((aligned(16))) unsigned char lds[];
    Frame F;
    F.lds = (LAS unsigned char*)lds; F.MISC = (volatile LAS unsigned*)(F.lds + MISC_OFF);
    F.tid = threadIdx.x; F.lane = F.tid & 63; F.wave = __builtin_amdgcn_readfirstlane(F.tid >> 6);
    F.G = gridDim.x; F.blk = blockIdx.x;
    for (int u = F.tid; u < (LDS_BYTES - LDSCTL_OFF) / 4; u += NWAVES * 64) ((LAS unsigned*)(F.lds + LDSCTL_OFF))[u] = 0u;
    __syncthreads();
    const int lo = args.ph_lo, hi = args.ph_hi;
    if (hi - lo > 1 && F.tid == 0) { unsigned* bw = (unsigned*)(args.ws + WS_CTL) + CW_BAR; (void)xb_add(&bw[XB_XCNT(xb_xcc_id())], 1u); }
#define IN(k) (((PHM >> (k)) & 1) && lo <= (k) && (k) < hi)
#ifndef PH_REP
#define PH_REP 0
#endif
#define NREP(k) (((PH_REP >> (k)) & 1) ? 2 : 1)
#define FRESH() KArgs ap = fresh_args(); unsigned char* ws = ap->ws; (void)ws; { int _l; asm volatile("v_mbcnt_lo_u32_b32 %0, -1, 0\n\tv_mbcnt_hi_u32_b32 %0, -1, %0" : "=v"(_l)); F.lane = _l; F.tid = F.wave * 64 + _l; }
#define SEAM(k) do { if (IN(k) && IN((k) + 1)) { XcdBarrier bar; bar.bar = (unsigned*)(ws + WS_CTL) + CW_BAR; bar.x = xb_xcc_id(); bar.st = F.MISC + 8; xcd_barrier(bar, F.wave); } } while (0)
    LAS unsigned char* ring = F.lds;

    if (IN(0)) for (int rep_ = 0; rep_ < NREP(0); ++rep_) { FRESH(); p0_prologue(F, ap); SEAM(0); }
    if (IN(1)) for (int rep_ = 0; rep_ < NREP(1); ++rep_) {
        FRESH();
        { pg8::Gemm g{(const pg8::bf16_t*)(ws + WS_H), (const pg8::bf16_t*)(ws + WS_WIN), M, NB16, D}; pg8::StaticOrder S; S.init(M, NB16, F.G, F.blk);
          pg8::EpiU E{(pg8::bf16_t*)(ws + WS_U), LDU, 0, 1.f, GATE_FP8 != 0};
          pg8::gemm_phase<pg8::EpiU, pg8::StaticOrder, true, true>(ring, g, S, E, F.wave); }
#if GATE_FP8
        { FRESH();
          pg8::Gemm g{(const pg8::bf16_t*)(ws + WS_H8), (const pg8::bf16_t*)(ws + WS_WG8), M, NG8, D / 2};
          pg8::EpiU E{(pg8::bf16_t*)(ws + WS_U), LDU, 44, 1.f / 64.f, false};
          if (F.G == 256) { pg8::LateOrder S; S.init2(M, NG8, F.G, F.blk, 64, 2);
              pg8::gemm_phase<pg8::EpiU, pg8::LateOrder, true, true, true>(ring, g, S, E, F.wave); }
          else { pg8::StaticOrder S; S.init(M, NG8, F.G, F.blk); pg8::gemm_phase<pg8::EpiU, pg8::StaticOrder, true, true, true>(ring, g, S, E, F.wave); } }
#endif
        SEAM(1);
    }
    if (IN(2)) for (int rep_ = 0; rep_ < NREP(2); ++rep_) { FRESH(); p2_im2col(F, ap); SEAM(2); }
    if (IN(3)) for (int rep_ = 0; rep_ < NREP(3); ++rep_) {
        FRESH();
        pg8::Gemm g{(const pg8::bf16_t*)(ws + WS_ACMP), (const pg8::bf16_t*)(ws + WS_W1C), 8192, 256, 4096}; pg8::StaticOrder S; S.init(8192, 256, F.G, F.blk);
        pg8::EpiAct<1> E{(pg8::bf16_t*)(ws + WS_HC), 256};
        pg8::gemm_phase<pg8::EpiAct<1>, pg8::StaticOrder, true, true, false, true>(ring, g, S, E, F.wave);
        VM_WAIT(); __syncthreads();
        { FRESH();
          pg8::Gemm g2{(const pg8::bf16_t*)(ws + WS_HC), (const pg8::bf16_t*)(ws + WS_W2B), 8192, 256, 256}; pg8::StaticOrder S2; S2.init(8192, 256, F.G, F.blk);
          pg8::EpiAct<0> E2{(pg8::bf16_t*)(ws + WS_OC), 256};
          pg8::gemm_phase<pg8::EpiAct<0>, pg8::StaticOrder, true, true>(ring, g2, S2, E2, F.wave); }
#if GLA_IMPL == 2
        if (F.blk >= 32 && F.G > 32) { FRESH(); gla_pre_items(F, ap, F.blk - 32, F.G - 32); }
#endif
        SEAM(3);
    }
#if defined(NSA_CHECK)
    if (IN(5)) {
        { FRESH(); const int nG = 64; if (F.blk < nG) gla_chain(F, ap, F.blk); else { LAS float* wl = (LAS float*)F.lds + F.wave * 2048; const int nw = (F.G - nG) * NWAVES; for (int it = (F.blk - nG) * NWAVES + F.wave; it < BATCH * NSA_G * SEQ; it += nw) nsa_item(F, ap, it, wl); }
          XcdBarrier bar; bar.bar = (unsigned*)(ws + WS_CTL) + CW_BAR; bar.x = xb_xcc_id(); bar.st = F.MISC + 8; xcd_barrier(bar, F.wave); }
        { FRESH(); nsa_wg_all(F, ap, F.blk, F.G, WS_R2 + 192 * MiB);
          XcdBarrier bar; bar.bar = (unsigned*)(ws + WS_CTL) + CW_BAR; bar.x = xb_xcc_id(); bar.st = F.MISC + 8; xcd_barrier(bar, F.wave); }
        { FRESH(); const bf16* a = (const bf16*)(ws + WS_ONSA); const bf16* c = (const bf16*)(ws + WS_R2 + 192 * MiB); float num = 0.f, den = 0.f;
          for (size_t i = (size_t)F.blk * 512 + F.tid; i < (size_t)M * 2048; i += (size_t)F.G * 512) { const float x = __uint_as_float((unsigned)a[i] << 16), y = __uint_as_float((unsigned)c[i] << 16); num += (x - y) * (x - y); den += x * x; }
          num = wave_sum(num); den = wave_sum(den); float* cw = (float*)(ws + WS_CTL) + 2048; if (F.lane == 0) { atomicAdd(cw, num); atomicAdd(cw + 64, den); }
          SEAM(5); } }
#elif defined(GLA_CHECK)
    if (IN(5)) {
        { FRESH(); if (F.blk < 64) gla_chain(F, ap, F.blk); else if (F.blk < 128) gla_chain_mfma(F, ap, F.blk - 64, WS_R2 + 192 * MiB); else nsa_wg_all(F, ap, F.blk - 128, F.G - 128, WS_ONSA);
          XcdBarrier bar; bar.bar = (unsigned*)(ws + WS_CTL) + CW_BAR; bar.x = xb_xcc_id(); bar.st = F.MISC + 8; xcd_barrier(bar, F.wave); }
        { FRESH(); const bf16* a = (const bf16*)(ws + WS_OGLA); const bf16* c = (const bf16*)(ws + WS_R2 + 192 * MiB); float num = 0.f, den = 0.f;
          for (size_t i = (size_t)F.blk * 512 + F.tid; i < (size_t)M * 2048; i += (size_t)F.G * 512) { const float x = __uint_as_float((unsigned)a[i] << 16), y = __uint_as_float((unsigned)c[i] << 16); num += (x - y) * (x - y); den += x * x; }
          num = wave_sum(num); den = wave_sum(den); float* cw = (float*)(ws + WS_CTL) + 2048; if (F.lane == 0) { atomicAdd(cw, num); atomicAdd(cw + 64, den); }
          SEAM(5); } }
#else
    if (IN(5)) for (int rep_ = 0; rep_ < NREP(5); ++rep_) { FRESH(); p5_mixers(F, ap, rep_); SEAM(5); }
#endif
    if (IN(6)) for (int rep_ = 0; rep_ < NREP(6); ++rep_) {
        { FRESH();
          pg8::Gemm g{(const pg8::bf16_t*)(ws + WS_OGLA), (const pg8::bf16_t*)(ws + WS_WGLA), M, D, 2048}; pg8::StaticOrder S; S.init(M, D, F.G, F.blk);
          pg8::EpiMix<false> E{(pg8::bf16_t*)(ws + WS_MIX), D, (const pg8::bf16_t*)(ws + WS_U) + U_MG, LDU};
          pg8::gemm_phase<pg8::EpiMix<false>, pg8::StaticOrder, true, true>(ring, g, S, E, F.wave); }
        VM_WAIT(); __syncthreads();
        { FRESH();
          pg8::Gemm g{(const pg8::bf16_t*)(ws + WS_ONSA), (const pg8::bf16_t*)(ws + WS_WNSA), M, D, 2048}; pg8::StaticOrder S; S.init(M, D, F.G, F.blk);
          pg8::EpiMix<true> E{(pg8::bf16_t*)(ws + WS_MIX), D, (const pg8::bf16_t*)(ws + WS_U) + U_MN, LDU};
          pg8::gemm_phase<pg8::EpiMix<true>, pg8::StaticOrder, true, true>(ring, g, S, E, F.wave);
          SEAM(6); }
    }
    if (IN(7)) for (int rep_ = 0; rep_ < NREP(7); ++rep_) {
        FRESH();
        pg8::Gemm g{(const pg8::bf16_t*)(ws + WS_MIX), (const pg8::bf16_t*)(ws + WS_WOUT), M, D, D}; pg8::StaticOrder S; S.init(M, D, F.G, F.blk);
        pg8::EpiResN E{ap->in[0], ap->out, D, ap->in[16], (pg8::bf16_t*)(ws + WS_H2), (float*)(ws + WS_RS)};
        pg8::gemm_phase<pg8::EpiResN, pg8::StaticOrder, true, true>(ring, g, S, E, F.wave);
        SEAM(7);
    }
    if (IN(8)) for (int rep_ = 0; rep_ < NREP(8); ++rep_) {
        FRESH();
        const int gw = F.blk * NWAVES + F.wave, NGW = F.G * NWAVES; LAS float* scr = (LAS float*)(F.lds + F.wave * 16384);
        bf16* H2 = (bf16*)(ws + WS_H2); bf16* WdT = (bf16*)(ws + WS_WDOWN); const float* x1 = ap->out;
        { const float* Wd = ap->in[18]; const int lane_ = F.lane;
          auto dec = [&](int r) -> TD { TD d; const int nblk = D / 32, kb = r / nblk, nb = r % nblk; d.W = Wd; d.WT = (unsigned char*)WdT; d.K = FF; d.ldw = D; d.drow = 32 * nb; d.k0 = 64 * kb; d.scol = 32 * nb + (lane_ & 31); d.f8 = 0; return d; };
          transpose_stream(F, dec, (FF / 64) * (D / 32), scr, gw, NGW); }
        { const float* RS = (const float*)(ws + WS_RS); float* RS2 = (float*)(ws + WS_RS2);
          for (int m = gw; m < M; m += NGW) { const float t = wave_sum(RS[(size_t)m * 64 + F.lane]); if (F.lane == 0) RS2[m] = 1.f / (t * (1.f / D) + NORM_EPS); } }
        SEAM(8);
    }
    if (IN(9)) for (int rep_ = 0; rep_ < NREP(9); ++rep_) {
        FRESH();
        pg8::Gemm g{(const pg8::bf16_t*)(ws + WS_H2), (const pg8::bf16_t*)(ws + WS_WUP), M, FF, D}; pg8::StaticOrder S; S.init(M, FF, F.G, F.blk);
        pg8::EpiRelu2R E{(pg8::bf16_t*)(ws + WS_U), FF, (const float*)(ws + WS_RS2)};
        pg8::gemm_phase<pg8::EpiRelu2R, pg8::StaticOrder, true, true>(ring, g, S, E, F.wave);
        SEAM(9);
    }
    if (IN(10)) {
        FRESH();
        pg8::Gemm g{(const pg8::bf16_t*)(ws + WS_U), (const pg8::bf16_t*)(ws + WS_WDOWN), M, D, FF}; pg8::StaticOrder S; S.init(M, D, F.G, F.blk);
        pg8::EpiRes E{ap->out, ap->out, D};
        pg8::gemm_phase<pg8::EpiRes, pg8::StaticOrder, true, true>(ring, g, S, E, F.wave);
        SEAM(10);
    }
    if (IN(11)) {
        FRESH();
        const int gw = F.blk * NWAVES + F.wave, NGW = F.G * NWAVES; float* xo = ap->out;
        rms_rows(F, xo, ap->in[19], nullptr, nullptr, xo, gw, NGW);
#if defined(NSA_CHECK) || defined(GLA_CHECK)
        { const float* cw = (const float*)(ws + WS_CTL) + 2048; const float e = sqrtf(cw[0] / cw[64]); const float sc = 1.f + CHECK_AMP * e;
          for (int m = gw; m < M; m += NGW) { GAS f32x4* xr = (GAS f32x4*)(xo + (size_t)m * D) + F.lane; for (int j = 0; j < 16; ++j) xr[64 * j] = xr[64 * j] * sc; } }
#endif
    }
#undef IN
#undef SEAM
#undef FRESH
}

extern "C" void kernel_launch(void* const* d_in, const int* in_sizes, int n_in, void* d_out, int out_size, void* d_ws, size_t ws_size, hipStream_t stream) {
    static int grid = 0;
    if (grid == 0) {
        if (n_in != 20 || in_sizes[0] != M * D || out_size != M * D || ws_size < WS_END) { fprintf(stderr, "kernel_launch: unexpected shapes (n_in %d, in0 %d, out %d, ws %zu); nothing launched\n", n_in, n_in > 0 ? in_sizes[0] : -1, out_size, ws_size); grid = -1; return; }
        int dev = 0, cus = 0, per_cu = 0;
        if (hipGetDevice(&dev) != hipSuccess || hipDeviceGetAttribute(&cus, hipDeviceAttributeMultiprocessorCount, dev) != hipSuccess) { grid = -1; return; }
        if (hipFuncSetAttribute((const void*)hybrid_fwd, hipFuncAttributeMaxDynamicSharedMemorySize, LDS_BYTES) != hipSuccess) { fprintf(stderr, "kernel_launch: hipFuncSetAttribute failed\n"); grid = -1; return; }
        if (hipOccupancyMaxActiveBlocksPerMultiprocessor(&per_cu, (const void*)hybrid_fwd, NWAVES * 64, LDS_BYTES) != hipSuccess || per_cu < 1) { fprintf(stderr, "kernel_launch: occupancy query says %d blocks per CU\n", per_cu); }
        (void)hipGetLastError();
        grid = cus;
    }
    if (grid < 0) return;
    if (hipMemsetAsync((char*)d_ws + WS_CTL, 0, CTL_ZERO_BYTES, stream) != hipSuccess) return;
    Args a{};
    for (int i = 0; i < 20; ++i) a.in[i] = (const float*)d_in[i];
    a.out = (float*)d_out; a.ws = (unsigned char*)d_ws;
    if (N_LAUNCHES == 1) { a.ph_lo = 0; a.ph_hi = NPHASE; hipLaunchKernelGGL(hybrid_fwd, dim3(grid), dim3(NWAVES * 64), LDS_BYTES, stream, a); }
    else for (int p = 0; p < NPHASE; ++p) { a.ph_lo = p; a.ph_hi = p + 1; hipLaunchKernelGGL(hybrid_fwd, dim3(grid), dim3(NWAVES * 64), LDS_BYTES, stream, a); }
}
```

```cpp
#include <hip/hip_runtime.h>
#include <cstdio>
#include <cstdint>
#ifndef MK_N_LAUNCHES
#define MK_N_LAUNCHES 1
#endif
#ifndef NSA_SB
#define NSA_SB()
#endif
namespace pg8 {
#define PG8_LAS __attribute__((address_space(3)))
typedef unsigned short bf16_t;
typedef short bf16x8 __attribute__((ext_vector_type(8)));
typedef float f32x4 __attribute__((ext_vector_type(4)));
typedef unsigned u32x4 __attribute__((ext_vector_type(4)));
constexpr int BM = 256, BK = 64, HALF = 128, HTB = HALF * BK * 2  , STAGE_BYTES = 8 * HTB, NXCD = 8, WGM = 8;

__host__ __device__ __forceinline__ int lds_byte(int r, int c) { const int st = (r >> 4) * 2 + (c >> 5), rr = r & 15, cc = c & 31, ob = rr * 64 + cc * 2; return st * 1024 + (ob ^ (((ob >> 9) & 1) << 5)); }
__host__ __device__ __forceinline__ void stage_rc(int b, int& R, int& C) { const int st = b / 1024, sb = b % 1024, swz = sb ^ (((sb >> 9) & 1) << 5); R = (st >> 1) * 16 + swz / 64; C = (st & 1) * 32 + (swz % 64) / 2; }
__host__ __device__ __forceinline__ int perm32(int rho) { const int n = rho >> 4, i = rho & 15; return 8 * (i >> 2) + 4 * n + (i & 3); }

struct Unit { int pm, pn; };
struct Gemm { const bf16_t* A; const bf16_t* Bt; int M, N, K; };

struct StaticOrder {
    int nM, nN, nwg, G, c;
    __host__ __device__ void init(int M, int N, int G_, int c_) { nM = M / BM; nN = N / BM; nwg = nM * nN; G = G_; c = c_; }
    __host__ __device__ bool next(int i, Unit& u) const {
        const long L = (long)i * G + c; if (L >= nwg) return false;
        int wgid = (int)L; { const int q = nwg / NXCD, r = nwg % NXCD, xcd = wgid % NXCD, off = wgid / NXCD; wgid = (xcd < r ? xcd * (q + 1) : r * (q + 1) + (xcd - r) * q) + off; }
        const int nig = WGM * nN, gid = wgid / nig, fm = gid * WGM, gsz = (nM - fm) < WGM ? (nM - fm) : WGM;
        u.pm = fm + ((wgid % nig) % gsz); u.pn = (wgid % nig) / gsz; return true;
    }
    __device__ __forceinline__ void a_ready(const Unit&) const {}
    __device__ __forceinline__ void done(const Unit&) const {}
};
struct LateOrder : StaticOrder {
    int nlate, cut, nfull;
    __host__ __device__ void init2(int M, int N, int G_, int c_, int nlate_, int cut_) { init(M, N, G_, c_); nlate = nlate_; cut = cut_; nfull = nwg / G_; }
    __host__ __device__ bool next(int i, Unit& u) const {
        long L;
        if (c < nlate) { if (i >= nfull - cut) return false; L = (long)i * G + c; }
        else if (i < nfull) L = (long)i * G + c;
        else { const int e = c - nlate; if (i > nfull || e >= nlate * cut) return false; L = (long)(nfull - cut + e / nlate) * G + (e % nlate); }
        int wgid = (int)L; { const int q = nwg / NXCD, r = nwg % NXCD, xcd = wgid % NXCD, off = wgid / NXCD; wgid = (xcd < r ? xcd * (q + 1) : r * (q + 1) + (xcd - r) * q) + off; }
        const int nig = WGM * nN, gid = wgid / nig, fm = gid * WGM, gsz = (nM - fm) < WGM ? (nM - fm) : WGM;
        u.pm = fm + ((wgid % nig) % gsz); u.pn = (wgid % nig) / gsz; return true;
    }
};


__device__ __forceinline__ unsigned cvt_pk_bf16(float lo, float hi) { unsigned r; asm volatile("v_cvt_pk_bf16_f32 %0, %1, %2" : "=v"(r) : "v"(lo), "v"(hi)); return r; }
typedef float f32x2 __attribute__((ext_vector_type(2)));
__device__ __forceinline__ float sigmoid_f(float x) { return __builtin_amdgcn_rcpf(1.0f + __expf(-x)); }
__device__ __forceinline__ float bf_lo(unsigned w) { return __uint_as_float(w << 16); }
__device__ __forceinline__ float bf_hi(unsigned w) { return __uint_as_float(w & 0xffff0000u); }

struct EpiU {
    static constexpr bool PERM = true, AFTER_DRAIN = false;
    bf16_t* O; int ldc; int pn_off; float scl; bool remap;
    __device__ __forceinline__ void operator()(const f32x4 (&acc)[2][2][4][2], const Unit& u, int wr, int wc, int fr, int fq) const {
        const int ct = (remap && u.pn == 44) ? 76 : u.pn + pn_off;
        const int row0 = u.pm * BM + wr * 64 + fr, col0 = ct * BM + wc * 32 + 8 * fq;
        const int mode = (ct >= 16 && ct < 24) ? 1 : ((ct >= 44 && ct < 76) ? 2 : (ct == 76 ? 3 : 0));
#pragma unroll
        for (int ai = 0; ai < 2; ++ai)
#pragma unroll
            for (int m = 0; m < 4; ++m) { bf16_t* rowp = O + (size_t)(row0 + ai * HALF + m * 16) * ldc + col0;
#pragma unroll
                for (int bj = 0; bj < 2; ++bj) { f32x4 v0 = acc[ai][bj][m][0] * scl, v1 = acc[ai][bj][m][1] * scl;
                    if (mode == 1) {
#pragma unroll
                        for (int j = 0; j < 4; ++j) { v0[j] = v0[j] * sigmoid_f(v0[j]); v1[j] = v1[j] * sigmoid_f(v1[j]); } }
                    else if (mode == 2 || (mode == 3 && (bj * HALF + wc * 32 + 8 * fq) >= 16)) {
#pragma unroll
                        for (int j = 0; j < 4; ++j) { v0[j] = sigmoid_f(v0[j]); v1[j] = sigmoid_f(v1[j]); } }
                    u32x4 w; w.x = cvt_pk_bf16(v0[0], v0[1]); w.y = cvt_pk_bf16(v0[2], v0[3]); w.z = cvt_pk_bf16(v1[0], v1[1]); w.w = cvt_pk_bf16(v1[2], v1[3]);
                    *(u32x4*)(rowp + bj * HALF) = w; } }
    }
};
template <int ACT> struct EpiAct {
    static constexpr bool PERM = true, AFTER_DRAIN = false;
    bf16_t* O; int ldc;
    __device__ __forceinline__ void operator()(const f32x4 (&acc)[2][2][4][2], const Unit& u, int wr, int wc, int fr, int fq) const {
        const int row0 = u.pm * BM + wr * 64 + fr, col0 = u.pn * BM + wc * 32 + 8 * fq;
#pragma unroll
        for (int ai = 0; ai < 2; ++ai)
#pragma unroll
            for (int m = 0; m < 4; ++m) { bf16_t* rowp = O + (size_t)(row0 + ai * HALF + m * 16) * ldc + col0;
#pragma unroll
                for (int bj = 0; bj < 2; ++bj) { f32x4 v0 = acc[ai][bj][m][0], v1 = acc[ai][bj][m][1];
                    if (ACT >= 1) {
#pragma unroll
                        for (int j = 0; j < 4; ++j) { v0[j] = fmaxf(v0[j], 0.f); v1[j] = fmaxf(v1[j], 0.f); if (ACT == 2) { v0[j] *= v0[j]; v1[j] *= v1[j]; } } }
                    u32x4 w; w.x = cvt_pk_bf16(v0[0], v0[1]); w.y = cvt_pk_bf16(v0[2], v0[3]); w.z = cvt_pk_bf16(v1[0], v1[1]); w.w = cvt_pk_bf16(v1[2], v1[3]);
                    *(u32x4*)(rowp + bj * HALF) = w; } }
    }
};
template <bool ACCUM> struct EpiMix {
    static constexpr bool PERM = true, AFTER_DRAIN = false;
    bf16_t* O; int ldc; const bf16_t* Gt; int ldg;
    __device__ __forceinline__ void operator()(const f32x4 (&acc)[2][2][4][2], const Unit& u, int wr, int wc, int fr, int fq) const {
        const int row0 = u.pm * BM + wr * 64 + fr, col0 = u.pn * BM + wc * 32 + 8 * fq;
#pragma unroll
        for (int ai = 0; ai < 2; ++ai)
#pragma unroll
            for (int m = 0; m < 4; ++m) { const size_t r = (size_t)(row0 + ai * HALF + m * 16); bf16_t* rowp = O + r * ldc + col0; const bf16_t* gp = Gt + r * ldg + col0;
#pragma unroll
                for (int bj = 0; bj < 2; ++bj) { f32x4 v0 = acc[ai][bj][m][0], v1 = acc[ai][bj][m][1];
                    const u32x4 gw = *(const u32x4*)(gp + bj * HALF);
                    v0[0] *= bf_lo(gw.x); v0[1] *= bf_hi(gw.x); v0[2] *= bf_lo(gw.y); v0[3] *= bf_hi(gw.y); v1[0] *= bf_lo(gw.z); v1[1] *= bf_hi(gw.z); v1[2] *= bf_lo(gw.w); v1[3] *= bf_hi(gw.w);
                    if (ACCUM) { const u32x4 ow = *(const u32x4*)(rowp + bj * HALF);
                        v0[0] += bf_lo(ow.x); v0[1] += bf_hi(ow.x); v0[2] += bf_lo(ow.y); v0[3] += bf_hi(ow.y); v1[0] += bf_lo(ow.z); v1[1] += bf_hi(ow.z); v1[2] += bf_lo(ow.w); v1[3] += bf_hi(ow.w); }
                    u32x4 w; w.x = cvt_pk_bf16(v0[0], v0[1]); w.y = cvt_pk_bf16(v0[2], v0[3]); w.z = cvt_pk_bf16(v1[0], v1[1]); w.w = cvt_pk_bf16(v1[2], v1[3]);
                    *(u32x4*)(rowp + bj * HALF) = w; } }
    }
};
struct EpiRes {
    static constexpr bool PERM = false, AFTER_DRAIN = false;
    const float* base; float* out; int ldc;
    __device__ __forceinline__ void operator()(const f32x4 (&acc)[2][2][4][2], const Unit& u, int wr, int wc, int fr, int fq) const {
        const int row0 = u.pm * BM + wr * 64 + fr, col0 = u.pn * BM + wc * 32 + 4 * fq;
#pragma unroll
        for (int ai = 0; ai < 2; ++ai)
#pragma unroll
            for (int m = 0; m < 4; ++m) { const size_t off = (size_t)(row0 + ai * HALF + m * 16) * ldc + col0;
#pragma unroll
                for (int bj = 0; bj < 2; ++bj)
#pragma unroll
                    for (int n = 0; n < 2; ++n) { const f32x4 bs = *(const f32x4*)(base + off + bj * HALF + n * 16); *(f32x4*)(out + off + bj * HALF + n * 16) = bs + acc[ai][bj][m][n]; } }
    }
};
struct EpiResN {
    static constexpr bool PERM = false, AFTER_DRAIN = false;
    const float* base; float* out; int ldc; const float* gain; bf16_t* XB; float* RS;
    __device__ __forceinline__ void operator()(const f32x4 (&acc)[2][2][4][2], const Unit& u, int wr, int wc, int fr, int fq) const {
        const int row0 = u.pm * BM + wr * 64 + fr, col0 = u.pn * BM + wc * 32 + 4 * fq;
        f32x4 gv[2][2];
#pragma unroll
        for (int bj = 0; bj < 2; ++bj)
#pragma unroll
            for (int n = 0; n < 2; ++n) gv[bj][n] = *(const f32x4*)(gain + col0 + bj * HALF + n * 16);
#pragma unroll
        for (int ai = 0; ai < 2; ++ai)
#pragma unroll
            for (int m = 0; m < 4; ++m) { const int row = row0 + ai * HALF + m * 16; const size_t off = (size_t)row * ldc + col0; float ss = 0.f;
#pragma unroll
                for (int bj = 0; bj < 2; ++bj)
#pragma unroll
                    for (int n = 0; n < 2; ++n) { const f32x4 bs = *(const f32x4*)(base + off + bj * HALF + n * 16); const f32x4 v = bs + acc[ai][bj][m][n]; *(f32x4*)(out + off + bj * HALF + n * 16) = v;
                        ss += (v[0] * v[0] + v[1] * v[1]) + (v[2] * v[2] + v[3] * v[3]);
                        const f32x4 w = v * gv[bj][n]; unsigned long long pk = (unsigned long long)cvt_pk_bf16(w[0], w[1]) | ((unsigned long long)cvt_pk_bf16(w[2], w[3]) << 32);
                        *(unsigned long long*)(XB + off + bj * HALF + n * 16) = pk; }
                ss += __shfl_xor(ss, 16); ss += __shfl_xor(ss, 32);
                if (fq == 0) RS[(size_t)row * 64 + u.pn * 4 + wc] = ss; }
    }
};
struct EpiRelu2R {
    static constexpr bool PERM = true, AFTER_DRAIN = false;
    bf16_t* O; int ldc; const float* rs2;
    __device__ __forceinline__ void operator()(const f32x4 (&acc)[2][2][4][2], const Unit& u, int wr, int wc, int fr, int fq) const {
        const int row0 = u.pm * BM + wr * 64 + fr, col0 = u.pn * BM + wc * 32 + 8 * fq;
#pragma unroll
        for (int ai = 0; ai < 2; ++ai)
#pragma unroll
            for (int m = 0; m < 4; ++m) { const int row = row0 + ai * HALF + m * 16; bf16_t* rowp = O + (size_t)row * ldc + col0; const float r2 = rs2[row];
#pragma unroll
                for (int bj = 0; bj < 2; ++bj) { f32x4 v0 = acc[ai][bj][m][0], v1 = acc[ai][bj][m][1];
#pragma unroll
                    for (int j = 0; j < 4; ++j) { v0[j] = fmaxf(v0[j], 0.f); v1[j] = fmaxf(v1[j], 0.f); v0[j] = v0[j] * v0[j] * r2; v1[j] = v1[j] * v1[j] * r2; }
                    u32x4 w; w.x = cvt_pk_bf16(v0[0], v0[1]); w.y = cvt_pk_bf16(v0[2], v0[3]); w.z = cvt_pk_bf16(v1[0], v1[1]); w.w = cvt_pk_bf16(v1[2], v1[3]);
                    *(u32x4*)(rowp + bj * HALF) = w; } }
    }
};


typedef int v8i_t __attribute__((ext_vector_type(8)));
template <class Epi, class Sched, bool ALIGN_EPI = false, bool SP2 = false, bool F8 = false, bool HALFSEL = false>
__device__ __forceinline__ void gemm_phase(PG8_LAS unsigned char* lds, const Gemm g, const Sched& S, const Epi& E, const int wid_in) {
    int lane_; asm volatile("v_mbcnt_lo_u32_b32 %0, -1, 0\n\tv_mbcnt_hi_u32_b32 %0, -1, %0" : "=v"(lane_));
    const int wid = wid_in, lane = lane_, tid = wid * 64 + lane, wr = wid >> 2, wc = wid & 3, fr = lane & 15, fq = lane >> 4;
    const int K = g.K, nt = K / BK;
    unsigned voffA[2], voffB[2];
#pragma unroll
    for (int i = 0; i < 2; ++i) { int R, C; stage_rc(tid * 16 + i * 8192, R, C); const int Rb = Epi::PERM ? ((R & ~31) + perm32(R & 31)) : R;
        voffA[i] = (unsigned)(R * K + C) * 2u; voffB[i] = (unsigned)(Rb * K + C) * 2u; }
    const size_t kstep = (size_t)(BK * 2);
    const size_t hstep = (size_t)HALF * K * 2;
    const size_t tstep = 2 * hstep;
    const unsigned ldsw = (unsigned)wid * 1024u;
    const int aoff = lds_byte(wr * 64 + fr, fq * 8), boff = lds_byte(wc * 32 + fr, fq * 8);
#define PG8_SA(b, h) (((b) * 2 + (h)) * HTB)
#define PG8_SB(b, h) ((4 + (b) * 2 + (h)) * HTB)
#define PG8_STAGE(bufoff, gbase, voff) do { _Pragma("unroll") for (int _i = 0; _i < 2; ++_i) \
        __builtin_amdgcn_global_load_lds((const unsigned*)((const char*)(gbase) + (voff)[_i]), (PG8_LAS unsigned*)(lds + (bufoff) + ldsw + _i * 8192), 16, 0, 0); } while (0)
#define PG8_LDA(dst, b, h) do { _Pragma("unroll") for (int m = 0; m < 4; ++m) { if constexpr (F8) { dst##8[m] = __builtin_bit_cast(v8i_t, __builtin_shufflevector(*(const PG8_LAS bf16x8*)(lds + PG8_SA(b, h) + aoff + m * 2048), *(const PG8_LAS bf16x8*)(lds + PG8_SA(b, h) + aoff + m * 2048 + 1024), 0, 1, 2, 3, 4, 5, 6, 7, 8, 9, 10, 11, 12, 13, 14, 15)); } \
        else { _Pragma("unroll") for (int k = 0; k < 2; ++k) dst[m][k] = *(const PG8_LAS bf16x8*)(lds + PG8_SA(b, h) + aoff + m * 2048 + k * 1024); } } } while (0)
#define PG8_LDB(dst, b, h) do { _Pragma("unroll") for (int n = 0; n < 2; ++n) { if constexpr (F8) { dst##8[n] = __builtin_bit_cast(v8i_t, __builtin_shufflevector(*(const PG8_LAS bf16x8*)(lds + PG8_SB(b, h) + boff + n * 2048), *(const PG8_LAS bf16x8*)(lds + PG8_SB(b, h) + boff + n * 2048 + 1024), 0, 1, 2, 3, 4, 5, 6, 7, 8, 9, 10, 11, 12, 13, 14, 15)); } \
        else { _Pragma("unroll") for (int k = 0; k < 2; ++k) dst[n][k] = *(const PG8_LAS bf16x8*)(lds + PG8_SB(b, h) + boff + n * 2048 + k * 1024); } } } while (0)
#define PG8_MMA(ai, bj, At, Bt) do { if (HALFSEL && !((bjm >> (bj)) & 1)) break; __builtin_amdgcn_s_setprio(1); _Pragma("unroll") for (int m = 0; m < 4; ++m) _Pragma("unroll") for (int n = 0; n < 2; ++n) { \
        if constexpr (F8) { asm volatile("v_mfma_f32_16x16x128_f8f6f4 %0, %1, %2, %0" : "+v"(acc[ai][bj][m][n]) : "v"(Bt##8[n]), "v"(At##8[m])); } \
        else { _Pragma("unroll") for (int k = 0; k < 2; ++k) acc[ai][bj][m][n] = __builtin_amdgcn_mfma_f32_16x16x32_bf16(Bt[n][k], At[m][k], acc[ai][bj][m][n], 0, 0, 0); } } __builtin_amdgcn_s_setprio(0); } while (0)
#define PG8_WAIT_V(n) asm volatile("s_waitcnt vmcnt(" #n ")" ::: "memory")
#define PG8_WAIT_L(n) asm volatile("s_waitcnt lgkmcnt(" #n ")" ::: "memory")
#define PG8_BAR __builtin_amdgcn_s_barrier()
#define PG8_SCHED __builtin_amdgcn_sched_barrier(0)
    Unit cur, nxt; int ui = 0;
    if (!S.next(0, cur)) return;
    f32x4 acc[2][2][4][2];
#pragma unroll
    for (int a = 0; a < 2; ++a)
#pragma unroll
        for (int b = 0; b < 2; ++b)
#pragma unroll
            for (int m = 0; m < 4; ++m)
#pragma unroll
                for (int n = 0; n < 2; ++n) acc[a][b][m][n] = (f32x4){0.f, 0.f, 0.f, 0.f};
    bf16x8 At[4][2], B0[2][2], B1[2][2]; v8i_t At8[4], B08[2], B18[2]; (void)At; (void)B0; (void)B1; (void)At8; (void)B08; (void)B18;
    const char* cA = (const char*)g.A + (size_t)cur.pm * tstep; const char* cB = (const char*)g.Bt + (size_t)cur.pn * tstep;
    S.a_ready(cur);
    if constexpr (SP2) {
        PG8_STAGE(PG8_SB(0, 0), cB, voffB); PG8_STAGE(PG8_SB(0, 1), cB + hstep, voffB); PG8_STAGE(PG8_SA(0, 0), cA, voffA); PG8_STAGE(PG8_SA(0, 1), cA + hstep, voffA);
        if (wr == 1) PG8_BAR;
        PG8_WAIT_V(2); PG8_BAR;
        PG8_STAGE(PG8_SB(1, 0), cB + kstep, voffB); PG8_STAGE(PG8_SA(1, 0), cA + kstep, voffA); PG8_STAGE(PG8_SB(1, 1), cB + hstep + kstep, voffB);
        PG8_WAIT_V(6); PG8_BAR;
    } else {
        PG8_STAGE(PG8_SB(0, 0), cB, voffB); PG8_STAGE(PG8_SA(0, 0), cA, voffA); PG8_STAGE(PG8_SB(0, 1), cB + hstep, voffB); PG8_STAGE(PG8_SA(0, 1), cA + hstep, voffA);
        if (wr == 1) PG8_BAR;
        PG8_WAIT_V(4); PG8_BAR;
        PG8_STAGE(PG8_SB(1, 0), cB + kstep, voffB); PG8_STAGE(PG8_SA(1, 0), cA + kstep, voffA); PG8_STAGE(PG8_SB(1, 1), cB + hstep + kstep, voffB);
        PG8_WAIT_V(6); PG8_BAR;
    }
    for (;;) {
        const int bjm = HALFSEL ? ((2 * cur.pm < g.M / BM) ? 1 : 2) : 3; (void)bjm;
        const bool has_next = S.next(ui + 1, nxt);
        const char* nA = has_next ? (const char*)g.A + (size_t)nxt.pm * tstep : cA; const char* nB = has_next ? (const char*)g.Bt + (size_t)nxt.pn * tstep : cB;
        for (int t = 0; t < nt; t += 2) {
            const bool last = (t == nt - 2);
            const char* a1 = cA + (size_t)(t + 1) * kstep;
            const char* a2 = last ? nA : cA + (size_t)(t + 2) * kstep; const char* b2 = last ? nB : cB + (size_t)(t + 2) * kstep;
            const char* a3 = a2 + kstep; const char* b3 = b2 + kstep;
            if (last && has_next) S.a_ready(nxt);
            if constexpr (SP2) {
            PG8_LDB(B0, 0, 0); PG8_LDB(B1, 0, 1); PG8_SCHED; PG8_LDA(At, 0, 0); PG8_STAGE(PG8_SA(1, 1), a1 + hstep, voffA);
            PG8_WAIT_V(8); PG8_WAIT_L(0); PG8_BAR; PG8_MMA(0, 0, At, B0); PG8_MMA(0, 1, At, B1); PG8_BAR; PG8_SCHED;
            PG8_LDA(At, 0, 1); PG8_STAGE(PG8_SB(0, 0), b2, voffB); PG8_STAGE(PG8_SB(0, 1), b2 + hstep, voffB); PG8_STAGE(PG8_SA(0, 0), a2, voffA);
            PG8_WAIT_V(8); PG8_WAIT_L(0); PG8_BAR; PG8_MMA(1, 0, At, B0); PG8_MMA(1, 1, At, B1); PG8_BAR; PG8_SCHED;
            PG8_LDB(B0, 1, 0); PG8_LDB(B1, 1, 1); PG8_SCHED; PG8_LDA(At, 1, 0); PG8_STAGE(PG8_SA(0, 1), a2 + hstep, voffA);
            PG8_WAIT_V(8); PG8_WAIT_L(0); PG8_BAR; PG8_MMA(0, 0, At, B0); PG8_MMA(0, 1, At, B1); PG8_BAR; PG8_SCHED;
            PG8_LDA(At, 1, 1); PG8_STAGE(PG8_SB(1, 0), b3, voffB); PG8_STAGE(PG8_SB(1, 1), b3 + hstep, voffB); PG8_STAGE(PG8_SA(1, 0), a3, voffA);
            PG8_WAIT_V(8); PG8_WAIT_L(0); PG8_BAR; PG8_MMA(1, 0, At, B0); PG8_MMA(1, 1, At, B1); PG8_BAR; PG8_SCHED;
            } else {
            PG8_LDB(B0, 0, 0); PG8_SCHED; PG8_LDA(At, 0, 0); PG8_STAGE(PG8_SA(1, 1), a1 + hstep, voffA);
            PG8_WAIT_L(8); PG8_BAR; PG8_WAIT_L(0); PG8_MMA(0, 0, At, B0); PG8_BAR; PG8_SCHED;
            PG8_LDB(B1, 0, 1); PG8_STAGE(PG8_SB(0, 0), b2, voffB);
            PG8_BAR; PG8_WAIT_L(0); PG8_MMA(0, 1, At, B1); PG8_BAR;
            PG8_LDA(At, 0, 1); PG8_STAGE(PG8_SA(0, 0), a2, voffA);
            PG8_BAR; PG8_WAIT_L(0); PG8_MMA(1, 0, At, B0); PG8_BAR; PG8_SCHED;
            PG8_STAGE(PG8_SB(0, 1), b2 + hstep, voffB);
            PG8_WAIT_V(6); PG8_BAR; PG8_MMA(1, 1, At, B1); PG8_BAR;
            PG8_LDB(B0, 1, 0); PG8_SCHED; PG8_LDA(At, 1, 0); PG8_STAGE(PG8_SA(0, 1), a2 + hstep, voffA);
            PG8_WAIT_L(8); PG8_BAR; PG8_WAIT_L(0); PG8_MMA(0, 0, At, B0); PG8_BAR; PG8_SCHED;
            PG8_LDB(B1, 1, 1); PG8_STAGE(PG8_SB(1, 0), b3, voffB);
            PG8_BAR; PG8_WAIT_L(0); PG8_MMA(0, 1, At, B1); PG8_BAR;
            PG8_LDA(At, 1, 1); PG8_STAGE(PG8_SA(1, 0), a3, voffA);
            PG8_BAR; PG8_WAIT_L(0); PG8_MMA(1, 0, At, B0); PG8_BAR; PG8_SCHED;
            PG8_STAGE(PG8_SB(1, 1), b3 + hstep, voffB);
            PG8_WAIT_V(6); PG8_BAR; PG8_MMA(1, 1, At, B1); PG8_BAR;
            }
        }
        if constexpr (ALIGN_EPI) { if (wr == 0) PG8_BAR; }
        if constexpr (F8) {
            asm volatile("s_nop 15\n\ts_nop 15\n\ts_nop 7" : "+v"(acc[0][0][0][0]), "+v"(acc[0][0][0][1]), "+v"(acc[0][0][1][0]), "+v"(acc[0][0][1][1]), "+v"(acc[0][0][2][0]), "+v"(acc[0][0][2][1]), "+v"(acc[0][0][3][0]), "+v"(acc[0][0][3][1]), "+v"(acc[0][1][0][0]), "+v"(acc[0][1][0][1]), "+v"(acc[0][1][1][0]), "+v"(acc[0][1][1][1]), "+v"(acc[0][1][2][0]), "+v"(acc[0][1][2][1]), "+v"(acc[0][1][3][0]), "+v"(acc[0][1][3][1]));
            asm volatile("s_nop 0" : "+v"(acc[1][0][0][0]), "+v"(acc[1][0][0][1]), "+v"(acc[1][0][1][0]), "+v"(acc[1][0][1][1]), "+v"(acc[1][0][2][0]), "+v"(acc[1][0][2][1]), "+v"(acc[1][0][3][0]), "+v"(acc[1][0][3][1]), "+v"(acc[1][1][0][0]), "+v"(acc[1][1][0][1]), "+v"(acc[1][1][1][0]), "+v"(acc[1][1][1][1]), "+v"(acc[1][1][2][0]), "+v"(acc[1][1][2][1]), "+v"(acc[1][1][3][0]), "+v"(acc[1][1][3][1])); }
        if constexpr (!Epi::AFTER_DRAIN) { E(acc, cur, wr, wc, fr, fq); S.done(cur); }
        if (!has_next) break;
#pragma unroll
        for (int a = 0; a < 2; ++a)
#pragma unroll
            for (int b = 0; b < 2; ++b)
#pragma unroll
                for (int m = 0; m < 4; ++m)
#pragma unroll
                    for (int n = 0; n < 2; ++n) acc[a][b][m][n] = (f32x4){0.f, 0.f, 0.f, 0.f};
        cur = nxt; cA = nA; cB = nB; ++ui;
        if constexpr (ALIGN_EPI) { if (wr == 1) PG8_BAR; }
    }
    PG8_WAIT_V(0);
    if constexpr (!ALIGN_EPI) { if (wr == 0) PG8_BAR; }
    PG8_BAR;
    if constexpr (Epi::AFTER_DRAIN) { E.fused(acc, cur, wr, wc, fr, fq, lds, wid, lane); S.done(cur); }
#undef PG8_SA
#undef PG8_SB
#undef PG8_STAGE
#undef PG8_LDA
#undef PG8_LDB
#undef PG8_MMA
#undef PG8_WAIT_V
#undef PG8_WAIT_L
#undef PG8_BAR
#undef PG8_SCHED
}
}

constexpr int NWAVES = 8;
constexpr int N_LAUNCHES = MK_N_LAUNCHES;
constexpr int NPHASE = 12;
constexpr int BATCH = 4, SEQ = 4096, M = BATCH * SEQ, D = 4096, FF = 16384;
constexpr int NIN = 19520, LDU = 19712;
constexpr int GLA_H = 16, GLA_DK = 64, GLA_DV = 128;
constexpr int NSA_G = 4, NSA_R = 4, NSA_D = 128;
constexpr float NORM_EPS = 1e-6f;
constexpr int U_GQ = 0, U_GK = 1024, U_GV = 2048, U_GR = 4096, U_NQ = 6144, U_KC = 8192, U_VC = 8704, U_KSL = 9216, U_VSL = 9728, U_KW = 10240, U_VW = 10752,
              U_MG = 11264, U_MN = 15360, U_GA = 19456, U_NG = 19472;
__host__ __device__ __forceinline__ int orig_col(int n) {
    if (n < 4096) return n;
    if (n < 6144) return n - 4096 + 4112;
    if (n < 11264) return n - 6144 + 6160;
    if (n < 19456) return n - 11264 + 11328;
    if (n < 19472) return n - 19456 + 4096;
    if (n < 19520) return n - 19472 + 11280;
    return -1;
}
constexpr size_t MiB = 1u << 20;
constexpr size_t WS_CTL = 0, CTL_ZERO_BYTES = 1 * MiB;
constexpr size_t WS_W1C = 1 * MiB;
constexpr size_t WS_W2B = 3 * MiB;
constexpr size_t WS_HC = 4 * MiB;
constexpr size_t WS_OC = 8 * MiB;
constexpr size_t WS_RS = 12 * MiB;
constexpr size_t WS_RS2 = 3 * MiB + 256 * 1024;
constexpr size_t WS_U = 16 * MiB;
constexpr size_t WS_R2 = 632 * MiB;
constexpr size_t WS_WIN = WS_R2;
constexpr size_t WS_H = WS_R2 + 154 * MiB;
constexpr size_t WS_OGLA = WS_R2;
constexpr size_t WS_ONSA = WS_R2 + 64 * MiB;
constexpr size_t WS_MIX = WS_R2 + 128 * MiB;
constexpr size_t WS_ACMP = WS_R2 + 128 * MiB;
constexpr size_t WS_H2 = WS_R2;
constexpr size_t WS_WDOWN = WS_R2 + 128 * MiB;
constexpr size_t WS_WGLA = 914 * MiB, WS_WNSA = 930 * MiB, WS_WOUT = 946 * MiB, WS_WUP = 978 * MiB, WS_H8 = 1106 * MiB, WS_END = 1170 * MiB;
#ifndef GATE_FP8
#define GATE_FP8 1
#endif
constexpr int NB16 = GATE_FP8 ? 11520 : LDU;
constexpr int NG8 = 8192;
constexpr size_t WS_WG8 = WS_R2 + 90 * MiB;
constexpr int CW_TMO = 0, CW_BAR = 4096;
constexpr int RING_BYTES = 155648, LDSCTL_OFF = RING_BYTES, MISC_OFF = LDSCTL_OFF + 320, LDS_BYTES = 157696;

#define GAS __attribute__((address_space(1)))
#define LAS __attribute__((address_space(3)))
typedef unsigned short bf16;
typedef unsigned v4u __attribute__((ext_vector_type(4)));
typedef unsigned v2u __attribute__((ext_vector_type(2)));
typedef float f32x4 __attribute__((ext_vector_type(4)));
typedef GAS unsigned gu32;
#define RLX_AGENT __ATOMIC_RELAXED, __HIP_MEMORY_SCOPE_AGENT
#define LDS_WAIT() asm volatile("s_waitcnt lgkmcnt(0)" ::: "memory")
#define VM_WAIT() asm volatile("s_waitcnt vmcnt(0)" ::: "memory")
__device__ __forceinline__ unsigned f2bf(float f) { unsigned u = __builtin_bit_cast(unsigned, f); return (u + 0x7fffu + ((u >> 16) & 1u)) >> 16; }
__device__ __forceinline__ unsigned pk2(float lo, float hi) { return f2bf(lo) | (f2bf(hi) << 16); }
__device__ __forceinline__ float bfl(unsigned w) { return __uint_as_float(w << 16); }
__device__ __forceinline__ float bfh(unsigned w) { return __uint_as_float(w & 0xffff0000u); }

struct Args { const float* in[20]; float* out; unsigned char* ws; int ph_lo, ph_hi; };
typedef const __attribute__((address_space(4))) Args* KArgs;
__device__ __forceinline__ KArgs fresh_args() { KArgs p = (KArgs)__builtin_amdgcn_kernarg_segment_ptr(); asm volatile("" : "+s"(p)); return p; }
#define AIN ap->in
#define XB_TMO      128
#define XB_XCNT(j)  (256  + 64 * (j))
#define XB_XSUB(j)  (1280 + 64 * (j))
#define XB_XGEN(j)  (2304 + 64 * (j))
#define XB_TOP      3328
#define XB_TOPGEN   3392
#define XCD_BAR_WORDS 3456
#define XB_SPIN_CAP (1u << 22)
__device__ __forceinline__ unsigned xb_ld(unsigned* p)              { return __hip_atomic_load(p, __ATOMIC_RELAXED, __HIP_MEMORY_SCOPE_AGENT); }
__device__ __forceinline__ unsigned xb_add(unsigned* p, unsigned v) { return __hip_atomic_fetch_add(p, v, __ATOMIC_RELAXED, __HIP_MEMORY_SCOPE_AGENT); }
__device__ __forceinline__ unsigned xb_xcc_id() { return (unsigned)__builtin_amdgcn_s_getreg((3 << 11) | 20) & 0xFu; }
#define XB_SPIN(cond, bar) do { unsigned _sp = 0; while (cond) { __builtin_amdgcn_s_sleep(1); \
    if ((++_sp & 255u) == 0u) { if (xb_ld(&(bar)[XB_TMO])) break; if (_sp > XB_SPIN_CAP) { atomicAdd(&(bar)[XB_TMO], 1u); break; } } } } while (0)

struct XcdBarrier {
    unsigned* bar; unsigned x;
    volatile LAS unsigned* st;
};

__device__ __forceinline__ XcdBarrier xcd_barrier_post(unsigned* bar, volatile LAS unsigned* st) {
    XcdBarrier b; b.bar = bar; b.x = xb_xcc_id(); b.st = st;
    if (threadIdx.x == 0) (void)xb_add(&bar[XB_XCNT(b.x)], 1u);
    return b;
}
__device__ __forceinline__ void xcd_barrier_complete(unsigned* bar, unsigned x, unsigned& nloc, unsigned& nx) {
    const unsigned G = gridDim.x * gridDim.y * gridDim.z;
    unsigned sum, cnt, mine, sp = 0u;
    for (;;) {
        sum = 0u; cnt = 0u; mine = 0u;
#pragma unroll
        for (unsigned j = 0; j < 16; ++j) { const unsigned c = xb_ld(&bar[XB_XCNT(j)]); sum += c; cnt += (c > 0u) ? 1u : 0u; mine = (j == x) ? c : mine; }
        if (sum == G) break;
        __builtin_amdgcn_s_sleep(1);
        if ((++sp & 255u) == 0u) { if (xb_ld(&bar[XB_TMO])) break; if (sp > XB_SPIN_CAP) { atomicAdd(&bar[XB_TMO], 1u); break; } }
    }
    nloc = mine > 0u ? mine : 1u; nx = cnt > 0u ? cnt : 1u;
}

__device__ __forceinline__ void xcd_barrier(const XcdBarrier& b, const int wave) {
    int lane_; asm volatile("v_mbcnt_lo_u32_b32 %0, -1, 0\n\tv_mbcnt_hi_u32_b32 %0, -1, %0" : "=v"(lane_)); const bool is_t0 = (wave == 0) && (lane_ == 0);
    asm volatile("s_waitcnt vmcnt(0)" ::: "memory");
    __syncthreads();
    if (is_t0) {
        unsigned* bar = b.bar;
        __builtin_amdgcn_s_waitcnt(0);
        unsigned nloc = b.st[0], nx = b.st[1];
        if (nloc == 0u) { xcd_barrier_complete(bar, b.x, nloc, nx); b.st[0] = nloc; b.st[1] = nx; }
        const unsigned old = xb_add(&bar[XB_XSUB(b.x)], 1u);
        const unsigned gen = old / nloc;
        if (old + 1u == (gen + 1u) * nloc) {
            __builtin_amdgcn_fence(__ATOMIC_RELEASE, "agent");
            asm volatile("s_waitcnt vmcnt(0)" ::: "memory");
            const unsigned og = xb_add(&bar[XB_TOP], 1u);
            const unsigned tg = og / nx;
            if (og + 1u == (tg + 1u) * nx) xb_add(&bar[XB_TOPGEN], 1u);
            else XB_SPIN(xb_ld(&bar[XB_TOPGEN]) == tg, bar);
            __builtin_amdgcn_fence(__ATOMIC_ACQUIRE, "agent");
            xb_add(&bar[XB_XGEN(b.x)], 1u);
            asm volatile("s_waitcnt vmcnt(0)" ::: "memory");
        } else {
            XB_SPIN(xb_ld(&bar[XB_XGEN(b.x)]) == gen, bar);
            __builtin_amdgcn_fence(__ATOMIC_ACQUIRE, "agent");
            asm volatile("s_waitcnt vmcnt(0)" ::: "memory");
        }
    }
    __syncthreads();
}

struct Frame {
    LAS unsigned char* lds;
    volatile LAS unsigned* MISC;
    int tid, lane, wave, G, blk;
};
__device__ __forceinline__ float wave_sum(float v) {
#pragma unroll
    for (int o = 1; o < 64; o <<= 1) v += __shfl_xor(v, o);
    return v;
}
__device__ __forceinline__ float wave_max(float v) {
#pragma unroll
    for (int o = 1; o < 64; o <<= 1) v = fmaxf(v, __shfl_xor(v, o));
    return v;
}
__device__ const unsigned char REL_LUT[128] = {0,1,2,3,4,5,6,7,8,9,10,11,12,13,14,15,16,16,16,17,17,18,18,18,19,19,19,20,20,20,20,21,21,21,21,22,22,22,22,22,23,23,23,23,23,23,24,24,24,24,24,24,25,25,25,25,25,25,25,
    26,26,26,26,26,26,26,26,27,27,27,27,27,27,27,27,27,27,28,28,28,28,28,28,28,28,28,28,29,29,29,29,29,29,29,29,29,29,29,29,30,30,30,30,30,30,30,30,30,30,30,30,30,30,31,31,31,31,31,31,31,31,31,31,31,31,31,31,31};

__device__ __forceinline__ float fp8_rt(float v) { const int p = __builtin_amdgcn_cvt_pk_fp8_f32(v, v, 0, false); return __builtin_amdgcn_cvt_f32_fp8(p, 0); }
__device__ __forceinline__ unsigned pk4_fp8(float a, float b, float c, float d) { int p = __builtin_amdgcn_cvt_pk_fp8_f32(a, b, 0, false); p = __builtin_amdgcn_cvt_pk_fp8_f32(c, d, p, true); return (unsigned)p; }
__device__ __forceinline__ void transpose_item_fp8(const float* W, int K, int ldw, unsigned char* WT8, int dst_row0, int src_col, int k0, LAS float* scr, int lane, float mul) {
#pragma unroll 8
    for (int i = 0; i < 32; ++i) { const int kk = 2 * i + (lane >> 5); scr[kk * 33 + (lane & 31)] = W[(size_t)(k0 + kk) * ldw + src_col] * mul; }
    LDS_WAIT(); asm volatile("" ::: "memory");
    const int c = lane & 7;
#pragma unroll
    for (int j = 0; j < 4; ++j) { const int n = (lane >> 3) + 8 * j; const LAS float* s = scr + (8 * c) * 33 + n;
        v2u o; o.x = pk4_fp8(s[0 * 33], s[1 * 33], s[2 * 33], s[3 * 33]); o.y = pk4_fp8(s[4 * 33], s[5 * 33], s[6 * 33], s[7 * 33]);
        *(GAS v2u*)(WT8 + (size_t)(dst_row0 + n) * K + k0 + 8 * c) = o; }
    LDS_WAIT(); asm volatile("" ::: "memory");
}
__device__ __forceinline__ void transpose_item(const float* W, int K, int ldw, bf16* WT, int dst_row0, int src_col, int k0, LAS float* scr, int lane, bool q8 = false) {
#pragma unroll 8
    for (int i = 0; i < 32; ++i) { const int kk = 2 * i + (lane >> 5); float wv = src_col >= 0 ? W[(size_t)(k0 + kk) * ldw + src_col] : 0.f; if (q8) wv = fp8_rt(wv * 64.f) * (1.f / 64.f); scr[kk * 33 + (lane & 31)] = wv; }
    LDS_WAIT(); asm volatile("" ::: "memory");
    const int c = lane & 7;
#pragma unroll
    for (int j = 0; j < 4; ++j) { const int n = (lane >> 3) + 8 * j; const LAS float* s = scr + (8 * c) * 33 + n;
        v4u o; o.x = pk2(s[0 * 33], s[1 * 33]); o.y = pk2(s[2 * 33], s[3 * 33]); o.z = pk2(s[4 * 33], s[5 * 33]); o.w = pk2(s[6 * 33], s[7 * 33]);
        *(GAS v4u*)(WT + (size_t)(dst_row0 + n) * K + k0 + 8 * c) = o; }
    LDS_WAIT(); asm volatile("" ::: "memory");
}
__device__ __forceinline__ void transpose_plain(const float* W, int K, int N, bf16* WT, int row_off, int item, LAS float* scr, int lane) {
    const int nblk = N / 32, kb = item / nblk, nb = item % nblk;
    transpose_item(W, K, N, WT, row_off + 32 * nb, 32 * nb + (lane & 31), 64 * kb, scr, lane);
}
__device__ __forceinline__ void rms_row_to_bf16(const float* xrow, const float* gain, bf16* orow, int lane, bool q8 = false, unsigned char* o8row = nullptr) {
    const GAS f32x4* xr = (const GAS f32x4*)xrow + lane; const GAS f32x4* gr = (const GAS f32x4*)gain + lane;
    f32x4 v[16]; float s = 0.f;
#pragma unroll
    for (int j = 0; j < 16; ++j) { v[j] = xr[64 * j]; s += (v[j].x * v[j].x + v[j].y * v[j].y) + (v[j].z * v[j].z + v[j].w * v[j].w); }
    const float rstd = 1.f / sqrtf(wave_sum(s) * (1.f / D) + NORM_EPS);
    GAS v2u* o8 = (GAS v2u*)orow + lane;
#pragma unroll
    for (int j = 0; j < 16; ++j) { const f32x4 g = gr[64 * j]; float a0 = v[j].x * rstd * g.x, a1 = v[j].y * rstd * g.y, a2 = v[j].z * rstd * g.z, a3 = v[j].w * rstd * g.w;
        if (q8) { a0 = fp8_rt(a0); a1 = fp8_rt(a1); a2 = fp8_rt(a2); a3 = fp8_rt(a3); }
        v2u o; o.x = pk2(a0, a1); o.y = pk2(a2, a3); o8[64 * j] = o;
        if (o8row) ((GAS unsigned*)o8row)[lane + 64 * j] = pk4_fp8(a0, a1, a2, a3); }
}
__device__ __forceinline__ void rms_row_inplace(float* xrow, const float* gain, int lane) {
    GAS f32x4* xr = (GAS f32x4*)xrow + lane; const GAS f32x4* gr = (const GAS f32x4*)gain + lane;
    f32x4 v[16]; float s = 0.f;
#pragma unroll
    for (int j = 0; j < 16; ++j) { v[j] = xr[64 * j]; s += (v[j].x * v[j].x + v[j].y * v[j].y) + (v[j].z * v[j].z + v[j].w * v[j].w); }
    const float rstd = 1.f / sqrtf(wave_sum(s) * (1.f / D) + NORM_EPS);
#pragma unroll
    for (int j = 0; j < 16; ++j) { const f32x4 g = gr[64 * j]; xr[64 * j] = (f32x4){v[j].x * rstd * g.x, v[j].y * rstd * g.y, v[j].z * rstd * g.z, v[j].w * rstd * g.w}; }
}

#ifndef FP8_EMU_W
#define FP8_EMU_W false
#endif
#ifndef FP8_EMU_H
#define FP8_EMU_H false
#endif
__device__ __forceinline__ void rms_rows(Frame& F, const float* X, const float* gain, bf16* H, unsigned char* H8, float* OUT, const int gw, const int NGW) {
    f32x4 v[16];
    if (gw < M) { const GAS f32x4* xr = (const GAS f32x4*)(X + (size_t)gw * D) + F.lane;
#pragma unroll
        for (int j = 0; j < 16; ++j) v[j] = xr[64 * j]; }
    for (int m = gw; m < M; m += NGW) { f32x4 vn[16]; const bool has = m + NGW < M;
        if (has) { const GAS f32x4* xr = (const GAS f32x4*)(X + (size_t)(m + NGW) * D) + F.lane;
#pragma unroll
            for (int j = 0; j < 16; ++j) vn[j] = xr[64 * j]; }
        float ssum = 0.f;
#pragma unroll
        for (int j = 0; j < 16; ++j) ssum += (v[j].x * v[j].x + v[j].y * v[j].y) + (v[j].z * v[j].z + v[j].w * v[j].w);
        const float rstd = 1.f / sqrtf(wave_sum(ssum) * (1.f / D) + NORM_EPS);
        const GAS f32x4* gr = (const GAS f32x4*)gain + F.lane;
#pragma unroll
        for (int j = 0; j < 16; ++j) { const f32x4 g = gr[64 * j]; const float a0 = v[j].x * rstd * g.x, a1 = v[j].y * rstd * g.y, a2 = v[j].z * rstd * g.z, a3 = v[j].w * rstd * g.w;
            if (OUT) ((GAS f32x4*)(OUT + (size_t)m * D) + F.lane)[64 * j] = (f32x4){a0, a1, a2, a3};
            if (H) { v2u o; o.x = pk2(a0, a1); o.y = pk2(a2, a3); ((GAS v2u*)(H + (size_t)m * D) + F.lane)[64 * j] = o; }
            if (H8) ((GAS unsigned*)(H8 + (size_t)m * D))[F.lane + 64 * j] = pk4_fp8(a0, a1, a2, a3); }
        if (has) {
#pragma unroll
            for (int j = 0; j < 16; ++j) v[j] = vn[j]; } }
}
struct TD { const float* W; unsigned char* WT; int K, ldw, drow, k0, scol, f8; };
template <class Dec> __device__ __forceinline__ void transpose_stream(Frame& F, const Dec& decode, const int NITEMS, LAS float* scr, const int gw, const int NGW) {
    float tv[32];
    if (gw < NITEMS) { const TD d = decode(gw);
#pragma unroll
        for (int i = 0; i < 32; ++i) tv[i] = d.scol >= 0 ? d.W[(size_t)(d.k0 + 2 * i + (F.lane >> 5)) * d.ldw + d.scol] : 0.f; }
    for (int it = gw; it < NITEMS; it += NGW) {
        const TD d = decode(it); const bool has = it + NGW < NITEMS; float tn[32];
        if (has) { const TD e = decode(it + NGW);
#pragma unroll
            for (int i = 0; i < 32; ++i) tn[i] = e.scol >= 0 ? e.W[(size_t)(e.k0 + 2 * i + (F.lane >> 5)) * e.ldw + e.scol] : 0.f; }
        const float mul = d.f8 ? 64.f : 1.f;
#pragma unroll
        for (int i = 0; i < 32; ++i) scr[(2 * i + (F.lane >> 5)) * 33 + (F.lane & 31)] = tv[i] * mul;
        LDS_WAIT(); asm volatile("" ::: "memory");
        const int c = F.lane & 7;
#pragma unroll
        for (int j = 0; j < 4; ++j) { const int n = (F.lane >> 3) + 8 * j; const LAS float* sp = scr + (8 * c) * 33 + n;
            if (d.f8) { v2u o; o.x = pk4_fp8(sp[0 * 33], sp[1 * 33], sp[2 * 33], sp[3 * 33]); o.y = pk4_fp8(sp[4 * 33], sp[5 * 33], sp[6 * 33], sp[7 * 33]); *(GAS v2u*)(d.WT + (size_t)(d.drow + n) * d.K + d.k0 + 8 * c) = o; }
            else { v4u o; o.x = pk2(sp[0 * 33], sp[1 * 33]); o.y = pk2(sp[2 * 33], sp[3 * 33]); o.z = pk2(sp[4 * 33], sp[5 * 33]); o.w = pk2(sp[6 * 33], sp[7 * 33]); *(GAS v4u*)((bf16*)d.WT + (size_t)(d.drow + n) * d.K + d.k0 + 8 * c) = o; } }
        LDS_WAIT(); asm volatile("" ::: "memory");
        if (has) {
#pragma unroll
            for (int i = 0; i < 32; ++i) tv[i] = tn[i]; }
    }
}
__device__ __forceinline__ void p0_prologue(Frame& F, KArgs ap) {
    unsigned char* ws_ = ap->ws;
    LAS float* scr = (LAS float*)(F.lds + F.wave * 16384);
    const int gw = F.blk * NWAVES + F.wave, NGW = F.G * NWAVES;
    bf16* WinT = (bf16*)(ws_ + WS_WIN); bf16* WglaT = (bf16*)(ws_ + WS_WGLA); bf16* WnsaT = (bf16*)(ws_ + WS_WNSA); bf16* WoutT = (bf16*)(ws_ + WS_WOUT); bf16* WupT = (bf16*)(ws_ + WS_WUP);
    bf16* W1cT = (bf16*)(ws_ + WS_W1C); bf16* W2bT = (bf16*)(ws_ + WS_W2B);
    constexpr int I_IN = (D / 64) * (NB16 / 32), I_G8 = GATE_FP8 ? (D / 64) * (NG8 / 32) : 0, I_GLA = (2048 / 64) * (D / 32), I_NSA = I_GLA, I_OUT = (D / 64) * (D / 32), I_UP = (D / 64) * (FF / 32), I_PHI = (4096 / 64) * (128 / 32);
    constexpr int NITEMS = I_IN + I_G8 + I_GLA + I_NSA + I_OUT + I_UP + 2 * I_PHI;
    auto decode = [&](int it) -> TD { TD d; int r = it; d.f8 = 0;
        if (r < I_IN) { const int nblk = NB16 / 32, kb = r / nblk, nb = r % nblk; const int ucol = (!GATE_FP8 || 32 * nb < 11264) ? 32 * nb : 32 * nb - 11264 + 19456;
            d.W = AIN[2]; d.WT = (unsigned char*)WinT; d.K = D; d.ldw = NIN; d.drow = 32 * nb; d.k0 = 64 * kb; d.scol = orig_col(ucol + (F.lane & 31)); return d; } r -= I_IN;
        if (r < I_G8) { const int nblk = NG8 / 32, kb = r / nblk, nb = r % nblk;
            d.W = AIN[2]; d.WT = ws_ + WS_WG8; d.K = D; d.ldw = NIN; d.drow = 32 * nb; d.k0 = 64 * kb; d.scol = orig_col(11264 + 32 * nb + (F.lane & 31)); d.f8 = 1; return d; } r -= I_G8;
        const float* W; bf16* WT; int K, N, roff = 0;
        if (r < I_GLA) { W = AIN[13]; WT = WglaT; K = 2048; N = D; } else if ((r -= I_GLA) < I_NSA) { W = AIN[14]; WT = WnsaT; K = 2048; N = D; } else if ((r -= I_NSA) < I_OUT) { W = AIN[15]; WT = WoutT; K = D; N = D; }
        else if ((r -= I_OUT) < I_UP) { W = AIN[17]; WT = WupT; K = D; N = FF; } else if ((r -= I_UP) < I_PHI) { W = AIN[8]; WT = W1cT; K = 4096; N = 128; } else { r -= I_PHI; W = AIN[10]; WT = W1cT; K = 4096; N = 128; roff = 128; }
        const int nblk = N / 32, kb = r / nblk, nb = r % nblk;
        d.W = W; d.WT = (unsigned char*)WT; d.K = K; d.ldw = N; d.drow = roff + 32 * nb; d.k0 = 64 * kb; d.scol = 32 * nb + (F.lane & 31); return d; };
    transpose_stream(F, decode, NITEMS, scr, gw, NGW);
    for (int i = gw * 64 + F.lane; i < 256 * 256; i += NGW * 64) { const int n = i >> 8, k = i & 255; float v = 0.f;
        if (n < 128 && k < 128) v = AIN[9][k * 128 + n]; else if (n >= 128 && k >= 128) v = AIN[11][(k - 128) * 128 + (n - 128)];
        W2bT[i] = (bf16)f2bf(v); }
    bf16* H = (bf16*)(ws_ + WS_H);
    rms_rows(F, AIN[0], AIN[1], H, GATE_FP8 ? ws_ + WS_H8 : nullptr, nullptr, gw, NGW);
}
__device__ __forceinline__ void p2_im2col(Frame& F, KArgs ap, int row_lo = 0, int row_hi = 8192, int gw_in = -1, int ngw_in = 0) {
    unsigned char* ws_ = ap->ws;
    const int gw = gw_in >= 0 ? gw_in : F.blk * NWAVES + F.wave, NGW = gw_in >= 0 ? ngw_in : F.G * NWAVES;
    const bf16* U = (const bf16*)(ws_ + WS_U); bf16* A = (bf16*)(ws_ + WS_ACMP);
    const int tq = F.lane >> 4, dc = (F.lane & 15) * 8;
    for (int row = row_lo + gw; row < row_hi; row += NGW) {
        const int kv = row >> 12, bg = (row >> 8) & 15, c = row & 255, b = bg >> 2, g = bg & 3;
        const float* pos = AIN[6 + kv]; const int ucol = (kv ? U_VC : U_KC) + g * 128 + dc;
#pragma unroll
        for (int i = 0; i < 8; ++i) { const int t = 4 * i + tq; v4u o = (v4u){0u, 0u, 0u, 0u};
            if (c < 255) { const v4u w = *(const GAS v4u*)(U + (size_t)(b * SEQ + 16 * c + t) * LDU + ucol);
                const f32x4 p0 = *(const GAS f32x4*)(pos + t * 128 + dc), p1 = *(const GAS f32x4*)(pos + t * 128 + dc + 4);
                o.x = pk2(bfl(w.x) + p0.x, bfh(w.x) + p0.y); o.y = pk2(bfl(w.y) + p0.z, bfh(w.y) + p0.w); o.z = pk2(bfl(w.z) + p1.x, bfh(w.z) + p1.y); o.w = pk2(bfl(w.w) + p1.z, bfh(w.w) + p1.w); }
            *(GAS v4u*)(A + (size_t)row * 4096 + t * 128 + dc) = o; }
    }
}
__device__ __forceinline__ void gla_chain(Frame& F, KArgs ap, int bh) {
    unsigned char* ws_ = ap->ws;
    const int b = bh >> 4, h = bh & 15, tid = F.tid, lane = F.lane, wave = F.wave;
    LAS float* A = (LAS float*)F.lds; LAS float* Kf = A + 4096; LAS float* Qf = Kf + 4096; LAS float* V = Qf + 4096; LAS float* O = V + 8192; LAS float* W2 = O + 8192; LAS float* Bal = W2 + 1024;
    const bf16* U = (const bf16*)(ws_ + WS_U); bf16* OG = (bf16*)(ws_ + WS_OGLA);
    for (int i = tid; i < 1024; i += 512) W2[i] = AIN[3][(i >> 6) * 1024 + h * 64 + (i & 63)];
    if (tid < 64) Bal[tid] = AIN[4][h * 64 + tid];
    const int grp = tid & 3, e = tid >> 2;
    float st[16];
#pragma unroll
    for (int j = 0; j < 16; ++j) st[j] = 0.f;
    const float g0 = AIN[5][h * 128 + 2 * lane], g1 = AIN[5][h * 128 + 2 * lane + 1];
    __syncthreads();
    for (int n = 0; n < 64; ++n) {
        const size_t tok0 = (size_t)b * SEQ + n * 64;
        { const int t = tid >> 3, dd = (tid & 7) * 8; const bf16* ur = U + (tok0 + t) * LDU;
          const v4u a0 = *(const GAS v4u*)(ur + U_GA), a1 = *(const GAS v4u*)(ur + U_GA + 8);
          float alr[16]; alr[0] = bfl(a0.x); alr[1] = bfh(a0.x); alr[2] = bfl(a0.y); alr[3] = bfh(a0.y); alr[4] = bfl(a0.z); alr[5] = bfh(a0.z); alr[6] = bfl(a0.w); alr[7] = bfh(a0.w);
          alr[8] = bfl(a1.x); alr[9] = bfh(a1.x); alr[10] = bfl(a1.y); alr[11] = bfh(a1.y); alr[12] = bfl(a1.z); alr[13] = bfh(a1.z); alr[14] = bfl(a1.w); alr[15] = bfh(a1.w);
#pragma unroll
          for (int j = 0; j < 8; ++j) { const int d = dd + j; float pre = Bal[d];
#pragma unroll
              for (int i = 0; i < 16; ++i) pre += alr[i] * W2[i * 64 + d];
              const float ls = fminf(pre, 0.f) - log1pf(expf(-fabsf(pre)));
              A[t * 64 + d] = expf(ls * (1.f / 16.f)); }
          const v4u qw = *(const GAS v4u*)(ur + U_GQ + h * 64 + dd), kw = *(const GAS v4u*)(ur + U_GK + h * 64 + dd);
          LAS float* qd = Qf + t * 64 + dd; LAS float* kd = Kf + t * 64 + dd;
          qd[0] = bfl(qw.x) * 0.125f; qd[1] = bfh(qw.x) * 0.125f; qd[2] = bfl(qw.y) * 0.125f; qd[3] = bfh(qw.y) * 0.125f; qd[4] = bfl(qw.z) * 0.125f; qd[5] = bfh(qw.z) * 0.125f; qd[6] = bfl(qw.w) * 0.125f; qd[7] = bfh(qw.w) * 0.125f;
          kd[0] = bfl(kw.x); kd[1] = bfh(kw.x); kd[2] = bfl(kw.y); kd[3] = bfh(kw.y); kd[4] = bfl(kw.z); kd[5] = bfh(kw.z); kd[6] = bfl(kw.w); kd[7] = bfh(kw.w);
          const int e0 = (tid & 7) * 16; const v4u v0 = *(const GAS v4u*)(ur + U_GV + h * 128 + e0), v1 = *(const GAS v4u*)(ur + U_GV + h * 128 + e0 + 8);
          LAS float* vd = V + t * 128 + e0;
          vd[0] = bfl(v0.x); vd[1] = bfh(v0.x); vd[2] = bfl(v0.y); vd[3] = bfh(v0.y); vd[4] = bfl(v0.z); vd[5] = bfh(v0.z); vd[6] = bfl(v0.w); vd[7] = bfh(v0.w);
          vd[8] = bfl(v1.x); vd[9] = bfh(v1.x); vd[10] = bfl(v1.y); vd[11] = bfh(v1.y); vd[12] = bfl(v1.z); vd[13] = bfh(v1.z); vd[14] = bfl(v1.w); vd[15] = bfh(v1.w); }
        __syncthreads();
        for (int t = 0; t < 64; ++t) {
            const LAS f32x4* ap = (const LAS f32x4*)(A + t * 64 + grp * 16); const LAS f32x4* kp = (const LAS f32x4*)(Kf + t * 64 + grp * 16); const LAS f32x4* qp = (const LAS f32x4*)(Qf + t * 64 + grp * 16);
            const float v = V[t * 128 + e]; float o = 0.f;
#pragma unroll
            for (int j4 = 0; j4 < 4; ++j4) { const f32x4 a = ap[j4], k = kp[j4], q = qp[j4];
                st[4 * j4 + 0] = a.x * st[4 * j4 + 0] + k.x * v; st[4 * j4 + 1] = a.y * st[4 * j4 + 1] + k.y * v; st[4 * j4 + 2] = a.z * st[4 * j4 + 2] + k.z * v; st[4 * j4 + 3] = a.w * st[4 * j4 + 3] + k.w * v;
                o += q.x * st[4 * j4 + 0] + q.y * st[4 * j4 + 1] + q.z * st[4 * j4 + 2] + q.w * st[4 * j4 + 3]; }
            o += __shfl_xor(o, 1); o += __shfl_xor(o, 2);
            if (grp == 0) O[t * 128 + e] = o;
        }
        __syncthreads();
#pragma unroll 2
        for (int i = 0; i < 8; ++i) { const int t = wave * 8 + i; const float o0 = O[t * 128 + 2 * lane], o1 = O[t * 128 + 2 * lane + 1];
            const float rstd = 1.f / sqrtf(wave_sum(o0 * o0 + o1 * o1) * (1.f / 128.f) + NORM_EPS);
            const unsigned rw = *(const GAS unsigned*)(U + (tok0 + t) * LDU + U_GR + h * 128 + 2 * lane);
            *(GAS unsigned*)(OG + (tok0 + t) * 2048 + h * 128 + 2 * lane) = pk2(o0 * rstd * g0 * bfl(rw), o1 * rstd * g1 * bfh(rw)); }
    }
    __syncthreads();
}

__device__ __forceinline__ void qk4(const bf16* krow, const LAS float* qs, float (&sc)[4]) {
#pragma unroll
    for (int r = 0; r < 4; ++r) sc[r] = 0.f;
#pragma unroll 4
    for (int d8 = 0; d8 < 16; ++d8) { const v4u w = *(const GAS v4u*)(krow + 8 * d8);
        const float k0 = bfl(w.x), k1 = bfh(w.x), k2 = bfl(w.y), k3 = bfh(w.y), k4 = bfl(w.z), k5 = bfh(w.z), k6 = bfl(w.w), k7 = bfh(w.w);
#pragma unroll
        for (int r = 0; r < 4; ++r) { const f32x4 qa = *(const LAS f32x4*)(qs + r * 128 + 8 * d8), qb = *(const LAS f32x4*)(qs + r * 128 + 8 * d8 + 4);
            sc[r] += (k0 * qa.x + k1 * qa.y) + (k2 * qa.z + k3 * qa.w) + (k4 * qb.x + k5 * qb.y) + (k6 * qb.z + k7 * qb.w); } }
}
__device__ __forceinline__ void pv4(const bf16* vbase, size_t vstride, const LAS float* pT, int nk, int lane, float (&o)[4][2]) {
#pragma unroll 4
    for (int key = 0; key < nk; ++key) { const unsigned w = *(const GAS unsigned*)(vbase + (size_t)key * vstride + 2 * lane); const float v0 = bfl(w), v1 = bfh(w);
        const f32x4 p = *(const LAS f32x4*)(pT + 4 * key);
        o[0][0] += p.x * v0; o[0][1] += p.x * v1; o[1][0] += p.y * v0; o[1][1] += p.y * v1; o[2][0] += p.z * v0; o[2][1] += p.z * v1; o[3][0] += p.w * v0; o[3][1] += p.w * v1; }
}
__device__ __forceinline__ void attend64(const bf16* Ub, int kb, bool valid, int dist, int koff, int voff, const LAS float* qs, LAS float* pT, const LAS float* bias, float (&m)[4], float (&l)[4], float (&o)[4][2], int lane) {
    float sc[4]; qk4(Ub + (size_t)(kb + lane) * LDU + koff, qs, sc);
    const int dd = dist < 0 ? 0 : (dist > 127 ? 127 : dist); const int bk = REL_LUT[dd];
    const f32x4 bv = *(const LAS f32x4*)(bias + 4 * bk);
    float p[4];
#pragma unroll
    for (int r = 0; r < 4; ++r) { const float x = sc[r] + bv[r]; const float bm = wave_max(valid ? x : -1e30f); const float mn = fmaxf(m[r], bm); const float al = __expf(m[r] - mn);
        p[r] = valid ? __expf(x - mn) : 0.f; l[r] = l[r] * al + wave_sum(p[r]); o[r][0] *= al; o[r][1] *= al; m[r] = mn; }
    asm volatile("" ::: "memory");
    *(LAS f32x4*)(pT + 4 * lane) = (f32x4){p[0], p[1], p[2], p[3]};
    LDS_WAIT(); __builtin_amdgcn_wave_barrier(); asm volatile("" ::: "memory");
    pv4(Ub + (size_t)kb * LDU + voff, LDU, pT, 64, lane, o);
    asm volatile("" ::: "memory");
}
__device__ __forceinline__ void nsa_item(Frame& F, KArgs ap, int item, LAS float* wl) {
    unsigned char* ws_ = ap->ws;
    const int lane = F.lane; const int s = item & (SEQ - 1), g = (item >> 12) & 3, b = item >> 14;
    LAS float* qs = wl; LAS float* pT = wl + 512; LAS float* bias = wl + 512 + 1024;
    const bf16* U = (const bf16*)(ws_ + WS_U); const bf16* Ub = U + (size_t)b * SEQ * LDU; const bf16* OC = (const bf16*)(ws_ + WS_OC);
    const size_t tok = (size_t)b * SEQ + s; const float scale = 0.08838834764831845f;
    asm volatile("" ::: "memory");
#pragma unroll
    for (int r = 0; r < 4; ++r) { const unsigned w = *(const GAS unsigned*)(U + tok * LDU + U_NQ + (g * 4 + r) * 128 + 2 * lane); qs[r * 128 + 2 * lane] = bfl(w) * scale; qs[r * 128 + 2 * lane + 1] = bfh(w) * scale; }
    for (int i = lane; i < 128; i += 64) bias[i] = AIN[12][(i >> 2) * 16 + g * 4 + (i & 3)];
    LDS_WAIT(); __builtin_amdgcn_wave_barrier(); asm volatile("" ::: "memory");
    float sc[4][4];
    const bf16* kc = OC + (size_t)((b * 4 + g) * 256) * 256; const bf16* vc = OC + (size_t)(4096 + (b * 4 + g) * 256) * 256 + 128;
    float mx[4] = {-1e30f, -1e30f, -1e30f, -1e30f};
#pragma unroll
    for (int i = 0; i < 4; ++i) { const int c = 64 * i + lane; qk4(kc + (size_t)c * 256, qs, sc[i]); const int dist = s - (16 * c + 31); const bool valid = (c < 255) && dist >= 0;
        const int dd = dist < 0 ? 0 : (dist > 127 ? 127 : dist); const f32x4 bv = *(const LAS f32x4*)(bias + 4 * REL_LUT[dd]);
#pragma unroll
        for (int r = 0; r < 4; ++r) { sc[i][r] = valid ? sc[i][r] + bv[r] : -1e30f; mx[r] = fmaxf(mx[r], sc[i][r]); } }
    float inv[4];
#pragma unroll
    for (int r = 0; r < 4; ++r) { mx[r] = wave_max(mx[r]); float sum = 0.f;
#pragma unroll
        for (int i = 0; i < 4; ++i) { sc[i][r] = sc[i][r] > -1e29f ? __expf(sc[i][r] - mx[r]) : 0.f; sum += sc[i][r]; }
        sum = wave_sum(sum); inv[r] = sum > 0.f ? 1.f / sum : 0.f; }
#pragma unroll
    for (int i = 0; i < 4; ++i) *(LAS f32x4*)(pT + 4 * (64 * i + lane)) = (f32x4){sc[i][0] * inv[0], sc[i][1] * inv[1], sc[i][2] * inv[2], sc[i][3] * inv[3]};
    LDS_WAIT(); __builtin_amdgcn_wave_barrier(); asm volatile("" ::: "memory");
    float ocmp[4][2];
#pragma unroll
    for (int r = 0; r < 4; ++r) { ocmp[r][0] = 0.f; ocmp[r][1] = 0.f; }
    const int nvalid = s >= 31 ? ((s - 31) >> 4) + 1 : 0;
    pv4(vc, 256, pT, nvalid, lane, ocmp);
    float imp = 0.f;
#pragma unroll
    for (int dc = -1; dc <= 3; ++dc) { const int c = 4 * lane + dc; if (c >= 0 && c < 255) { const f32x4 p = *(const LAS f32x4*)(pT + 4 * c); const float w = (dc == -1 || dc == 3) ? 1.f : 2.f; imp += w * ((p.x + p.y) + (p.z + p.w)); } }
    const int cur = s >> 6; const bool forced = (lane == 0) || (lane <= cur && lane > cur - 2); const bool reach = lane <= cur;
    const float score = forced ? 1e4f : (reach ? imp : -1e4f);
    int rank = 0;
#pragma unroll
    for (int jp = 0; jp < 64; ++jp) { const float sj = __int_as_float(__builtin_amdgcn_readlane(__float_as_int(score), jp)); rank += (sj > score || (sj == score && jp < lane)) ? 1 : 0; }
    unsigned long long mask = __ballot(rank < 16 && reach);
    asm volatile("" ::: "memory");
    float ms[4], ls[4], osel[4][2];
#pragma unroll
    for (int r = 0; r < 4; ++r) { ms[r] = -1e30f; ls[r] = 0.f; osel[r][0] = 0.f; osel[r][1] = 0.f; }
    while (mask) { const int j = __builtin_ctzll(mask); mask &= mask - 1; const int kpos = 64 * j + lane;
        attend64(Ub, 64 * j, kpos <= s, s - kpos, U_KSL + g * 128, U_VSL + g * 128, qs, pT, bias, ms, ls, osel, lane); }
    float mw[4], lw[4], owin[4][2];
#pragma unroll
    for (int r = 0; r < 4; ++r) { mw[r] = -1e30f; lw[r] = 0.f; owin[r][0] = 0.f; owin[r][1] = 0.f; }
    const int lo = s - 511 > 0 ? s - 511 : 0;
    for (int kb = lo & ~63; kb <= s; kb += 64) { const int kpos = kb + lane;
        attend64(Ub, kb, kpos >= lo && kpos <= s, s - kpos, U_KW + g * 128, U_VW + g * 128, qs, pT, bias, mw, lw, owin, lane); }
    bf16* ON = (bf16*)(ws_ + WS_ONSA);
#pragma unroll
    for (int r = 0; r < 4; ++r) { const bf16* gp = U + tok * LDU + U_NG + (g * 4 + r) * 3;
        const float g0 = __uint_as_float((unsigned)gp[0] << 16), g1 = __uint_as_float((unsigned)gp[1] << 16), g2 = __uint_as_float((unsigned)gp[2] << 16);
        const float is = g1 / ls[r], iw = g2 / lw[r];
        *(GAS unsigned*)(ON + tok * 2048 + (g * 4 + r) * 128 + 2 * lane) = pk2(g0 * ocmp[r][0] + is * osel[r][0] + iw * owin[r][0], g0 * ocmp[r][1] + is * osel[r][1] + iw * owin[r][1]); }
    asm volatile("" ::: "memory");
}
#ifndef NSA_SB2
#define NSA_SB2()
#endif
#ifndef NSA_SB
#define NSA_SB() __builtin_amdgcn_sched_barrier(0)
#endif
typedef short bf16x8_t __attribute__((ext_vector_type(8)));
typedef short s16x4_t __attribute__((ext_vector_type(4)));
constexpr int NT_ROWB = 288;
constexpr int NT_TILEB = 64 * NT_ROWB;
constexpr int NL_K = 0, NL_V = 2 * NT_TILEB, NL_Q = 4 * NT_TILEB, NL_BIAS = NL_Q + 256 * NT_ROWB, NL_SELM = NL_BIAS + 2048, NL_WUN = NL_SELM + 512, NL_END = NL_WUN + 64, NL_IMP = NL_K;
static_assert(NL_END <= RING_BYTES, "NSA LDS map");
__device__ __forceinline__ s16x4_t tr_rd(LAS const unsigned char* p) { return __builtin_bit_cast(s16x4_t, __builtin_amdgcn_ds_read_tr16_b64_v4i16((LAS s16x4_t*)p)); }
__device__ __forceinline__ unsigned cvtpk(float lo, float hi) { unsigned r; asm volatile("v_cvt_pk_bf16_f32 %0, %1, %2" : "=v"(r) : "v"(lo), "v"(hi)); return r; }
__device__ __forceinline__ float xrow16_max(float x) {
    auto s = __builtin_amdgcn_permlane16_swap(__float_as_uint(x), __float_as_uint(x), false, false); x = fmaxf(__uint_as_float(s[0]), __uint_as_float(s[1]));
    auto t = __builtin_amdgcn_permlane32_swap(__float_as_uint(x), __float_as_uint(x), false, false); return fmaxf(__uint_as_float(t[0]), __uint_as_float(t[1])); }
__device__ __forceinline__ float xrow16_sum(float x) {
    auto s = __builtin_amdgcn_permlane16_swap(__float_as_uint(x), __float_as_uint(x), false, false); x = __uint_as_float(s[0]) + __uint_as_float(s[1]);
    auto t = __builtin_amdgcn_permlane32_swap(__float_as_uint(x), __float_as_uint(x), false, false); return __uint_as_float(t[0]) + __uint_as_float(t[1]); }
template <int CTRL> __device__ __forceinline__ float dppf(float x) { return __builtin_bit_cast(float, __builtin_amdgcn_mov_dpp(__builtin_bit_cast(int, x), CTRL, 0xf, 0xf, true)); }
__device__ __forceinline__ float quad_sum(float x) { x += dppf<0xB1>(x); x += dppf<0x4E>(x); return x; }
#ifndef NSA_THR
#define NSA_THR 8.0f
#endif


struct NsaTileSrc { const unsigned char* k; const unsigned char* v; unsigned stride; };
struct NsaRegs { v4u k0, k1, v0, v1; };
__device__ __forceinline__ void nsa_ld(const NsaTileSrc& s, int tid_in, NsaRegs& r) {
    int tid = tid_in; asm volatile("" : "+v"(tid));
    const int row = tid >> 4, c16 = (tid & 15) * 16;
    r.k0 = *(const GAS v4u*)(s.k + (size_t)row * s.stride + c16); r.k1 = *(const GAS v4u*)(s.k + (size_t)(row + 32) * s.stride + c16);
    r.v0 = *(const GAS v4u*)(s.v + (size_t)row * s.stride + c16); r.v1 = *(const GAS v4u*)(s.v + (size_t)(row + 32) * s.stride + c16);
}
__device__ __forceinline__ void nsa_st(LAS unsigned char* lds, int buf, int tid_in, const NsaRegs& r) {
    int tid = tid_in; asm volatile("" : "+v"(tid));
    const int row = tid >> 4, c16 = (tid & 15) * 16; LAS unsigned char* kb = lds + NL_K + buf * NT_TILEB + row * NT_ROWB + c16; LAS unsigned char* vb = lds + NL_V + buf * NT_TILEB + row * NT_ROWB + c16;
    *(LAS v4u*)kb = r.k0; *(LAS v4u*)(kb + 32 * NT_ROWB) = r.k1; *(LAS v4u*)vb = r.v0; *(LAS v4u*)(vb + 32 * NT_ROWB) = r.v1;
}
struct NsaAcc { f32x4 o[8][2]; float m[2], l[2]; };
template <int BR>
__device__ __forceinline__ void nsa_tile(LAS const unsigned char* lds, int buf, int wave, NsaAcc& A, f32x4 (&imp)[4][2], int pos0, const int (&qpos)[2], const bool (&selbit)[2], bool far, bool FAST, int rhead, int lane_in, bool pre, const NsaTileSrc& nsrc, int tid, NsaRegs& R) {
    int lane = lane_in; asm volatile("" : "+v"(lane));
    const int n = lane & 15, g = lane >> 4;
    if (BR != 0 && pre) nsa_ld(nsrc, tid, R);
    LAS const unsigned char* kb = lds + NL_K + buf * NT_TILEB + n * NT_ROWB + g * 16;
    LAS const unsigned char* qb = lds + NL_Q + (32 * wave + n) * NT_ROWB + g * 16;
    const bool act0 = (BR != 1) || (__builtin_amdgcn_ballot_w64(selbit[0]) != 0ull), act1 = (BR != 1) || (__builtin_amdgcn_ballot_w64(selbit[1]) != 0ull);
    f32x4 s[4][2];
#pragma unroll
    for (int kt = 0; kt < 4; ++kt) { s[kt][0] = (f32x4){0.f, 0.f, 0.f, 0.f}; s[kt][1] = (f32x4){0.f, 0.f, 0.f, 0.f}; }
#pragma unroll
    for (int ks = 0; ks < 4; ++ks) { bf16x8_t kf[4];
        const bf16x8_t q0 = *(LAS const bf16x8_t*)(qb + ks * 64), q1 = *(LAS const bf16x8_t*)(qb + 16 * NT_ROWB + ks * 64);
#pragma unroll
        for (int kt = 0; kt < 4; ++kt) kf[kt] = *(LAS const bf16x8_t*)(kb + kt * 16 * NT_ROWB + ks * 64);
#pragma unroll
        for (int kt = 0; kt < 4; ++kt) {
            if (act0) s[kt][0] = __builtin_amdgcn_mfma_f32_16x16x32_bf16(kf[kt], q0, s[kt][0], 0, 0, 0);
            if (act1) s[kt][1] = __builtin_amdgcn_mfma_f32_16x16x32_bf16(kf[kt], q1, s[kt][1], 0, 0, 0); }
        NSA_SB(); }
    const float C1 = 0.08838834764831845f * 1.4426950408889634f;
    LAS const float* bl = (LAS const float*)(lds + NL_BIAS) + rhead * 128;
    const float bfar = bl[127];
    bf16x8_t pf[2][2];
#pragma unroll
    for (int t = 0; t < 2; ++t) {
        NSA_SB2();
        if (!(t == 0 ? act0 : act1)) { pf[0][t] = (bf16x8_t){0, 0, 0, 0, 0, 0, 0, 0}; pf[1][t] = pf[0][t]; continue; }
        float x[4][4]; bool vld[4][4]; float mx = -1e30f; float ps = 0.f; float p[4][4]; float mn, al;
        if (FAST) {
            const bool rv = (BR == 1) ? selbit[t] : true;
            float m0 = fmaxf(fmaxf(s[0][t][0], s[0][t][1]), fmaxf(s[0][t][2], s[0][t][3]));
#pragma unroll
            for (int kt = 1; kt < 4; ++kt) m0 = fmaxf(m0, fmaxf(fmaxf(s[kt][t][0], s[kt][t][1]), fmaxf(s[kt][t][2], s[kt][t][3])));
            mx = rv ? m0 * C1 + bfar : -1e30f;
            mx = xrow16_max(mx);
            if (__builtin_amdgcn_ballot_w64(mx - A.m[t] > NSA_THR) != 0ull) { mn = fmaxf(A.m[t], mx); al = __builtin_amdgcn_exp2f(A.m[t] - mn); A.m[t] = mn; } else { mn = A.m[t]; al = 1.0f; }
            const float sh = bfar - mn;
#pragma unroll
            for (int kt = 0; kt < 4; ++kt)
#pragma unroll
                for (int i = 0; i < 4; ++i) { const float e = __builtin_amdgcn_exp2f(s[kt][t][i] * C1 + sh); p[kt][i] = rv ? e : 0.f; ps += p[kt][i]; }
        } else {
#pragma unroll
        for (int kt = 0; kt < 4; ++kt)
#pragma unroll
            for (int i = 0; i < 4; ++i) { const int kk = 16 * kt + 4 * g + i; int dist; bool v;
                if (BR == 0) { const int c = pos0 + kk; dist = qpos[t] - (16 * c + 31); v = dist >= 0 && c < 255; }
                else if (BR == 1) { dist = qpos[t] - (pos0 + kk); v = dist >= 0 && selbit[t]; }
                else { dist = qpos[t] - (pos0 + kk); v = dist >= 0 && dist < 512; }
                float b2 = bfar; if (!far) { const int dd = dist < 0 ? 0 : (dist > 127 ? 127 : dist); b2 = bl[dd]; }
                x[kt][i] = s[kt][t][i] * C1 + b2; vld[kt][i] = v; mx = fmaxf(mx, v ? x[kt][i] : -1e30f); }
        mx = xrow16_max(mx);
        if (__builtin_amdgcn_ballot_w64(mx - A.m[t] > NSA_THR) != 0ull) { mn = fmaxf(A.m[t], mx); al = __builtin_amdgcn_exp2f(A.m[t] - mn); A.m[t] = mn; } else { mn = A.m[t]; al = 1.0f; }
#pragma unroll
        for (int kt = 0; kt < 4; ++kt)
#pragma unroll
            for (int i = 0; i < 4; ++i) { p[kt][i] = vld[kt][i] ? __builtin_amdgcn_exp2f(x[kt][i] - mn) : 0.f; ps += p[kt][i]; }
        }
        A.l[t] = A.l[t] * al + ps;
        if (__builtin_amdgcn_ballot_w64(al != 1.0f) != 0ull) {
#pragma unroll
            for (int dt = 0; dt < 8; ++dt) A.o[dt][t] *= al;
            if (BR == 0) {
#pragma unroll
                for (int jt = 0; jt < 4; ++jt) imp[jt][t] *= al; } }
#pragma unroll
        for (int k2 = 0; k2 < 2; ++k2) { v4u w; w.x = cvtpk(p[2 * k2][0], p[2 * k2][1]); w.y = cvtpk(p[2 * k2][2], p[2 * k2][3]); w.z = cvtpk(p[2 * k2 + 1][0], p[2 * k2 + 1][1]); w.w = cvtpk(p[2 * k2 + 1][2], p[2 * k2 + 1][3]);
            pf[k2][t] = __builtin_bit_cast(bf16x8_t, w); }
    }
    NSA_SB2();
    if (BR == 0 && pre) nsa_ld(nsrc, tid, R);
    NSA_SB2();
    LAS const unsigned char* vb = lds + NL_V + buf * NT_TILEB + (4 * g + (n >> 2)) * NT_ROWB + (n & 3) * 8;
#pragma unroll
    for (int k2 = 0; k2 < 2; ++k2)
#pragma unroll
        for (int d4 = 0; d4 < 2; ++d4) { bf16x8_t vf[4];
#pragma unroll
            for (int q = 0; q < 4; ++q) { const int dt = 4 * d4 + q; const s16x4_t lo = tr_rd(vb + (32 * k2) * NT_ROWB + dt * 32), hi = tr_rd(vb + (32 * k2 + 16) * NT_ROWB + dt * 32);
                vf[q] = __builtin_shufflevector(lo, hi, 0, 1, 2, 3, 4, 5, 6, 7); }
#pragma unroll
            for (int q = 0; q < 4; ++q) { const int dt = 4 * d4 + q;
                if (act0) A.o[dt][0] = __builtin_amdgcn_mfma_f32_16x16x32_bf16(vf[q], pf[k2][0], A.o[dt][0], 0, 0, 0);
                if (act1) A.o[dt][1] = __builtin_amdgcn_mfma_f32_16x16x32_bf16(vf[q], pf[k2][1], A.o[dt][1], 0, 0, 0); }
            NSA_SB(); }
    if (BR == 0) {
#pragma unroll
        for (int jt = 0; jt < 4; ++jt) { if (16 * jt > (pos0 >> 2) + 16 || 16 * jt + 15 < (pos0 >> 2)) continue;
            const int jb = 16 * jt + n;
#pragma unroll
            for (int k2 = 0; k2 < 2; ++k2) { unsigned short e[8];
#pragma unroll
                for (int q = 0; q < 8; ++q) { const int c = pos0 + 32 * k2 + (q < 4 ? 4 * g + q : 16 + 4 * g + (q - 4)); const int dz = c - 4 * jb;
                    e[q] = (c < 255) ? ((dz == -1 || dz == 3) ? 0x3F80 : ((dz >= 0 && dz <= 2) ? 0x4000 : 0)) : 0; }
                v4u w; w.x = e[0] | ((unsigned)e[1] << 16); w.y = e[2] | ((unsigned)e[3] << 16); w.z = e[4] | ((unsigned)e[5] << 16); w.w = e[6] | ((unsigned)e[7] << 16);
                const bf16x8_t mf = __builtin_bit_cast(bf16x8_t, w);
                imp[jt][0] = __builtin_amdgcn_mfma_f32_16x16x32_bf16(mf, pf[k2][0], imp[jt][0], 0, 0, 0);
                imp[jt][1] = __builtin_amdgcn_mfma_f32_16x16x32_bf16(mf, pf[k2][1], imp[jt][1], 0, 0, 0); } }
    }
}
template <bool ACCUM>
__device__ __forceinline__ void nsa_flush(NsaAcc& A, bf16* ON, const bf16* U, int b, int q0, int gk, int wave, int br, int lane_in) {
    int lane = lane_in; asm volatile("" : "+v"(lane)); const int n = lane & 15, g = lane >> 4, rhead = n & 3;
#pragma unroll
    for (int t = 0; t < 2; ++t) { const float l = xrow16_sum(A.l[t]); A.l[t] = l;
        const size_t tok = (size_t)b * SEQ + q0 + ((32 * wave + 16 * t + n) >> 2);
        const float gate = __uint_as_float((unsigned)U[tok * LDU + U_NG + (gk * 4 + rhead) * 3 + br] << 16); const float sc = l > 0.f ? gate / l : 0.f;
        bf16* orow_t = ON + tok * 2048 + (gk * 4 + rhead) * 128;
#pragma unroll
        for (int dt = 0; dt < 8; ++dt) { GAS v2u* p = (GAS v2u*)(orow_t + 16 * dt + 4 * g); f32x4 v = A.o[dt][t] * sc;
            if (ACCUM) { const v2u w = *p; v[0] += bfl(w.x); v[1] += bfh(w.x); v[2] += bfl(w.y); v[3] += bfh(w.y); }
            v2u w; w.x = cvtpk(v[0], v[1]); w.y = cvtpk(v[2], v[3]); *p = w; } }
}
__device__ __forceinline__ void nsa_acc_reset(NsaAcc& A) {
#pragma unroll
    for (int t = 0; t < 2; ++t) { A.m[t] = -1e30f; A.l[t] = 0.f;
#pragma unroll
        for (int dt = 0; dt < 8; ++dt) A.o[dt][t] = (f32x4){0.f, 0.f, 0.f, 0.f}; }
}
__device__ __forceinline__ void nsa_wg_item(Frame& F, KArgs ap, int item, size_t on_off) {
    unsigned char* ws_ = ap->ws;
    const int qt = item & 63, gk = (item >> 6) & 3, b = item >> 8;
    int lane = F.lane; asm volatile("" : "+v"(lane));
    const int wave = F.wave, tid = wave * 64 + lane, n = lane & 15, g = lane >> 4;
    LAS unsigned char* lds = F.lds;
    const bf16* U = (const bf16*)(ws_ + WS_U); const bf16* OC = (const bf16*)(ws_ + WS_OC); bf16* ON = (bf16*)(ws_ + on_off);
    const int q0 = 64 * qt, rhead = n & 3;
    int qpos[2];
#pragma unroll
    for (int t = 0; t < 2; ++t) qpos[t] = q0 + ((32 * wave + 16 * t + n) >> 2);
#pragma unroll
    for (int i = 0; i < 8; ++i) { const int cid = tid + 512 * i, row = cid >> 4, c16 = cid & 15;
        const v4u w = *(const GAS v4u*)(U + ((size_t)b * SEQ + q0 + (row >> 2)) * LDU + U_NQ + (gk * 4 + (row & 3)) * 128 + c16 * 8);
        *(LAS v4u*)(lds + NL_Q + row * NT_ROWB + c16 * 16) = w; }
    { LAS float* bl = (LAS float*)(lds + NL_BIAS); const int r = tid >> 7, dd = tid & 127; bl[tid] = ap->in[12][REL_LUT[dd] * 16 + gk * 4 + r] * 1.4426950408889634f; }
    NsaAcc A; f32x4 imp[4][2]; NsaRegs R; const bool nosel[2] = {true, true};
    nsa_acc_reset(A);
#pragma unroll
    for (int jt = 0; jt < 4; ++jt) { imp[jt][0] = (f32x4){0.f, 0.f, 0.f, 0.f}; imp[jt][1] = (f32x4){0.f, 0.f, 0.f, 0.f}; }
    { const unsigned char* kbase = (const unsigned char*)(OC + (size_t)((b * 4 + gk) * 256) * 256); const unsigned char* vbase = (const unsigned char*)(OC + (size_t)(4096 + (b * 4 + gk) * 256) * 256 + 128);
      const int ntile = (q0 + 63 >= 31) ? (((q0 + 63 - 31) >> 4) >> 6) + 1 : 0;
      NsaTileSrc src{kbase, vbase, 512u};
      if (ntile > 0) { nsa_ld(src, tid, R); nsa_st(lds, 0, tid, R); }
      __syncthreads();
      for (int i = 0; i < ntile; ++i) {
          const NsaTileSrc s2{kbase + (size_t)(i + 1) * 64 * 512, vbase + (size_t)(i + 1) * 64 * 512, 512u};
          const bool far = (q0 - (16 * (64 * i + 63) + 31)) >= 128;
          nsa_tile<0>(lds, i & 1, wave, A, imp, 64 * i, qpos, nosel, far, far, rhead, lane, i + 1 < ntile, s2, tid, R);
          if (i + 1 < ntile) nsa_st(lds, (i + 1) & 1, tid, R);
          __syncthreads();
      }
      nsa_flush<false>(A, ON, U, b, q0, gk, wave, 0, lane);
    }
    unsigned long long mymask[2];
    { LAS float* ib = (LAS float*)(lds + NL_IMP) + wave * 512;
#pragma unroll
      for (int t = 0; t < 2; ++t) { const float inv = A.l[t] > 0.f ? 1.f / A.l[t] : 0.f;
#pragma unroll
          for (int jt = 0; jt < 4; ++jt) { f32x4 v = imp[jt][t] * inv;
#pragma unroll
              for (int i = 0; i < 4; ++i) v[i] = quad_sum(v[i]);
              if (rhead == 0) *(LAS f32x4*)(ib + (4 * t + (n >> 2)) * 64 + 16 * jt + 4 * g) = v; } }
      LDS_WAIT(); __builtin_amdgcn_wave_barrier(); asm volatile("" ::: "memory");
      const int qw = lane >> 3, js = lane & 7; const int cur = qt;
      unsigned lo = 0u, hi = 0u;
      if (cur < 16) { const unsigned long long all = (cur >= 63) ? ~0ull : ((1ull << (cur + 1)) - 1ull); lo = (unsigned)all; hi = (unsigned)(all >> 32); }
      else {
          float sc[64];
#pragma unroll
          for (int j4 = 0; j4 < 16; ++j4) { const f32x4 v = *(LAS const f32x4*)(ib + qw * 64 + 4 * j4);
#pragma unroll
              for (int i = 0; i < 4; ++i) { const int j = 4 * j4 + i; const bool forced = (j == 0) || (j <= cur && j > cur - 2); sc[j] = forced ? 1e4f : (j <= cur ? v[i] : -1e4f); } }
#pragma unroll
          for (int k = 0; k < 8; ++k) { const int j = js + 8 * k; const bool forced = (j == 0) || (j <= cur && j > cur - 2); const float mine = forced ? 1e4f : (j <= cur ? ib[qw * 64 + j] : -1e4f);
              int rank = 0;
#pragma unroll
              for (int jp = 0; jp < 64; ++jp) rank += (sc[jp] > mine || (sc[jp] == mine && jp < j)) ? 1 : 0;
              const bool sel = rank < 16 && j <= cur;
              if (k < 4) lo |= sel ? (1u << (js + 8 * k)) : 0u; else hi |= sel ? (1u << (js + 8 * (k - 4))) : 0u; }
          lo |= __shfl_xor(lo, 1); lo |= __shfl_xor(lo, 2); lo |= __shfl_xor(lo, 4); hi |= __shfl_xor(hi, 1); hi |= __shfl_xor(hi, 2); hi |= __shfl_xor(hi, 4);
      }
      LAS unsigned* sm = (LAS unsigned*)(lds + NL_SELM) + wave * 16;
      if (js == 0) { sm[2 * qw] = lo; sm[2 * qw + 1] = hi; }
      unsigned ulo = lo, uhi = hi;
      ulo |= __shfl_xor(ulo, 8); ulo |= __shfl_xor(ulo, 16); ulo |= __shfl_xor(ulo, 32); uhi |= __shfl_xor(uhi, 8); uhi |= __shfl_xor(uhi, 16); uhi |= __shfl_xor(uhi, 32);
      LAS unsigned* wu = (LAS unsigned*)(lds + NL_WUN);
      if (lane == 0) { wu[2 * wave] = ulo; wu[2 * wave + 1] = uhi; }
      LDS_WAIT(); __builtin_amdgcn_wave_barrier(); asm volatile("" ::: "memory");
#pragma unroll
      for (int t = 0; t < 2; ++t) { const int qi = 4 * t + (n >> 2); mymask[t] = (unsigned long long)sm[2 * qi] | ((unsigned long long)sm[2 * qi + 1] << 32); }
    }
    __syncthreads();
    unsigned long long wgmask = 0ull, wvmask;
    { LAS const unsigned* wu = (LAS const unsigned*)(lds + NL_WUN);
#pragma unroll
      for (int w = 0; w < 8; ++w) wgmask |= (unsigned long long)wu[2 * w] | ((unsigned long long)wu[2 * w + 1] << 32);
      wvmask = (unsigned long long)wu[2 * wave] | ((unsigned long long)wu[2 * wave + 1] << 32);
      wgmask = ((unsigned long long)__builtin_amdgcn_readfirstlane((unsigned)(wgmask >> 32)) << 32) | (unsigned)__builtin_amdgcn_readfirstlane((unsigned)wgmask);
      wvmask = ((unsigned long long)__builtin_amdgcn_readfirstlane((unsigned)(wvmask >> 32)) << 32) | (unsigned)__builtin_amdgcn_readfirstlane((unsigned)wvmask); }
    nsa_acc_reset(A);
    { const unsigned char* kbase = (const unsigned char*)(U + (size_t)b * SEQ * LDU + U_KSL + gk * 128); const unsigned char* vbase = (const unsigned char*)(U + (size_t)b * SEQ * LDU + U_VSL + gk * 128);
      unsigned long long rem = wgmask; int j = __builtin_ctzll(rem); rem &= rem - 1;
      { NsaTileSrc src{kbase + (size_t)j * 64 * LDU * 2, vbase + (size_t)j * 64 * LDU * 2, (unsigned)(LDU * 2)}; nsa_ld(src, tid, R); nsa_st(lds, 0, tid, R); }
      __syncthreads();
      for (int i = 0;; ++i) {
          const bool more = rem != 0ull; int jn = 0;
          if (more) { jn = __builtin_ctzll(rem); rem &= rem - 1; }
          const NsaTileSrc s2{kbase + (size_t)jn * 64 * LDU * 2, vbase + (size_t)jn * 64 * LDU * 2, (unsigned)(LDU * 2)};
          if ((wvmask >> j) & 1ull) { const bool sb[2] = {(bool)((mymask[0] >> j) & 1ull), (bool)((mymask[1] >> j) & 1ull)}; const bool far = (q0 - (64 * j + 63)) >= 128;
              nsa_tile<1>(lds, i & 1, wave, A, imp, 64 * j, qpos, sb, far, far, rhead, lane, more, s2, tid, R); }
          else if (more) nsa_ld(s2, tid, R);
          if (more) nsa_st(lds, (i + 1) & 1, tid, R);
          __syncthreads();
          if (!more) break;
          j = jn;
      }
      nsa_flush<true>(A, ON, U, b, q0, gk, wave, 1, lane);
    }
    nsa_acc_reset(A);
    { const unsigned char* kbase = (const unsigned char*)(U + (size_t)b * SEQ * LDU + U_KW + gk * 128); const unsigned char* vbase = (const unsigned char*)(U + (size_t)b * SEQ * LDU + U_VW + gk * 128);
      const int j0 = qt >= 8 ? qt - 8 : 0, ntile = qt - j0 + 1;
      { NsaTileSrc src{kbase + (size_t)j0 * 64 * LDU * 2, vbase + (size_t)j0 * 64 * LDU * 2, (unsigned)(LDU * 2)}; nsa_ld(src, tid, R); nsa_st(lds, 0, tid, R); }
      __syncthreads();
      for (int i = 0; i < ntile; ++i) { const int j = j0 + i;
          const NsaTileSrc s2{kbase + (size_t)(j + 1) * 64 * LDU * 2, vbase + (size_t)(j + 1) * 64 * LDU * 2, (unsigned)(LDU * 2)};
          const bool far = (q0 - (64 * j + 63)) >= 128;
          nsa_tile<2>(lds, i & 1, wave, A, imp, 64 * j, qpos, nosel, far, far && j > qt - 8, rhead, lane, i + 1 < ntile, s2, tid, R);
          if (i + 1 < ntile) nsa_st(lds, (i + 1) & 1, tid, R);
          __syncthreads();
      }
      nsa_flush<true>(A, ON, U, b, q0, gk, wave, 2, lane);
    }
    __syncthreads();
}

constexpr int GP = 288;
constexpr int GL_QE = 0, GL_KE = 64 * GP, GL_KD = 2 * 64 * GP, GL_V = 3 * 64 * GP, GL_ST = 4 * 64 * GP, GL_W2 = GL_ST + 128 * GP, GL_BAL = GL_W2 + 4096, GL_ALR = GL_BAL + 256, GL_WT = GL_ALR + 4096,
              GL_DEC = GL_WT + 2048, GL_SSQ = GL_DEC + 256, GL_END = GL_SSQ + 512;
static_assert(GL_END <= RING_BYTES, "GLA LDS map");
__device__ __forceinline__ bf16x8_t tr2(LAS const unsigned char* p) { const s16x4_t lo = tr_rd(p), hi = tr_rd(p + 16 * GP); return __builtin_shufflevector(lo, hi, 0, 1, 2, 3, 4, 5, 6, 7); }
__device__ __forceinline__ void gla_chain_mfma(Frame& F, KArgs ap, int bh, size_t og_off = WS_OGLA) {
    unsigned char* ws_ = ap->ws;
    const int b = bh >> 4, h = bh & 15;
    int lane = F.lane; asm volatile("" : "+v"(lane));
    const int wave = F.wave, tid = wave * 64 + lane, n = lane & 15, g = lane >> 4;
    LAS unsigned char* lds = F.lds;
    const bf16* U = (const bf16*)(ws_ + WS_U); bf16* OG = (bf16*)(ws_ + og_off);
    LAS float* W2 = (LAS float*)(lds + GL_W2); LAS float* Bal = (LAS float*)(lds + GL_BAL); LAS float* ALR = (LAS float*)(lds + GL_ALR); LAS float* WT = (LAS float*)(lds + GL_WT);
    LAS float* DEC = (LAS float*)(lds + GL_DEC); LAS float* SSQ = (LAS float*)(lds + GL_SSQ);
    for (int i = tid; i < 1024; i += 512) W2[i] = ap->in[3][(i >> 6) * 1024 + h * 64 + (i & 63)];
    if (tid < 64) Bal[tid] = ap->in[4][h * 64 + tid];
    for (int i = tid; i < 128 * GP / 4; i += 512) ((LAS unsigned*)(lds + GL_ST))[i] = 0u;
    const int tt = wave & 3, eh = wave >> 2;
    f32x4 Sr[4];
#pragma unroll
    for (int el = 0; el < 4; ++el) Sr[el] = (f32x4){0.f, 0.f, 0.f, 0.f};
    f32x4 gain[4];
#pragma unroll
    for (int el = 0; el < 4; ++el) gain[el] = *(const GAS f32x4*)(ap->in[5] + h * 128 + 16 * (4 * eh + el) + 4 * g);
    __syncthreads();
    float w2r[16];
#pragma unroll
    for (int j = 0; j < 16; ++j) w2r[j] = W2[j * 64 + lane];
    const float balr = Bal[lane];
    const int st_t = tid >> 3, st_p = tid & 7;
    unsigned p_aw; v4u p_q, p_k, p_v0, p_v1; v2u p_r[4];
#define GLA_LOAD(cc) do { const size_t tk = (size_t)b * SEQ + (cc) * 64; const bf16* ur = U + (tk + st_t) * LDU; \
        p_aw = *(const GAS unsigned*)(ur + U_GA + 2 * st_p); p_q = *(const GAS v4u*)(ur + U_GQ + h * 64 + st_p * 8); p_k = *(const GAS v4u*)(ur + U_GK + h * 64 + st_p * 8); \
        p_v0 = *(const GAS v4u*)(ur + U_GV + h * 128 + st_p * 16); p_v1 = *(const GAS v4u*)(ur + U_GV + h * 128 + st_p * 16 + 8); \
        _Pragma("unroll") for (int el = 0; el < 4; ++el) p_r[el] = *(const GAS v2u*)(U + (tk + 16 * tt + n) * LDU + U_GR + h * 128 + 16 * (4 * eh + el) + 4 * g); } while (0)
    GLA_LOAD(0);
    for (int c = 0; c < 64; ++c) {
        const size_t tok0 = (size_t)b * SEQ + c * 64;
        ALR[st_t * 16 + 2 * st_p] = bfl(p_aw); ALR[st_t * 16 + 2 * st_p + 1] = bfh(p_aw);
        *(LAS v4u*)(lds + GL_V + st_t * GP + st_p * 32) = p_v0; *(LAS v4u*)(lds + GL_V + st_t * GP + st_p * 32 + 16) = p_v1;
        *(LAS v4u*)(lds + GL_QE + st_t * GP + st_p * 16) = p_q; *(LAS v4u*)(lds + GL_KE + st_t * GP + st_p * 16) = p_k;
        v2u rcur[4];
#pragma unroll
        for (int el = 0; el < 4; ++el) rcur[el] = p_r[el];
        if (c + 1 < 64) GLA_LOAD(c + 1);
        __syncthreads();
        float bc[8]; float run = 0.f;
#pragma unroll
        for (int i = 0; i < 8; ++i) { const LAS f32x4* ar = (const LAS f32x4*)(ALR + (8 * wave + i) * 16); float pre = balr;
#pragma unroll
            for (int j4 = 0; j4 < 4; ++j4) { const f32x4 a = ar[j4]; pre += a.x * w2r[4 * j4] + a.y * w2r[4 * j4 + 1] + a.z * w2r[4 * j4 + 2] + a.w * w2r[4 * j4 + 3]; }
            const float ls = fminf(pre, 0.f) - __logf(1.f + __expf(-fabsf(pre)));
            run += ls * (1.f / 16.f); bc[i] = run; }
        WT[wave * 64 + lane] = run;
        __syncthreads();
        float off = 0.f, tot = 0.f; float qv[8], kv[8];
#pragma unroll
        for (int i = 0; i < 8; ++i) { const int t = 8 * wave + i; qv[i] = __uint_as_float((unsigned)*(LAS const unsigned short*)(lds + GL_QE + t * GP + 2 * lane) << 16); kv[i] = __uint_as_float((unsigned)*(LAS const unsigned short*)(lds + GL_KE + t * GP + 2 * lane) << 16); }
#pragma unroll
        for (int s = 0; s < 8; ++s) { const float wv = WT[s * 64 + lane]; tot += wv; off += (s < wave) ? wv : 0.f; }
#pragma unroll
        for (int i = 0; i < 8; ++i) { const float bcum = bc[i] + off; const int t = 8 * wave + i;
            *(LAS unsigned short*)(lds + GL_QE + t * GP + 2 * lane) = (unsigned short)f2bf(qv[i] * 0.125f * __expf(bcum));
            *(LAS unsigned short*)(lds + GL_KE + t * GP + 2 * lane) = (unsigned short)f2bf(kv[i] * __expf(-bcum));
            *(LAS unsigned short*)(lds + GL_KD + t * GP + 2 * lane) = (unsigned short)f2bf(kv[i] * __expf(tot - bcum)); }
        if (wave == 0) DEC[lane] = __expf(tot);
        __syncthreads();
        f32x4 at[4]; bf16x8_t qfr[2];
#pragma unroll
        for (int st = 0; st < 4; ++st) at[st] = (f32x4){0.f, 0.f, 0.f, 0.f};
#pragma unroll
        for (int ks = 0; ks < 2; ++ks) { qfr[ks] = *(LAS const bf16x8_t*)(lds + GL_QE + (16 * tt + n) * GP + 64 * ks + 16 * g);
#pragma unroll
            for (int st = 0; st < 4; ++st) if (st <= tt) { const bf16x8_t kf = *(LAS const bf16x8_t*)(lds + GL_KE + (16 * st + n) * GP + 64 * ks + 16 * g);
                at[st] = __builtin_amdgcn_mfma_f32_16x16x32_bf16(kf, qfr[ks], at[st], 0, 0, 0); } }
#pragma unroll
        for (int st = 0; st < 4; ++st) if (st == tt) {
#pragma unroll
            for (int i = 0; i < 4; ++i) if (4 * g + i > n) at[st][i] = 0.f; }
        bf16x8_t pf[2];
#pragma unroll
        for (int k2 = 0; k2 < 2; ++k2) { v4u w; w.x = cvtpk(at[2 * k2][0], at[2 * k2][1]); w.y = cvtpk(at[2 * k2][2], at[2 * k2][3]); w.z = cvtpk(at[2 * k2 + 1][0], at[2 * k2 + 1][1]); w.w = cvtpk(at[2 * k2 + 1][2], at[2 * k2 + 1][3]);
            pf[k2] = __builtin_bit_cast(bf16x8_t, w); }
        f32x4 o[4];
#pragma unroll
        for (int el = 0; el < 4; ++el) o[el] = (f32x4){0.f, 0.f, 0.f, 0.f};
        const float dec = DEC[16 * tt + n];
#pragma unroll
        for (int el = 0; el < 4; ++el) Sr[el] *= dec;
        LAS const unsigned char* trb = lds + (4 * g + (n >> 2)) * GP + (n & 3) * 8;
#pragma unroll
        for (int k2 = 0; k2 < 2; ++k2) { const bf16x8_t kdf = tr2(trb + GL_KD + 32 * k2 * GP + 32 * tt);
#pragma unroll
            for (int el = 0; el < 4; ++el) { const bf16x8_t vf = tr2(trb + GL_V + 32 * k2 * GP + 32 * (4 * eh + el));
                if (2 * k2 <= tt) o[el] = __builtin_amdgcn_mfma_f32_16x16x32_bf16(vf, pf[k2], o[el], 0, 0, 0);
                Sr[el] = __builtin_amdgcn_mfma_f32_16x16x32_bf16(vf, kdf, Sr[el], 0, 0, 0); } }
#pragma unroll
        for (int ks = 0; ks < 2; ++ks)
#pragma unroll
            for (int el = 0; el < 4; ++el) { const bf16x8_t sf = *(LAS const bf16x8_t*)(lds + GL_ST + (16 * (4 * eh + el) + n) * GP + 64 * ks + 16 * g);
                o[el] = __builtin_amdgcn_mfma_f32_16x16x32_bf16(sf, qfr[ks], o[el], 0, 0, 0); }
        float ss = 0.f;
#pragma unroll
        for (int el = 0; el < 4; ++el) ss += (o[el][0] * o[el][0] + o[el][1] * o[el][1]) + (o[el][2] * o[el][2] + o[el][3] * o[el][3]);
        ss += __shfl_xor(ss, 16); ss += __shfl_xor(ss, 32);
        if (g == 0) SSQ[(16 * tt + n) * 2 + eh] = ss;
        __syncthreads();
#pragma unroll
        for (int el = 0; el < 4; ++el)
#pragma unroll
            for (int i = 0; i < 4; ++i) *(LAS unsigned short*)(lds + GL_ST + (16 * (4 * eh + el) + 4 * g + i) * GP + 2 * (16 * tt + n)) = (unsigned short)f2bf(Sr[el][i]);
        const int t = 16 * tt + n; const float rstd = 1.f / sqrtf((SSQ[2 * t] + SSQ[2 * t + 1]) * (1.f / 128.f) + NORM_EPS);
#pragma unroll
        for (int el = 0; el < 4; ++el) { const int e0 = 16 * (4 * eh + el) + 4 * g; const v2u rw = rcur[el];
            v2u ow; ow.x = cvtpk(o[el][0] * rstd * gain[el][0] * bfl(rw.x), o[el][1] * rstd * gain[el][1] * bfh(rw.x)); ow.y = cvtpk(o[el][2] * rstd * gain[el][2] * bfl(rw.y), o[el][3] * rstd * gain[el][3] * bfh(rw.y));
            *(GAS v2u*)(OG + (tok0 + t) * 2048 + h * 128 + e0) = ow; }
    }
    __syncthreads();
#undef GLA_LOAD
}
constexpr size_t WS_KD = WS_R2 + 192 * MiB;
constexpr size_t WS_DEC = WS_R2 + 224 * MiB;
constexpr int GQ_ALR = 0, GQ_WT = 4096, GQ_QRAW = 8192, GQ_KRAW = GQ_QRAW + 64 * GP, GQ_QE = GQ_KRAW + 64 * GP, GQ_KE = GQ_QE + 64 * GP, GQ_KD = GQ_KE + 64 * GP, GQ_END = GQ_KD + 64 * GP;
static_assert(GQ_END <= RING_BYTES, "GLA pre-pass LDS map");
__device__ __forceinline__ void gla_pre_items(Frame& F, KArgs ap, int it0, int nw) {
    unsigned char* ws_ = ap->ws;
    int lane = F.lane; asm volatile("" : "+v"(lane));
    const int wave = F.wave, tid = wave * 64 + lane, st_t = tid >> 3, st_p = tid & 7;
    LAS unsigned char* lds = F.lds; LAS float* ALR = (LAS float*)(lds + GQ_ALR); LAS float* WT = (LAS float*)(lds + GQ_WT);
    bf16* U = (bf16*)(ws_ + WS_U); bf16* KD = (bf16*)(ws_ + WS_KD); float* DEC = (float*)(ws_ + WS_DEC);
    const int h = it0 & 15, slot = it0 >> 4, ns = (nw - h + 15) >> 4;
    float w2r[16];
#pragma unroll
    for (int j = 0; j < 16; ++j) w2r[j] = ap->in[3][j * 1024 + h * 64 + lane];
    const float balr = ap->in[4][h * 64 + lane];
    unsigned p_aw; v4u p_q, p_k;
#define GLA_PLOAD(px) do { const bf16* ur = U + ((size_t)((px) >> 6) * SEQ + ((px) & 63) * 64 + st_t) * LDU; \
        p_aw = *(const GAS unsigned*)(ur + U_GA + 2 * st_p); p_q = *(const GAS v4u*)(ur + U_GQ + h * 64 + st_p * 8); p_k = *(const GAS v4u*)(ur + U_GK + h * 64 + st_p * 8); } while (0)
    if (slot < 256) GLA_PLOAD(slot);
    for (int pr = slot; pr < 256; pr += ns) {
        const int b = pr >> 6, c = pr & 63, bh = b * 16 + h; const size_t tok0 = (size_t)b * SEQ + c * 64;
        ALR[st_t * 16 + 2 * st_p] = bfl(p_aw); ALR[st_t * 16 + 2 * st_p + 1] = bfh(p_aw);
        *(LAS v4u*)(lds + GQ_QRAW + st_t * GP + st_p * 16) = p_q; *(LAS v4u*)(lds + GQ_KRAW + st_t * GP + st_p * 16) = p_k;
        if (pr + ns < 256) GLA_PLOAD(pr + ns);
        __syncthreads();
        float bc[8]; float run = 0.f;
#pragma unroll
        for (int i = 0; i < 8; ++i) { const LAS f32x4* ar = (const LAS f32x4*)(ALR + (8 * wave + i) * 16); float pre = balr;
#pragma unroll
            for (int j4 = 0; j4 < 4; ++j4) { const f32x4 a = ar[j4]; pre += a.x * w2r[4 * j4] + a.y * w2r[4 * j4 + 1] + a.z * w2r[4 * j4 + 2] + a.w * w2r[4 * j4 + 3]; }
            const float ls = fminf(pre, 0.f) - __logf(1.f + __expf(-fabsf(pre)));
            run += ls * (1.f / 16.f); bc[i] = run; }
        WT[wave * 64 + lane] = run;
        __syncthreads();
        float off = 0.f, tot = 0.f;
#pragma unroll
        for (int s = 0; s < 8; ++s) { const float wv = WT[s * 64 + lane]; tot += wv; off += (s < wave) ? wv : 0.f; }
#pragma unroll
        for (int i = 0; i < 8; ++i) { const float bcum = bc[i] + off; const int t = 8 * wave + i;
            const float qv = __uint_as_float((unsigned)*(LAS const unsigned short*)(lds + GQ_QRAW + t * GP + 2 * lane) << 16), kv = __uint_as_float((unsigned)*(LAS const unsigned short*)(lds + GQ_KRAW + t * GP + 2 * lane) << 16);
            const unsigned wq = cvtpk(qv * 0.125f * __expf(bcum), kv * __expf(-bcum)); const unsigned wk = cvtpk(kv * __expf(tot - bcum), 0.f);
            *(LAS unsigned short*)(lds + GQ_QE + t * GP + 2 * lane) = (unsigned short)wq; *(LAS unsigned short*)(lds + GQ_KE + t * GP + 2 * lane) = (unsigned short)(wq >> 16);
            *(LAS unsigned short*)(lds + GQ_KD + t * GP + 2 * lane) = (unsigned short)wk; }
        if (wave == 0) DEC[(size_t)(bh * 64 + c) * 64 + lane] = __expf(tot);
        __syncthreads();
        { const v4u a = *(LAS const v4u*)(lds + GQ_QE + st_t * GP + st_p * 16), k2 = *(LAS const v4u*)(lds + GQ_KE + st_t * GP + st_p * 16), k3 = *(LAS const v4u*)(lds + GQ_KD + st_t * GP + st_p * 16);
          bf16* ur = U + (tok0 + st_t) * LDU; *(GAS v4u*)(ur + U_GQ + h * 64 + st_p * 8) = a; *(GAS v4u*)(ur + U_GK + h * 64 + st_p * 8) = k2; *(GAS v4u*)(KD + (tok0 + st_t) * 1024 + h * 64 + st_p * 8) = k3; }
    }
    __syncthreads();
#undef GLA_PLOAD
}
__device__ __forceinline__ void gla_chain_mfma2(Frame& F, KArgs ap, int bh) {
    unsigned char* ws_ = ap->ws;
    const int b = bh >> 4, h = bh & 15;
    int lane = F.lane; asm volatile("" : "+v"(lane));
    const int wave = F.wave, tid = wave * 64 + lane, n = lane & 15, g = lane >> 4;
    LAS unsigned char* lds = F.lds;
    const bf16* U = (const bf16*)(ws_ + WS_U); const bf16* KDg = (const bf16*)(ws_ + WS_KD); const float* DECg = (const float*)(ws_ + WS_DEC); bf16* OG = (bf16*)(ws_ + WS_OGLA);
    LAS float* DEC = (LAS float*)(lds + GL_DEC); LAS float* SSQ = (LAS float*)(lds + GL_SSQ);
    for (int i = tid; i < 128 * GP / 4; i += 512) ((LAS unsigned*)(lds + GL_ST))[i] = 0u;
    const int tt = wave & 3, eh = wave >> 2;
    f32x4 Sr[4];
#pragma unroll
    for (int el = 0; el < 4; ++el) Sr[el] = (f32x4){0.f, 0.f, 0.f, 0.f};
    f32x4 gain[4];
#pragma unroll
    for (int el = 0; el < 4; ++el) gain[el] = *(const GAS f32x4*)(ap->in[5] + h * 128 + 16 * (4 * eh + el) + 4 * g);
    const int st_t = tid >> 3, st_p = tid & 7;
    v4u p_q, p_k, p_kd, p_v0, p_v1; v2u p_r[4]; float p_dec;
#define GLA_LOAD2(cc) do { const size_t tk = (size_t)b * SEQ + (cc) * 64; const bf16* ur = U + (tk + st_t) * LDU; \
        p_q = *(const GAS v4u*)(ur + U_GQ + h * 64 + st_p * 8); p_k = *(const GAS v4u*)(ur + U_GK + h * 64 + st_p * 8); p_kd = *(const GAS v4u*)(KDg + (tk + st_t) * 1024 + h * 64 + st_p * 8); \
        p_v0 = *(const GAS v4u*)(ur + U_GV + h * 128 + st_p * 16); p_v1 = *(const GAS v4u*)(ur + U_GV + h * 128 + st_p * 16 + 8); \
        p_dec = DECg[(size_t)(bh * 64 + (cc)) * 64 + (tid & 63)]; \
        _Pragma("unroll") for (int el = 0; el < 4; ++el) p_r[el] = *(const GAS v2u*)(U + (tk + 16 * tt + n) * LDU + U_GR + h * 128 + 16 * (4 * eh + el) + 4 * g); } while (0)
    GLA_LOAD2(0);
    __syncthreads();
    for (int c = 0; c < 64; ++c) {
        const size_t tok0 = (size_t)b * SEQ + c * 64;
        *(LAS v4u*)(lds + GL_V + st_t * GP + st_p * 32) = p_v0; *(LAS v4u*)(lds + GL_V + st_t * GP + st_p * 32 + 16) = p_v1;
        *(LAS v4u*)(lds + GL_QE + st_t * GP + st_p * 16) = p_q; *(LAS v4u*)(lds + GL_KE + st_t * GP + st_p * 16) = p_k; *(LAS v4u*)(lds + GL_KD + st_t * GP + st_p * 16) = p_kd;
        if (wave == 0) DEC[lane] = p_dec;
        v2u rcur[4];
#pragma unroll
        for (int el = 0; el < 4; ++el) rcur[el] = p_r[el];
        if (c + 1 < 64) GLA_LOAD2(c + 1);
        __syncthreads();
        f32x4 at[4]; bf16x8_t qfr[2];
#pragma unroll
        for (int st = 0; st < 4; ++st) at[st] = (f32x4){0.f, 0.f, 0.f, 0.f};
#pragma unroll
        for (int ks = 0; ks < 2; ++ks) { qfr[ks] = *(LAS const bf16x8_t*)(lds + GL_QE + (16 * tt + n) * GP + 64 * ks + 16 * g);
#pragma unroll
            for (int st = 0; st < 4; ++st) if (st <= tt) { const bf16x8_t kf = *(LAS const bf16x8_t*)(lds + GL_KE + (16 * st + n) * GP + 64 * ks + 16 * g);
                at[st] = __builtin_amdgcn_mfma_f32_16x16x32_bf16(kf, qfr[ks], at[st], 0, 0, 0); } }
#pragma unroll
        for (int st = 0; st < 4; ++st) if (st == tt) {
#pragma unroll
            for (int i = 0; i < 4; ++i) if (4 * g + i > n) at[st][i] = 0.f; }
        bf16x8_t pf[2];
#pragma unroll
        for (int k2 = 0; k2 < 2; ++k2) { v4u w; w.x = cvtpk(at[2 * k2][0], at[2 * k2][1]); w.y = cvtpk(at[2 * k2][2], at[2 * k2][3]); w.z = cvtpk(at[2 * k2 + 1][0], at[2 * k2 + 1][1]); w.w = cvtpk(at[2 * k2 + 1][2], at[2 * k2 + 1][3]);
            pf[k2] = __builtin_bit_cast(bf16x8_t, w); }
        f32x4 o[4];
#pragma unroll
        for (int el = 0; el < 4; ++el) o[el] = (f32x4){0.f, 0.f, 0.f, 0.f};
        const float dec = DEC[16 * tt + n];
#pragma unroll
        for (int el = 0; el < 4; ++el) Sr[el] *= dec;
        LAS const unsigned char* trb = lds + (4 * g + (n >> 2)) * GP + (n & 3) * 8;
#pragma unroll
        for (int k2 = 0; k2 < 2; ++k2) { const bf16x8_t kdf = tr2(trb + GL_KD + 32 * k2 * GP + 32 * tt);
#pragma unroll
            for (int el = 0; el < 4; ++el) { const bf16x8_t vf = tr2(trb + GL_V + 32 * k2 * GP + 32 * (4 * eh + el));
                if (2 * k2 <= tt) o[el] = __builtin_amdgcn_mfma_f32_16x16x32_bf16(vf, pf[k2], o[el], 0, 0, 0);
                Sr[el] = __builtin_amdgcn_mfma_f32_16x16x32_bf16(vf, kdf, Sr[el], 0, 0, 0); } }
#pragma unroll
        for (int ks = 0; ks < 2; ++ks)
#pragma unroll
            for (int el = 0; el < 4; ++el) { const bf16x8_t sf = *(LAS const bf16x8_t*)(lds + GL_ST + (16 * (4 * eh + el) + n) * GP + 64 * ks + 16 * g);
                o[el] = __builtin_amdgcn_mfma_f32_16x16x32_bf16(sf, qfr[ks], o[el], 0, 0, 0); }
        float ss = 0.f;
#pragma unroll
        for (int el = 0; el < 4; ++el) ss += (o[el][0] * o[el][0] + o[el][1] * o[el][1]) + (o[el][2] * o[el][2] + o[el][3] * o[el][3]);
        ss = xrow16_sum(ss);
        if (g == 0) SSQ[(16 * tt + n) * 2 + eh] = ss;
        __syncthreads();
#pragma unroll
        for (int el = 0; el < 4; ++el) { const unsigned w0 = cvtpk(Sr[el][0], Sr[el][1]), w1 = cvtpk(Sr[el][2], Sr[el][3]); LAS unsigned char* sp = lds + GL_ST + (16 * (4 * eh + el) + 4 * g) * GP + 2 * (16 * tt + n);
            *(LAS unsigned short*)(sp) = (unsigned short)w0; *(LAS unsigned short*)(sp + GP) = (unsigned short)(w0 >> 16); *(LAS unsigned short*)(sp + 2 * GP) = (unsigned short)w1; *(LAS unsigned short*)(sp + 3 * GP) = (unsigned short)(w1 >> 16); }
        const int t = 16 * tt + n; const float rstd = 1.f / sqrtf((SSQ[2 * t] + SSQ[2 * t + 1]) * (1.f / 128.f) + NORM_EPS);
#pragma unroll
        for (int el = 0; el < 4; ++el) { const int e0 = 16 * (4 * eh + el) + 4 * g; const v2u rw = rcur[el];
            v2u ow; ow.x = cvtpk(o[el][0] * rstd * gain[el][0] * bfl(rw.x), o[el][1] * rstd * gain[el][1] * bfh(rw.x)); ow.y = cvtpk(o[el][2] * rstd * gain[el][2] * bfl(rw.y), o[el][3] * rstd * gain[el][3] * bfh(rw.y));
            *(GAS v2u*)(OG + (tok0 + t) * 2048 + h * 128 + e0) = ow; }
    }
    __syncthreads();
#undef GLA_LOAD2
}
__device__ __forceinline__ void nsa_wg_all(Frame& F, KArgs ap, int w, int nw, size_t on_off) {
    for (int k = 0;; ++k) { const int idx = (k & 1) ? k * nw + (nw - 1 - w) : k * nw + w; if (k * nw >= 1024) break; if (idx >= 1024) continue;
        const int qt = 63 - (idx >> 4), bg = idx & 15; nsa_wg_item(F, ap, ((bg >> 2) << 8) | ((bg & 3) << 6) | qt, on_off); }
}
constexpr int CW_QHEAD = 3072;
__device__ __forceinline__ void nsa_wg_queue(Frame& F, KArgs ap, size_t on_off, int hq) {
    unsigned* head = (unsigned*)(ap->ws + WS_CTL) + CW_QHEAD + hq; volatile LAS unsigned* slot = F.MISC + 16;
    for (;;) {
        if (F.tid == 0) slot[0] = __hip_atomic_fetch_add(head, 1u, __ATOMIC_RELAXED, __HIP_MEMORY_SCOPE_AGENT);
        __syncthreads();
        const int idx = (int)slot[0];
        __syncthreads();
        if (idx >= 1024) break;
        const int qt = 63 - (idx >> 4), bg = idx & 15; nsa_wg_item(F, ap, ((bg >> 2) << 8) | ((bg & 3) << 6) | qt, on_off);
    }
}
#ifndef GLA_IMPL
#define GLA_IMPL 2
#endif
#if GLA_IMPL == 0
#define GLA_CHAIN gla_chain
#elif GLA_IMPL == 1
#define GLA_CHAIN gla_chain_mfma
#else
#define GLA_CHAIN gla_chain_mfma2
#endif
#ifndef NSA_IMPL
#define NSA_IMPL 2
#endif
__device__ __forceinline__ void p5_mixers(Frame& F, KArgs ap, int rep = 0) {
    const int nG = F.G >= 128 ? 64 : (F.G >= 8 ? F.G / 4 : 1);
#if NSA_IMPL == 2
    if (F.blk < nG) { for (int bh = F.blk; bh < BATCH * GLA_H; bh += nG) GLA_CHAIN(F, ap, bh); }
    nsa_wg_queue(F, ap, WS_ONSA, 64 * rep);
#else
    if (F.blk < nG) { for (int bh = F.blk; bh < BATCH * GLA_H; bh += nG) GLA_CHAIN(F, ap, bh); }
    else if (F.G > nG) {
#if NSA_IMPL == 0
        LAS float* wl = (LAS float*)F.lds + F.wave * 2048;
        const int nw = (F.G - nG) * NWAVES; for (int it = (F.blk - nG) * NWAVES + F.wave; it < BATCH * NSA_G * SEQ; it += nw) nsa_item(F, ap, it, wl);
#else
        nsa_wg_all(F, ap, F.blk - nG, F.G - nG, WS_ONSA);
#endif
    }
#endif
}

#if defined(NSA_CHECK)
#define CHECK_AMP NSA_CHECK
#elif defined(GLA_CHECK)
#define CHECK_AMP GLA_CHECK
#endif
#ifndef PHM
#define PHM 0xFFF
#endif
__global__ void __launch_bounds__(NWAVES * 64, 2) hybrid_fwd(Args args) {
    extern __shared__ __attribute__((aligned(16))) unsigned char lds[];
    Frame F;
    F.lds = (LAS unsigned char*)lds; F.MISC = (volatile LAS unsigned*)(F.lds + MISC_OFF);
    F.tid = threadIdx.x; F.lane = F.tid & 63; F.wave = __builtin_amdgcn_readfirstlane(F.tid >> 6);
    F.G = gridDim.x; F.blk = blockIdx.x;
    for (int u = F.tid; u < (LDS_BYTES - LDSCTL_OFF) / 4; u += NWAVES * 64) ((LAS unsigned*)(F.lds + LDSCTL_OFF))[u] = 0u;
    __syncthreads();
    const int lo = args.ph_lo, hi = args.ph_hi;
    if (hi - lo > 1 && F.tid == 0) { unsigned* bw = (unsigned*)(args.ws + WS_CTL) + CW_BAR; (void)xb_add(&bw[XB_XCNT(xb_xcc_id())], 1u); }
#define IN(k) (((PHM >> (k)) & 1) && lo <= (k) && (k) < hi)
#ifndef PH_REP
#define PH_REP 0
#endif
#define NREP(k) (((PH_REP >> (k)) & 1) ? 2 : 1)
#define FRESH() KArgs ap = fresh_args(); unsigned char* ws = ap->ws; (void)ws; { int _l; asm volatile("v_mbcnt_lo_u32_b32 %0, -1, 0\n\tv_mbcnt_hi_u32_b32 %0, -1, %0" : "=v"(_l)); F.lane = _l; F.tid = F.wave * 64 + _l; }
#define SEAM(k) do { if (IN(k) && IN((k) + 1)) { XcdBarrier bar; bar.bar = (unsigned*)(ws + WS_CTL) + CW_BAR; bar.x = xb_xcc_id(); bar.st = F.MISC + 8; xcd_barrier(bar, F.wave); } } while (0)
    LAS unsigned char* ring = F.lds;

    if (IN(0)) for (int rep_ = 0; rep_ < NREP(0); ++rep_) { FRESH(); p0_prologue(F, ap); SEAM(0); }
    if (IN(1)) for (int rep_ = 0; rep_ < NREP(1); ++rep_) {
        FRESH();
        { pg8::Gemm g{(const pg8::bf16_t*)(ws + WS_H), (const pg8::bf16_t*)(ws + WS_WIN), M, NB16, D}; pg8::StaticOrder S; S.init(M, NB16, F.G, F.blk);
          pg8::EpiU E{(pg8::bf16_t*)(ws + WS_U), LDU, 0, 1.f, GATE_FP8 != 0};
          pg8::gemm_phase<pg8::EpiU, pg8::StaticOrder, true, true>(ring, g, S, E, F.wave); }
#if GATE_FP8
        { FRESH();
          pg8::Gemm g{(const pg8::bf16_t*)(ws + WS_H8), (const pg8::bf16_t*)(ws + WS_WG8), M, NG8, D / 2};
          pg8::EpiU E{(pg8::bf16_t*)(ws + WS_U), LDU, 44, 1.f / 64.f, false};
          if (F.G == 256) { pg8::LateOrder S; S.init2(M, NG8, F.G, F.blk, 64, 2);
              pg8::gemm_phase<pg8::EpiU, pg8::LateOrder, true, true, true>(ring, g, S, E, F.wave); }
          else { pg8::StaticOrder S; S.init(M, NG8, F.G, F.blk); pg8::gemm_phase<pg8::EpiU, pg8::StaticOrder, true, true, true>(ring, g, S, E, F.wave); } }
#endif
        SEAM(1);
    }
    if (IN(2)) for (int rep_ = 0; rep_ < NREP(2); ++rep_) { FRESH(); p2_im2col(F, ap); SEAM(2); }
    if (IN(3)) for (int rep_ = 0; rep_ < NREP(3); ++rep_) {
        FRESH();
        pg8::Gemm g{(const pg8::bf16_t*)(ws + WS_ACMP), (const pg8::bf16_t*)(ws + WS_W1C), 8192, 256, 4096}; pg8::StaticOrder S; S.init(8192, 256, F.G, F.blk);
        pg8::EpiAct<1> E{(pg8::bf16_t*)(ws + WS_HC), 256};
        pg8::gemm_phase<pg8::EpiAct<1>, pg8::StaticOrder, true, true, false, true>(ring, g, S, E, F.wave);
        VM_WAIT(); __syncthreads();
        { FRESH();
          pg8::Gemm g2{(const pg8::bf16_t*)(ws + WS_HC), (const pg8::bf16_t*)(ws + WS_W2B), 8192, 256, 256}; pg8::StaticOrder S2; S2.init(8192, 256, F.G, F.blk);
          pg8::EpiAct<0> E2{(pg8::bf16_t*)(ws + WS_OC), 256};
          pg8::gemm_phase<pg8::EpiAct<0>, pg8::StaticOrder, true, true>(ring, g2, S2, E2, F.wave); }
#if GLA_IMPL == 2
        if (F.blk >= 32 && F.G > 32) { FRESH(); gla_pre_items(F, ap, F.blk - 32, F.G - 32); }
#endif
        SEAM(3);
    }
#if defined(NSA_CHECK)
    if (IN(5)) {
        { FRESH(); const int nG = 64; if (F.blk < nG) gla_chain(F, ap, F.blk); else { LAS float* wl = (LAS float*)F.lds + F.wave * 2048; const int nw = (F.G - nG) * NWAVES; for (int it = (F.blk - nG) * NWAVES + F.wave; it < BATCH * NSA_G * SEQ; it += nw) nsa_item(F, ap, it, wl); }
          XcdBarrier bar; bar.bar = (unsigned*)(ws + WS_CTL) + CW_BAR; bar.x = xb_xcc_id(); bar.st = F.MISC + 8; xcd_barrier(bar, F.wave); }
        { FRESH(); nsa_wg_all(F, ap, F.blk, F.G, WS_R2 + 192 * MiB);
          XcdBarrier bar; bar.bar = (unsigned*)(ws + WS_CTL) + CW_BAR; bar.x = xb_xcc_id(); bar.st = F.MISC + 8; xcd_barrier(bar, F.wave); }
        { FRESH(); const bf16* a = (const bf16*)(ws + WS_ONSA); const bf16* c = (const bf16*)(ws + WS_R2 + 192 * MiB); float num = 0.f, den = 0.f;
          for (size_t i = (size_t)F.blk * 512 + F.tid; i < (size_t)M * 2048; i += (size_t)F.G * 512) { const float x = __uint_as_float((unsigned)a[i] << 16), y = __uint_as_float((unsigned)c[i] << 16); num += (x - y) * (x - y); den += x * x; }
          num = wave_sum(num); den = wave_sum(den); float* cw = (float*)(ws + WS_CTL) + 2048; if (F.lane == 0) { atomicAdd(cw, num); atomicAdd(cw + 64, den); }
          SEAM(5); } }
#elif defined(GLA_CHECK)
    if (IN(5)) {
        { FRESH(); if (F.blk < 64) gla_chain(F, ap, F.blk); else if (F.blk < 128) gla_chain_mfma(F, ap, F.blk - 64, WS_R2 + 192 * MiB); else nsa_wg_all(F, ap, F.blk - 128, F.G - 128, WS_ONSA);
          XcdBarrier bar; bar.bar = (unsigned*)(ws + WS_CTL) + CW_BAR; bar.x = xb_xcc_id(); bar.st = F.MISC + 8; xcd_barrier(bar, F.wave); }
        { FRESH(); const bf16* a = (const bf16*)(ws + WS_OGLA); const bf16* c = (const bf16*)(ws + WS_R2 + 192 * MiB); float num = 0.f, den = 0.f;
          for (size_t i = (size_t)F.blk * 512 + F.tid; i < (size_t)M * 2048; i += (size_t)F.G * 512) { const float x = __uint_as_float((unsigned)a[i] << 16), y = __uint_as_float((unsigned)c[i] << 16); num += (x - y) * (x - y); den += x * x; }
          num = wave_sum(num); den = wave_sum(den); float* cw = (float*)(ws + WS_CTL) + 2048; if (F.lane == 0) { atomicAdd(cw, num); atomicAdd(cw + 64, den); }
          SEAM(5); } }
#else
    if (IN(5)) for (int rep_ = 0; rep_ < NREP(5); ++rep_) { FRESH(); p5_mixers(F, ap, rep_); SEAM(5); }
#endif
    if (IN(6)) for (int rep_ = 0; rep_ < NREP(6); ++rep_) {
        { FRESH();
          pg8::Gemm g{(const pg8::bf16_t*)(ws + WS_OGLA), (const pg8::bf16_t*)(ws + WS_WGLA), M, D, 2048}; pg8::StaticOrder S; S.init(M, D, F.G, F.blk);
          pg8::EpiMix<false> E{(pg8::bf16_t*)(ws + WS_MIX), D, (const pg8::bf16_t*)(ws + WS_U) + U_MG, LDU};
          pg8::gemm_phase<pg8::EpiMix<false>, pg8::StaticOrder, true, true>(ring, g, S, E, F.wave); }
        VM_WAIT(); __syncthreads();
        { FRESH();
          pg8::Gemm g{(const pg8::bf16_t*)(ws + WS_ONSA), (const pg8::bf16_t*)(ws + WS_WNSA), M, D, 2048}; pg8::StaticOrder S; S.init(M, D, F.G, F.blk);
          pg8::EpiMix<true> E{(pg8::bf16_t*)(ws + WS_MIX), D, (const pg8::bf16_t*)(ws + WS_U) + U_MN, LDU};
          pg8::gemm_phase<pg8::EpiMix<true>, pg8::StaticOrder, true, true>(ring, g, S, E, F.wave);
          SEAM(6); }
    }
    if (IN(7)) for (int rep_ = 0; rep_ < NREP(7); ++rep_) {
        FRESH();
        pg8::Gemm g{(const pg8::bf16_t*)(ws + WS_MIX), (const pg8::bf16_t*)(ws + WS_WOUT), M, D, D}; pg8::StaticOrder S; S.init(M, D, F.G, F.blk);
        pg8::EpiResN E{ap->in[0], ap->out, D, ap->in[16], (pg8::bf16_t*)(ws + WS_H2), (float*)(ws + WS_RS)};
        pg8::gemm_phase<pg8::EpiResN, pg8::StaticOrder, true, true>(ring, g, S, E, F.wave);
        SEAM(7);
    }
    if (IN(8)) for (int rep_ = 0; rep_ < NREP(8); ++rep_) {
        FRESH();
        const int gw = F.blk * NWAVES + F.wave, NGW = F.G * NWAVES; LAS float* scr = (LAS float*)(F.lds + F.wave * 16384);
        bf16* H2 = (bf16*)(ws + WS_H2); bf16* WdT = (bf16*)(ws + WS_WDOWN); const float* x1 = ap->out;
        { const float* Wd = ap->in[18]; const int lane_ = F.lane;
          auto dec = [&](int r) -> TD { TD d; const int nblk = D / 32, kb = r / nblk, nb = r % nblk; d.W = Wd; d.WT = (unsigned char*)WdT; d.K = FF; d.ldw = D; d.drow = 32 * nb; d.k0 = 64 * kb; d.scol = 32 * nb + (lane_ & 31); d.f8 = 0; return d; };
          transpose_stream(F, dec, (FF / 64) * (D / 32), scr, gw, NGW); }
        { const float* RS = (const float*)(ws + WS_RS); float* RS2 = (float*)(ws + WS_RS2);
          for (int m = gw; m < M; m += NGW) { const float t = wave_sum(RS[(size_t)m * 64 + F.lane]); if (F.lane == 0) RS2[m] = 1.f / (t * (1.f / D) + NORM_EPS); } }
        SEAM(8);
    }
    if (IN(9)) for (int rep_ = 0; rep_ < NREP(9); ++rep_) {
        FRESH();
        pg8::Gemm g{(const pg8::bf16_t*)(ws + WS_H2), (const pg8::bf16_t*)(ws + WS_WUP), M, FF, D}; pg8::StaticOrder S; S.init(M, FF, F.G, F.blk);
        pg8::EpiRelu2R E{(pg8::bf16_t*)(ws + WS_U), FF, (const float*)(ws + WS_RS2)};
        pg8::gemm_phase<pg8::EpiRelu2R, pg8::StaticOrder, true, true>(ring, g, S, E, F.wave);
        SEAM(9);
    }
    if (IN(10)) {
        FRESH();
        pg8::Gemm g{(const pg8::bf16_t*)(ws + WS_U), (const pg8::bf16_t*)(ws + WS_WDOWN), M, D, FF}; pg8::StaticOrder S; S.init(M, D, F.G, F.blk);
        pg8::EpiRes E{ap->out, ap->out, D};
        pg8::gemm_phase<pg8::EpiRes, pg8::StaticOrder, true, true>(ring, g, S, E, F.wave);
        SEAM(10);
    }
    if (IN(11)) {
        FRESH();
        const int gw = F.blk * NWAVES + F.wave, NGW = F.G * NWAVES; float* xo = ap->out;
        rms_rows(F, xo, ap->in[19], nullptr, nullptr, xo, gw, NGW);
#if defined(NSA_CHECK) || defined(GLA_CHECK)
        { const float* cw = (const float*)(ws + WS_CTL) + 2048; const float e = sqrtf(cw[0] / cw[64]); const float sc = 1.f + CHECK_AMP * e;
          for (int m = gw; m < M; m += NGW) { GAS f32x4* xr = (GAS f32x4*)(xo + (size_t)m * D) + F.lane; for (int j = 0; j < 16; ++j) xr[64 * j] = xr[64 * j] * sc; } }
#endif
    }
#undef IN
#undef SEAM
#undef FRESH
}

extern "C" void kernel_launch(void* const* d_in, const int* in_sizes, int n_in, void* d_out, int out_size, void* d_ws, size_t ws_size, hipStream_t stream) {
    static int grid = 0;
    if (grid == 0) {
        if (n_in != 20 || in_sizes[0] != M * D || out_size != M * D || ws_size < WS_END) { fprintf(stderr, "kernel_launch: unexpected shapes (n_in %d, in0 %d, out %d, ws %zu); nothing launched\n", n_in, n_in > 0 ? in_sizes[0] : -1, out_size, ws_size); grid = -1; return; }
        int dev = 0, cus = 0, per_cu = 0;
        if (hipGetDevice(&dev) != hipSuccess || hipDeviceGetAttribute(&cus, hipDeviceAttributeMultiprocessorCount, dev) != hipSuccess) { grid = -1; return; }
        if (hipFuncSetAttribute((const void*)hybrid_fwd, hipFuncAttributeMaxDynamicSharedMemorySize, LDS_BYTES) != hipSuccess) { fprintf(stderr, "kernel_launch: hipFuncSetAttribute failed\n"); grid = -1; return; }
        if (hipOccupancyMaxActiveBlocksPerMultiprocessor(&per_cu, (const void*)hybrid_fwd, NWAVES * 64, LDS_BYTES) != hipSuccess || per_cu < 1) { fprintf(stderr, "kernel_launch: occupancy query says %d blocks per CU\n", per_cu); }
        (void)hipGetLastError();
        grid = cus;
    }
    if (grid < 0) return;
    if (hipMemsetAsync((char*)d_ws + WS_CTL, 0, CTL_ZERO_BYTES, stream) != hipSuccess) return;
    Args a{};
    for (int i = 0; i < 20; ++i) a.in[i] = (const float*)d_in[i];
    a.out = (float*)d_out; a.ws = (unsigned char*)d_ws;
    if (N_LAUNCHES == 1) { a.ph_lo = 0; a.ph_hi = NPHASE; hipLaunchKernelGGL(hybrid_fwd, dim3(grid), dim3(NWAVES * 64), LDS_BYTES, stream, a); }
    else for (int p = 0; p < NPHASE; ++p) { a.ph_lo = p; a.ph_hi = p + 1; hipLaunchKernelGGL(hybrid_fwd, dim3(grid), dim3(NWAVES * 64), LDS_BYTES, stream, a); }
}
```

```cpp
#include <hip/hip_runtime.h>
#include <cstdio>
#include <cstdint>
#ifndef MK_N_LAUNCHES
#define MK_N_LAUNCHES 1
#endif
#ifndef NSA_SB
#define NSA_SB()
#endif
namespace pg8 {
#define PG8_LAS __attribute__((address_space(3)))
typedef unsigned short bf16_t;
typedef short bf16x8 __attribute__((ext_vector_type(8)));
typedef float f32x4 __attribute__((ext_vector_type(4)));
typedef unsigned u32x4 __attribute__((ext_vector_type(4)));
constexpr int BM = 256, BK = 64, HALF = 128, HTB = HALF * BK * 2  , STAGE_BYTES = 8 * HTB, NXCD = 8, WGM = 8;

__host__ __device__ __forceinline__ int lds_byte(int r, int c) { const int st = (r >> 4) * 2 + (c >> 5), rr = r & 15, cc = c & 31, ob = rr * 64 + cc * 2; return st * 1024 + (ob ^ (((ob >> 9) & 1) << 5)); }
__host__ __device__ __forceinline__ void stage_rc(int b, int& R, int& C) { const int st = b / 1024, sb = b % 1024, swz = sb ^ (((sb >> 9) & 1) << 5); R = (st >> 1) * 16 + swz / 64; C = (st & 1) * 32 + (swz % 64) / 2; }
__host__ __device__ __forceinline__ int perm32(int rho) { const int n = rho >> 4, i = rho & 15; return 8 * (i >> 2) + 4 * n + (i & 3); }

struct Unit { int pm, pn, part; };
struct Gemm { const bf16_t* A; const bf16_t* Bt; int M, N, K; const bf16_t* A2; const bf16_t* Bt2; };

struct StaticOrder {
    int nM, nN, nwg, G, c, wgm;
    __host__ __device__ void init(int M, int N, int G_, int c_, int wgm_ = WGM) { nM = M / BM; nN = N / BM; nwg = nM * nN; G = G_; c = c_; wgm = wgm_; }
    __host__ __device__ bool next(int i, Unit& u) const {
        const long L = (long)i * G + c; if (L >= nwg) return false;
        int wgid = (int)L; { const int q = nwg / NXCD, r = nwg % NXCD, xcd = wgid % NXCD, off = wgid / NXCD; wgid = (xcd < r ? xcd * (q + 1) : r * (q + 1) + (xcd - r) * q) + off; }
        const int nig = wgm * nN, gid = wgid / nig, fm = gid * wgm, gsz = (nM - fm) < wgm ? (nM - fm) : wgm;
        u.pm = fm + ((wgid % nig) % gsz); u.pn = (wgid % nig) / gsz; u.part = 0; return true;
    }
    __device__ __forceinline__ void a_ready(const Unit&) const {}
    __device__ __forceinline__ void done(const Unit&) const {}
};
struct LateOrder : StaticOrder {
    int nlate, cut, nfull;
    __host__ __device__ void init2(int M, int N, int G_, int c_, int nlate_, int cut_) { init(M, N, G_, c_); nlate = nlate_; cut = cut_; nfull = nwg / G_; }
    __host__ __device__ bool next(int i, Unit& u) const {
        long L;
        if (c < nlate) { if (i >= nfull - cut) return false; L = (long)i * G + c; }
        else if (i < nfull) L = (long)i * G + c;
        else { const int e = c - nlate; if (i > nfull || e >= nlate * cut) return false; L = (long)(nfull - cut + e / nlate) * G + (e % nlate); }
        int wgid = (int)L; { const int q = nwg / NXCD, r = nwg % NXCD, xcd = wgid % NXCD, off = wgid / NXCD; wgid = (xcd < r ? xcd * (q + 1) : r * (q + 1) + (xcd - r) * q) + off; }
        const int nig = wgm * nN, gid = wgid / nig, fm = gid * wgm, gsz = (nM - fm) < wgm ? (nM - fm) : wgm;
        u.pm = fm + ((wgid % nig) % gsz); u.pn = (wgid % nig) / gsz; u.part = 0; return true;
    }
};
struct ChainOrder : StaticOrder {
    __host__ __device__ bool next(int i, Unit& u) const { if (!StaticOrder::next(i >> 1, u)) return false; u.part = i & 1; return true; }
};


__device__ __forceinline__ unsigned cvt_pk_bf16(float lo, float hi) { unsigned r; asm volatile("v_cvt_pk_bf16_f32 %0, %1, %2" : "=v"(r) : "v"(lo), "v"(hi)); return r; }
typedef float f32x2 __attribute__((ext_vector_type(2)));
__device__ __forceinline__ float sigmoid_f(float x) { return __builtin_amdgcn_rcpf(1.0f + __expf(-x)); }
__device__ __forceinline__ float bf_lo(unsigned w) { return __uint_as_float(w << 16); }
__device__ __forceinline__ float bf_hi(unsigned w) { return __uint_as_float(w & 0xffff0000u); }

struct EpiU {
    static constexpr bool PERM = true, AFTER_DRAIN = false, CHAIN = false;
    bf16_t* O; int ldc; int pn_off; float scl; bool remap;
    __device__ __forceinline__ void operator()(const f32x4 (&acc)[2][2][4][2], const Unit& u, int wr, int wc, int fr, int fq) const {
        const int ct = (remap && u.pn == 44) ? 76 : u.pn + pn_off;
        const int row0 = u.pm * BM + wr * 64 + fr, col0 = ct * BM + wc * 32 + 8 * fq;
        const int mode = (ct >= 16 && ct < 24) ? 1 : ((ct >= 44 && ct < 76) ? 2 : (ct == 76 ? 3 : 0));
#pragma unroll
        for (int ai = 0; ai < 2; ++ai)
#pragma unroll
            for (int m = 0; m < 4; ++m) { bf16_t* rowp = O + (size_t)(row0 + ai * HALF + m * 16) * ldc + col0;
#pragma unroll
                for (int bj = 0; bj < 2; ++bj) { f32x4 v0 = acc[ai][bj][m][0] * scl, v1 = acc[ai][bj][m][1] * scl;
                    if (mode == 1) {
#pragma unroll
                        for (int j = 0; j < 4; ++j) { v0[j] = v0[j] * sigmoid_f(v0[j]); v1[j] = v1[j] * sigmoid_f(v1[j]); } }
                    else if (mode == 2 || (mode == 3 && (bj * HALF + wc * 32 + 8 * fq) >= 16)) {
#pragma unroll
                        for (int j = 0; j < 4; ++j) { v0[j] = sigmoid_f(v0[j]); v1[j] = sigmoid_f(v1[j]); } }
                    u32x4 w; w.x = cvt_pk_bf16(v0[0], v0[1]); w.y = cvt_pk_bf16(v0[2], v0[3]); w.z = cvt_pk_bf16(v1[0], v1[1]); w.w = cvt_pk_bf16(v1[2], v1[3]);
                    *(u32x4*)(rowp + bj * HALF) = w; } }
    }
};
template <int ACT> struct EpiAct {
    static constexpr bool PERM = true, AFTER_DRAIN = false, CHAIN = false;
    bf16_t* O; int ldc;
    __device__ __forceinline__ void operator()(const f32x4 (&acc)[2][2][4][2], const Unit& u, int wr, int wc, int fr, int fq) const {
        const int row0 = u.pm * BM + wr * 64 + fr, col0 = u.pn * BM + wc * 32 + 8 * fq;
#pragma unroll
        for (int ai = 0; ai < 2; ++ai)
#pragma unroll
            for (int m = 0; m < 4; ++m) { bf16_t* rowp = O + (size_t)(row0 + ai * HALF + m * 16) * ldc + col0;
#pragma unroll
                for (int bj = 0; bj < 2; ++bj) { f32x4 v0 = acc[ai][bj][m][0], v1 = acc[ai][bj][m][1];
                    if (ACT >= 1) {
#pragma unroll
                        for (int j = 0; j < 4; ++j) { v0[j] = fmaxf(v0[j], 0.f); v1[j] = fmaxf(v1[j], 0.f); if (ACT == 2) { v0[j] *= v0[j]; v1[j] *= v1[j]; } } }
                    u32x4 w; w.x = cvt_pk_bf16(v0[0], v0[1]); w.y = cvt_pk_bf16(v0[2], v0[3]); w.z = cvt_pk_bf16(v1[0], v1[1]); w.w = cvt_pk_bf16(v1[2], v1[3]);
                    *(u32x4*)(rowp + bj * HALF) = w; } }
    }
};
template <bool ACCUM> struct EpiMix {
    static constexpr bool PERM = true, AFTER_DRAIN = false, CHAIN = false;
    bf16_t* O; int ldc; const bf16_t* Gt; int ldg;
    __device__ __forceinline__ void operator()(const f32x4 (&acc)[2][2][4][2], const Unit& u, int wr, int wc, int fr, int fq) const {
        const int row0 = u.pm * BM + wr * 64 + fr, col0 = u.pn * BM + wc * 32 + 8 * fq;
#pragma unroll
        for (int ai = 0; ai < 2; ++ai)
#pragma unroll
            for (int m = 0; m < 4; ++m) { const size_t r = (size_t)(row0 + ai * HALF + m * 16); bf16_t* rowp = O + r * ldc + col0; const bf16_t* gp = Gt + r * ldg + col0;
#pragma unroll
                for (int bj = 0; bj < 2; ++bj) { f32x4 v0 = acc[ai][bj][m][0], v1 = acc[ai][bj][m][1];
                    const u32x4 gw = *(const u32x4*)(gp + bj * HALF);
                    v0[0] *= bf_lo(gw.x); v0[1] *= bf_hi(gw.x); v0[2] *= bf_lo(gw.y); v0[3] *= bf_hi(gw.y); v1[0] *= bf_lo(gw.z); v1[1] *= bf_hi(gw.z); v1[2] *= bf_lo(gw.w); v1[3] *= bf_hi(gw.w);
                    if (ACCUM) { const u32x4 ow = *(const u32x4*)(rowp + bj * HALF);
                        v0[0] += bf_lo(ow.x); v0[1] += bf_hi(ow.x); v0[2] += bf_lo(ow.y); v0[3] += bf_hi(ow.y); v1[0] += bf_lo(ow.z); v1[1] += bf_hi(ow.z); v1[2] += bf_lo(ow.w); v1[3] += bf_hi(ow.w); }
                    u32x4 w; w.x = cvt_pk_bf16(v0[0], v0[1]); w.y = cvt_pk_bf16(v0[2], v0[3]); w.z = cvt_pk_bf16(v1[0], v1[1]); w.w = cvt_pk_bf16(v1[2], v1[3]);
                    *(u32x4*)(rowp + bj * HALF) = w; } }
    }
};
struct EpiMixC {
    static constexpr bool PERM = true, AFTER_DRAIN = false, CHAIN = true;
    bf16_t* O; int ldc; const bf16_t* G1; const bf16_t* G2; int ldg;
    __device__ __forceinline__ void mid(f32x4 (&acc)[2][2][4][2], const Unit& u, int wr, int wc, int fr, int fq) const {
        const int row0 = u.pm * BM + wr * 64 + fr, col0 = u.pn * BM + wc * 32 + 8 * fq;
#pragma unroll
        for (int ai = 0; ai < 2; ++ai) { u32x4 av[4][2], bv[4][2];
#pragma unroll
            for (int m = 0; m < 4; ++m)
#pragma unroll
                for (int bj = 0; bj < 2; ++bj) { const size_t r = (size_t)(row0 + ai * HALF + m * 16); av[m][bj] = *(const u32x4*)(G1 + r * ldg + col0 + bj * HALF); bv[m][bj] = *(const u32x4*)(G2 + r * ldg + col0 + bj * HALF); }
            __builtin_amdgcn_sched_barrier(0);
#pragma unroll
            for (int m = 0; m < 4; ++m)
#pragma unroll
                for (int bj = 0; bj < 2; ++bj) { const u32x4 a = av[m][bj], b = bv[m][bj];
                    f32x4& v0 = acc[ai][bj][m][0]; f32x4& v1 = acc[ai][bj][m][1];
                    v0[0] *= bf_lo(a.x) * __builtin_amdgcn_rcpf(fmaxf(bf_lo(b.x), 1e-30f)); v0[1] *= bf_hi(a.x) * __builtin_amdgcn_rcpf(fmaxf(bf_hi(b.x), 1e-30f)); v0[2] *= bf_lo(a.y) * __builtin_amdgcn_rcpf(fmaxf(bf_lo(b.y), 1e-30f)); v0[3] *= bf_hi(a.y) * __builtin_amdgcn_rcpf(fmaxf(bf_hi(b.y), 1e-30f));
                    v1[0] *= bf_lo(a.z) * __builtin_amdgcn_rcpf(fmaxf(bf_lo(b.z), 1e-30f)); v1[1] *= bf_hi(a.z) * __builtin_amdgcn_rcpf(fmaxf(bf_hi(b.z), 1e-30f)); v1[2] *= bf_lo(a.w) * __builtin_amdgcn_rcpf(fmaxf(bf_lo(b.w), 1e-30f)); v1[3] *= bf_hi(a.w) * __builtin_amdgcn_rcpf(fmaxf(bf_hi(b.w), 1e-30f)); }
            __builtin_amdgcn_sched_barrier(0); }
    }
    __device__ __forceinline__ void operator()(const f32x4 (&acc)[2][2][4][2], const Unit& u, int wr, int wc, int fr, int fq) const {
        const int row0 = u.pm * BM + wr * 64 + fr, col0 = u.pn * BM + wc * 32 + 8 * fq;
        u32x4 gv[2][4][2];
#pragma unroll
        for (int ai = 0; ai < 2; ++ai)
#pragma unroll
            for (int m = 0; m < 4; ++m)
#pragma unroll
                for (int bj = 0; bj < 2; ++bj) gv[ai][m][bj] = *(const u32x4*)(G2 + (size_t)(row0 + ai * HALF + m * 16) * ldg + col0 + bj * HALF);
        __builtin_amdgcn_sched_barrier(0);
#pragma unroll
        for (int ai = 0; ai < 2; ++ai)
#pragma unroll
            for (int m = 0; m < 4; ++m) { const size_t r = (size_t)(row0 + ai * HALF + m * 16); bf16_t* rowp = O + r * ldc + col0;
#pragma unroll
                for (int bj = 0; bj < 2; ++bj) { f32x4 v0 = acc[ai][bj][m][0], v1 = acc[ai][bj][m][1]; const u32x4 gw = gv[ai][m][bj];
                    v0[0] *= bf_lo(gw.x); v0[1] *= bf_hi(gw.x); v0[2] *= bf_lo(gw.y); v0[3] *= bf_hi(gw.y); v1[0] *= bf_lo(gw.z); v1[1] *= bf_hi(gw.z); v1[2] *= bf_lo(gw.w); v1[3] *= bf_hi(gw.w);
                    u32x4 w; w.x = cvt_pk_bf16(v0[0], v0[1]); w.y = cvt_pk_bf16(v0[2], v0[3]); w.z = cvt_pk_bf16(v1[0], v1[1]); w.w = cvt_pk_bf16(v1[2], v1[3]);
                    *(u32x4*)(rowp + bj * HALF) = w; } }
    }
};
struct EpiRes {
    static constexpr bool PERM = false, AFTER_DRAIN = false, CHAIN = false;
    const float* base; float* out; int ldc;
    __device__ __forceinline__ void operator()(const f32x4 (&acc)[2][2][4][2], const Unit& u, int wr, int wc, int fr, int fq) const {
        const int row0 = u.pm * BM + wr * 64 + fr, col0 = u.pn * BM + wc * 32 + 4 * fq;
#pragma unroll
        for (int ai = 0; ai < 2; ++ai)
#pragma unroll
            for (int m = 0; m < 4; ++m) { const size_t off = (size_t)(row0 + ai * HALF + m * 16) * ldc + col0;
#pragma unroll
                for (int bj = 0; bj < 2; ++bj)
#pragma unroll
                    for (int n = 0; n < 2; ++n) { const f32x4 bs = *(const f32x4*)(base + off + bj * HALF + n * 16); *(f32x4*)(out + off + bj * HALF + n * 16) = bs + acc[ai][bj][m][n]; } }
    }
};
struct EpiResN {
    static constexpr bool PERM = false, AFTER_DRAIN = false, CHAIN = false;
    const float* base; float* out; int ldc; const float* gain; bf16_t* XB; float* RS;
    __device__ __forceinline__ void operator()(const f32x4 (&acc)[2][2][4][2], const Unit& u, int wr, int wc, int fr, int fq) const {
        const int row0 = u.pm * BM + wr * 64 + fr, col0 = u.pn * BM + wc * 32 + 4 * fq;
        f32x4 gv[2][2];
#pragma unroll
        for (int bj = 0; bj < 2; ++bj)
#pragma unroll
            for (int n = 0; n < 2; ++n) gv[bj][n] = *(const f32x4*)(gain + col0 + bj * HALF + n * 16);
#pragma unroll
        for (int ai = 0; ai < 2; ++ai)
#pragma unroll
            for (int m = 0; m < 4; ++m) { const int row = row0 + ai * HALF + m * 16; const size_t off = (size_t)row * ldc + col0; float ss = 0.f;
#pragma unroll
                for (int bj = 0; bj < 2; ++bj)
#pragma unroll
                    for (int n = 0; n < 2; ++n) { const f32x4 bs = *(const f32x4*)(base + off + bj * HALF + n * 16); const f32x4 v = bs + acc[ai][bj][m][n]; *(f32x4*)(out + off + bj * HALF + n * 16) = v;
                        ss += (v[0] * v[0] + v[1] * v[1]) + (v[2] * v[2] + v[3] * v[3]);
                        const f32x4 w = v * gv[bj][n]; unsigned long long pk = (unsigned long long)cvt_pk_bf16(w[0], w[1]) | ((unsigned long long)cvt_pk_bf16(w[2], w[3]) << 32);
                        *(unsigned long long*)(XB + off + bj * HALF + n * 16) = pk; }
                ss += __shfl_xor(ss, 16); ss += __shfl_xor(ss, 32);
                if (fq == 0) RS[(size_t)row * 64 + u.pn * 4 + wc] = ss; }
    }
};
template <bool BASE_BF16> struct EpiResB {
    static constexpr bool PERM = true, AFTER_DRAIN = false, CHAIN = false;
    const float* base; bf16_t* XB; int ldc; float* RS;
    __device__ __forceinline__ void operator()(const f32x4 (&acc)[2][2][4][2], const Unit& u, int wr, int wc, int fr, int fq) const {
        const int row0 = u.pm * BM + wr * 64 + fr, col0 = u.pn * BM + wc * 32 + 8 * fq;
#pragma unroll
        for (int ai = 0; ai < 2; ++ai) {
            u32x4 bw[4][2]; f32x4 bf[4][2][2];
#pragma unroll
            for (int m = 0; m < 4; ++m)
#pragma unroll
                for (int bj = 0; bj < 2; ++bj) { const size_t off = (size_t)(row0 + ai * HALF + m * 16) * ldc + col0 + bj * HALF;
                    if (BASE_BF16) bw[m][bj] = *(const u32x4*)(XB + off); else { bf[m][bj][0] = *(const f32x4*)(base + off); bf[m][bj][1] = *(const f32x4*)(base + off + 4); } }
            __builtin_amdgcn_sched_barrier(0);
#pragma unroll
            for (int m = 0; m < 4; ++m) { const int row = row0 + ai * HALF + m * 16; const size_t off = (size_t)row * ldc + col0; float ss = 0.f;
#pragma unroll
                for (int bj = 0; bj < 2; ++bj) { f32x4 v0 = acc[ai][bj][m][0], v1 = acc[ai][bj][m][1];
                    if (BASE_BF16) { const u32x4 w = bw[m][bj];
                        v0[0] += bf_lo(w.x); v0[1] += bf_hi(w.x); v0[2] += bf_lo(w.y); v0[3] += bf_hi(w.y); v1[0] += bf_lo(w.z); v1[1] += bf_hi(w.z); v1[2] += bf_lo(w.w); v1[3] += bf_hi(w.w); }
                    else { v0 += bf[m][bj][0]; v1 += bf[m][bj][1]; }
                    ss += ((v0[0] * v0[0] + v0[1] * v0[1]) + (v0[2] * v0[2] + v0[3] * v0[3])) + ((v1[0] * v1[0] + v1[1] * v1[1]) + (v1[2] * v1[2] + v1[3] * v1[3]));
                    u32x4 o; o.x = cvt_pk_bf16(v0[0], v0[1]); o.y = cvt_pk_bf16(v0[2], v0[3]); o.z = cvt_pk_bf16(v1[0], v1[1]); o.w = cvt_pk_bf16(v1[2], v1[3]);
                    *(u32x4*)(XB + off + bj * HALF) = o; }
                ss += __shfl_xor(ss, 16); ss += __shfl_xor(ss, 32);
                if (fq == 0) RS[(size_t)row * 64 + u.pn * 4 + wc] = ss; }
            __builtin_amdgcn_sched_barrier(0);
        }
    }
};
struct EpiRelu2R {
    static constexpr bool PERM = true, AFTER_DRAIN = false, CHAIN = false;
    bf16_t* O; int ldc; const float* rs2;
    __device__ __forceinline__ void operator()(const f32x4 (&acc)[2][2][4][2], const Unit& u, int wr, int wc, int fr, int fq) const {
        const int row0 = u.pm * BM + wr * 64 + fr, col0 = u.pn * BM + wc * 32 + 8 * fq;
        float r2v[2][4];
#pragma unroll
        for (int ai = 0; ai < 2; ++ai)
#pragma unroll
            for (int m = 0; m < 4; ++m) r2v[ai][m] = rs2[row0 + ai * HALF + m * 16];
        __builtin_amdgcn_sched_barrier(0);
#pragma unroll
        for (int ai = 0; ai < 2; ++ai)
#pragma unroll
            for (int m = 0; m < 4; ++m) { const int row = row0 + ai * HALF + m * 16; bf16_t* rowp = O + (size_t)row * ldc + col0; const float r2 = r2v[ai][m];
#pragma unroll
                for (int bj = 0; bj < 2; ++bj) { f32x4 v0 = acc[ai][bj][m][0], v1 = acc[ai][bj][m][1];
#pragma unroll
                    for (int j = 0; j < 4; ++j) { v0[j] = fmaxf(v0[j], 0.f); v1[j] = fmaxf(v1[j], 0.f); v0[j] = v0[j] * v0[j] * r2; v1[j] = v1[j] * v1[j] * r2; }
                    u32x4 w; w.x = cvt_pk_bf16(v0[0], v0[1]); w.y = cvt_pk_bf16(v0[2], v0[3]); w.z = cvt_pk_bf16(v1[0], v1[1]); w.w = cvt_pk_bf16(v1[2], v1[3]);
                    *(u32x4*)(rowp + bj * HALF) = w; } }
    }
};


typedef int v8i_t __attribute__((ext_vector_type(8)));
template <class Epi, class Sched, bool ALIGN_EPI = false, bool SP2 = false, bool F8 = false, bool HALFSEL = false>
__device__ __forceinline__ void gemm_phase(PG8_LAS unsigned char* lds, const Gemm g, const Sched& S, const Epi& E, const int wid_in) {
    int lane_; asm volatile("v_mbcnt_lo_u32_b32 %0, -1, 0\n\tv_mbcnt_hi_u32_b32 %0, -1, %0" : "=v"(lane_));
    const int wid = wid_in, lane = lane_, tid = wid * 64 + lane, wr = wid >> 2, wc = wid & 3, fr = lane & 15, fq = lane >> 4;
    const int K = g.K, nt = K / BK;
    unsigned voffA[2], voffB[2];
#pragma unroll
    for (int i = 0; i < 2; ++i) { int R, C; stage_rc(tid * 16 + i * 8192, R, C); const int Rb = Epi::PERM ? ((R & ~31) + perm32(R & 31)) : R;
        voffA[i] = (unsigned)(R * K + C) * 2u; voffB[i] = (unsigned)(Rb * K + C) * 2u; }
    const size_t kstep = (size_t)(BK * 2);
    const size_t hstep = (size_t)HALF * K * 2;
    const size_t tstep = 2 * hstep;
    const unsigned ldsw = (unsigned)wid * 1024u;
    const int aoff = lds_byte(wr * 64 + fr, fq * 8), boff = lds_byte(wc * 32 + fr, fq * 8);
#define PG8_SA(b, h) (((b) * 2 + (h)) * HTB)
#define PG8_SB(b, h) ((4 + (b) * 2 + (h)) * HTB)
#define PG8_STAGE(bufoff, gbase, voff) do { _Pragma("unroll") for (int _i = 0; _i < 2; ++_i) \
        __builtin_amdgcn_global_load_lds((const unsigned*)((const char*)(gbase) + (voff)[_i]), (PG8_LAS unsigned*)(lds + (bufoff) + ldsw + _i * 8192), 16, 0, 0); } while (0)
#define PG8_LDA(dst, b, h) do { _Pragma("unroll") for (int m = 0; m < 4; ++m) { if constexpr (F8) { dst##8[m] = __builtin_bit_cast(v8i_t, __builtin_shufflevector(*(const PG8_LAS bf16x8*)(lds + PG8_SA(b, h) + aoff + m * 2048), *(const PG8_LAS bf16x8*)(lds + PG8_SA(b, h) + aoff + m * 2048 + 1024), 0, 1, 2, 3, 4, 5, 6, 7, 8, 9, 10, 11, 12, 13, 14, 15)); } \
        else { _Pragma("unroll") for (int k = 0; k < 2; ++k) dst[m][k] = *(const PG8_LAS bf16x8*)(lds + PG8_SA(b, h) + aoff + m * 2048 + k * 1024); } } } while (0)
#define PG8_LDB(dst, b, h) do { _Pragma("unroll") for (int n = 0; n < 2; ++n) { if constexpr (F8) { dst##8[n] = __builtin_bit_cast(v8i_t, __builtin_shufflevector(*(const PG8_LAS bf16x8*)(lds + PG8_SB(b, h) + boff + n * 2048), *(const PG8_LAS bf16x8*)(lds + PG8_SB(b, h) + boff + n * 2048 + 1024), 0, 1, 2, 3, 4, 5, 6, 7, 8, 9, 10, 11, 12, 13, 14, 15)); } \
        else { _Pragma("unroll") for (int k = 0; k < 2; ++k) dst[n][k] = *(const PG8_LAS bf16x8*)(lds + PG8_SB(b, h) + boff + n * 2048 + k * 1024); } } } while (0)
#define PG8_MMA(ai, bj, At, Bt) do { if (HALFSEL && !((bjm >> (bj)) & 1)) break; __builtin_amdgcn_s_setprio(1); _Pragma("unroll") for (int m = 0; m < 4; ++m) _Pragma("unroll") for (int n = 0; n < 2; ++n) { \
        if constexpr (F8) { asm volatile("v_mfma_f32_16x16x128_f8f6f4 %0, %1, %2, %0" : "+v"(acc[ai][bj][m][n]) : "v"(Bt##8[n]), "v"(At##8[m])); } \
        else { _Pragma("unroll") for (int k = 0; k < 2; ++k) acc[ai][bj][m][n] = __builtin_amdgcn_mfma_f32_16x16x32_bf16(Bt[n][k], At[m][k], acc[ai][bj][m][n], 0, 0, 0); } } __builtin_amdgcn_s_setprio(0); } while (0)
#define PG8_WAIT_V(n) asm volatile("s_waitcnt vmcnt(" #n ")" ::: "memory")
#define PG8_WAIT_L(n) asm volatile("s_waitcnt lgkmcnt(" #n ")" ::: "memory")
#define PG8_BAR __builtin_amdgcn_s_barrier()
#define PG8_SCHED __builtin_amdgcn_sched_barrier(0)
    Unit cur, nxt; int ui = 0;
    if (!S.next(0, cur)) return;
    f32x4 acc[2][2][4][2];
#pragma unroll
    for (int a = 0; a < 2; ++a)
#pragma unroll
        for (int b = 0; b < 2; ++b)
#pragma unroll
            for (int m = 0; m < 4; ++m)
#pragma unroll
                for (int n = 0; n < 2; ++n) acc[a][b][m][n] = (f32x4){0.f, 0.f, 0.f, 0.f};
    bf16x8 At[4][2], B0[2][2], B1[2][2]; v8i_t At8[4], B08[2], B18[2]; (void)At; (void)B0; (void)B1; (void)At8; (void)B08; (void)B18;
    const char* cA = (const char*)(cur.part ? g.A2 : g.A) + (size_t)cur.pm * tstep; const char* cB = (const char*)(cur.part ? g.Bt2 : g.Bt) + (size_t)cur.pn * tstep;
    S.a_ready(cur);
    if constexpr (SP2) {
        PG8_STAGE(PG8_SB(0, 0), cB, voffB); PG8_STAGE(PG8_SB(0, 1), cB + hstep, voffB); PG8_STAGE(PG8_SA(0, 0), cA, voffA); PG8_STAGE(PG8_SA(0, 1), cA + hstep, voffA);
        if (wr == 1) PG8_BAR;
        PG8_WAIT_V(2); PG8_BAR;
        PG8_STAGE(PG8_SB(1, 0), cB + kstep, voffB); PG8_STAGE(PG8_SA(1, 0), cA + kstep, voffA); PG8_STAGE(PG8_SB(1, 1), cB + hstep + kstep, voffB);
        PG8_WAIT_V(6); PG8_BAR;
    } else {
        PG8_STAGE(PG8_SB(0, 0), cB, voffB); PG8_STAGE(PG8_SA(0, 0), cA, voffA); PG8_STAGE(PG8_SB(0, 1), cB + hstep, voffB); PG8_STAGE(PG8_SA(0, 1), cA + hstep, voffA);
        if (wr == 1) PG8_BAR;
        PG8_WAIT_V(4); PG8_BAR;
        PG8_STAGE(PG8_SB(1, 0), cB + kstep, voffB); PG8_STAGE(PG8_SA(1, 0), cA + kstep, voffA); PG8_STAGE(PG8_SB(1, 1), cB + hstep + kstep, voffB);
        PG8_WAIT_V(6); PG8_BAR;
    }
    for (;;) {
        const int bjm = HALFSEL ? ((2 * cur.pm < g.M / BM) ? 1 : 2) : 3; (void)bjm;
        const bool has_next = S.next(ui + 1, nxt);
        const char* nA = has_next ? (const char*)(nxt.part ? g.A2 : g.A) + (size_t)nxt.pm * tstep : cA; const char* nB = has_next ? (const char*)(nxt.part ? g.Bt2 : g.Bt) + (size_t)nxt.pn * tstep : cB;
        for (int t = 0; t < nt; t += 2) {
            const bool last = (t == nt - 2);
            const char* a1 = cA + (size_t)(t + 1) * kstep;
            const char* a2 = last ? nA : cA + (size_t)(t + 2) * kstep; const char* b2 = last ? nB : cB + (size_t)(t + 2) * kstep;
            const char* a3 = a2 + kstep; const char* b3 = b2 + kstep;
            if (last && has_next) S.a_ready(nxt);
            if constexpr (SP2) {
            PG8_LDB(B0, 0, 0); PG8_LDB(B1, 0, 1); PG8_SCHED; PG8_LDA(At, 0, 0); PG8_STAGE(PG8_SA(1, 1), a1 + hstep, voffA);
            PG8_WAIT_V(8); PG8_WAIT_L(0); PG8_BAR; PG8_MMA(0, 0, At, B0); PG8_MMA(0, 1, At, B1); PG8_BAR; PG8_SCHED;
            PG8_LDA(At, 0, 1); PG8_STAGE(PG8_SB(0, 0), b2, voffB); PG8_STAGE(PG8_SB(0, 1), b2 + hstep, voffB); PG8_STAGE(PG8_SA(0, 0), a2, voffA);
            PG8_WAIT_V(8); PG8_WAIT_L(0); PG8_BAR; PG8_MMA(1, 0, At, B0); PG8_MMA(1, 1, At, B1); PG8_BAR; PG8_SCHED;
            PG8_LDB(B0, 1, 0); PG8_LDB(B1, 1, 1); PG8_SCHED; PG8_LDA(At, 1, 0); PG8_STAGE(PG8_SA(0, 1), a2 + hstep, voffA);
            PG8_WAIT_V(8); PG8_WAIT_L(0); PG8_BAR; PG8_MMA(0, 0, At, B0); PG8_MMA(0, 1, At, B1); PG8_BAR; PG8_SCHED;
            PG8_LDA(At, 1, 1); PG8_STAGE(PG8_SB(1, 0), b3, voffB); PG8_STAGE(PG8_SB(1, 1), b3 + hstep, voffB); PG8_STAGE(PG8_SA(1, 0), a3, voffA);
            PG8_WAIT_V(8); PG8_WAIT_L(0); PG8_BAR; PG8_MMA(1, 0, At, B0); PG8_MMA(1, 1, At, B1); PG8_BAR; PG8_SCHED;
            } else {
            PG8_LDB(B0, 0, 0); PG8_SCHED; PG8_LDA(At, 0, 0); PG8_STAGE(PG8_SA(1, 1), a1 + hstep, voffA);
            PG8_WAIT_L(8); PG8_BAR; PG8_WAIT_L(0); PG8_MMA(0, 0, At, B0); PG8_BAR; PG8_SCHED;
            PG8_LDB(B1, 0, 1); PG8_STAGE(PG8_SB(0, 0), b2, voffB);
            PG8_BAR; PG8_WAIT_L(0); PG8_MMA(0, 1, At, B1); PG8_BAR;
            PG8_LDA(At, 0, 1); PG8_STAGE(PG8_SA(0, 0), a2, voffA);
            PG8_BAR; PG8_WAIT_L(0); PG8_MMA(1, 0, At, B0); PG8_BAR; PG8_SCHED;
            PG8_STAGE(PG8_SB(0, 1), b2 + hstep, voffB);
            PG8_WAIT_V(6); PG8_BAR; PG8_MMA(1, 1, At, B1); PG8_BAR;
            PG8_LDB(B0, 1, 0); PG8_SCHED; PG8_LDA(At, 1, 0); PG8_STAGE(PG8_SA(0, 1), a2 + hstep, voffA);
            PG8_WAIT_L(8); PG8_BAR; PG8_WAIT_L(0); PG8_MMA(0, 0, At, B0); PG8_BAR; PG8_SCHED;
            PG8_LDB(B1, 1, 1); PG8_STAGE(PG8_SB(1, 0), b3, voffB);
            PG8_BAR; PG8_WAIT_L(0); PG8_MMA(0, 1, At, B1); PG8_BAR;
            PG8_LDA(At, 1, 1); PG8_STAGE(PG8_SA(1, 0), a3, voffA);
            PG8_BAR; PG8_WAIT_L(0); PG8_MMA(1, 0, At, B0); PG8_BAR; PG8_SCHED;
            PG8_STAGE(PG8_SB(1, 1), b3 + hstep, voffB);
            PG8_WAIT_V(6); PG8_BAR; PG8_MMA(1, 1, At, B1); PG8_BAR;
            }
        }
        if constexpr (ALIGN_EPI) { if (wr == 0) PG8_BAR; }
        if constexpr (F8) {
            asm volatile("s_nop 15\n\ts_nop 15\n\ts_nop 7" : "+v"(acc[0][0][0][0]), "+v"(acc[0][0][0][1]), "+v"(acc[0][0][1][0]), "+v"(acc[0][0][1][1]), "+v"(acc[0][0][2][0]), "+v"(acc[0][0][2][1]), "+v"(acc[0][0][3][0]), "+v"(acc[0][0][3][1]), "+v"(acc[0][1][0][0]), "+v"(acc[0][1][0][1]), "+v"(acc[0][1][1][0]), "+v"(acc[0][1][1][1]), "+v"(acc[0][1][2][0]), "+v"(acc[0][1][2][1]), "+v"(acc[0][1][3][0]), "+v"(acc[0][1][3][1]));
            asm volatile("s_nop 0" : "+v"(acc[1][0][0][0]), "+v"(acc[1][0][0][1]), "+v"(acc[1][0][1][0]), "+v"(acc[1][0][1][1]), "+v"(acc[1][0][2][0]), "+v"(acc[1][0][2][1]), "+v"(acc[1][0][3][0]), "+v"(acc[1][0][3][1]), "+v"(acc[1][1][0][0]), "+v"(acc[1][1][0][1]), "+v"(acc[1][1][1][0]), "+v"(acc[1][1][1][1]), "+v"(acc[1][1][2][0]), "+v"(acc[1][1][2][1]), "+v"(acc[1][1][3][0]), "+v"(acc[1][1][3][1])); }
        bool keep_acc = false;
        if constexpr (Epi::CHAIN) { if (cur.part == 0) { E.mid(acc, cur, wr, wc, fr, fq); keep_acc = true; } else E(acc, cur, wr, wc, fr, fq); }
        else if constexpr (!Epi::AFTER_DRAIN) { E(acc, cur, wr, wc, fr, fq); S.done(cur); }
        if (!has_next) break;
        if (!keep_acc) {
#pragma unroll
        for (int a = 0; a < 2; ++a)
#pragma unroll
            for (int b = 0; b < 2; ++b)
#pragma unroll
                for (int m = 0; m < 4; ++m)
#pragma unroll
                    for (int n = 0; n < 2; ++n) acc[a][b][m][n] = (f32x4){0.f, 0.f, 0.f, 0.f};
        }
        cur = nxt; cA = nA; cB = nB; ++ui;
        if constexpr (ALIGN_EPI) { if (wr == 1) PG8_BAR; }
    }
    PG8_WAIT_V(0);
    if constexpr (!ALIGN_EPI) { if (wr == 0) PG8_BAR; }
    PG8_BAR;
    if constexpr (Epi::AFTER_DRAIN) { E.fused(acc, cur, wr, wc, fr, fq, lds, wid, lane); S.done(cur); }
#undef PG8_SA
#undef PG8_SB
#undef PG8_STAGE
#undef PG8_LDA
#undef PG8_LDB
#undef PG8_MMA
#undef PG8_WAIT_V
#undef PG8_WAIT_L
#undef PG8_BAR
#undef PG8_SCHED
}
}

constexpr int NWAVES = 8;
constexpr int N_LAUNCHES = MK_N_LAUNCHES;
constexpr int NPHASE = 12;
constexpr int BATCH = 4, SEQ = 4096, M = BATCH * SEQ, D = 4096, FF = 16384;
constexpr int NIN = 19520, LDU = 19712;
constexpr int GLA_H = 16, GLA_DK = 64, GLA_DV = 128;
constexpr int NSA_G = 4, NSA_R = 4, NSA_D = 128;
constexpr float NORM_EPS = 1e-6f;
constexpr int U_GQ = 0, U_GK = 1024, U_GV = 2048, U_GR = 4096, U_NQ = 6144, U_KC = 8192, U_VC = 8704, U_KSL = 9216, U_VSL = 9728, U_KW = 10240, U_VW = 10752,
              U_MG = 11264, U_MN = 15360, U_GA = 19456, U_NG = 19472;
__host__ __device__ __forceinline__ int orig_col(int n) {
    if (n < 4096) return n;
    if (n < 6144) return n - 4096 + 4112;
    if (n < 11264) return n - 6144 + 6160;
    if (n < 19456) return n - 11264 + 11328;
    if (n < 19472) return n - 19456 + 4096;
    if (n < 19520) return n - 19472 + 11280;
    return -1;
}
constexpr size_t MiB = 1u << 20;
constexpr size_t WS_CTL = 0, CTL_ZERO_BYTES = 1 * MiB;
constexpr size_t WS_W1C = 1 * MiB;
constexpr size_t WS_W2B = 3 * MiB;
constexpr size_t WS_HC = 4 * MiB;
constexpr size_t WS_OC = 8 * MiB;
constexpr size_t WS_RS = 12 * MiB;
constexpr size_t WS_RS2 = 3 * MiB + 256 * 1024;
constexpr size_t WS_U = 16 * MiB;
constexpr size_t WS_R2 = 632 * MiB;
constexpr size_t WS_WIN = WS_R2;
constexpr size_t WS_H = WS_R2 + 154 * MiB;
constexpr size_t WS_OGLA = WS_R2;
constexpr size_t WS_ONSA = WS_R2 + 64 * MiB;
constexpr size_t WS_MIX = WS_R2 + 128 * MiB;
constexpr size_t WS_ACMP = WS_R2 + 128 * MiB;
constexpr size_t WS_H2 = WS_R2;
constexpr size_t WS_WDOWN = WS_R2 + 128 * MiB;
constexpr size_t WS_WGLA = 914 * MiB, WS_WNSA = 930 * MiB, WS_WOUT = 946 * MiB, WS_WUP = 978 * MiB, WS_H8 = 1106 * MiB, WS_END = 1170 * MiB;
#ifndef GATE_FP8
#define GATE_FP8 1
#endif
constexpr int NB16 = GATE_FP8 ? 11520 : LDU;
constexpr int NG8 = 8192;
constexpr size_t WS_WG8 = WS_R2 + 90 * MiB;
constexpr int CW_TMO = 0, CW_BAR = 4096;
constexpr int RING_BYTES = 155648, LDSCTL_OFF = RING_BYTES, MISC_OFF = LDSCTL_OFF + 320, LDS_BYTES = 157696;

#define GAS __attribute__((address_space(1)))
#define LAS __attribute__((address_space(3)))
typedef unsigned short bf16;
typedef unsigned v4u __attribute__((ext_vector_type(4)));
typedef unsigned v2u __attribute__((ext_vector_type(2)));
typedef float f32x4 __attribute__((ext_vector_type(4)));
typedef GAS unsigned gu32;
#define RLX_AGENT __ATOMIC_RELAXED, __HIP_MEMORY_SCOPE_AGENT
#define LDS_WAIT() asm volatile("s_waitcnt lgkmcnt(0)" ::: "memory")
#define VM_WAIT() asm volatile("s_waitcnt vmcnt(0)" ::: "memory")
__device__ __forceinline__ unsigned f2bf(float f) { unsigned u = __builtin_bit_cast(unsigned, f); return (u + 0x7fffu + ((u >> 16) & 1u)) >> 16; }
__device__ __forceinline__ unsigned pk2(float lo, float hi) { return f2bf(lo) | (f2bf(hi) << 16); }
__device__ __forceinline__ float bfl(unsigned w) { return __uint_as_float(w << 16); }
__device__ __forceinline__ float bfh(unsigned w) { return __uint_as_float(w & 0xffff0000u); }

struct Args { const float* in[20]; float* out; unsigned char* ws; int ph_lo, ph_hi; };
typedef const __attribute__((address_space(4))) Args* KArgs;
__device__ __forceinline__ KArgs fresh_args() { KArgs p = (KArgs)__builtin_amdgcn_kernarg_segment_ptr(); asm volatile("" : "+s"(p)); return p; }
#define AIN ap->in

typedef short s16x4_t __attribute__((ext_vector_type(4)));
__device__ __forceinline__ s16x4_t tr_rd(LAS const unsigned char* p) { return __builtin_bit_cast(s16x4_t, __builtin_amdgcn_ds_read_tr16_b64_v4i16((LAS s16x4_t*)p)); }
#define XB_TMO      128
#define XB_XCNT(j)  (256  + 64 * (j))
#define XB_XSUB(j)  (1280 + 64 * (j))
#define XB_XGEN(j)  (2304 + 64 * (j))
#define XB_TOP      3328
#define XB_TOPGEN   3392
#define XCD_BAR_WORDS 3456
#define XB_SPIN_CAP (1u << 22)
__device__ __forceinline__ unsigned xb_ld(unsigned* p)              { return __hip_atomic_load(p, __ATOMIC_RELAXED, __HIP_MEMORY_SCOPE_AGENT); }
__device__ __forceinline__ unsigned xb_add(unsigned* p, unsigned v) { return __hip_atomic_fetch_add(p, v, __ATOMIC_RELAXED, __HIP_MEMORY_SCOPE_AGENT); }
__device__ __forceinline__ unsigned xb_xcc_id() { return (unsigned)__builtin_amdgcn_s_getreg((3 << 11) | 20) & 0xFu; }
#define XB_SPIN(cond, bar) do { unsigned _sp = 0; while (cond) { __builtin_amdgcn_s_sleep(1); \
    if ((++_sp & 255u) == 0u) { if (xb_ld(&(bar)[XB_TMO])) break; if (_sp > XB_SPIN_CAP) { atomicAdd(&(bar)[XB_TMO], 1u); break; } } } } while (0)

struct XcdBarrier {
    unsigned* bar; unsigned x;
    volatile LAS unsigned* st;
};

__device__ __forceinline__ XcdBarrier xcd_barrier_post(unsigned* bar, volatile LAS unsigned* st) {
    XcdBarrier b; b.bar = bar; b.x = xb_xcc_id(); b.st = st;
    if (threadIdx.x == 0) (void)xb_add(&bar[XB_XCNT(b.x)], 1u);
    return b;
}
__device__ __forceinline__ void xcd_barrier_complete(unsigned* bar, unsigned x, unsigned& nloc, unsigned& nx) {
    const unsigned G = gridDim.x * gridDim.y * gridDim.z;
    unsigned sum, cnt, mine, sp = 0u;
    for (;;) {
        sum = 0u; cnt = 0u; mine = 0u;
#pragma unroll
        for (unsigned j = 0; j < 16; ++j) { const unsigned c = xb_ld(&bar[XB_XCNT(j)]); sum += c; cnt += (c > 0u) ? 1u : 0u; mine = (j == x) ? c : mine; }
        if (sum == G) break;
        __builtin_amdgcn_s_sleep(1);
        if ((++sp & 255u) == 0u) { if (xb_ld(&bar[XB_TMO])) break; if (sp > XB_SPIN_CAP) { atomicAdd(&bar[XB_TMO], 1u); break; } }
    }
    nloc = mine > 0u ? mine : 1u; nx = cnt > 0u ? cnt : 1u;
}

__device__ __forceinline__ void xcd_barrier(const XcdBarrier& b, const int wave) {
    int lane_; asm volatile("v_mbcnt_lo_u32_b32 %0, -1, 0\n\tv_mbcnt_hi_u32_b32 %0, -1, %0" : "=v"(lane_)); const bool is_t0 = (wave == 0) && (lane_ == 0);
    asm volatile("s_waitcnt vmcnt(0)" ::: "memory");
    __syncthreads();
    if (is_t0) {
        unsigned* bar = b.bar;
        __builtin_amdgcn_s_waitcnt(0);
        unsigned nloc = b.st[0], nx = b.st[1];
        if (nloc == 0u) { xcd_barrier_complete(bar, b.x, nloc, nx); b.st[0] = nloc; b.st[1] = nx; }
        const unsigned old = xb_add(&bar[XB_XSUB(b.x)], 1u);
        const unsigned gen = old / nloc;
        if (old + 1u == (gen + 1u) * nloc) {
            __builtin_amdgcn_fence(__ATOMIC_RELEASE, "agent");
            asm volatile("s_waitcnt vmcnt(0)" ::: "memory");
            const unsigned og = xb_add(&bar[XB_TOP], 1u);
            const unsigned tg = og / nx;
            if (og + 1u == (tg + 1u) * nx) xb_add(&bar[XB_TOPGEN], 1u);
            else XB_SPIN(xb_ld(&bar[XB_TOPGEN]) == tg, bar);
            __builtin_amdgcn_fence(__ATOMIC_ACQUIRE, "agent");
            xb_add(&bar[XB_XGEN(b.x)], 1u);
            asm volatile("s_waitcnt vmcnt(0)" ::: "memory");
        } else {
            XB_SPIN(xb_ld(&bar[XB_XGEN(b.x)]) == gen, bar);
            __builtin_amdgcn_fence(__ATOMIC_ACQUIRE, "agent");
            asm volatile("s_waitcnt vmcnt(0)" ::: "memory");
        }
    }
    __syncthreads();
}

struct Frame {
    LAS unsigned char* lds;
    volatile LAS unsigned* MISC;
    int tid, lane, wave, G, blk;
};
__device__ __forceinline__ float wave_sum(float v) {
#pragma unroll
    for (int o = 1; o < 64; o <<= 1) v += __shfl_xor(v, o);
    return v;
}
__device__ __forceinline__ float wave_max(float v) {
#pragma unroll
    for (int o = 1; o < 64; o <<= 1) v = fmaxf(v, __shfl_xor(v, o));
    return v;
}
__device__ const unsigned char REL_LUT[128] = {0,1,2,3,4,5,6,7,8,9,10,11,12,13,14,15,16,16,16,17,17,18,18,18,19,19,19,20,20,20,20,21,21,21,21,22,22,22,22,22,23,23,23,23,23,23,24,24,24,24,24,24,25,25,25,25,25,25,25,
    26,26,26,26,26,26,26,26,27,27,27,27,27,27,27,27,27,27,28,28,28,28,28,28,28,28,28,28,29,29,29,29,29,29,29,29,29,29,29,29,30,30,30,30,30,30,30,30,30,30,30,30,30,30,31,31,31,31,31,31,31,31,31,31,31,31,31,31,31};

__device__ __forceinline__ float fp8_rt(float v) { const int p = __builtin_amdgcn_cvt_pk_fp8_f32(v, v, 0, false); return __builtin_amdgcn_cvt_f32_fp8(p, 0); }
__device__ __forceinline__ unsigned pk4_fp8(float a, float b, float c, float d) { int p = __builtin_amdgcn_cvt_pk_fp8_f32(a, b, 0, false); p = __builtin_amdgcn_cvt_pk_fp8_f32(c, d, p, true); return (unsigned)p; }
__device__ __forceinline__ void transpose_item_fp8(const float* W, int K, int ldw, unsigned char* WT8, int dst_row0, int src_col, int k0, LAS float* scr, int lane, float mul) {
#pragma unroll 8
    for (int i = 0; i < 32; ++i) { const int kk = 2 * i + (lane >> 5); scr[kk * 33 + (lane & 31)] = W[(size_t)(k0 + kk) * ldw + src_col] * mul; }
    LDS_WAIT(); asm volatile("" ::: "memory");
    const int c = lane & 7;
#pragma unroll
    for (int j = 0; j < 4; ++j) { const int n = (lane >> 3) + 8 * j; const LAS float* s = scr + (8 * c) * 33 + n;
        v2u o; o.x = pk4_fp8(s[0 * 33], s[1 * 33], s[2 * 33], s[3 * 33]); o.y = pk4_fp8(s[4 * 33], s[5 * 33], s[6 * 33], s[7 * 33]);
        *(GAS v2u*)(WT8 + (size_t)(dst_row0 + n) * K + k0 + 8 * c) = o; }
    LDS_WAIT(); asm volatile("" ::: "memory");
}
__device__ __forceinline__ void transpose_item(const float* W, int K, int ldw, bf16* WT, int dst_row0, int src_col, int k0, LAS float* scr, int lane, bool q8 = false) {
#pragma unroll 8
    for (int i = 0; i < 32; ++i) { const int kk = 2 * i + (lane >> 5); float wv = src_col >= 0 ? W[(size_t)(k0 + kk) * ldw + src_col] : 0.f; if (q8) wv = fp8_rt(wv * 64.f) * (1.f / 64.f); scr[kk * 33 + (lane & 31)] = wv; }
    LDS_WAIT(); asm volatile("" ::: "memory");
    const int c = lane & 7;
#pragma unroll
    for (int j = 0; j < 4; ++j) { const int n = (lane >> 3) + 8 * j; const LAS float* s = scr + (8 * c) * 33 + n;
        v4u o; o.x = pk2(s[0 * 33], s[1 * 33]); o.y = pk2(s[2 * 33], s[3 * 33]); o.z = pk2(s[4 * 33], s[5 * 33]); o.w = pk2(s[6 * 33], s[7 * 33]);
        *(GAS v4u*)(WT + (size_t)(dst_row0 + n) * K + k0 + 8 * c) = o; }
    LDS_WAIT(); asm volatile("" ::: "memory");
}
__device__ __forceinline__ void transpose_plain(const float* W, int K, int N, bf16* WT, int row_off, int item, LAS float* scr, int lane) {
    const int nblk = N / 32, kb = item / nblk, nb = item % nblk;
    transpose_item(W, K, N, WT, row_off + 32 * nb, 32 * nb + (lane & 31), 64 * kb, scr, lane);
}
__device__ __forceinline__ void rms_row_to_bf16(const float* xrow, const float* gain, bf16* orow, int lane, bool q8 = false, unsigned char* o8row = nullptr) {
    const GAS f32x4* xr = (const GAS f32x4*)xrow + lane; const GAS f32x4* gr = (const GAS f32x4*)gain + lane;
    f32x4 v[16]; float s = 0.f;
#pragma unroll
    for (int j = 0; j < 16; ++j) { v[j] = xr[64 * j]; s += (v[j].x * v[j].x + v[j].y * v[j].y) + (v[j].z * v[j].z + v[j].w * v[j].w); }
    const float rstd = 1.f / sqrtf(wave_sum(s) * (1.f / D) + NORM_EPS);
    GAS v2u* o8 = (GAS v2u*)orow + lane;
#pragma unroll
    for (int j = 0; j < 16; ++j) { const f32x4 g = gr[64 * j]; float a0 = v[j].x * rstd * g.x, a1 = v[j].y * rstd * g.y, a2 = v[j].z * rstd * g.z, a3 = v[j].w * rstd * g.w;
        if (q8) { a0 = fp8_rt(a0); a1 = fp8_rt(a1); a2 = fp8_rt(a2); a3 = fp8_rt(a3); }
        v2u o; o.x = pk2(a0, a1); o.y = pk2(a2, a3); o8[64 * j] = o;
        if (o8row) ((GAS unsigned*)o8row)[lane + 64 * j] = pk4_fp8(a0, a1, a2, a3); }
}
__device__ __forceinline__ void rms_row_inplace(float* xrow, const float* gain, int lane) {
    GAS f32x4* xr = (GAS f32x4*)xrow + lane; const GAS f32x4* gr = (const GAS f32x4*)gain + lane;
    f32x4 v[16]; float s = 0.f;
#pragma unroll
    for (int j = 0; j < 16; ++j) { v[j] = xr[64 * j]; s += (v[j].x * v[j].x + v[j].y * v[j].y) + (v[j].z * v[j].z + v[j].w * v[j].w); }
    const float rstd = 1.f / sqrtf(wave_sum(s) * (1.f / D) + NORM_EPS);
#pragma unroll
    for (int j = 0; j < 16; ++j) { const f32x4 g = gr[64 * j]; xr[64 * j] = (f32x4){v[j].x * rstd * g.x, v[j].y * rstd * g.y, v[j].z * rstd * g.z, v[j].w * rstd * g.w}; }
}

#ifndef FP8_EMU_W
#define FP8_EMU_W false
#endif
#ifndef FP8_EMU_H
#define FP8_EMU_H false
#endif
__device__ __forceinline__ void rms_rows(Frame& F, const float* X, const float* gain, bf16* H, unsigned char* H8, float* OUT, const int gw, const int NGW) {
    f32x4 v[16], gv[16];
    { const GAS f32x4* gr = (const GAS f32x4*)gain + F.lane;
#pragma unroll
      for (int j = 0; j < 16; ++j) gv[j] = gr[64 * j]; }
    if (gw < M) { const GAS f32x4* xr = (const GAS f32x4*)(X + (size_t)gw * D) + F.lane;
#pragma unroll
        for (int j = 0; j < 16; ++j) v[j] = xr[64 * j]; }
    for (int m = gw; m < M; m += NGW) { f32x4 vn[16]; const bool has = m + NGW < M;
        if (has) { const GAS f32x4* xr = (const GAS f32x4*)(X + (size_t)(m + NGW) * D) + F.lane;
#pragma unroll
            for (int j = 0; j < 16; ++j) vn[j] = xr[64 * j]; }
        float ssum = 0.f;
#pragma unroll
        for (int j = 0; j < 16; ++j) ssum += (v[j].x * v[j].x + v[j].y * v[j].y) + (v[j].z * v[j].z + v[j].w * v[j].w);
        const float rstd = 1.f / sqrtf(wave_sum(ssum) * (1.f / D) + NORM_EPS);
#pragma unroll
        for (int j = 0; j < 16; ++j) { const f32x4 g = gv[j]; const float a0 = v[j].x * rstd * g.x, a1 = v[j].y * rstd * g.y, a2 = v[j].z * rstd * g.z, a3 = v[j].w * rstd * g.w;
            if (OUT) ((GAS f32x4*)(OUT + (size_t)m * D) + F.lane)[64 * j] = (f32x4){a0, a1, a2, a3};
            if (H) { v2u o; o.x = pk2(a0, a1); o.y = pk2(a2, a3); ((GAS v2u*)(H + (size_t)m * D) + F.lane)[64 * j] = o; }
            if (H8) ((GAS unsigned*)(H8 + (size_t)m * D))[F.lane + 64 * j] = pk4_fp8(a0, a1, a2, a3); }
        if (has) {
#pragma unroll
            for (int j = 0; j < 16; ++j) v[j] = vn[j]; } }
}
struct TD { const float* W; unsigned char* WT; int K, ldw, drow, k0, scol, f8; const float* rs; };
#ifndef TR_DEPTH
#define TR_DEPTH 1
#endif
#ifndef TR_SK
#define TR_SK 1
#endif
#ifndef TR_SN
#define TR_SN 8
#endif
#define TR_MAP(r_, nblk_, kb_, nb_) do { if ((nblk_) < TR_SN || (TR_SK == 1 && TR_SN == 8)) { kb_ = (r_) / (nblk_); nb_ = (r_) % (nblk_); } else { const int g_ = (r_) / (TR_SK * TR_SN), s_ = (r_) % (TR_SK * TR_SN), ng_ = (nblk_) / TR_SN; kb_ = (g_ / ng_) * TR_SK + s_ / TR_SN; nb_ = (g_ % ng_) * TR_SN + s_ % TR_SN; } } while (0)
template <class Dec> __device__ __forceinline__ void transpose_stream(Frame& F, const Dec& decode, const int NITEMS, LAS float* scr, const int gw, const int NGW) {
    float tv[32];
#if TR_DEPTH == 2
    float tm[32];
#endif
    f32x4 ga = (f32x4){1.f, 1.f, 1.f, 1.f}, gb = ga;
    static_assert(TR_DEPTH == 1 || TR_DEPTH == 2, "TR_DEPTH");
    if (gw < NITEMS) { const TD d = decode(gw);
        if (d.rs) { ga = *(const GAS f32x4*)(d.rs + d.k0 + 8 * (F.lane & 7)); gb = *(const GAS f32x4*)(d.rs + d.k0 + 8 * (F.lane & 7) + 4); }
#pragma unroll
        for (int i = 0; i < 32; ++i) tv[i] = d.scol >= 0 ? d.W[(size_t)(d.k0 + 2 * i + (F.lane >> 5)) * d.ldw + d.scol] : 0.f; }
#if TR_DEPTH == 2
    if (gw + NGW < NITEMS) { const TD d = decode(gw + NGW);
#pragma unroll
        for (int i = 0; i < 32; ++i) tm[i] = d.scol >= 0 ? d.W[(size_t)(d.k0 + 2 * i + (F.lane >> 5)) * d.ldw + d.scol] : 0.f; }
#endif
    for (int it = gw; it < NITEMS; it += NGW) {
        const TD d = decode(it); const bool has = it + TR_DEPTH * NGW < NITEMS; float tn[32]; f32x4 gna = (f32x4){1.f, 1.f, 1.f, 1.f}, gnb = gna;
        if (it + NGW < NITEMS) { const TD e1 = decode(it + NGW); if (e1.rs) { gna = *(const GAS f32x4*)(e1.rs + e1.k0 + 8 * (F.lane & 7)); gnb = *(const GAS f32x4*)(e1.rs + e1.k0 + 8 * (F.lane & 7) + 4); } }
        if (has) { const TD e = decode(it + TR_DEPTH * NGW);
#pragma unroll
            for (int i = 0; i < 32; ++i) tn[i] = e.scol >= 0 ? e.W[(size_t)(e.k0 + 2 * i + (F.lane >> 5)) * e.ldw + e.scol] : 0.f; }
        const float mul = d.f8 ? 64.f : 1.f;
#pragma unroll
        for (int i = 0; i < 32; ++i) scr[(2 * i + (F.lane >> 5)) * 33 + (F.lane & 31)] = tv[i] * mul;
        LDS_WAIT(); asm volatile("" ::: "memory");
        const int c = F.lane & 7;
#pragma unroll
        for (int j = 0; j < 4; ++j) { const int n = (F.lane >> 3) + 8 * j; const LAS float* sp = scr + (8 * c) * 33 + n;
            if (d.f8) { v2u o; o.x = pk4_fp8(sp[0 * 33], sp[1 * 33], sp[2 * 33], sp[3 * 33]); o.y = pk4_fp8(sp[4 * 33], sp[5 * 33], sp[6 * 33], sp[7 * 33]); *(GAS v2u*)(d.WT + (size_t)(d.drow + n) * d.K + d.k0 + 8 * c) = o; }
            else { v4u o; o.x = pk2(sp[0 * 33] * ga.x, sp[1 * 33] * ga.y); o.y = pk2(sp[2 * 33] * ga.z, sp[3 * 33] * ga.w); o.z = pk2(sp[4 * 33] * gb.x, sp[5 * 33] * gb.y); o.w = pk2(sp[6 * 33] * gb.z, sp[7 * 33] * gb.w); *(GAS v4u*)((bf16*)d.WT + (size_t)(d.drow + n) * d.K + d.k0 + 8 * c) = o; } }
        LDS_WAIT(); asm volatile("" ::: "memory");
        ga = gna; gb = gnb;
#if TR_DEPTH == 2
#pragma unroll
        for (int i = 0; i < 32; ++i) { tv[i] = tm[i]; tm[i] = tn[i]; }
#else
        if (has) {
#pragma unroll
            for (int i = 0; i < 32; ++i) tv[i] = tn[i]; }
#endif
    }
}
#ifndef P0_DEFER
#define P0_DEFER 1
#endif
#ifndef P0_DEFER_UP
#define P0_DEFER_UP 16384
#endif
__device__ __forceinline__ void p0_prologue(Frame& F, KArgs ap, bool first = true, int gw2 = 0, int ngw2 = 1) {
    unsigned char* ws_ = ap->ws;
    LAS float* scr = (LAS float*)(F.lds + F.wave * 16384);
    const int gw = F.blk * NWAVES + F.wave, NGW = F.G * NWAVES;
    bf16* WinT = (bf16*)(ws_ + WS_WIN); bf16* WglaT = (bf16*)(ws_ + WS_WGLA); bf16* WnsaT = (bf16*)(ws_ + WS_WNSA); bf16* WoutT = (bf16*)(ws_ + WS_WOUT); bf16* WupT = (bf16*)(ws_ + WS_WUP);
    bf16* W1cT = (bf16*)(ws_ + WS_W1C); bf16* W2bT = (bf16*)(ws_ + WS_W2B);
    constexpr int I_IN = (D / 64) * (NB16 / 32), I_G8 = GATE_FP8 ? (D / 64) * (NG8 / 32) : 0, I_GLA = (2048 / 64) * (D / 32), I_NSA = I_GLA, I_OUT = (D / 64) * (D / 32), I_UP = (D / 64) * (FF / 32), I_PHI = (4096 / 64) * (128 / 32);
    constexpr int NITEMS = I_IN + I_G8 + I_GLA + I_NSA + I_OUT + I_UP + 2 * I_PHI;
    constexpr int NITEMS0 = P0_DEFER ? NITEMS - (I_GLA + I_NSA + I_OUT) - P0_DEFER_UP : NITEMS;
    auto decode = [&](int it) -> TD { TD d; int r = it; d.f8 = 0; d.rs = nullptr;
        if (r < I_IN) { const int nblk = NB16 / 32; int kb, nb; TR_MAP(r, nblk, kb, nb); const int ucol = (!GATE_FP8 || 32 * nb < 11264) ? 32 * nb : 32 * nb - 11264 + 19456;
            d.W = AIN[2]; d.WT = (unsigned char*)WinT; d.K = D; d.ldw = NIN; d.drow = 32 * nb; d.k0 = 64 * kb; d.scol = orig_col(ucol + (F.lane & 31)); return d; } r -= I_IN;
        if (r < I_G8) { const int nblk = NG8 / 32; int kb, nb; TR_MAP(r, nblk, kb, nb);
            d.W = AIN[2]; d.WT = ws_ + WS_WG8; d.K = D; d.ldw = NIN; d.drow = 32 * nb; d.k0 = 64 * kb; d.scol = orig_col(11264 + 32 * nb + (F.lane & 31)); d.f8 = 1; return d; } r -= I_G8;
        const float* W; bf16* WT; int K, N, roff = 0;
        if (r < I_PHI) { W = AIN[8]; WT = W1cT; K = 4096; N = 128; } else if ((r -= I_PHI) < I_PHI) { W = AIN[10]; WT = W1cT; K = 4096; N = 128; roff = 128; }
        else if ((r -= I_PHI) < I_UP) { W = AIN[17]; WT = WupT; K = D; N = FF; d.rs = AIN[16];   }
        else if ((r -= I_UP) < I_GLA) { W = AIN[13]; WT = WglaT; K = 2048; N = D; } else if ((r -= I_GLA) < I_NSA) { W = AIN[14]; WT = WnsaT; K = 2048; N = D; } else { r -= I_NSA; W = AIN[15]; WT = WoutT; K = D; N = D; }
        const int nblk = N / 32; int kb, nb; TR_MAP(r, nblk, kb, nb);
        d.W = W; d.WT = (unsigned char*)WT; d.K = K; d.ldw = N; d.drow = roff + 32 * nb; d.k0 = 64 * kb; d.scol = 32 * nb + (F.lane & 31); return d; };
    if (first) transpose_stream(F, decode, NITEMS0, scr, gw, NGW);
    else { transpose_stream(F, decode, NITEMS, scr, NITEMS0 + gw2, ngw2); return; }
    for (int i = gw * 64 + F.lane; i < 256 * 256; i += NGW * 64) { const int n = i >> 8, k = i & 255; float v = 0.f;
        if (n < 128 && k < 128) v = AIN[9][k * 128 + n]; else if (n >= 128 && k >= 128) v = AIN[11][(k - 128) * 128 + (n - 128)];
        W2bT[i] = (bf16)f2bf(v); }
    bf16* H = (bf16*)(ws_ + WS_H);
    rms_rows(F, AIN[0], AIN[1], H, GATE_FP8 ? ws_ + WS_H8 : nullptr, nullptr, gw, NGW);
}
__device__ __forceinline__ void p2_im2col(Frame& F, KArgs ap, int row_lo = 0, int row_hi = 8192, int gw_in = -1, int ngw_in = 0) {
    unsigned char* ws_ = ap->ws;
    const int gw = gw_in >= 0 ? gw_in : F.blk * NWAVES + F.wave, NGW = gw_in >= 0 ? ngw_in : F.G * NWAVES;
    const bf16* U = (const bf16*)(ws_ + WS_U); bf16* A = (bf16*)(ws_ + WS_ACMP);
    const int tq = F.lane >> 4, dc = (F.lane & 15) * 8;
    for (int row = row_lo + gw; row < row_hi; row += NGW) {
        const int kv = row >> 12, bg = (row >> 8) & 15, c = row & 255, b = bg >> 2, g = bg & 3;
        const float* pos = AIN[6 + kv]; const int ucol = (kv ? U_VC : U_KC) + g * 128 + dc;
#pragma unroll
        for (int i = 0; i < 8; ++i) { const int t = 4 * i + tq; v4u o = (v4u){0u, 0u, 0u, 0u};
            if (c < 255) { const v4u w = *(const GAS v4u*)(U + (size_t)(b * SEQ + 16 * c + t) * LDU + ucol);
                const f32x4 p0 = *(const GAS f32x4*)(pos + t * 128 + dc), p1 = *(const GAS f32x4*)(pos + t * 128 + dc + 4);
                o.x = pk2(bfl(w.x) + p0.x, bfh(w.x) + p0.y); o.y = pk2(bfl(w.y) + p0.z, bfh(w.y) + p0.w); o.z = pk2(bfl(w.z) + p1.x, bfh(w.z) + p1.y); o.w = pk2(bfl(w.w) + p1.z, bfh(w.w) + p1.w); }
            *(GAS v4u*)(A + (size_t)row * 4096 + t * 128 + dc) = o; }
    }
}
__device__ __forceinline__ void gla_chain(Frame& F, KArgs ap, int bh) {
    unsigned char* ws_ = ap->ws;
    const int b = bh >> 4, h = bh & 15, tid = F.tid, lane = F.lane, wave = F.wave;
    LAS float* A = (LAS float*)F.lds; LAS float* Kf = A + 4096; LAS float* Qf = Kf + 4096; LAS float* V = Qf + 4096; LAS float* O = V + 8192; LAS float* W2 = O + 8192; LAS float* Bal = W2 + 1024;
    const bf16* U = (const bf16*)(ws_ + WS_U); bf16* OG = (bf16*)(ws_ + WS_OGLA);
    for (int i = tid; i < 1024; i += 512) W2[i] = AIN[3][(i >> 6) * 1024 + h * 64 + (i & 63)];
    if (tid < 64) Bal[tid] = AIN[4][h * 64 + tid];
    const int grp = tid & 3, e = tid >> 2;
    float st[16];
#pragma unroll
    for (int j = 0; j < 16; ++j) st[j] = 0.f;
    const float g0 = AIN[5][h * 128 + 2 * lane], g1 = AIN[5][h * 128 + 2 * lane + 1];
    __syncthreads();
    for (int n = 0; n < 64; ++n) {
        const size_t tok0 = (size_t)b * SEQ + n * 64;
        { const int t = tid >> 3, dd = (tid & 7) * 8; const bf16* ur = U + (tok0 + t) * LDU;
          const v4u a0 = *(const GAS v4u*)(ur + U_GA), a1 = *(const GAS v4u*)(ur + U_GA + 8);
          float alr[16]; alr[0] = bfl(a0.x); alr[1] = bfh(a0.x); alr[2] = bfl(a0.y); alr[3] = bfh(a0.y); alr[4] = bfl(a0.z); alr[5] = bfh(a0.z); alr[6] = bfl(a0.w); alr[7] = bfh(a0.w);
          alr[8] = bfl(a1.x); alr[9] = bfh(a1.x); alr[10] = bfl(a1.y); alr[11] = bfh(a1.y); alr[12] = bfl(a1.z); alr[13] = bfh(a1.z); alr[14] = bfl(a1.w); alr[15] = bfh(a1.w);
#pragma unroll
          for (int j = 0; j < 8; ++j) { const int d = dd + j; float pre = Bal[d];
#pragma unroll
              for (int i = 0; i < 16; ++i) pre += alr[i] * W2[i * 64 + d];
              const float ls = fminf(pre, 0.f) - log1pf(expf(-fabsf(pre)));
              A[t * 64 + d] = expf(ls * (1.f / 16.f)); }
          const v4u qw = *(const GAS v4u*)(ur + U_GQ + h * 64 + dd), kw = *(const GAS v4u*)(ur + U_GK + h * 64 + dd);
          LAS float* qd = Qf + t * 64 + dd; LAS float* kd = Kf + t * 64 + dd;
          qd[0] = bfl(qw.x) * 0.125f; qd[1] = bfh(qw.x) * 0.125f; qd[2] = bfl(qw.y) * 0.125f; qd[3] = bfh(qw.y) * 0.125f; qd[4] = bfl(qw.z) * 0.125f; qd[5] = bfh(qw.z) * 0.125f; qd[6] = bfl(qw.w) * 0.125f; qd[7] = bfh(qw.w) * 0.125f;
          kd[0] = bfl(kw.x); kd[1] = bfh(kw.x); kd[2] = bfl(kw.y); kd[3] = bfh(kw.y); kd[4] = bfl(kw.z); kd[5] = bfh(kw.z); kd[6] = bfl(kw.w); kd[7] = bfh(kw.w);
          const int e0 = (tid & 7) * 16; const v4u v0 = *(const GAS v4u*)(ur + U_GV + h * 128 + e0), v1 = *(const GAS v4u*)(ur + U_GV + h * 128 + e0 + 8);
          LAS float* vd = V + t * 128 + e0;
          vd[0] = bfl(v0.x); vd[1] = bfh(v0.x); vd[2] = bfl(v0.y); vd[3] = bfh(v0.y); vd[4] = bfl(v0.z); vd[5] = bfh(v0.z); vd[6] = bfl(v0.w); vd[7] = bfh(v0.w);
          vd[8] = bfl(v1.x); vd[9] = bfh(v1.x); vd[10] = bfl(v1.y); vd[11] = bfh(v1.y); vd[12] = bfl(v1.z); vd[13] = bfh(v1.z); vd[14] = bfl(v1.w); vd[15] = bfh(v1.w); }
        __syncthreads();
        for (int t = 0; t < 64; ++t) {
            const LAS f32x4* ap = (const LAS f32x4*)(A + t * 64 + grp * 16); const LAS f32x4* kp = (const LAS f32x4*)(Kf + t * 64 + grp * 16); const LAS f32x4* qp = (const LAS f32x4*)(Qf + t * 64 + grp * 16);
            const float v = V[t * 128 + e]; float o = 0.f;
#pragma unroll
            for (int j4 = 0; j4 < 4; ++j4) { const f32x4 a = ap[j4], k = kp[j4], q = qp[j4];
                st[4 * j4 + 0] = a.x * st[4 * j4 + 0] + k.x * v; st[4 * j4 + 1] = a.y * st[4 * j4 + 1] + k.y * v; st[4 * j4 + 2] = a.z * st[4 * j4 + 2] + k.z * v; st[4 * j4 + 3] = a.w * st[4 * j4 + 3] + k.w * v;
                o += q.x * st[4 * j4 + 0] + q.y * st[4 * j4 + 1] + q.z * st[4 * j4 + 2] + q.w * st[4 * j4 + 3]; }
            o += __shfl_xor(o, 1); o += __shfl_xor(o, 2);
            if (grp == 0) O[t * 128 + e] = o;
        }
        __syncthreads();
#pragma unroll 2
        for (int i = 0; i < 8; ++i) { const int t = wave * 8 + i; const float o0 = O[t * 128 + 2 * lane], o1 = O[t * 128 + 2 * lane + 1];
            const float rstd = 1.f / sqrtf(wave_sum(o0 * o0 + o1 * o1) * (1.f / 128.f) + NORM_EPS);
            const unsigned rw = *(const GAS unsigned*)(U + (tok0 + t) * LDU + U_GR + h * 128 + 2 * lane);
            *(GAS unsigned*)(OG + (tok0 + t) * 2048 + h * 128 + 2 * lane) = pk2(o0 * rstd * g0 * bfl(rw), o1 * rstd * g1 * bfh(rw)); }
    }
    __syncthreads();
}

__device__ __forceinline__ void qk4(const bf16* krow, const LAS float* qs, float (&sc)[4]) {
#pragma unroll
    for (int r = 0; r < 4; ++r) sc[r] = 0.f;
#pragma unroll 4
    for (int d8 = 0; d8 < 16; ++d8) { const v4u w = *(const GAS v4u*)(krow + 8 * d8);
        const float k0 = bfl(w.x), k1 = bfh(w.x), k2 = bfl(w.y), k3 = bfh(w.y), k4 = bfl(w.z), k5 = bfh(w.z), k6 = bfl(w.w), k7 = bfh(w.w);
#pragma unroll
        for (int r = 0; r < 4; ++r) { const f32x4 qa = *(const LAS f32x4*)(qs + r * 128 + 8 * d8), qb = *(const LAS f32x4*)(qs + r * 128 + 8 * d8 + 4);
            sc[r] += (k0 * qa.x + k1 * qa.y) + (k2 * qa.z + k3 * qa.w) + (k4 * qb.x + k5 * qb.y) + (k6 * qb.z + k7 * qb.w); } }
}
__device__ __forceinline__ void pv4(const bf16* vbase, size_t vstride, const LAS float* pT, int nk, int lane, float (&o)[4][2]) {
#pragma unroll 4
    for (int key = 0; key < nk; ++key) { const unsigned w = *(const GAS unsigned*)(vbase + (size_t)key * vstride + 2 * lane); const float v0 = bfl(w), v1 = bfh(w);
        const f32x4 p = *(const LAS f32x4*)(pT + 4 * key);
        o[0][0] += p.x * v0; o[0][1] += p.x * v1; o[1][0] += p.y * v0; o[1][1] += p.y * v1; o[2][0] += p.z * v0; o[2][1] += p.z * v1; o[3][0] += p.w * v0; o[3][1] += p.w * v1; }
}
__device__ __forceinline__ void attend64(const bf16* Ub, int kb, bool valid, int dist, int koff, int voff, const LAS float* qs, LAS float* pT, const LAS float* bias, float (&m)[4], float (&l)[4], float (&o)[4][2], int lane) {
    float sc[4]; qk4(Ub + (size_t)(kb + lane) * LDU + koff, qs, sc);
    const int dd = dist < 0 ? 0 : (dist > 127 ? 127 : dist); const int bk = REL_LUT[dd];
    const f32x4 bv = *(const LAS f32x4*)(bias + 4 * bk);
    float p[4];
#pragma unroll
    for (int r = 0; r < 4; ++r) { const float x = sc[r] + bv[r]; const float bm = wave_max(valid ? x : -1e30f); const float mn = fmaxf(m[r], bm); const float al = __expf(m[r] - mn);
        p[r] = valid ? __expf(x - mn) : 0.f; l[r] = l[r] * al + wave_sum(p[r]); o[r][0] *= al; o[r][1] *= al; m[r] = mn; }
    asm volatile("" ::: "memory");
    *(LAS f32x4*)(pT + 4 * lane) = (f32x4){p[0], p[1], p[2], p[3]};
    LDS_WAIT(); __builtin_amdgcn_wave_barrier(); asm volatile("" ::: "memory");
    pv4(Ub + (size_t)kb * LDU + voff, LDU, pT, 64, lane, o);
    asm volatile("" ::: "memory");
}
__device__ __forceinline__ void nsa_item(Frame& F, KArgs ap, int item, LAS float* wl) {
    unsigned char* ws_ = ap->ws;
    const int lane = F.lane; const int s = item & (SEQ - 1), g = (item >> 12) & 3, b = item >> 14;
    LAS float* qs = wl; LAS float* pT = wl + 512; LAS float* bias = wl + 512 + 1024;
    const bf16* U = (const bf16*)(ws_ + WS_U); const bf16* Ub = U + (size_t)b * SEQ * LDU; const bf16* OC = (const bf16*)(ws_ + WS_OC);
    const size_t tok = (size_t)b * SEQ + s; const float scale = 0.08838834764831845f;
    asm volatile("" ::: "memory");
#pragma unroll
    for (int r = 0; r < 4; ++r) { const unsigned w = *(const GAS unsigned*)(U + tok * LDU + U_NQ + (g * 4 + r) * 128 + 2 * lane); qs[r * 128 + 2 * lane] = bfl(w) * scale; qs[r * 128 + 2 * lane + 1] = bfh(w) * scale; }
    for (int i = lane; i < 128; i += 64) bias[i] = AIN[12][(i >> 2) * 16 + g * 4 + (i & 3)];
    LDS_WAIT(); __builtin_amdgcn_wave_barrier(); asm volatile("" ::: "memory");
    float sc[4][4];
    const bf16* kc = OC + (size_t)((b * 4 + g) * 256) * 256; const bf16* vc = OC + (size_t)(4096 + (b * 4 + g) * 256) * 256 + 128;
    float mx[4] = {-1e30f, -1e30f, -1e30f, -1e30f};
#pragma unroll
    for (int i = 0; i < 4; ++i) { const int c = 64 * i + lane; qk4(kc + (size_t)c * 256, qs, sc[i]); const int dist = s - (16 * c + 31); const bool valid = (c < 255) && dist >= 0;
        const int dd = dist < 0 ? 0 : (dist > 127 ? 127 : dist); const f32x4 bv = *(const LAS f32x4*)(bias + 4 * REL_LUT[dd]);
#pragma unroll
        for (int r = 0; r < 4; ++r) { sc[i][r] = valid ? sc[i][r] + bv[r] : -1e30f; mx[r] = fmaxf(mx[r], sc[i][r]); } }
    float inv[4];
#pragma unroll
    for (int r = 0; r < 4; ++r) { mx[r] = wave_max(mx[r]); float sum = 0.f;
#pragma unroll
        for (int i = 0; i < 4; ++i) { sc[i][r] = sc[i][r] > -1e29f ? __expf(sc[i][r] - mx[r]) : 0.f; sum += sc[i][r]; }
        sum = wave_sum(sum); inv[r] = sum > 0.f ? 1.f / sum : 0.f; }
#pragma unroll
    for (int i = 0; i < 4; ++i) *(LAS f32x4*)(pT + 4 * (64 * i + lane)) = (f32x4){sc[i][0] * inv[0], sc[i][1] * inv[1], sc[i][2] * inv[2], sc[i][3] * inv[3]};
    LDS_WAIT(); __builtin_amdgcn_wave_barrier(); asm volatile("" ::: "memory");
    float ocmp[4][2];
#pragma unroll
    for (int r = 0; r < 4; ++r) { ocmp[r][0] = 0.f; ocmp[r][1] = 0.f; }
    const int nvalid = s >= 31 ? ((s - 31) >> 4) + 1 : 0;
    pv4(vc, 256, pT, nvalid, lane, ocmp);
    float imp = 0.f;
#pragma unroll
    for (int dc = -1; dc <= 3; ++dc) { const int c = 4 * lane + dc; if (c >= 0 && c < 255) { const f32x4 p = *(const LAS f32x4*)(pT + 4 * c); const float w = (dc == -1 || dc == 3) ? 1.f : 2.f; imp += w * ((p.x + p.y) + (p.z + p.w)); } }
    const int cur = s >> 6; const bool forced = (lane == 0) || (lane <= cur && lane > cur - 2); const bool reach = lane <= cur;
    const float score = forced ? 1e4f : (reach ? imp : -1e4f);
    int rank = 0;
#pragma unroll
    for (int jp = 0; jp < 64; ++jp) { const float sj = __int_as_float(__builtin_amdgcn_readlane(__float_as_int(score), jp)); rank += (sj > score || (sj == score && jp < lane)) ? 1 : 0; }
    unsigned long long mask = __ballot(rank < 16 && reach);
    asm volatile("" ::: "memory");
    float ms[4], ls[4], osel[4][2];
#pragma unroll
    for (int r = 0; r < 4; ++r) { ms[r] = -1e30f; ls[r] = 0.f; osel[r][0] = 0.f; osel[r][1] = 0.f; }
    while (mask) { const int j = __builtin_ctzll(mask); mask &= mask - 1; const int kpos = 64 * j + lane;
        attend64(Ub, 64 * j, kpos <= s, s - kpos, U_KSL + g * 128, U_VSL + g * 128, qs, pT, bias, ms, ls, osel, lane); }
    float mw[4], lw[4], owin[4][2];
#pragma unroll
    for (int r = 0; r < 4; ++r) { mw[r] = -1e30f; lw[r] = 0.f; owin[r][0] = 0.f; owin[r][1] = 0.f; }
    const int lo = s - 511 > 0 ? s - 511 : 0;
    for (int kb = lo & ~63; kb <= s; kb += 64) { const int kpos = kb + lane;
        attend64(Ub, kb, kpos >= lo && kpos <= s, s - kpos, U_KW + g * 128, U_VW + g * 128, qs, pT, bias, mw, lw, owin, lane); }
    bf16* ON = (bf16*)(ws_ + WS_ONSA);
#pragma unroll
    for (int r = 0; r < 4; ++r) { const bf16* gp = U + tok * LDU + U_NG + (g * 4 + r) * 3;
        const float g0 = __uint_as_float((unsigned)gp[0] << 16), g1 = __uint_as_float((unsigned)gp[1] << 16), g2 = __uint_as_float((unsigned)gp[2] << 16);
        const float is = g1 / ls[r], iw = g2 / lw[r];
        *(GAS unsigned*)(ON + tok * 2048 + (g * 4 + r) * 128 + 2 * lane) = pk2(g0 * ocmp[r][0] + is * osel[r][0] + iw * owin[r][0], g0 * ocmp[r][1] + is * osel[r][1] + iw * owin[r][1]); }
    asm volatile("" ::: "memory");
}
#ifndef NSA_QREG
#define NSA_QREG 1
#endif
#ifndef NSA_DMA
#define NSA_DMA 1
#endif
#ifndef NSA_PAIR
#define NSA_PAIR 1
#endif
#ifndef NSA_DMA0
#define NSA_DMA0 0
#endif
#ifndef NSA_TRASM
#define NSA_TRASM 0
#endif
#ifndef NSA_PFK
#define NSA_PFK 1
#endif
#ifndef NSA_PFV
#define NSA_PFV 1
#endif
#ifndef NSA_DUPSEL
#define NSA_DUPSEL 1
#endif
#ifndef NSA_DUPWIN
#define NSA_DUPWIN 1
#endif
#ifndef NSA_ACT3ONLY
#define NSA_ACT3ONLY 1
#endif
#ifndef NSA_HALF
#define NSA_HALF 0
#endif
#ifndef NSA_IGL_N
#define NSA_IGL_N 6
#endif
#define NSA_IGL() do { _Pragma("unroll") for (int i_ = 0; i_ < 16; ++i_) { __builtin_amdgcn_sched_group_barrier(0x008, 1, 0); __builtin_amdgcn_sched_group_barrier(0x002, NSA_IGL_N, 0); } } while (0)
#ifndef NSA_SWAPSEL
#define NSA_SWAPSEL(w) ((w) >> 2)
#endif
#ifndef NSA_HSB
#define NSA_HSB() __builtin_amdgcn_sched_barrier(0)
#endif
#ifndef NSA_BIASASM
#define NSA_BIASASM 1
#endif
#ifndef NSA_BIASASM_MASK
#define NSA_BIASASM_MASK 0
#endif
#ifndef NSA_QREG_KS
#define NSA_QREG_KS 4
#endif
#ifndef NSA_PRIO
#define NSA_PRIO(x)
#endif
#ifndef NSA_SB2
#define NSA_SB2()
#endif
#ifndef NSA_SB
#define NSA_SB() __builtin_amdgcn_sched_barrier(0)
#endif
typedef short bf16x8_t __attribute__((ext_vector_type(8)));
constexpr int NT_ROWB = 288;
constexpr int NT_TILEB = 64 * NT_ROWB;
constexpr int NL_K = 0, NL_V = 2 * NT_TILEB, NL_Q = 4 * NT_TILEB, NL_BIAS = NL_Q + 256 * NT_ROWB, NL_SELM = NL_BIAS + 2048, NL_WUN = NL_SELM + 512, NL_JL = NL_WUN + 64, NL_END = NL_JL + 64, NL_IMP = NL_K;
static_assert(NL_END <= RING_BYTES, "NSA LDS map");
__device__ __forceinline__ unsigned cvtpk(float lo, float hi) { unsigned r; asm volatile("v_cvt_pk_bf16_f32 %0, %1, %2" : "=v"(r) : "v"(lo), "v"(hi)); return r; }
__device__ __forceinline__ float xrow16_max(float x) {
    auto s = __builtin_amdgcn_permlane16_swap(__float_as_uint(x), __float_as_uint(x), false, false); x = fmaxf(__uint_as_float(s[0]), __uint_as_float(s[1]));
    auto t = __builtin_amdgcn_permlane32_swap(__float_as_uint(x), __float_as_uint(x), false, false); return fmaxf(__uint_as_float(t[0]), __uint_as_float(t[1])); }
__device__ __forceinline__ float xrow16_sum(float x) {
    auto s = __builtin_amdgcn_permlane16_swap(__float_as_uint(x), __float_as_uint(x), false, false); x = __uint_as_float(s[0]) + __uint_as_float(s[1]);
    auto t = __builtin_amdgcn_permlane32_swap(__float_as_uint(x), __float_as_uint(x), false, false); return __uint_as_float(t[0]) + __uint_as_float(t[1]); }
template <int CTRL> __device__ __forceinline__ float dppf(float x) { return __builtin_bit_cast(float, __builtin_amdgcn_mov_dpp(__builtin_bit_cast(int, x), CTRL, 0xf, 0xf, true)); }
__device__ __forceinline__ float quad_sum(float x) { x += dppf<0xB1>(x); x += dppf<0x4E>(x); return x; }
#ifndef NSA_THR
#define NSA_THR 8.0f
#endif


struct NsaTileSrc { const unsigned char* k; const unsigned char* v; unsigned stride; };
struct NsaRegs { v4u k0, k1, v0, v1; };
__device__ __forceinline__ void nsa_ld(const NsaTileSrc& s, int tid_in, NsaRegs& r) {
    int tid = tid_in; asm volatile("" : "+v"(tid));
    const int row = tid >> 4, c16 = (tid & 15) * 16;
    r.k0 = *(const GAS v4u*)(s.k + (size_t)row * s.stride + c16); r.k1 = *(const GAS v4u*)(s.k + (size_t)(row + 32) * s.stride + c16);
    r.v0 = *(const GAS v4u*)(s.v + (size_t)row * s.stride + c16); r.v1 = *(const GAS v4u*)(s.v + (size_t)(row + 32) * s.stride + c16);
}
__device__ __forceinline__ void nsa_st(LAS unsigned char* lds, int buf, int tid_in, const NsaRegs& r) {
    int tid = tid_in; asm volatile("" : "+v"(tid));
    const int row = tid >> 4, c16 = (tid & 15) * 16; LAS unsigned char* kb = lds + NL_K + buf * NT_TILEB + row * NT_ROWB + c16; LAS unsigned char* vb = lds + NL_V + buf * NT_TILEB + row * NT_ROWB + c16;
    *(LAS v4u*)kb = r.k0; *(LAS v4u*)(kb + 32 * NT_ROWB) = r.k1; *(LAS v4u*)vb = r.v0; *(LAS v4u*)(vb + 32 * NT_ROWB) = r.v1;
}
struct NsaAcc { f32x4 o[8][2]; float m[2], l[2]; };
__device__ __forceinline__ constexpr int nsa_koff(int buf) { return NSA_PAIR ? buf * 32768 : NL_K + buf * NT_TILEB; }
__device__ __forceinline__ constexpr int nsa_voff(int buf) { return NSA_PAIR ? buf * 32768 + 16384 : NL_V + buf * NT_TILEB; }
#if NSA_PAIR
static_assert(NSA_QREG && NSA_QREG_KS == 4 && NSA_DMA && !NSA_DMA0 && 4 * 32768 <= NL_BIAS, "NSA_PAIR needs every Q fragment in registers and the DMA staging");
#endif
__device__ __forceinline__ void nsa_dma(LAS unsigned char* lds, int buf, int wave, int lane_in, const NsaTileSrc& s) {
    int lane = lane_in; asm volatile("" : "+v"(lane));
#pragma unroll
    for (int i = 0; i < 2; ++i) { const int r = (wave * 2 + i) * 4 + (lane >> 4); const int c = (lane & 15) ^ ((r & 7) << 1);
        const size_t go = (size_t)r * s.stride + (size_t)(c * 16);
        __builtin_amdgcn_global_load_lds((const unsigned*)(s.k + go), (LAS unsigned*)(lds + nsa_koff(buf) + (wave * 2 + i) * 1024), 16, 0, 0);
        __builtin_amdgcn_global_load_lds((const unsigned*)(s.v + go), (LAS unsigned*)(lds + nsa_voff(buf) + (wave * 2 + i) * 1024), 16, 0, 0); }
}
#define NSA_DMA_WAIT() asm volatile("s_waitcnt vmcnt(0)" ::: "memory")
__device__ __forceinline__ unsigned cvtpk_nv(float lo, float hi) { unsigned r; asm("v_cvt_pk_bf16_f32 %0, %1, %2" : "=v"(r) : "v"(lo), "v"(hi)); return r; }
#define NSA_SMH(S_, PF_, AL_) do { _Pragma("unroll") for (int t = 0; t < 2; ++t) { const bool rv = (BR == 1) ? selbit[t] : true; \
        float m0 = fmaxf(fmaxf(fmaxf(S_[0][t][0], S_[0][t][1]), fmaxf(S_[0][t][2], S_[0][t][3])), fmaxf(fmaxf(S_[1][t][0], S_[1][t][1]), fmaxf(S_[1][t][2], S_[1][t][3]))); \
        float mx = rv ? m0 * C1 + bfar : -1e30f; mx = xrow16_max(mx); \
        const bool upd = __builtin_amdgcn_ballot_w64(mx - A.m[t] > NSA_THR) != 0ull; \
        const float mn = upd ? fmaxf(A.m[t], mx) : A.m[t]; AL_[t] = upd ? __builtin_amdgcn_exp2f(A.m[t] - mn) : 1.0f; A.m[t] = mn; \
        const float sh = rv ? bfar - mn : -__builtin_inff(); float pp[2][4]; float ps = 0.f; \
        _Pragma("unroll") for (int k1 = 0; k1 < 2; ++k1) _Pragma("unroll") for (int i = 0; i < 4; ++i) { pp[k1][i] = __builtin_amdgcn_exp2f(S_[k1][t][i] * C1 + sh); ps += pp[k1][i]; } \
        A.l[t] = A.l[t] * AL_[t] + ps; \
        v4u w; w.x = cvtpk_nv(pp[0][0], pp[0][1]); w.y = cvtpk_nv(pp[0][2], pp[0][3]); w.z = cvtpk_nv(pp[1][0], pp[1][1]); w.w = cvtpk_nv(pp[1][2], pp[1][3]); PF_[t] = __builtin_bit_cast(bf16x8_t, w); } } while (0)
#define NSA_QKH(S_, H_) do { _Pragma("unroll") for (int k1 = 0; k1 < 2; ++k1) { S_[k1][0] = (f32x4){0.f, 0.f, 0.f, 0.f}; S_[k1][1] = (f32x4){0.f, 0.f, 0.f, 0.f}; } \
        _Pragma("unroll") for (int ks = 0; ks < 4; ++ks) { \
            const bf16x8_t q0 = (NSA_QREG && ks < NSA_QREG_KS) ? qr[ks][0] : *(LAS const bf16x8_t*)(qb + ks * 64), q1 = (NSA_QREG && ks < NSA_QREG_KS) ? qr[ks][1] : *(LAS const bf16x8_t*)(qb + 16 * NT_ROWB + ks * 64); \
            bf16x8_t kf[2]; _Pragma("unroll") for (int k1 = 0; k1 < 2; ++k1) kf[k1] = *(LAS const bf16x8_t*)(kb + (2 * (H_) + k1) * 4096 + (((g + 4 * ks) ^ ksw) << 4)); \
            _Pragma("unroll") for (int k1 = 0; k1 < 2; ++k1) { S_[k1][0] = __builtin_amdgcn_mfma_f32_16x16x32_bf16(kf[k1], q0, S_[k1][0], 0, 0, 0); S_[k1][1] = __builtin_amdgcn_mfma_f32_16x16x32_bf16(kf[k1], q1, S_[k1][1], 0, 0, 0); } } } while (0)
#define NSA_PVH(PF_, H_) do { _Pragma("unroll") for (int d4 = 0; d4 < 2; ++d4) { bf16x8_t vf[4]; \
        _Pragma("unroll") for (int q = 0; q < 4; ++q) { const int dt = 4 * d4 + q; const s16x4_t lo = tr_rd(vb + (32 * (H_)) * 256 + ((dt * 32) ^ vsw)), hi = tr_rd(vb + (32 * (H_) + 16) * 256 + ((dt * 32) ^ vsw)); \
            vf[q] = __builtin_shufflevector(lo, hi, 0, 1, 2, 3, 4, 5, 6, 7); } \
        _Pragma("unroll") for (int q = 0; q < 4; ++q) { const int dt = 4 * d4 + q; \
            A.o[dt][0] = __builtin_amdgcn_mfma_f32_16x16x32_bf16(vf[q], PF_[0], A.o[dt][0], 0, 0, 0); A.o[dt][1] = __builtin_amdgcn_mfma_f32_16x16x32_bf16(vf[q], PF_[1], A.o[dt][1], 0, 0, 0); } } } while (0)
#define NSA_RESC(AL_) do { if (__builtin_amdgcn_ballot_w64(AL_[0] != 1.0f || AL_[1] != 1.0f) != 0ull) { _Pragma("unroll") for (int dt = 0; dt < 8; ++dt) { A.o[dt][0] *= AL_[0]; A.o[dt][1] *= AL_[1]; } } } while (0)
template <int BR>
__device__ __forceinline__ void nsa_fast_half(LAS const unsigned char* lds, int buf, int wave, NsaAcc& A, const bool (&selbit)[2], int rhead, int lane_in, const bf16x8_t (&qr)[4][2]) {
    int lane = lane_in; asm volatile("" : "+v"(lane));
    const int n = lane & 15, g = lane >> 4;
    LAS const unsigned char* kb = lds + NL_K + buf * NT_TILEB + n * 256; const int ksw = (n & 7) << 1;
    LAS const unsigned char* qb = lds + NL_Q + (32 * wave + n) * NT_ROWB + g * 16;
    LAS const unsigned char* vb = lds + NL_V + buf * NT_TILEB + (4 * g + (n >> 2)) * 256 + (n & 3) * 8; const int vsw = ((4 * g + (n >> 2)) & 7) << 5;
    const float C1 = 0.08838834764831845f * 1.4426950408889634f;
    const float bfar = ((LAS const float*)(lds + NL_BIAS))[rhead * 128 + 127];
    f32x4 sa[2][2], sb[2][2]; bf16x8_t pfa[2], pfb[2]; float ala[2], alb[2];
    NSA_QKH(sa, 0);
    NSA_HSB();
    const bool swp = (NSA_SWAPSEL(__builtin_amdgcn_readfirstlane(wave)) & 1) != 0;
    pfa[0] = pfa[1] = pfb[0] = pfb[1] = (bf16x8_t){0, 0, 0, 0, 0, 0, 0, 0}; ala[0] = ala[1] = alb[0] = alb[1] = 1.0f;
#pragma nounroll
    for (int st = 0; st < 2; ++st) { if ((st != 0) == swp) { NSA_QKH(sb, 1); } else { NSA_SMH(sa, pfa, ala); } NSA_HSB(); }
    NSA_HSB();
    NSA_RESC(ala);
#pragma nounroll
    for (int st = 0; st < 2; ++st) { if ((st != 0) == swp) { NSA_PVH(pfa, 0); } else { NSA_SMH(sb, pfb, alb); } NSA_HSB(); }
    NSA_HSB();
    NSA_RESC(alb);
    NSA_PVH(pfb, 1);
}
template <int BR, int ACT = 3>
__device__ __forceinline__ void nsa_tile(LAS const unsigned char* lds, int buf, int wave, NsaAcc& A, f32x4 (&imp)[4][2], int pos0, const int (&qpos)[2], const bool (&selbit)[2], bool far, bool FAST, int rhead, int lane_in, bool pre, const NsaTileSrc& nsrc, int tid, NsaRegs& R, const bf16x8_t (&qr)[4][2]) {
    int lane = lane_in; asm volatile("" : "+v"(lane));
    const int n = lane & 15, g = lane >> 4;
    if (BR != 0 && pre) { if (NSA_DMA) nsa_dma((LAS unsigned char*)lds, buf ^ 1, wave, lane, nsrc); else nsa_ld(nsrc, tid, R); }
#if NSA_HALF
    if constexpr (BR != 0 && ACT == 3 && NSA_DMA) { if (FAST) { nsa_fast_half<BR>(lds, buf, wave, A, selbit, rhead, lane, qr); return; } }
#endif
    constexpr bool SWZ = NSA_DMA && BR != 0;
    LAS const unsigned char* kb = SWZ ? lds + nsa_koff(buf) + n * 256 : lds + NL_K + buf * NT_TILEB + n * NT_ROWB + g * 16;
    const int ksw = (n & 7) << 1;
    LAS const unsigned char* qb = lds + NL_Q + (32 * wave + n) * NT_ROWB + g * 16;
    constexpr bool act0 = (ACT & 1) != 0, act1 = (ACT & 2) != 0;
    f32x4 s[4][2];
#pragma unroll
    for (int kt = 0; kt < 4; ++kt) { s[kt][0] = (f32x4){0.f, 0.f, 0.f, 0.f}; s[kt][1] = (f32x4){0.f, 0.f, 0.f, 0.f}; }
    NSA_PRIO(1);
#if NSA_PFK
    if constexpr (SWZ) {
        bf16x8_t kfa[4][4], qa[4][2];
#pragma unroll
        for (int ks = 0; ks < 4; ++ks) {
            if (!(NSA_QREG && ks < NSA_QREG_KS)) { qa[ks][0] = *(LAS const bf16x8_t*)(qb + ks * 64); qa[ks][1] = *(LAS const bf16x8_t*)(qb + 16 * NT_ROWB + ks * 64); }
#pragma unroll
            for (int kt = 0; kt < 4; ++kt) kfa[ks][kt] = *(LAS const bf16x8_t*)(kb + kt * 4096 + (((g + 4 * ks) ^ ksw) << 4)); }
        __builtin_amdgcn_sched_barrier(0);
#pragma unroll
        for (int ks = 0; ks < 4; ++ks) { const bf16x8_t q0 = (NSA_QREG && ks < NSA_QREG_KS) ? qr[ks][0] : qa[ks][0], q1 = (NSA_QREG && ks < NSA_QREG_KS) ? qr[ks][1] : qa[ks][1];
#pragma unroll
            for (int kt = 0; kt < 4; ++kt) {
                if (act0) s[kt][0] = __builtin_amdgcn_mfma_f32_16x16x32_bf16(kfa[ks][kt], q0, s[kt][0], 0, 0, 0);
                if (act1) s[kt][1] = __builtin_amdgcn_mfma_f32_16x16x32_bf16(kfa[ks][kt], q1, s[kt][1], 0, 0, 0); } }
        __builtin_amdgcn_sched_barrier(0);
    } else
#endif
#pragma unroll
    for (int ks = 0; ks < 4; ++ks) { bf16x8_t kf[4];
        const bf16x8_t q0 = (NSA_QREG && BR != 0 && ks < NSA_QREG_KS) ? qr[ks][0] : *(LAS const bf16x8_t*)(qb + ks * 64), q1 = (NSA_QREG && BR != 0 && ks < NSA_QREG_KS) ? qr[ks][1] : *(LAS const bf16x8_t*)(qb + 16 * NT_ROWB + ks * 64);
#pragma unroll
        for (int kt = 0; kt < 4; ++kt) kf[kt] = SWZ ? *(LAS const bf16x8_t*)(kb + kt * 4096 + (((g + 4 * ks) ^ ksw) << 4)) : *(LAS const bf16x8_t*)(kb + kt * 16 * NT_ROWB + ks * 64);
#pragma unroll
        for (int kt = 0; kt < 4; ++kt) {
            if (act0) s[kt][0] = __builtin_amdgcn_mfma_f32_16x16x32_bf16(kf[kt], q0, s[kt][0], 0, 0, 0);
            if (act1) s[kt][1] = __builtin_amdgcn_mfma_f32_16x16x32_bf16(kf[kt], q1, s[kt][1], 0, 0, 0); }
        NSA_SB(); }
    NSA_PRIO(0);
    const float C1 = 0.08838834764831845f * 1.4426950408889634f;
    LAS const float* bl = (LAS const float*)(lds + NL_BIAS) + rhead * 128;
    const float bfar = bl[127];
    bf16x8_t pf[2][2];
#pragma unroll
    for (int t = 0; t < 2; ++t) {
        NSA_SB2();
        if (!(t == 0 ? act0 : act1)) { pf[0][t] = (bf16x8_t){0, 0, 0, 0, 0, 0, 0, 0}; pf[1][t] = pf[0][t]; continue; }
        float x[4][4]; bool vld[4][4]; float mx = -1e30f; float ps = 0.f; float p[4][4]; float mn, al;
        if (FAST) {
            const bool rv = (BR == 1) ? selbit[t] : true;
            float m0 = fmaxf(fmaxf(s[0][t][0], s[0][t][1]), fmaxf(s[0][t][2], s[0][t][3]));
#pragma unroll
            for (int kt = 1; kt < 4; ++kt) m0 = fmaxf(m0, fmaxf(fmaxf(s[kt][t][0], s[kt][t][1]), fmaxf(s[kt][t][2], s[kt][t][3])));
            mx = rv ? m0 * C1 + bfar : -1e30f;
            mx = xrow16_max(mx);
            if (__builtin_amdgcn_ballot_w64(mx - A.m[t] > NSA_THR) != 0ull) { mn = fmaxf(A.m[t], mx); al = __builtin_amdgcn_exp2f(A.m[t] - mn); A.m[t] = mn; } else { mn = A.m[t]; al = 1.0f; }
            const float sh = rv ? bfar - mn : -__builtin_inff();
#pragma unroll
            for (int kt = 0; kt < 4; ++kt)
#pragma unroll
                for (int i = 0; i < 4; ++i) { p[kt][i] = __builtin_amdgcn_exp2f(s[kt][t][i] * C1 + sh); ps += p[kt][i]; }
        } else {
#if NSA_BIASASM
        if (((NSA_BIASASM_MASK >> BR) & 1) && !far) {
            const unsigned blb = (unsigned)(unsigned long)bl;
#pragma unroll
            for (int h2 = 0; h2 < 2; ++h2) { float bb[2][4];
#pragma unroll
                for (int k1 = 0; k1 < 2; ++k1)
#pragma unroll
                    for (int i = 0; i < 4; ++i) { const int kk = 16 * (2 * h2 + k1) + 4 * g + i; const int dist = (BR == 0) ? qpos[t] - (16 * (pos0 + kk) + 31) : qpos[t] - (pos0 + kk);
                        const int dd = dist < 0 ? 0 : (dist > 127 ? 127 : dist); const unsigned a = blb + 4u * (unsigned)dd;
                        asm volatile("ds_read_b32 %0, %1" : "=v"(bb[k1][i]) : "v"(a)); }
                asm volatile("s_waitcnt lgkmcnt(0)" : "+v"(bb[0][0]), "+v"(bb[0][1]), "+v"(bb[0][2]), "+v"(bb[0][3]), "+v"(bb[1][0]), "+v"(bb[1][1]), "+v"(bb[1][2]), "+v"(bb[1][3]));
#pragma unroll
                for (int k1 = 0; k1 < 2; ++k1)
#pragma unroll
                    for (int i = 0; i < 4; ++i) { const int kt = 2 * h2 + k1; const int kk = 16 * kt + 4 * g + i; int dist; bool v;
                        if (BR == 0) { const int c = pos0 + kk; dist = qpos[t] - (16 * c + 31); v = dist >= 0 && c < 255; }
                        else if (BR == 1) { dist = qpos[t] - (pos0 + kk); v = dist >= 0 && selbit[t]; }
                        else { dist = qpos[t] - (pos0 + kk); v = dist >= 0 && dist < 512; }
                        x[kt][i] = s[kt][t][i] * C1 + bb[k1][i]; vld[kt][i] = v; mx = fmaxf(mx, v ? x[kt][i] : -1e30f); } }
        } else
#endif
        {
#pragma unroll
        for (int kt = 0; kt < 4; ++kt)
#pragma unroll
            for (int i = 0; i < 4; ++i) { const int kk = 16 * kt + 4 * g + i; int dist; bool v;
                if (BR == 0) { const int c = pos0 + kk; dist = qpos[t] - (16 * c + 31); v = dist >= 0 && c < 255; }
                else if (BR == 1) { dist = qpos[t] - (pos0 + kk); v = dist >= 0 && selbit[t]; }
                else { dist = qpos[t] - (pos0 + kk); v = dist >= 0 && dist < 512; }
                float b2 = bfar; if (!far) { const int dd = dist < 0 ? 0 : (dist > 127 ? 127 : dist); b2 = bl[dd]; }
                x[kt][i] = s[kt][t][i] * C1 + b2; vld[kt][i] = v; mx = fmaxf(mx, v ? x[kt][i] : -1e30f); }
        }
        mx = xrow16_max(mx);
        if (__builtin_amdgcn_ballot_w64(mx - A.m[t] > NSA_THR) != 0ull) { mn = fmaxf(A.m[t], mx); al = __builtin_amdgcn_exp2f(A.m[t] - mn); A.m[t] = mn; } else { mn = A.m[t]; al = 1.0f; }
#pragma unroll
        for (int kt = 0; kt < 4; ++kt)
#pragma unroll
            for (int i = 0; i < 4; ++i) { p[kt][i] = vld[kt][i] ? __builtin_amdgcn_exp2f(x[kt][i] - mn) : 0.f; ps += p[kt][i]; }
        }
        A.l[t] = A.l[t] * al + ps;
        if (__builtin_amdgcn_ballot_w64(al != 1.0f) != 0ull) {
#pragma unroll
            for (int dt = 0; dt < 8; ++dt) A.o[dt][t] *= al;
            if (BR == 0) {
#pragma unroll
                for (int jt = 0; jt < 4; ++jt) imp[jt][t] *= al; } }
#pragma unroll
        for (int k2 = 0; k2 < 2; ++k2) { v4u w; w.x = cvtpk(p[2 * k2][0], p[2 * k2][1]); w.y = cvtpk(p[2 * k2][2], p[2 * k2][3]); w.z = cvtpk(p[2 * k2 + 1][0], p[2 * k2 + 1][1]); w.w = cvtpk(p[2 * k2 + 1][2], p[2 * k2 + 1][3]);
            pf[k2][t] = __builtin_bit_cast(bf16x8_t, w); }
    }
    NSA_SB2();
    if (BR == 0 && pre) nsa_ld(nsrc, tid, R);
    NSA_SB2();
    NSA_PRIO(1);
    LAS const unsigned char* vb = SWZ ? lds + nsa_voff(buf) + (4 * g + (n >> 2)) * 256 + (n & 3) * 8 : lds + NL_V + buf * NT_TILEB + (4 * g + (n >> 2)) * NT_ROWB + (n & 3) * 8;
    const int vsw = ((4 * g + (n >> 2)) & 7) << 5;
#if NSA_PFV
    if constexpr (SWZ) {
#pragma unroll
        for (int k2 = 0; k2 < 2; ++k2) { bf16x8_t vfa[8];
#if NSA_TRASM
            s16x4_t lo_[8], hi_[8];
#pragma unroll
            for (int dt = 0; dt < 8; ++dt) { const unsigned a0 = (unsigned)(unsigned long)(vb + (32 * k2) * 256) + (unsigned)((dt * 32) ^ vsw);
                asm volatile("ds_read_b64_tr_b16 %0, %1" : "=v"(lo_[dt]) : "v"(a0)); asm volatile("ds_read_b64_tr_b16 %0, %1 offset:4096" : "=v"(hi_[dt]) : "v"(a0)); }
            asm volatile("s_waitcnt lgkmcnt(0)" : "+v"(lo_[0]), "+v"(lo_[1]), "+v"(lo_[2]), "+v"(lo_[3]), "+v"(lo_[4]), "+v"(lo_[5]), "+v"(lo_[6]), "+v"(lo_[7]),
                         "+v"(hi_[0]), "+v"(hi_[1]), "+v"(hi_[2]), "+v"(hi_[3]), "+v"(hi_[4]), "+v"(hi_[5]), "+v"(hi_[6]), "+v"(hi_[7]));
#pragma unroll
            for (int dt = 0; dt < 8; ++dt) vfa[dt] = __builtin_shufflevector(lo_[dt], hi_[dt], 0, 1, 2, 3, 4, 5, 6, 7);
#else
#pragma unroll
            for (int dt = 0; dt < 8; ++dt) { const s16x4_t lo = tr_rd(vb + (32 * k2) * 256 + ((dt * 32) ^ vsw)), hi = tr_rd(vb + (32 * k2 + 16) * 256 + ((dt * 32) ^ vsw)); vfa[dt] = __builtin_shufflevector(lo, hi, 0, 1, 2, 3, 4, 5, 6, 7); }
#endif
            __builtin_amdgcn_sched_barrier(0);
#pragma unroll
            for (int dt = 0; dt < 8; ++dt) {
                if (act0) A.o[dt][0] = __builtin_amdgcn_mfma_f32_16x16x32_bf16(vfa[dt], pf[k2][0], A.o[dt][0], 0, 0, 0);
                if (act1) A.o[dt][1] = __builtin_amdgcn_mfma_f32_16x16x32_bf16(vfa[dt], pf[k2][1], A.o[dt][1], 0, 0, 0); }
            __builtin_amdgcn_sched_barrier(0); }
    } else
#endif
#pragma unroll
    for (int k2 = 0; k2 < 2; ++k2)
#pragma unroll
        for (int d4 = 0; d4 < 2; ++d4) { bf16x8_t vf[4];
#pragma unroll
            for (int q = 0; q < 4; ++q) { const int dt = 4 * d4 + q; const s16x4_t lo = SWZ ? tr_rd(vb + (32 * k2) * 256 + ((dt * 32) ^ vsw)) : tr_rd(vb + (32 * k2) * NT_ROWB + dt * 32), hi = SWZ ? tr_rd(vb + (32 * k2 + 16) * 256 + ((dt * 32) ^ vsw)) : tr_rd(vb + (32 * k2 + 16) * NT_ROWB + dt * 32);
                vf[q] = __builtin_shufflevector(lo, hi, 0, 1, 2, 3, 4, 5, 6, 7); }
#pragma unroll
            for (int q = 0; q < 4; ++q) { const int dt = 4 * d4 + q;
                if (act0) A.o[dt][0] = __builtin_amdgcn_mfma_f32_16x16x32_bf16(vf[q], pf[k2][0], A.o[dt][0], 0, 0, 0);
                if (act1) A.o[dt][1] = __builtin_amdgcn_mfma_f32_16x16x32_bf16(vf[q], pf[k2][1], A.o[dt][1], 0, 0, 0); }
            NSA_SB(); }
    NSA_PRIO(0);
    if (BR == 0) {
#pragma unroll
        for (int jt = 0; jt < 4; ++jt) { if (16 * jt > (pos0 >> 2) + 16 || 16 * jt + 15 < (pos0 >> 2)) continue;
            const int jb = 16 * jt + n;
#pragma unroll
            for (int k2 = 0; k2 < 2; ++k2) { unsigned short e[8];
#pragma unroll
                for (int q = 0; q < 8; ++q) { const int c = pos0 + 32 * k2 + (q < 4 ? 4 * g + q : 16 + 4 * g + (q - 4)); const int dz = c - 4 * jb;
                    e[q] = (c < 255) ? ((dz == -1 || dz == 3) ? 0x3F80 : ((dz >= 0 && dz <= 2) ? 0x4000 : 0)) : 0; }
                v4u w; w.x = e[0] | ((unsigned)e[1] << 16); w.y = e[2] | ((unsigned)e[3] << 16); w.z = e[4] | ((unsigned)e[5] << 16); w.w = e[6] | ((unsigned)e[7] << 16);
                const bf16x8_t mf = __builtin_bit_cast(bf16x8_t, w);
                imp[jt][0] = __builtin_amdgcn_mfma_f32_16x16x32_bf16(mf, pf[k2][0], imp[jt][0], 0, 0, 0);
                imp[jt][1] = __builtin_amdgcn_mfma_f32_16x16x32_bf16(mf, pf[k2][1], imp[jt][1], 0, 0, 0); } }
    }
}
template <bool ACCUM>
__device__ __forceinline__ void nsa_flush(NsaAcc& A, bf16* ON, const bf16* U, int b, int q0, int gk, int wave, int br, int lane_in) {
    int lane = lane_in; asm volatile("" : "+v"(lane)); const int n = lane & 15, g = lane >> 4, rhead = n & 3;
    unsigned short gw_[2]; v2u old_[2][8];
#pragma unroll
    for (int t = 0; t < 2; ++t) { const size_t tok = (size_t)b * SEQ + q0 + ((32 * wave + 16 * t + n) >> 2);
        gw_[t] = U[tok * LDU + U_NG + (gk * 4 + rhead) * 3 + br];
        if (ACCUM) { const bf16* orow_t = ON + tok * 2048 + (gk * 4 + rhead) * 128;
#pragma unroll
            for (int dt = 0; dt < 8; ++dt) old_[t][dt] = *(const GAS v2u*)(orow_t + 16 * dt + 4 * g); } }
    __builtin_amdgcn_sched_barrier(0);
#pragma unroll
    for (int t = 0; t < 2; ++t) { const float l = xrow16_sum(A.l[t]); A.l[t] = l;
        const size_t tok = (size_t)b * SEQ + q0 + ((32 * wave + 16 * t + n) >> 2);
        const float gate = __uint_as_float((unsigned)gw_[t] << 16); const float sc = l > 0.f ? gate / l : 0.f;
        bf16* orow_t = ON + tok * 2048 + (gk * 4 + rhead) * 128;
#pragma unroll
        for (int dt = 0; dt < 8; ++dt) { GAS v2u* p = (GAS v2u*)(orow_t + 16 * dt + 4 * g); f32x4 v = A.o[dt][t] * sc;
            if (ACCUM) { const v2u w = old_[t][dt]; v[0] += bfl(w.x); v[1] += bfh(w.x); v[2] += bfl(w.y); v[3] += bfh(w.y); }
            v2u w; w.x = cvtpk(v[0], v[1]); w.y = cvtpk(v[2], v[3]); *p = w; } }
}
__device__ __forceinline__ void nsa_acc_reset(NsaAcc& A) {
#pragma unroll
    for (int t = 0; t < 2; ++t) { A.m[t] = -1e30f; A.l[t] = 0.f;
#pragma unroll
        for (int dt = 0; dt < 8; ++dt) A.o[dt][t] = (f32x4){0.f, 0.f, 0.f, 0.f}; }
}
__device__ __forceinline__ void nsa_wg_item(Frame& F, KArgs ap, int item, size_t on_off) {
    unsigned char* ws_ = ap->ws;
    const int qt = item & 63, gk = (item >> 6) & 3, b = item >> 8;
    int lane = F.lane; asm volatile("" : "+v"(lane));
    const int wave = F.wave, tid = wave * 64 + lane, n = lane & 15, g = lane >> 4;
    LAS unsigned char* lds = F.lds;
    const bf16* U = (const bf16*)(ws_ + WS_U); const bf16* OC = (const bf16*)(ws_ + WS_OC); bf16* ON = (bf16*)(ws_ + on_off);
    const int q0 = 64 * qt, rhead = n & 3;
    int qpos[2];
#pragma unroll
    for (int t = 0; t < 2; ++t) qpos[t] = q0 + ((32 * wave + 16 * t + n) >> 2);
#pragma unroll
    for (int i = 0; i < 8; ++i) { const int cid = tid + 512 * i, row = cid >> 4, c16 = cid & 15;
        const v4u w = *(const GAS v4u*)(U + ((size_t)b * SEQ + q0 + (row >> 2)) * LDU + U_NQ + (gk * 4 + (row & 3)) * 128 + c16 * 8);
        *(LAS v4u*)(lds + NL_Q + row * NT_ROWB + c16 * 16) = w; }
    { LAS float* bl = (LAS float*)(lds + NL_BIAS); const int r = tid >> 7, dd = tid & 127; bl[tid] = ap->in[12][REL_LUT[dd] * 16 + gk * 4 + r] * 1.4426950408889634f; }
    NsaAcc A; f32x4 imp[4][2]; NsaRegs R; const bool nosel[2] = {true, true}; bf16x8_t qr[4][2];
    nsa_acc_reset(A);
#pragma unroll
    for (int jt = 0; jt < 4; ++jt) { imp[jt][0] = (f32x4){0.f, 0.f, 0.f, 0.f}; imp[jt][1] = (f32x4){0.f, 0.f, 0.f, 0.f}; }
    { const unsigned char* kbase = (const unsigned char*)(OC + (size_t)((b * 4 + gk) * 256) * 256); const unsigned char* vbase = (const unsigned char*)(OC + (size_t)(4096 + (b * 4 + gk) * 256) * 256 + 128);
      const int ntile = (q0 + 63 >= 31) ? (((q0 + 63 - 31) >> 4) >> 6) + 1 : 0;
      NsaTileSrc src{kbase, vbase, 512u};
      if (ntile > 0) { nsa_ld(src, tid, R); nsa_st(lds, 0, tid, R); }
      __syncthreads();
      for (int i = 0; i < ntile; ++i) {
          const NsaTileSrc s2{kbase + (size_t)(i + 1) * 64 * 512, vbase + (size_t)(i + 1) * 64 * 512, 512u};
          const bool far = (q0 - (16 * (64 * i + 63) + 31)) >= 128;
          nsa_tile<0>(lds, i & 1, wave, A, imp, 64 * i, qpos, nosel, far, far, rhead, lane, i + 1 < ntile, s2, tid, R, qr);
          if (i + 1 < ntile) nsa_st(lds, (i + 1) & 1, tid, R);
          __syncthreads();
      }
      nsa_flush<false>(A, ON, U, b, q0, gk, wave, 0, lane);
    }
    unsigned long long mymask[2];
    { LAS float* ib = (LAS float*)(lds + NL_IMP) + wave * 512;
#pragma unroll
      for (int t = 0; t < 2; ++t) { const float inv = A.l[t] > 0.f ? 1.f / A.l[t] : 0.f;
#pragma unroll
          for (int jt = 0; jt < 4; ++jt) { f32x4 v = imp[jt][t] * inv;
#pragma unroll
              for (int i = 0; i < 4; ++i) v[i] = quad_sum(v[i]);
              if (rhead == 0) *(LAS f32x4*)(ib + (4 * t + (n >> 2)) * 64 + 16 * jt + 4 * g) = v; } }
      LDS_WAIT(); __builtin_amdgcn_wave_barrier(); asm volatile("" ::: "memory");
      const int qw = lane >> 3, js = lane & 7; const int cur = qt;
      unsigned lo = 0u, hi = 0u;
      if (cur < 16) { const unsigned long long all = (cur >= 63) ? ~0ull : ((1ull << (cur + 1)) - 1ull); lo = (unsigned)all; hi = (unsigned)(all >> 32); }
      else {
          float sc[64];
#pragma unroll
          for (int j4 = 0; j4 < 16; ++j4) { const f32x4 v = *(LAS const f32x4*)(ib + qw * 64 + 4 * j4);
#pragma unroll
              for (int i = 0; i < 4; ++i) { const int j = 4 * j4 + i; const bool forced = (j == 0) || (j <= cur && j > cur - 2); sc[j] = forced ? 1e4f : (j <= cur ? v[i] : -1e4f); } }
#pragma unroll
          for (int k = 0; k < 8; ++k) { const int j = js + 8 * k; const bool forced = (j == 0) || (j <= cur && j > cur - 2); const float mine = forced ? 1e4f : (j <= cur ? ib[qw * 64 + j] : -1e4f);
              int rank = 0;
#pragma unroll
              for (int jp = 0; jp < 64; ++jp) rank += (sc[jp] > mine || (sc[jp] == mine && jp < j)) ? 1 : 0;
              const bool sel = rank < 16 && j <= cur;
              if (k < 4) lo |= sel ? (1u << (js + 8 * k)) : 0u; else hi |= sel ? (1u << (js + 8 * (k - 4))) : 0u; }
          lo |= __shfl_xor(lo, 1); lo |= __shfl_xor(lo, 2); lo |= __shfl_xor(lo, 4); hi |= __shfl_xor(hi, 1); hi |= __shfl_xor(hi, 2); hi |= __shfl_xor(hi, 4);
      }
      LAS unsigned* sm = (LAS unsigned*)(lds + NL_SELM) + wave * 16;
      if (js == 0) { sm[2 * qw] = lo; sm[2 * qw + 1] = hi; }
      unsigned ulo = lo, uhi = hi;
      ulo |= __shfl_xor(ulo, 8); ulo |= __shfl_xor(ulo, 16); ulo |= __shfl_xor(ulo, 32); uhi |= __shfl_xor(uhi, 8); uhi |= __shfl_xor(uhi, 16); uhi |= __shfl_xor(uhi, 32);
      LAS unsigned* wu = (LAS unsigned*)(lds + NL_WUN);
      if (lane == 0) { wu[2 * wave] = ulo; wu[2 * wave + 1] = uhi; }
      LDS_WAIT(); __builtin_amdgcn_wave_barrier(); asm volatile("" ::: "memory");
#pragma unroll
      for (int t = 0; t < 2; ++t) { const int qi = 4 * t + (n >> 2); mymask[t] = (unsigned long long)sm[2 * qi] | ((unsigned long long)sm[2 * qi + 1] << 32); }
    }
    __syncthreads();
    unsigned long long wgmask = 0ull, wvmask;
    { LAS const unsigned* wu = (LAS const unsigned*)(lds + NL_WUN);
#pragma unroll
      for (int w = 0; w < 8; ++w) wgmask |= (unsigned long long)wu[2 * w] | ((unsigned long long)wu[2 * w + 1] << 32);
      wvmask = (unsigned long long)wu[2 * wave] | ((unsigned long long)wu[2 * wave + 1] << 32);
      wgmask = ((unsigned long long)__builtin_amdgcn_readfirstlane((unsigned)(wgmask >> 32)) << 32) | (unsigned)__builtin_amdgcn_readfirstlane((unsigned)wgmask);
      wvmask = ((unsigned long long)__builtin_amdgcn_readfirstlane((unsigned)(wvmask >> 32)) << 32) | (unsigned)__builtin_amdgcn_readfirstlane((unsigned)wvmask); }
    nsa_acc_reset(A);
#if NSA_QREG
    { int l2 = lane; asm volatile("" : "+v"(l2)); LAS const unsigned char* qb = lds + NL_Q + (32 * wave + (l2 & 15)) * NT_ROWB + (l2 >> 4) * 16;
#pragma unroll
      for (int ks = 0; ks < NSA_QREG_KS; ++ks) { qr[ks][0] = *(LAS const bf16x8_t*)(qb + ks * 64); qr[ks][1] = *(LAS const bf16x8_t*)(qb + 16 * NT_ROWB + ks * 64); } }
#endif
    { const unsigned char* kbase = (const unsigned char*)(U + (size_t)b * SEQ * LDU + U_KSL + gk * 128); const unsigned char* vbase = (const unsigned char*)(U + (size_t)b * SEQ * LDU + U_VSL + gk * 128);
      for (int dup_ = 0; dup_ < NSA_DUPSEL; ++dup_) { if (NSA_DUPSEL > 1) { int one_ = 1; asm volatile("" : "+s"(one_)); if (one_) nsa_acc_reset(A); }
#if NSA_PAIR
      { LAS unsigned char* jl = lds + NL_JL;
        if (tid < 64 && ((wgmask >> tid) & 1ull)) jl[__builtin_popcountll(wgmask & ((1ull << tid) - 1ull))] = (unsigned char)tid;
        const int nsel = __builtin_popcountll(wgmask);
        __syncthreads();
#pragma unroll
        for (int e = 0; e < 2; ++e) if (e < nsel) { const int j = jl[e]; const NsaTileSrc src{kbase + (size_t)j * 64 * LDU * 2, vbase + (size_t)j * 64 * LDU * 2, (unsigned)(LDU * 2)}; nsa_dma(lds, e, wave, lane, src); }
        NSA_DMA_WAIT(); __syncthreads();
        for (int it = 0; 2 * it < nsel; ++it) { const int st = it & 1;
#pragma unroll
            for (int e = 0; e < 2; ++e) { const int idx = 2 * (it + 1) + e; if (idx < nsel) { const int j = jl[idx]; const NsaTileSrc src{kbase + (size_t)j * 64 * LDU * 2, vbase + (size_t)j * 64 * LDU * 2, (unsigned)(LDU * 2)}; nsa_dma(lds, (st ^ 1) * 2 + e, wave, lane, src); } }
            const NsaTileSrc s2{kbase, vbase, (unsigned)(LDU * 2)};
#pragma nounroll
            for (int e = 0; e < 2; ++e) { const int idx = 2 * it + e; if (idx >= nsel) break; const int j = jl[idx];
                if ((wvmask >> j) & 1ull) { const bool sb[2] = {(bool)((mymask[0] >> j) & 1ull), (bool)((mymask[1] >> j) & 1ull)}; const bool far = (q0 - (64 * j + 63)) >= 128;
                    const bool a0 = __builtin_amdgcn_ballot_w64(sb[0]) != 0ull, a1 = __builtin_amdgcn_ballot_w64(sb[1]) != 0ull;
                    if (NSA_ACT3ONLY || (a0 && a1)) nsa_tile<1, 3>(lds, st * 2 + e, wave, A, imp, 64 * j, qpos, sb, far, far, rhead, lane, false, s2, tid, R, qr);
                    else if (a0) nsa_tile<1, 1>(lds, st * 2 + e, wave, A, imp, 64 * j, qpos, sb, far, far, rhead, lane, false, s2, tid, R, qr);
                    else nsa_tile<1, 2>(lds, st * 2 + e, wave, A, imp, 64 * j, qpos, sb, far, far, rhead, lane, false, s2, tid, R, qr); } }
            NSA_DMA_WAIT(); __syncthreads(); } }
      }
#else
      unsigned long long rem = wgmask; int j = __builtin_ctzll(rem); rem &= rem - 1;
      { NsaTileSrc src{kbase + (size_t)j * 64 * LDU * 2, vbase + (size_t)j * 64 * LDU * 2, (unsigned)(LDU * 2)};
        if (NSA_DMA) { nsa_dma(lds, 0, wave, lane, src); NSA_DMA_WAIT(); } else { nsa_ld(src, tid, R); nsa_st(lds, 0, tid, R); } }
      __syncthreads();
      for (int i = 0;; ++i) {
          const bool more = rem != 0ull; int jn = 0;
          if (more) { jn = __builtin_ctzll(rem); rem &= rem - 1; }
          const NsaTileSrc s2{kbase + (size_t)jn * 64 * LDU * 2, vbase + (size_t)jn * 64 * LDU * 2, (unsigned)(LDU * 2)};
          if ((wvmask >> j) & 1ull) { const bool sb[2] = {(bool)((mymask[0] >> j) & 1ull), (bool)((mymask[1] >> j) & 1ull)}; const bool far = (q0 - (64 * j + 63)) >= 128;
              const bool a0 = __builtin_amdgcn_ballot_w64(sb[0]) != 0ull, a1 = __builtin_amdgcn_ballot_w64(sb[1]) != 0ull;
              if (NSA_ACT3ONLY || (a0 && a1)) nsa_tile<1, 3>(lds, i & 1, wave, A, imp, 64 * j, qpos, sb, far, far, rhead, lane, more, s2, tid, R, qr);
              else if (a0) nsa_tile<1, 1>(lds, i & 1, wave, A, imp, 64 * j, qpos, sb, far, far, rhead, lane, more, s2, tid, R, qr);
              else nsa_tile<1, 2>(lds, i & 1, wave, A, imp, 64 * j, qpos, sb, far, far, rhead, lane, more, s2, tid, R, qr); }
          else if (more) { if (NSA_DMA) nsa_dma(lds, (i + 1) & 1, wave, lane, s2); else nsa_ld(s2, tid, R); }
          if (NSA_DMA) NSA_DMA_WAIT(); else if (more) nsa_st(lds, (i + 1) & 1, tid, R);
          __syncthreads();
          if (!more) break;
          j = jn;
      }
      }
#endif
      nsa_flush<true>(A, ON, U, b, q0, gk, wave, 1, lane);
    }
    nsa_acc_reset(A);
    { const unsigned char* kbase = (const unsigned char*)(U + (size_t)b * SEQ * LDU + U_KW + gk * 128); const unsigned char* vbase = (const unsigned char*)(U + (size_t)b * SEQ * LDU + U_VW + gk * 128);
      const int j0 = qt >= 8 ? qt - 8 : 0, ntile = qt - j0 + 1;
      for (int dup_ = 0; dup_ < NSA_DUPWIN; ++dup_) { if (NSA_DUPWIN > 1) { int one_ = 1; asm volatile("" : "+s"(one_)); if (one_) nsa_acc_reset(A); }
#if NSA_PAIR
      {
#pragma unroll
        for (int e = 0; e < 2; ++e) if (e < ntile) { const int j = j0 + e; const NsaTileSrc src{kbase + (size_t)j * 64 * LDU * 2, vbase + (size_t)j * 64 * LDU * 2, (unsigned)(LDU * 2)}; nsa_dma(lds, e, wave, lane, src); }
        NSA_DMA_WAIT(); __syncthreads();
        for (int it = 0; 2 * it < ntile; ++it) { const int st = it & 1;
#pragma unroll
            for (int e = 0; e < 2; ++e) { const int idx = 2 * (it + 1) + e; if (idx < ntile) { const int j = j0 + idx; const NsaTileSrc src{kbase + (size_t)j * 64 * LDU * 2, vbase + (size_t)j * 64 * LDU * 2, (unsigned)(LDU * 2)}; nsa_dma(lds, (st ^ 1) * 2 + e, wave, lane, src); } }
            const NsaTileSrc s2{kbase, vbase, (unsigned)(LDU * 2)};
#pragma nounroll
            for (int e = 0; e < 2; ++e) { const int idx = 2 * it + e; if (idx >= ntile) break; const int j = j0 + idx; const bool far = (q0 - (64 * j + 63)) >= 128;
                nsa_tile<2>(lds, st * 2 + e, wave, A, imp, 64 * j, qpos, nosel, far, far && j > qt - 8, rhead, lane, false, s2, tid, R, qr); }
            NSA_DMA_WAIT(); __syncthreads(); } }
      }
#else
      { NsaTileSrc src{kbase + (size_t)j0 * 64 * LDU * 2, vbase + (size_t)j0 * 64 * LDU * 2, (unsigned)(LDU * 2)};
        if (NSA_DMA) { nsa_dma(lds, 0, wave, lane, src); NSA_DMA_WAIT(); } else { nsa_ld(src, tid, R); nsa_st(lds, 0, tid, R); } }
      __syncthreads();
      for (int i = 0; i < ntile; ++i) { const int j = j0 + i;
          const NsaTileSrc s2{kbase + (size_t)(j + 1) * 64 * LDU * 2, vbase + (size_t)(j + 1) * 64 * LDU * 2, (unsigned)(LDU * 2)};
          const bool far = (q0 - (64 * j + 63)) >= 128;
          nsa_tile<2>(lds, i & 1, wave, A, imp, 64 * j, qpos, nosel, far, far && j > qt - 8, rhead, lane, i + 1 < ntile, s2, tid, R, qr);
          if (NSA_DMA) NSA_DMA_WAIT(); else if (i + 1 < ntile) nsa_st(lds, (i + 1) & 1, tid, R);
          __syncthreads();
      }
      }
#endif
      nsa_flush<true>(A, ON, U, b, q0, gk, wave, 2, lane);
    }
    __syncthreads();
}

constexpr int GP = 288;
constexpr int GL_QE = 0, GL_KE = 64 * GP, GL_KD = 2 * 64 * GP, GL_V = 3 * 64 * GP, GL_ST = 4 * 64 * GP, GL_W2 = GL_ST + 128 * GP, GL_BAL = GL_W2 + 4096, GL_ALR = GL_BAL + 256, GL_WT = GL_ALR + 4096,
              GL_DEC = GL_WT + 2048, GL_SSQ = GL_DEC + 256, GL_END = GL_SSQ + 512;
static_assert(GL_END <= RING_BYTES, "GLA LDS map");
__device__ __forceinline__ bf16x8_t tr2(LAS const unsigned char* p) { const s16x4_t lo = tr_rd(p), hi = tr_rd(p + 16 * GP); return __builtin_shufflevector(lo, hi, 0, 1, 2, 3, 4, 5, 6, 7); }
__device__ __forceinline__ void gla_chain_mfma(Frame& F, KArgs ap, int bh, size_t og_off = WS_OGLA) {
    unsigned char* ws_ = ap->ws;
    const int b = bh >> 4, h = bh & 15;
    int lane = F.lane; asm volatile("" : "+v"(lane));
    const int wave = F.wave, tid = wave * 64 + lane, n = lane & 15, g = lane >> 4;
    LAS unsigned char* lds = F.lds;
    const bf16* U = (const bf16*)(ws_ + WS_U); bf16* OG = (bf16*)(ws_ + og_off);
    LAS float* W2 = (LAS float*)(lds + GL_W2); LAS float* Bal = (LAS float*)(lds + GL_BAL); LAS float* ALR = (LAS float*)(lds + GL_ALR); LAS float* WT = (LAS float*)(lds + GL_WT);
    LAS float* DEC = (LAS float*)(lds + GL_DEC); LAS float* SSQ = (LAS float*)(lds + GL_SSQ);
    for (int i = tid; i < 1024; i += 512) W2[i] = ap->in[3][(i >> 6) * 1024 + h * 64 + (i & 63)];
    if (tid < 64) Bal[tid] = ap->in[4][h * 64 + tid];
    for (int i = tid; i < 128 * GP / 4; i += 512) ((LAS unsigned*)(lds + GL_ST))[i] = 0u;
    const int tt = wave & 3, eh = wave >> 2;
    f32x4 Sr[4];
#pragma unroll
    for (int el = 0; el < 4; ++el) Sr[el] = (f32x4){0.f, 0.f, 0.f, 0.f};
    f32x4 gain[4];
#pragma unroll
    for (int el = 0; el < 4; ++el) gain[el] = *(const GAS f32x4*)(ap->in[5] + h * 128 + 16 * (4 * eh + el) + 4 * g);
    __syncthreads();
    float w2r[16];
#pragma unroll
    for (int j = 0; j < 16; ++j) w2r[j] = W2[j * 64 + lane];
    const float balr = Bal[lane];
    const int st_t = tid >> 3, st_p = tid & 7;
    unsigned p_aw; v4u p_q, p_k, p_v0, p_v1; v2u p_r[4];
#define GLA_LOAD(cc) do { const size_t tk = (size_t)b * SEQ + (cc) * 64; const bf16* ur = U + (tk + st_t) * LDU; \
        p_aw = *(const GAS unsigned*)(ur + U_GA + 2 * st_p); p_q = *(const GAS v4u*)(ur + U_GQ + h * 64 + st_p * 8); p_k = *(const GAS v4u*)(ur + U_GK + h * 64 + st_p * 8); \
        p_v0 = *(const GAS v4u*)(ur + U_GV + h * 128 + st_p * 16); p_v1 = *(const GAS v4u*)(ur + U_GV + h * 128 + st_p * 16 + 8); \
        _Pragma("unroll") for (int el = 0; el < 4; ++el) p_r[el] = *(const GAS v2u*)(U + (tk + 16 * tt + n) * LDU + U_GR + h * 128 + 16 * (4 * eh + el) + 4 * g); } while (0)
    GLA_LOAD(0);
    for (int c = 0; c < 64; ++c) {
        const size_t tok0 = (size_t)b * SEQ + c * 64;
        ALR[st_t * 16 + 2 * st_p] = bfl(p_aw); ALR[st_t * 16 + 2 * st_p + 1] = bfh(p_aw);
        *(LAS v4u*)(lds + GL_V + st_t * GP + st_p * 32) = p_v0; *(LAS v4u*)(lds + GL_V + st_t * GP + st_p * 32 + 16) = p_v1;
        *(LAS v4u*)(lds + GL_QE + st_t * GP + st_p * 16) = p_q; *(LAS v4u*)(lds + GL_KE + st_t * GP + st_p * 16) = p_k;
        v2u rcur[4];
#pragma unroll
        for (int el = 0; el < 4; ++el) rcur[el] = p_r[el];
        if (c + 1 < 64) GLA_LOAD(c + 1);
        __syncthreads();
        float bc[8]; float run = 0.f;
#pragma unroll
        for (int i = 0; i < 8; ++i) { const LAS f32x4* ar = (const LAS f32x4*)(ALR + (8 * wave + i) * 16); float pre = balr;
#pragma unroll
            for (int j4 = 0; j4 < 4; ++j4) { const f32x4 a = ar[j4]; pre += a.x * w2r[4 * j4] + a.y * w2r[4 * j4 + 1] + a.z * w2r[4 * j4 + 2] + a.w * w2r[4 * j4 + 3]; }
            const float ls = fminf(pre, 0.f) - __logf(1.f + __expf(-fabsf(pre)));
            run += ls * (1.f / 16.f); bc[i] = run; }
        WT[wave * 64 + lane] = run;
        __syncthreads();
        float off = 0.f, tot = 0.f; float qv[8], kv[8];
#pragma unroll
        for (int i = 0; i < 8; ++i) { const int t = 8 * wave + i; qv[i] = __uint_as_float((unsigned)*(LAS const unsigned short*)(lds + GL_QE + t * GP + 2 * lane) << 16); kv[i] = __uint_as_float((unsigned)*(LAS const unsigned short*)(lds + GL_KE + t * GP + 2 * lane) << 16); }
#pragma unroll
        for (int s = 0; s < 8; ++s) { const float wv = WT[s * 64 + lane]; tot += wv; off += (s < wave) ? wv : 0.f; }
#pragma unroll
        for (int i = 0; i < 8; ++i) { const float bcum = bc[i] + off; const int t = 8 * wave + i;
            *(LAS unsigned short*)(lds + GL_QE + t * GP + 2 * lane) = (unsigned short)f2bf(qv[i] * 0.125f * __expf(bcum));
            *(LAS unsigned short*)(lds + GL_KE + t * GP + 2 * lane) = (unsigned short)f2bf(kv[i] * __expf(-bcum));
            *(LAS unsigned short*)(lds + GL_KD + t * GP + 2 * lane) = (unsigned short)f2bf(kv[i] * __expf(tot - bcum)); }
        if (wave == 0) DEC[lane] = __expf(tot);
        __syncthreads();
        f32x4 at[4]; bf16x8_t qfr[2];
#pragma unroll
        for (int st = 0; st < 4; ++st) at[st] = (f32x4){0.f, 0.f, 0.f, 0.f};
#pragma unroll
        for (int ks = 0; ks < 2; ++ks) { qfr[ks] = *(LAS const bf16x8_t*)(lds + GL_QE + (16 * tt + n) * GP + 64 * ks + 16 * g);
#pragma unroll
            for (int st = 0; st < 4; ++st) if (st <= tt) { const bf16x8_t kf = *(LAS const bf16x8_t*)(lds + GL_KE + (16 * st + n) * GP + 64 * ks + 16 * g);
                at[st] = __builtin_amdgcn_mfma_f32_16x16x32_bf16(kf, qfr[ks], at[st], 0, 0, 0); } }
#pragma unroll
        for (int st = 0; st < 4; ++st) if (st == tt) {
#pragma unroll
            for (int i = 0; i < 4; ++i) if (4 * g + i > n) at[st][i] = 0.f; }
        bf16x8_t pf[2];
#pragma unroll
        for (int k2 = 0; k2 < 2; ++k2) { v4u w; w.x = cvtpk(at[2 * k2][0], at[2 * k2][1]); w.y = cvtpk(at[2 * k2][2], at[2 * k2][3]); w.z = cvtpk(at[2 * k2 + 1][0], at[2 * k2 + 1][1]); w.w = cvtpk(at[2 * k2 + 1][2], at[2 * k2 + 1][3]);
            pf[k2] = __builtin_bit_cast(bf16x8_t, w); }
        f32x4 o[4];
#pragma unroll
        for (int el = 0; el < 4; ++el) o[el] = (f32x4){0.f, 0.f, 0.f, 0.f};
        const float dec = DEC[16 * tt + n];
#pragma unroll
        for (int el = 0; el < 4; ++el) Sr[el] *= dec;
        LAS const unsigned char* trb = lds + (4 * g + (n >> 2)) * GP + (n & 3) * 8;
#pragma unroll
        for (int k2 = 0; k2 < 2; ++k2) { const bf16x8_t kdf = tr2(trb + GL_KD + 32 * k2 * GP + 32 * tt);
#pragma unroll
            for (int el = 0; el < 4; ++el) { const bf16x8_t vf = tr2(trb + GL_V + 32 * k2 * GP + 32 * (4 * eh + el));
                if (2 * k2 <= tt) o[el] = __builtin_amdgcn_mfma_f32_16x16x32_bf16(vf, pf[k2], o[el], 0, 0, 0);
                Sr[el] = __builtin_amdgcn_mfma_f32_16x16x32_bf16(vf, kdf, Sr[el], 0, 0, 0); } }
#pragma unroll
        for (int ks = 0; ks < 2; ++ks)
#pragma unroll
            for (int el = 0; el < 4; ++el) { const bf16x8_t sf = *(LAS const bf16x8_t*)(lds + GL_ST + (16 * (4 * eh + el) + n) * GP + 64 * ks + 16 * g);
                o[el] = __builtin_amdgcn_mfma_f32_16x16x32_bf16(sf, qfr[ks], o[el], 0, 0, 0); }
        float ss = 0.f;
#pragma unroll
        for (int el = 0; el < 4; ++el) ss += (o[el][0] * o[el][0] + o[el][1] * o[el][1]) + (o[el][2] * o[el][2] + o[el][3] * o[el][3]);
        ss += __shfl_xor(ss, 16); ss += __shfl_xor(ss, 32);
        if (g == 0) SSQ[(16 * tt + n) * 2 + eh] = ss;
        __syncthreads();
#pragma unroll
        for (int el = 0; el < 4; ++el)
#pragma unroll
            for (int i = 0; i < 4; ++i) *(LAS unsigned short*)(lds + GL_ST + (16 * (4 * eh + el) + 4 * g + i) * GP + 2 * (16 * tt + n)) = (unsigned short)f2bf(Sr[el][i]);
        const int t = 16 * tt + n; const float rstd = 1.f / sqrtf((SSQ[2 * t] + SSQ[2 * t + 1]) * (1.f / 128.f) + NORM_EPS);
#pragma unroll
        for (int el = 0; el < 4; ++el) { const int e0 = 16 * (4 * eh + el) + 4 * g; const v2u rw = rcur[el];
            v2u ow; ow.x = cvtpk(o[el][0] * rstd * gain[el][0] * bfl(rw.x), o[el][1] * rstd * gain[el][1] * bfh(rw.x)); ow.y = cvtpk(o[el][2] * rstd * gain[el][2] * bfl(rw.y), o[el][3] * rstd * gain[el][3] * bfh(rw.y));
            *(GAS v2u*)(OG + (tok0 + t) * 2048 + h * 128 + e0) = ow; }
    }
    __syncthreads();
#undef GLA_LOAD
}
constexpr size_t WS_KD = WS_R2 + 192 * MiB;
constexpr size_t WS_DEC = WS_R2 + 224 * MiB;
constexpr int GQ_ALR = 0, GQ_WT = 4096, GQ_QRAW = 8192, GQ_KRAW = GQ_QRAW + 64 * GP, GQ_QE = GQ_KRAW + 64 * GP, GQ_KE = GQ_QE + 64 * GP, GQ_KD = GQ_KE + 64 * GP, GQ_END = GQ_KD + 64 * GP;
static_assert(GQ_END <= RING_BYTES, "GLA pre-pass LDS map");
__device__ __forceinline__ void gla_pre_items(Frame& F, KArgs ap, int it0, int nw) {
    unsigned char* ws_ = ap->ws;
    int lane = F.lane; asm volatile("" : "+v"(lane));
    const int wave = F.wave, tid = wave * 64 + lane, st_t = tid >> 3, st_p = tid & 7;
    LAS unsigned char* lds = F.lds; LAS float* ALR = (LAS float*)(lds + GQ_ALR); LAS float* WT = (LAS float*)(lds + GQ_WT);
    bf16* U = (bf16*)(ws_ + WS_U); bf16* KD = (bf16*)(ws_ + WS_KD); float* DEC = (float*)(ws_ + WS_DEC);
    const int h = it0 & 15, slot = it0 >> 4, ns = (nw - h + 15) >> 4;
    float w2r[16];
#pragma unroll
    for (int j = 0; j < 16; ++j) w2r[j] = ap->in[3][j * 1024 + h * 64 + lane];
    const float balr = ap->in[4][h * 64 + lane];
    unsigned p_aw; v4u p_q, p_k;
#define GLA_PLOAD(px) do { const bf16* ur = U + ((size_t)((px) >> 6) * SEQ + ((px) & 63) * 64 + st_t) * LDU; \
        p_aw = *(const GAS unsigned*)(ur + U_GA + 2 * st_p); p_q = *(const GAS v4u*)(ur + U_GQ + h * 64 + st_p * 8); p_k = *(const GAS v4u*)(ur + U_GK + h * 64 + st_p * 8); } while (0)
    if (slot < 256) GLA_PLOAD(slot);
    for (int pr = slot; pr < 256; pr += ns) {
        const int b = pr >> 6, c = pr & 63, bh = b * 16 + h; const size_t tok0 = (size_t)b * SEQ + c * 64;
        ALR[st_t * 16 + 2 * st_p] = bfl(p_aw); ALR[st_t * 16 + 2 * st_p + 1] = bfh(p_aw);
        *(LAS v4u*)(lds + GQ_QRAW + st_t * GP + st_p * 16) = p_q; *(LAS v4u*)(lds + GQ_KRAW + st_t * GP + st_p * 16) = p_k;
        if (pr + ns < 256) GLA_PLOAD(pr + ns);
        __syncthreads();
        float bc[8]; float run = 0.f;
#pragma unroll
        for (int i = 0; i < 8; ++i) { const LAS f32x4* ar = (const LAS f32x4*)(ALR + (8 * wave + i) * 16); float pre = balr;
#pragma unroll
            for (int j4 = 0; j4 < 4; ++j4) { const f32x4 a = ar[j4]; pre += a.x * w2r[4 * j4] + a.y * w2r[4 * j4 + 1] + a.z * w2r[4 * j4 + 2] + a.w * w2r[4 * j4 + 3]; }
            const float ls = fminf(pre, 0.f) - __logf(1.f + __expf(-fabsf(pre)));
            run += ls * (1.f / 16.f); bc[i] = run; }
        WT[wave * 64 + lane] = run;
        __syncthreads();
        float off = 0.f, tot = 0.f;
#pragma unroll
        for (int s = 0; s < 8; ++s) { const float wv = WT[s * 64 + lane]; tot += wv; off += (s < wave) ? wv : 0.f; }
#pragma unroll
        for (int i = 0; i < 8; ++i) { const float bcum = bc[i] + off; const int t = 8 * wave + i;
            const float qv = __uint_as_float((unsigned)*(LAS const unsigned short*)(lds + GQ_QRAW + t * GP + 2 * lane) << 16), kv = __uint_as_float((unsigned)*(LAS const unsigned short*)(lds + GQ_KRAW + t * GP + 2 * lane) << 16);
            const unsigned wq = cvtpk(qv * 0.125f * __expf(bcum), kv * __expf(-bcum)); const unsigned wk = cvtpk(kv * __expf(tot - bcum), 0.f);
            *(LAS unsigned short*)(lds + GQ_QE + t * GP + 2 * lane) = (unsigned short)wq; *(LAS unsigned short*)(lds + GQ_KE + t * GP + 2 * lane) = (unsigned short)(wq >> 16);
            *(LAS unsigned short*)(lds + GQ_KD + t * GP + 2 * lane) = (unsigned short)wk; }
        if (wave == 0) DEC[(size_t)(bh * 64 + c) * 64 + lane] = __expf(tot);
        __syncthreads();
        { const v4u a = *(LAS const v4u*)(lds + GQ_QE + st_t * GP + st_p * 16), k2 = *(LAS const v4u*)(lds + GQ_KE + st_t * GP + st_p * 16), k3 = *(LAS const v4u*)(lds + GQ_KD + st_t * GP + st_p * 16);
          bf16* ur = U + (tok0 + st_t) * LDU; *(GAS v4u*)(ur + U_GQ + h * 64 + st_p * 8) = a; *(GAS v4u*)(ur + U_GK + h * 64 + st_p * 8) = k2; *(GAS v4u*)(KD + (tok0 + st_t) * 1024 + h * 64 + st_p * 8) = k3; }
    }
    __syncthreads();
#undef GLA_PLOAD
}
__device__ __forceinline__ void gla_chain_mfma2(Frame& F, KArgs ap, int bh) {
    unsigned char* ws_ = ap->ws;
    const int b = bh >> 4, h = bh & 15;
    int lane = F.lane; asm volatile("" : "+v"(lane));
    const int wave = F.wave, tid = wave * 64 + lane, n = lane & 15, g = lane >> 4;
    LAS unsigned char* lds = F.lds;
    const bf16* U = (const bf16*)(ws_ + WS_U); const bf16* KDg = (const bf16*)(ws_ + WS_KD); const float* DECg = (const float*)(ws_ + WS_DEC); bf16* OG = (bf16*)(ws_ + WS_OGLA);
    LAS float* DEC = (LAS float*)(lds + GL_DEC); LAS float* SSQ = (LAS float*)(lds + GL_SSQ);
    for (int i = tid; i < 128 * GP / 4; i += 512) ((LAS unsigned*)(lds + GL_ST))[i] = 0u;
    const int tt = wave & 3, eh = wave >> 2;
    f32x4 Sr[4];
#pragma unroll
    for (int el = 0; el < 4; ++el) Sr[el] = (f32x4){0.f, 0.f, 0.f, 0.f};
    f32x4 gain[4];
#pragma unroll
    for (int el = 0; el < 4; ++el) gain[el] = *(const GAS f32x4*)(ap->in[5] + h * 128 + 16 * (4 * eh + el) + 4 * g);
    const int st_t = tid >> 3, st_p = tid & 7;
    v4u p_q, p_k, p_kd, p_v0, p_v1; v2u p_r[4]; float p_dec;
#define GLA_LOAD2(cc) do { const size_t tk = (size_t)b * SEQ + (cc) * 64; const bf16* ur = U + (tk + st_t) * LDU; \
        p_q = *(const GAS v4u*)(ur + U_GQ + h * 64 + st_p * 8); p_k = *(const GAS v4u*)(ur + U_GK + h * 64 + st_p * 8); p_kd = *(const GAS v4u*)(KDg + (tk + st_t) * 1024 + h * 64 + st_p * 8); \
        p_v0 = *(const GAS v4u*)(ur + U_GV + h * 128 + st_p * 16); p_v1 = *(const GAS v4u*)(ur + U_GV + h * 128 + st_p * 16 + 8); \
        p_dec = DECg[(size_t)(bh * 64 + (cc)) * 64 + (tid & 63)]; \
        _Pragma("unroll") for (int el = 0; el < 4; ++el) p_r[el] = *(const GAS v2u*)(U + (tk + 16 * tt + n) * LDU + U_GR + h * 128 + 16 * (4 * eh + el) + 4 * g); } while (0)
    GLA_LOAD2(0);
    __syncthreads();
    for (int c = 0; c < 64; ++c) {
        const size_t tok0 = (size_t)b * SEQ + c * 64;
        *(LAS v4u*)(lds + GL_V + st_t * GP + st_p * 32) = p_v0; *(LAS v4u*)(lds + GL_V + st_t * GP + st_p * 32 + 16) = p_v1;
        *(LAS v4u*)(lds + GL_QE + st_t * GP + st_p * 16) = p_q; *(LAS v4u*)(lds + GL_KE + st_t * GP + st_p * 16) = p_k; *(LAS v4u*)(lds + GL_KD + st_t * GP + st_p * 16) = p_kd;
        if (wave == 0) DEC[lane] = p_dec;
        v2u rcur[4];
#pragma unroll
        for (int el = 0; el < 4; ++el) rcur[el] = p_r[el];
        if (c + 1 < 64) GLA_LOAD2(c + 1);
        __syncthreads();
        f32x4 at[4]; bf16x8_t qfr[2];
#pragma unroll
        for (int st = 0; st < 4; ++st) at[st] = (f32x4){0.f, 0.f, 0.f, 0.f};
#pragma unroll
        for (int ks = 0; ks < 2; ++ks) { qfr[ks] = *(LAS const bf16x8_t*)(lds + GL_QE + (16 * tt + n) * GP + 64 * ks + 16 * g);
#pragma unroll
            for (int st = 0; st < 4; ++st) if (st <= tt) { const bf16x8_t kf = *(LAS const bf16x8_t*)(lds + GL_KE + (16 * st + n) * GP + 64 * ks + 16 * g);
                at[st] = __builtin_amdgcn_mfma_f32_16x16x32_bf16(kf, qfr[ks], at[st], 0, 0, 0); } }
#pragma unroll
        for (int st = 0; st < 4; ++st) if (st == tt) {
#pragma unroll
            for (int i = 0; i < 4; ++i) if (4 * g + i > n) at[st][i] = 0.f; }
        bf16x8_t pf[2];
#pragma unroll
        for (int k2 = 0; k2 < 2; ++k2) { v4u w; w.x = cvtpk(at[2 * k2][0], at[2 * k2][1]); w.y = cvtpk(at[2 * k2][2], at[2 * k2][3]); w.z = cvtpk(at[2 * k2 + 1][0], at[2 * k2 + 1][1]); w.w = cvtpk(at[2 * k2 + 1][2], at[2 * k2 + 1][3]);
            pf[k2] = __builtin_bit_cast(bf16x8_t, w); }
        f32x4 o[4];
#pragma unroll
        for (int el = 0; el < 4; ++el) o[el] = (f32x4){0.f, 0.f, 0.f, 0.f};
        const float dec = DEC[16 * tt + n];
#pragma unroll
        for (int el = 0; el < 4; ++el) Sr[el] *= dec;
        LAS const unsigned char* trb = lds + (4 * g + (n >> 2)) * GP + (n & 3) * 8;
#pragma unroll
        for (int k2 = 0; k2 < 2; ++k2) { const bf16x8_t kdf = tr2(trb + GL_KD + 32 * k2 * GP + 32 * tt);
#pragma unroll
            for (int el = 0; el < 4; ++el) { const bf16x8_t vf = tr2(trb + GL_V + 32 * k2 * GP + 32 * (4 * eh + el));
                if (2 * k2 <= tt) o[el] = __builtin_amdgcn_mfma_f32_16x16x32_bf16(vf, pf[k2], o[el], 0, 0, 0);
                Sr[el] = __builtin_amdgcn_mfma_f32_16x16x32_bf16(vf, kdf, Sr[el], 0, 0, 0); } }
#pragma unroll
        for (int ks = 0; ks < 2; ++ks)
#pragma unroll
            for (int el = 0; el < 4; ++el) { const bf16x8_t sf = *(LAS const bf16x8_t*)(lds + GL_ST + (16 * (4 * eh + el) + n) * GP + 64 * ks + 16 * g);
                o[el] = __builtin_amdgcn_mfma_f32_16x16x32_bf16(sf, qfr[ks], o[el], 0, 0, 0); }
        float ss = 0.f;
#pragma unroll
        for (int el = 0; el < 4; ++el) ss += (o[el][0] * o[el][0] + o[el][1] * o[el][1]) + (o[el][2] * o[el][2] + o[el][3] * o[el][3]);
        ss = xrow16_sum(ss);
        if (g == 0) SSQ[(16 * tt + n) * 2 + eh] = ss;
        __syncthreads();
#pragma unroll
        for (int el = 0; el < 4; ++el) { const unsigned w0 = cvtpk(Sr[el][0], Sr[el][1]), w1 = cvtpk(Sr[el][2], Sr[el][3]); LAS unsigned char* sp = lds + GL_ST + (16 * (4 * eh + el) + 4 * g) * GP + 2 * (16 * tt + n);
            *(LAS unsigned short*)(sp) = (unsigned short)w0; *(LAS unsigned short*)(sp + GP) = (unsigned short)(w0 >> 16); *(LAS unsigned short*)(sp + 2 * GP) = (unsigned short)w1; *(LAS unsigned short*)(sp + 3 * GP) = (unsigned short)(w1 >> 16); }
        const int t = 16 * tt + n; const float rstd = 1.f / sqrtf((SSQ[2 * t] + SSQ[2 * t + 1]) * (1.f / 128.f) + NORM_EPS);
#pragma unroll
        for (int el = 0; el < 4; ++el) { const int e0 = 16 * (4 * eh + el) + 4 * g; const v2u rw = rcur[el];
            v2u ow; ow.x = cvtpk(o[el][0] * rstd * gain[el][0] * bfl(rw.x), o[el][1] * rstd * gain[el][1] * bfh(rw.x)); ow.y = cvtpk(o[el][2] * rstd * gain[el][2] * bfl(rw.y), o[el][3] * rstd * gain[el][3] * bfh(rw.y));
            *(GAS v2u*)(OG + (tok0 + t) * 2048 + h * 128 + e0) = ow; }
    }
    __syncthreads();
#undef GLA_LOAD2
}
__device__ __forceinline__ void nsa_wg_all(Frame& F, KArgs ap, int w, int nw, size_t on_off) {
    for (int k = 0;; ++k) { const int idx = (k & 1) ? k * nw + (nw - 1 - w) : k * nw + w; if (k * nw >= 1024) break; if (idx >= 1024) continue;
        const int qt = 63 - (idx >> 4), bg = idx & 15; nsa_wg_item(F, ap, ((bg >> 2) << 8) | ((bg & 3) << 6) | qt, on_off); }
}
constexpr int CW_QHEAD = 3072;
__device__ __forceinline__ void nsa_wg_queue(Frame& F, KArgs ap, size_t on_off, int hq) {
    unsigned* head = (unsigned*)(ap->ws + WS_CTL) + CW_QHEAD + hq; volatile LAS unsigned* slot = F.MISC + 16;
    for (;;) {
        if (F.tid == 0) slot[0] = __hip_atomic_fetch_add(head, 1u, __ATOMIC_RELAXED, __HIP_MEMORY_SCOPE_AGENT);
        __syncthreads();
        const int idx = (int)slot[0];
        __syncthreads();
        if (idx >= 1024) break;
        const int qt = 63 - (idx >> 4), bg = idx & 15; nsa_wg_item(F, ap, ((bg >> 2) << 8) | ((bg & 3) << 6) | qt, on_off);
    }
}
#ifndef GLA_IMPL
#define GLA_IMPL 2
#endif
#if GLA_IMPL == 0
#define GLA_CHAIN gla_chain
#elif GLA_IMPL == 1
#define GLA_CHAIN gla_chain_mfma
#else
#define GLA_CHAIN gla_chain_mfma2
#endif
#ifndef NSA_IMPL
#define NSA_IMPL 2
#endif
__device__ __forceinline__ void p5_mixers(Frame& F, KArgs ap, int rep = 0) {
    const int nG = F.G >= 128 ? 64 : (F.G >= 8 ? F.G / 4 : 1);
#if NSA_IMPL == 2
    if (F.blk < nG) { for (int bh = F.blk; bh < BATCH * GLA_H; bh += nG) GLA_CHAIN(F, ap, bh); }
    nsa_wg_queue(F, ap, WS_ONSA, 64 * rep);
#else
    if (F.blk < nG) { for (int bh = F.blk; bh < BATCH * GLA_H; bh += nG) GLA_CHAIN(F, ap, bh); }
    else if (F.G > nG) {
#if NSA_IMPL == 0
        LAS float* wl = (LAS float*)F.lds + F.wave * 2048;
        const int nw = (F.G - nG) * NWAVES; for (int it = (F.blk - nG) * NWAVES + F.wave; it < BATCH * NSA_G * SEQ; it += nw) nsa_item(F, ap, it, wl);
#else
        nsa_wg_all(F, ap, F.blk - nG, F.G - nG, WS_ONSA);
#endif
    }
#endif
}

#if defined(NSA_CHECK)
#define CHECK_AMP NSA_CHECK
#elif defined(GLA_CHECK)
#define CHECK_AMP GLA_CHECK
#endif
#ifndef PHM
#define PHM 0xFFF
#endif
__global__ void __launch_bounds__(NWAVES * 64, 2) hybrid_fwd(Args args) {
    extern __shared__ __attribute__((aligned(16))) unsigned char lds[];
    Frame F;
    F.lds = (LAS unsigned char*)lds; F.MISC = (volatile LAS unsigned*)(F.lds + MISC_OFF);
    F.tid = threadIdx.x; F.lane = F.tid & 63; F.wave = __builtin_amdgcn_readfirstlane(F.tid >> 6);
    F.G = gridDim.x; F.blk = blockIdx.x;
    for (int u = F.tid; u < (LDS_BYTES - LDSCTL_OFF) / 4; u += NWAVES * 64) ((LAS unsigned*)(F.lds + LDSCTL_OFF))[u] = 0u;
    __syncthreads();
    const int lo = args.ph_lo, hi = args.ph_hi;
    if (hi - lo > 1 && F.tid == 0) { unsigned* bw = (unsigned*)(args.ws + WS_CTL) + CW_BAR; (void)xb_add(&bw[XB_XCNT(xb_xcc_id())], 1u); }
#define IN(k) (((PHM >> (k)) & 1) && lo <= (k) && (k) < hi)
#ifndef PH_REP
#define PH_REP 0
#endif
#ifndef PH_REPN
#define PH_REPN 2
#endif
#define NREP(k) (((PH_REP >> (k)) & 1) ? PH_REPN : 1)
#define FRESH() KArgs ap = fresh_args(); unsigned char* ws = ap->ws; (void)ws; { int _l; asm volatile("v_mbcnt_lo_u32_b32 %0, -1, 0\n\tv_mbcnt_hi_u32_b32 %0, -1, %0" : "=v"(_l)); F.lane = _l; F.tid = F.wave * 64 + _l; }
#ifndef WGM_UP
#define WGM_UP 8
#endif
#ifndef WGM_DOWN
#define WGM_DOWN 8
#endif
#ifndef DEPH9
#define DEPH9 1
#endif
#ifndef STAG_TICKS
#define STAG_TICKS 0
#endif
#ifndef STAG_MASK
#define STAG_MASK 0
#endif
#define STAGGER_P(k) do { if ((STAG_MASK >> (k)) & 1) STAGGER(); } while (0)
#define STAGGER() do { const unsigned long long t0_ = __builtin_amdgcn_s_memrealtime(); const unsigned long long dl_ = (unsigned long long)xb_xcc_id() * STAG_TICKS; while (__builtin_amdgcn_s_memrealtime() - t0_ < dl_) __builtin_amdgcn_s_sleep(8); } while (0)
#define SEAM(k) do { if (IN(k) && IN((k) + 1)) { XcdBarrier bar; bar.bar = (unsigned*)(ws + WS_CTL) + CW_BAR; bar.x = xb_xcc_id(); bar.st = F.MISC + 8; xcd_barrier(bar, F.wave); } } while (0)
    LAS unsigned char* ring = F.lds;

    if (IN(0)) for (int rep_ = 0; rep_ < NREP(0); ++rep_) { FRESH(); p0_prologue(F, ap); SEAM(0); }
#ifdef EXTRA_SEAMS
    for (int xs_ = 0; xs_ < EXTRA_SEAMS; ++xs_) { FRESH(); SEAM(0); }
#endif
    if (IN(1)) for (int rep_ = 0; rep_ < NREP(1); ++rep_) {
        FRESH();
        { pg8::Gemm g{(const pg8::bf16_t*)(ws + WS_H), (const pg8::bf16_t*)(ws + WS_WIN), M, NB16, D}; pg8::StaticOrder S; S.init(M, NB16, F.G, F.blk);
          pg8::EpiU E{(pg8::bf16_t*)(ws + WS_U), LDU, 0, 1.f, GATE_FP8 != 0};
          STAGGER_P(1);
          pg8::gemm_phase<pg8::EpiU, pg8::StaticOrder, true, true>(ring, g, S, E, F.wave); }
#if GATE_FP8
        { FRESH();
          pg8::Gemm g{(const pg8::bf16_t*)(ws + WS_H8), (const pg8::bf16_t*)(ws + WS_WG8), M, NG8, D / 2};
          pg8::EpiU E{(pg8::bf16_t*)(ws + WS_U), LDU, 44, 1.f / 64.f, false};
          if (F.G == 256) { pg8::LateOrder S; S.init2(M, NG8, F.G, F.blk, 64, 2);
              pg8::gemm_phase<pg8::EpiU, pg8::LateOrder, true, true, true>(ring, g, S, E, F.wave); }
          else { pg8::StaticOrder S; S.init(M, NG8, F.G, F.blk); pg8::gemm_phase<pg8::EpiU, pg8::StaticOrder, true, true, true>(ring, g, S, E, F.wave); } }
#endif
        SEAM(1);
    }
    if (IN(2)) for (int rep_ = 0; rep_ < NREP(2); ++rep_) { FRESH(); p2_im2col(F, ap); SEAM(2); }
    if (IN(3)) for (int rep_ = 0; rep_ < NREP(3); ++rep_) {
        FRESH();
        pg8::Gemm g{(const pg8::bf16_t*)(ws + WS_ACMP), (const pg8::bf16_t*)(ws + WS_W1C), 8192, 256, 4096}; pg8::StaticOrder S; S.init(8192, 256, F.G, F.blk);
        pg8::EpiAct<1> E{(pg8::bf16_t*)(ws + WS_HC), 256};
        pg8::gemm_phase<pg8::EpiAct<1>, pg8::StaticOrder, true, true, false, true>(ring, g, S, E, F.wave);
        VM_WAIT(); __syncthreads();
        { FRESH();
          pg8::Gemm g2{(const pg8::bf16_t*)(ws + WS_HC), (const pg8::bf16_t*)(ws + WS_W2B), 8192, 256, 256}; pg8::StaticOrder S2; S2.init(8192, 256, F.G, F.blk);
          pg8::EpiAct<0> E2{(pg8::bf16_t*)(ws + WS_OC), 256};
          pg8::gemm_phase<pg8::EpiAct<0>, pg8::StaticOrder, true, true>(ring, g2, S2, E2, F.wave); }
#if GLA_IMPL == 2
        if (F.blk >= 32 && F.G > 32) { FRESH(); gla_pre_items(F, ap, F.blk - 32, F.G - 32);
            if (P0_DEFER) p0_prologue(F, ap, false, (F.blk - 32) * NWAVES + F.wave, (F.G - 32) * NWAVES); }
#endif
        SEAM(3);
    }
#if defined(NSA_CHECK)
    if (IN(5)) {
        { FRESH(); const int nG = 64; if (F.blk < nG) gla_chain(F, ap, F.blk); else { LAS float* wl = (LAS float*)F.lds + F.wave * 2048; const int nw = (F.G - nG) * NWAVES; for (int it = (F.blk - nG) * NWAVES + F.wave; it < BATCH * NSA_G * SEQ; it += nw) nsa_item(F, ap, it, wl); }
          XcdBarrier bar; bar.bar = (unsigned*)(ws + WS_CTL) + CW_BAR; bar.x = xb_xcc_id(); bar.st = F.MISC + 8; xcd_barrier(bar, F.wave); }
        { FRESH(); nsa_wg_all(F, ap, F.blk, F.G, WS_R2 + 192 * MiB);
          XcdBarrier bar; bar.bar = (unsigned*)(ws + WS_CTL) + CW_BAR; bar.x = xb_xcc_id(); bar.st = F.MISC + 8; xcd_barrier(bar, F.wave); }
        { FRESH(); const bf16* a = (const bf16*)(ws + WS_ONSA); const bf16* c = (const bf16*)(ws + WS_R2 + 192 * MiB); float num = 0.f, den = 0.f;
          for (size_t i = (size_t)F.blk * 512 + F.tid; i < (size_t)M * 2048; i += (size_t)F.G * 512) { const float x = __uint_as_float((unsigned)a[i] << 16), y = __uint_as_float((unsigned)c[i] << 16); num += (x - y) * (x - y); den += x * x; }
          num = wave_sum(num); den = wave_sum(den); float* cw = (float*)(ws + WS_CTL) + 2048; if (F.lane == 0) { atomicAdd(cw, num); atomicAdd(cw + 64, den); }
          SEAM(5); } }
#elif defined(GLA_CHECK)
    if (IN(5)) {
        { FRESH(); if (F.blk < 64) gla_chain(F, ap, F.blk); else if (F.blk < 128) gla_chain_mfma(F, ap, F.blk - 64, WS_R2 + 192 * MiB); else nsa_wg_all(F, ap, F.blk - 128, F.G - 128, WS_ONSA);
          XcdBarrier bar; bar.bar = (unsigned*)(ws + WS_CTL) + CW_BAR; bar.x = xb_xcc_id(); bar.st = F.MISC + 8; xcd_barrier(bar, F.wave); }
        { FRESH(); const bf16* a = (const bf16*)(ws + WS_OGLA); const bf16* c = (const bf16*)(ws + WS_R2 + 192 * MiB); float num = 0.f, den = 0.f;
          for (size_t i = (size_t)F.blk * 512 + F.tid; i < (size_t)M * 2048; i += (size_t)F.G * 512) { const float x = __uint_as_float((unsigned)a[i] << 16), y = __uint_as_float((unsigned)c[i] << 16); num += (x - y) * (x - y); den += x * x; }
          num = wave_sum(num); den = wave_sum(den); float* cw = (float*)(ws + WS_CTL) + 2048; if (F.lane == 0) { atomicAdd(cw, num); atomicAdd(cw + 64, den); }
          SEAM(5); } }
#else
    if (IN(5)) for (int rep_ = 0; rep_ < NREP(5); ++rep_) { FRESH(); p5_mixers(F, ap, rep_); SEAM(5); }
#endif
    if (IN(6)) for (int rep_ = 0; rep_ < NREP(6); ++rep_) {
        { FRESH();
          pg8::Gemm g{(const pg8::bf16_t*)(ws + WS_OGLA), (const pg8::bf16_t*)(ws + WS_WGLA), M, D, 2048, (const pg8::bf16_t*)(ws + WS_ONSA), (const pg8::bf16_t*)(ws + WS_WNSA)};
          pg8::ChainOrder S; S.init(M, D, F.G, F.blk);
          pg8::EpiMixC E{(pg8::bf16_t*)(ws + WS_MIX), D, (const pg8::bf16_t*)(ws + WS_U) + U_MG, (const pg8::bf16_t*)(ws + WS_U) + U_MN, LDU};
          STAGGER_P(6);
          pg8::gemm_phase<pg8::EpiMixC, pg8::ChainOrder, true, true>(ring, g, S, E, F.wave);
          SEAM(6); }
    }
    if (IN(7)) for (int rep_ = 0; rep_ < NREP(7); ++rep_) {
        FRESH();
        pg8::Gemm g{(const pg8::bf16_t*)(ws + WS_MIX), (const pg8::bf16_t*)(ws + WS_WOUT), M, D, D}; pg8::StaticOrder S; S.init(M, D, F.G, F.blk);
        pg8::EpiResB<false> E{ap->in[0], (pg8::bf16_t*)(ws + WS_H2), D, (float*)(ws + WS_RS)};
        STAGGER_P(7);
        pg8::gemm_phase<pg8::EpiResB<false>, pg8::StaticOrder, true, true>(ring, g, S, E, F.wave);
        SEAM(7);
    }
    if (IN(8)) for (int rep_ = 0; rep_ < NREP(8); ++rep_) {
        FRESH();
        const int gw = F.blk * NWAVES + F.wave, NGW = F.G * NWAVES; LAS float* scr = (LAS float*)(F.lds + F.wave * 16384);
        bf16* H2 = (bf16*)(ws + WS_H2); bf16* WdT = (bf16*)(ws + WS_WDOWN); const float* x1 = ap->out;
#if !DEPH9
        { const float* Wd = ap->in[18]; const int lane_ = F.lane;
          auto dec = [&](int r) -> TD { TD d; const int nblk = D / 32; int kb, nb; TR_MAP(r, nblk, kb, nb); d.W = Wd; d.WT = (unsigned char*)WdT; d.K = FF; d.ldw = D; d.drow = 32 * nb; d.k0 = 64 * kb; d.scol = 32 * nb + (lane_ & 31); d.f8 = 0; d.rs = nullptr; return d; };
          transpose_stream(F, dec, (FF / 64) * (D / 32), scr, gw, NGW); }
#endif
        { const float* RS = (const float*)(ws + WS_RS); float* RS2 = (float*)(ws + WS_RS2);
          for (int m = gw; m < M; m += NGW) { const float t = wave_sum(RS[(size_t)m * 64 + F.lane]); if (F.lane == 0) RS2[m] = 1.f / (t * (1.f / D) + NORM_EPS); } }
        SEAM(8);
    }
    if (IN(9)) for (int rep_ = 0; rep_ < NREP(9); ++rep_) {
        FRESH();
        pg8::Gemm g{(const pg8::bf16_t*)(ws + WS_H2), (const pg8::bf16_t*)(ws + WS_WUP), M, FF, D}; pg8::StaticOrder S; S.init(M, FF, F.G, F.blk, WGM_UP);
        pg8::EpiRelu2R E{(pg8::bf16_t*)(ws + WS_U), FF, (const float*)(ws + WS_RS2)};
        STAGGER_P(9);
#if DEPH9
        const bool grpA = (F.G % 8 == 0) ? ((F.blk & 7) < 4) : true; const int nhalf = (F.G % 8 == 0) ? 2 : 1;
        const int gidx = (F.G % 8 == 0) ? ((F.blk >> 3) * 4 + (F.blk & 3)) : F.blk, gcnt = (F.G % 8 == 0) ? F.G / 2 : F.G;
        const int NIT9 = (FF / 64) * (D / 32);
#define DEPH9_COPY(lo_, hi_) do { FRESH(); const float* Wd = ap->in[18]; bf16* WdT = (bf16*)(ws + WS_WDOWN); const int lane_ = F.lane; LAS float* scr = (LAS float*)(F.lds + F.wave * 16384); const int lo9 = (lo_); \
          auto dec = [&](int r0) -> TD { TD d; const int r = r0 + lo9; const int nblk = D / 32; int kb, nb; TR_MAP(r, nblk, kb, nb); d.W = Wd; d.WT = (unsigned char*)WdT; d.K = FF; d.ldw = D; d.drow = 32 * nb; d.k0 = 64 * kb; d.scol = 32 * nb + (lane_ & 31); d.f8 = 0; d.rs = nullptr; return d; }; \
          transpose_stream(F, dec, (hi_) - (lo_), scr, gidx * NWAVES + F.wave, gcnt * NWAVES); LDS_WAIT(); __syncthreads(); } while (0)
        if (grpA) DEPH9_COPY(0, NIT9 / nhalf);
#endif
        pg8::gemm_phase<pg8::EpiRelu2R, pg8::StaticOrder, true, true>(ring, g, S, E, F.wave);
#if DEPH9
        if (!grpA) { VM_WAIT(); __syncthreads(); DEPH9_COPY(NIT9 / 2, NIT9); }
#endif
        SEAM(9);
    }
    if (IN(10)) {
        FRESH();
        pg8::Gemm g{(const pg8::bf16_t*)(ws + WS_U), (const pg8::bf16_t*)(ws + WS_WDOWN), M, D, FF}; pg8::StaticOrder S; S.init(M, D, F.G, F.blk, WGM_DOWN);
        pg8::EpiResB<true> E{nullptr, (pg8::bf16_t*)(ws + WS_H2), D, (float*)(ws + WS_RS)};
        STAGGER_P(10);
        pg8::gemm_phase<pg8::EpiResB<true>, pg8::StaticOrder, true, true>(ring, g, S, E, F.wave);
        SEAM(10);
    }
    if (IN(11)) {
        FRESH();
        const int gw = F.blk * NWAVES + F.wave, NGW = F.G * NWAVES; float* xo = ap->out;
        { const bf16* X2 = (const bf16*)(ws + WS_H2); const float* RS = (const float*)(ws + WS_RS); const float* gf = ap->in[19];
          f32x4 gq[8][2]; { const GAS f32x4* gr = (const GAS f32x4*)gf + 2 * F.lane;
#pragma unroll
            for (int j = 0; j < 8; ++j) { gq[j][0] = gr[128 * j]; gq[j][1] = gr[128 * j + 1]; } }
          v4u wv[8]; float rsv = 0.f;
          if (gw < M) { const GAS v4u* xr = (const GAS v4u*)(X2 + (size_t)gw * D) + F.lane; rsv = RS[(size_t)gw * 64 + F.lane];
#pragma unroll
            for (int j = 0; j < 8; ++j) wv[j] = xr[64 * j]; }
          for (int m = gw; m < M; m += NGW) { v4u wn[8]; float rsn = 0.f; const bool has = m + NGW < M;
              if (has) { const GAS v4u* xr = (const GAS v4u*)(X2 + (size_t)(m + NGW) * D) + F.lane; rsn = RS[(size_t)(m + NGW) * 64 + F.lane];
#pragma unroll
                  for (int j = 0; j < 8; ++j) wn[j] = xr[64 * j]; }
              const float rstd = 1.f / sqrtf(wave_sum(rsv) * (1.f / D) + NORM_EPS);
              GAS f32x4* orow = (GAS f32x4*)(xo + (size_t)m * D) + 2 * F.lane;
#pragma unroll
              for (int j = 0; j < 8; ++j) { const v4u w = wv[j]; const f32x4 g0 = gq[j][0], g1 = gq[j][1];
                  orow[128 * j] = (f32x4){bfl(w.x) * rstd * g0.x, bfh(w.x) * rstd * g0.y, bfl(w.y) * rstd * g0.z, bfh(w.y) * rstd * g0.w};
                  orow[128 * j + 1] = (f32x4){bfl(w.z) * rstd * g1.x, bfh(w.z) * rstd * g1.y, bfl(w.w) * rstd * g1.z, bfh(w.w) * rstd * g1.w}; }
              if (has) { rsv = rsn;
#pragma unroll
                  for (int j = 0; j < 8; ++j) wv[j] = wn[j]; } } }
#if defined(NSA_CHECK) || defined(GLA_CHECK)
        { const float* cw = (const float*)(ws + WS_CTL) + 2048; const float e = sqrtf(cw[0] / cw[64]); const float sc = 1.f + CHECK_AMP * e;
          for (int m = gw; m < M; m += NGW) { GAS f32x4* xr = (GAS f32x4*)(xo + (size_t)m * D) + F.lane; for (int j = 0; j < 16; ++j) xr[64 * j] = xr[64 * j] * sc; } }
#endif
    }
#undef IN
#undef SEAM
#undef FRESH
}

extern "C" void kernel_launch(void* const* d_in, const int* in_sizes, int n_in, void* d_out, int out_size, void* d_ws, size_t ws_size, hipStream_t stream) {
    static int grid = 0;
    if (grid == 0) {
        if (n_in != 20 || in_sizes[0] != M * D || out_size != M * D || ws_size < WS_END) { fprintf(stderr, "kernel_launch: unexpected shapes (n_in %d, in0 %d, out %d, ws %zu); nothing launched\n", n_in, n_in > 0 ? in_sizes[0] : -1, out_size, ws_size); grid = -1; return; }
        int dev = 0, cus = 0, per_cu = 0;
        if (hipGetDevice(&dev) != hipSuccess || hipDeviceGetAttribute(&cus, hipDeviceAttributeMultiprocessorCount, dev) != hipSuccess) { grid = -1; return; }
        if (hipFuncSetAttribute((const void*)hybrid_fwd, hipFuncAttributeMaxDynamicSharedMemorySize, LDS_BYTES) != hipSuccess) { fprintf(stderr, "kernel_launch: hipFuncSetAttribute failed\n"); grid = -1; return; }
        if (hipOccupancyMaxActiveBlocksPerMultiprocessor(&per_cu, (const void*)hybrid_fwd, NWAVES * 64, LDS_BYTES) != hipSuccess || per_cu < 1) { fprintf(stderr, "kernel_launch: occupancy query says %d blocks per CU\n", per_cu); }
        (void)hipGetLastError();
        grid = cus;
    }
    if (grid < 0) return;
    if (hipMemsetAsync((char*)d_ws + WS_CTL, 0, CTL_ZERO_BYTES, stream) != hipSuccess) return;
    Args a{};
    for (int i = 0; i < 20; ++i) a.in[i] = (const float*)d_in[i];
    a.out = (float*)d_out; a.ws = (unsigned char*)d_ws;
    if (N_LAUNCHES == 1) { a.ph_lo = 0; a.ph_hi = NPHASE; hipLaunchKernelGGL(hybrid_fwd, dim3(grid), dim3(NWAVES * 64), LDS_BYTES, stream, a); }
    else for (int p = 0; p < NPHASE; ++p) { a.ph_lo = p; a.ph_hi = p + 1; hipLaunchKernelGGL(hybrid_fwd, dim3(grid), dim3(NWAVES * 64), LDS_BYTES, stream, a); }
}
```

```cpp
#include <hip/hip_runtime.h>
#include <cstdio>
#include <cstdint>
#ifndef MK_N_LAUNCHES
#define MK_N_LAUNCHES 1
#endif
#ifndef NSA_SB
#define NSA_SB()
#endif
namespace pg8 {
#define PG8_LAS __attribute__((address_space(3)))
typedef unsigned short bf16_t;
typedef short bf16x8 __attribute__((ext_vector_type(8)));
typedef float f32x4 __attribute__((ext_vector_type(4)));
typedef unsigned u32x4 __attribute__((ext_vector_type(4)));
constexpr int BM = 256, BK = 64, HALF = 128, HTB = HALF * BK * 2  , STAGE_BYTES = 8 * HTB, NXCD = 8, WGM = 8;

__host__ __device__ __forceinline__ int lds_byte(int r, int c) { const int st = (r >> 4) * 2 + (c >> 5), rr = r & 15, cc = c & 31, ob = rr * 64 + cc * 2; return st * 1024 + (ob ^ (((ob >> 9) & 1) << 5)); }
__host__ __device__ __forceinline__ void stage_rc(int b, int& R, int& C) { const int st = b / 1024, sb = b % 1024, swz = sb ^ (((sb >> 9) & 1) << 5); R = (st >> 1) * 16 + swz / 64; C = (st & 1) * 32 + (swz % 64) / 2; }
__host__ __device__ __forceinline__ int perm32(int rho) { const int n = rho >> 4, i = rho & 15; return 8 * (i >> 2) + 4 * n + (i & 3); }

struct Unit { int pm, pn, part; };
struct Gemm { const bf16_t* A; const bf16_t* Bt; int M, N, K; const bf16_t* A2; const bf16_t* Bt2; };

struct StaticOrder {
    int nM, nN, nwg, G, c, wgm;
    __host__ __device__ void init(int M, int N, int G_, int c_, int wgm_ = WGM) { nM = M / BM; nN = N / BM; nwg = nM * nN; G = G_; c = c_; wgm = wgm_; }
    __host__ __device__ bool next(int i, Unit& u) const {
        const long L = (long)i * G + c; if (L >= nwg) return false;
        int wgid = (int)L; { const int q = nwg / NXCD, r = nwg % NXCD, xcd = wgid % NXCD, off = wgid / NXCD; wgid = (xcd < r ? xcd * (q + 1) : r * (q + 1) + (xcd - r) * q) + off; }
        const int nig = wgm * nN, gid = wgid / nig, fm = gid * wgm, gsz = (nM - fm) < wgm ? (nM - fm) : wgm;
        u.pm = fm + ((wgid % nig) % gsz); u.pn = (wgid % nig) / gsz; u.part = 0; return true;
    }
    __device__ __forceinline__ void a_ready(const Unit&) const {}
    __device__ __forceinline__ void done(const Unit&) const {}
};
struct LateOrder : StaticOrder {
    int nlate, cut, nfull;
    __host__ __device__ void init2(int M, int N, int G_, int c_, int nlate_, int cut_) { init(M, N, G_, c_); nlate = nlate_; cut = cut_; nfull = nwg / G_; }
    __host__ __device__ bool next(int i, Unit& u) const {
        long L;
        if (c < nlate) { if (i >= nfull - cut) return false; L = (long)i * G + c; }
        else if (i < nfull) L = (long)i * G + c;
        else { const int e = c - nlate; if (i > nfull || e >= nlate * cut) return false; L = (long)(nfull - cut + e / nlate) * G + (e % nlate); }
        int wgid = (int)L; { const int q = nwg / NXCD, r = nwg % NXCD, xcd = wgid % NXCD, off = wgid / NXCD; wgid = (xcd < r ? xcd * (q + 1) : r * (q + 1) + (xcd - r) * q) + off; }
        const int nig = wgm * nN, gid = wgid / nig, fm = gid * wgm, gsz = (nM - fm) < wgm ? (nM - fm) : wgm;
        u.pm = fm + ((wgid % nig) % gsz); u.pn = (wgid % nig) / gsz; u.part = 0; return true;
    }
};
struct ChainOrder : StaticOrder {
    __host__ __device__ bool next(int i, Unit& u) const { if (!StaticOrder::next(i >> 1, u)) return false; u.part = i & 1; return true; }
};


__device__ __forceinline__ unsigned cvt_pk_bf16(float lo, float hi) { unsigned r; asm volatile("v_cvt_pk_bf16_f32 %0, %1, %2" : "=v"(r) : "v"(lo), "v"(hi)); return r; }
typedef float f32x2 __attribute__((ext_vector_type(2)));
__device__ __forceinline__ float sigmoid_f(float x) { return __builtin_amdgcn_rcpf(1.0f + __expf(-x)); }
__device__ __forceinline__ float bf_lo(unsigned w) { return __uint_as_float(w << 16); }
__device__ __forceinline__ float bf_hi(unsigned w) { return __uint_as_float(w & 0xffff0000u); }

struct EpiU {
    static constexpr bool PERM = true, AFTER_DRAIN = false, CHAIN = false;
    bf16_t* O; int ldc; int pn_off; float scl; bool remap;
    __device__ __forceinline__ void operator()(const f32x4 (&acc)[2][2][4][2], const Unit& u, int wr, int wc, int fr, int fq) const {
        const int ct = (remap && u.pn == 44) ? 76 : u.pn + pn_off;
        const int row0 = u.pm * BM + wr * 64 + fr, col0 = ct * BM + wc * 32 + 8 * fq;
        const int mode = (ct >= 16 && ct < 24) ? 1 : ((ct >= 44 && ct < 76) ? 2 : (ct == 76 ? 3 : 0));
#pragma unroll
        for (int ai = 0; ai < 2; ++ai)
#pragma unroll
            for (int m = 0; m < 4; ++m) { bf16_t* rowp = O + (size_t)(row0 + ai * HALF + m * 16) * ldc + col0;
#pragma unroll
                for (int bj = 0; bj < 2; ++bj) { f32x4 v0 = acc[ai][bj][m][0] * scl, v1 = acc[ai][bj][m][1] * scl;
                    if (mode == 1) {
#pragma unroll
                        for (int j = 0; j < 4; ++j) { v0[j] = v0[j] * sigmoid_f(v0[j]); v1[j] = v1[j] * sigmoid_f(v1[j]); } }
                    else if (mode == 2 || (mode == 3 && (bj * HALF + wc * 32 + 8 * fq) >= 16)) {
#pragma unroll
                        for (int j = 0; j < 4; ++j) { v0[j] = sigmoid_f(v0[j]); v1[j] = sigmoid_f(v1[j]); } }
                    u32x4 w; w.x = cvt_pk_bf16(v0[0], v0[1]); w.y = cvt_pk_bf16(v0[2], v0[3]); w.z = cvt_pk_bf16(v1[0], v1[1]); w.w = cvt_pk_bf16(v1[2], v1[3]);
                    *(u32x4*)(rowp + bj * HALF) = w; } }
    }
};
template <int ACT> struct EpiAct {
    static constexpr bool PERM = true, AFTER_DRAIN = false, CHAIN = false;
    bf16_t* O; int ldc;
    __device__ __forceinline__ void operator()(const f32x4 (&acc)[2][2][4][2], const Unit& u, int wr, int wc, int fr, int fq) const {
        const int row0 = u.pm * BM + wr * 64 + fr, col0 = u.pn * BM + wc * 32 + 8 * fq;
#pragma unroll
        for (int ai = 0; ai < 2; ++ai)
#pragma unroll
            for (int m = 0; m < 4; ++m) { bf16_t* rowp = O + (size_t)(row0 + ai * HALF + m * 16) * ldc + col0;
#pragma unroll
                for (int bj = 0; bj < 2; ++bj) { f32x4 v0 = acc[ai][bj][m][0], v1 = acc[ai][bj][m][1];
                    if (ACT >= 1) {
#pragma unroll
                        for (int j = 0; j < 4; ++j) { v0[j] = fmaxf(v0[j], 0.f); v1[j] = fmaxf(v1[j], 0.f); if (ACT == 2) { v0[j] *= v0[j]; v1[j] *= v1[j]; } } }
                    u32x4 w; w.x = cvt_pk_bf16(v0[0], v0[1]); w.y = cvt_pk_bf16(v0[2], v0[3]); w.z = cvt_pk_bf16(v1[0], v1[1]); w.w = cvt_pk_bf16(v1[2], v1[3]);
                    *(u32x4*)(rowp + bj * HALF) = w; } }
    }
};
template <bool ACCUM> struct EpiMix {
    static constexpr bool PERM = true, AFTER_DRAIN = false, CHAIN = false;
    bf16_t* O; int ldc; const bf16_t* Gt; int ldg;
    __device__ __forceinline__ void operator()(const f32x4 (&acc)[2][2][4][2], const Unit& u, int wr, int wc, int fr, int fq) const {
        const int row0 = u.pm * BM + wr * 64 + fr, col0 = u.pn * BM + wc * 32 + 8 * fq;
#pragma unroll
        for (int ai = 0; ai < 2; ++ai)
#pragma unroll
            for (int m = 0; m < 4; ++m) { const size_t r = (size_t)(row0 + ai * HALF + m * 16); bf16_t* rowp = O + r * ldc + col0; const bf16_t* gp = Gt + r * ldg + col0;
#pragma unroll
                for (int bj = 0; bj < 2; ++bj) { f32x4 v0 = acc[ai][bj][m][0], v1 = acc[ai][bj][m][1];
                    const u32x4 gw = *(const u32x4*)(gp + bj * HALF);
                    v0[0] *= bf_lo(gw.x); v0[1] *= bf_hi(gw.x); v0[2] *= bf_lo(gw.y); v0[3] *= bf_hi(gw.y); v1[0] *= bf_lo(gw.z); v1[1] *= bf_hi(gw.z); v1[2] *= bf_lo(gw.w); v1[3] *= bf_hi(gw.w);
                    if (ACCUM) { const u32x4 ow = *(const u32x4*)(rowp + bj * HALF);
                        v0[0] += bf_lo(ow.x); v0[1] += bf_hi(ow.x); v0[2] += bf_lo(ow.y); v0[3] += bf_hi(ow.y); v1[0] += bf_lo(ow.z); v1[1] += bf_hi(ow.z); v1[2] += bf_lo(ow.w); v1[3] += bf_hi(ow.w); }
                    u32x4 w; w.x = cvt_pk_bf16(v0[0], v0[1]); w.y = cvt_pk_bf16(v0[2], v0[3]); w.z = cvt_pk_bf16(v1[0], v1[1]); w.w = cvt_pk_bf16(v1[2], v1[3]);
                    *(u32x4*)(rowp + bj * HALF) = w; } }
    }
};
struct EpiMixC {
    static constexpr bool PERM = true, AFTER_DRAIN = false, CHAIN = true;
    bf16_t* O; int ldc; const bf16_t* G1; const bf16_t* G2; int ldg;
    __device__ __forceinline__ void mid(f32x4 (&acc)[2][2][4][2], const Unit& u, int wr, int wc, int fr, int fq) const {
        const int row0 = u.pm * BM + wr * 64 + fr, col0 = u.pn * BM + wc * 32 + 8 * fq;
#pragma unroll
        for (int ai = 0; ai < 2; ++ai) { u32x4 av[4][2], bv[4][2];
#pragma unroll
            for (int m = 0; m < 4; ++m)
#pragma unroll
                for (int bj = 0; bj < 2; ++bj) { const size_t r = (size_t)(row0 + ai * HALF + m * 16); av[m][bj] = *(const u32x4*)(G1 + r * ldg + col0 + bj * HALF); bv[m][bj] = *(const u32x4*)(G2 + r * ldg + col0 + bj * HALF); }
            __builtin_amdgcn_sched_barrier(0);
#pragma unroll
            for (int m = 0; m < 4; ++m)
#pragma unroll
                for (int bj = 0; bj < 2; ++bj) { const u32x4 a = av[m][bj], b = bv[m][bj];
                    f32x4& v0 = acc[ai][bj][m][0]; f32x4& v1 = acc[ai][bj][m][1];
                    v0[0] *= bf_lo(a.x) * __builtin_amdgcn_rcpf(fmaxf(bf_lo(b.x), 1e-30f)); v0[1] *= bf_hi(a.x) * __builtin_amdgcn_rcpf(fmaxf(bf_hi(b.x), 1e-30f)); v0[2] *= bf_lo(a.y) * __builtin_amdgcn_rcpf(fmaxf(bf_lo(b.y), 1e-30f)); v0[3] *= bf_hi(a.y) * __builtin_amdgcn_rcpf(fmaxf(bf_hi(b.y), 1e-30f));
                    v1[0] *= bf_lo(a.z) * __builtin_amdgcn_rcpf(fmaxf(bf_lo(b.z), 1e-30f)); v1[1] *= bf_hi(a.z) * __builtin_amdgcn_rcpf(fmaxf(bf_hi(b.z), 1e-30f)); v1[2] *= bf_lo(a.w) * __builtin_amdgcn_rcpf(fmaxf(bf_lo(b.w), 1e-30f)); v1[3] *= bf_hi(a.w) * __builtin_amdgcn_rcpf(fmaxf(bf_hi(b.w), 1e-30f)); }
            __builtin_amdgcn_sched_barrier(0); }
    }
    __device__ __forceinline__ void operator()(const f32x4 (&acc)[2][2][4][2], const Unit& u, int wr, int wc, int fr, int fq) const {
        const int row0 = u.pm * BM + wr * 64 + fr, col0 = u.pn * BM + wc * 32 + 8 * fq;
        u32x4 gv[2][4][2];
#pragma unroll
        for (int ai = 0; ai < 2; ++ai)
#pragma unroll
            for (int m = 0; m < 4; ++m)
#pragma unroll
                for (int bj = 0; bj < 2; ++bj) gv[ai][m][bj] = *(const u32x4*)(G2 + (size_t)(row0 + ai * HALF + m * 16) * ldg + col0 + bj * HALF);
        __builtin_amdgcn_sched_barrier(0);
#pragma unroll
        for (int ai = 0; ai < 2; ++ai)
#pragma unroll
            for (int m = 0; m < 4; ++m) { const size_t r = (size_t)(row0 + ai * HALF + m * 16); bf16_t* rowp = O + r * ldc + col0;
#pragma unroll
                for (int bj = 0; bj < 2; ++bj) { f32x4 v0 = acc[ai][bj][m][0], v1 = acc[ai][bj][m][1]; const u32x4 gw = gv[ai][m][bj];
                    v0[0] *= bf_lo(gw.x); v0[1] *= bf_hi(gw.x); v0[2] *= bf_lo(gw.y); v0[3] *= bf_hi(gw.y); v1[0] *= bf_lo(gw.z); v1[1] *= bf_hi(gw.z); v1[2] *= bf_lo(gw.w); v1[3] *= bf_hi(gw.w);
                    u32x4 w; w.x = cvt_pk_bf16(v0[0], v0[1]); w.y = cvt_pk_bf16(v0[2], v0[3]); w.z = cvt_pk_bf16(v1[0], v1[1]); w.w = cvt_pk_bf16(v1[2], v1[3]);
                    *(u32x4*)(rowp + bj * HALF) = w; } }
    }
};
struct EpiRes {
    static constexpr bool PERM = false, AFTER_DRAIN = false, CHAIN = false;
    const float* base; float* out; int ldc;
    __device__ __forceinline__ void operator()(const f32x4 (&acc)[2][2][4][2], const Unit& u, int wr, int wc, int fr, int fq) const {
        const int row0 = u.pm * BM + wr * 64 + fr, col0 = u.pn * BM + wc * 32 + 4 * fq;
#pragma unroll
        for (int ai = 0; ai < 2; ++ai)
#pragma unroll
            for (int m = 0; m < 4; ++m) { const size_t off = (size_t)(row0 + ai * HALF + m * 16) * ldc + col0;
#pragma unroll
                for (int bj = 0; bj < 2; ++bj)
#pragma unroll
                    for (int n = 0; n < 2; ++n) { const f32x4 bs = *(const f32x4*)(base + off + bj * HALF + n * 16); *(f32x4*)(out + off + bj * HALF + n * 16) = bs + acc[ai][bj][m][n]; } }
    }
};
struct EpiResN {
    static constexpr bool PERM = false, AFTER_DRAIN = false, CHAIN = false;
    const float* base; float* out; int ldc; const float* gain; bf16_t* XB; float* RS;
    __device__ __forceinline__ void operator()(const f32x4 (&acc)[2][2][4][2], const Unit& u, int wr, int wc, int fr, int fq) const {
        const int row0 = u.pm * BM + wr * 64 + fr, col0 = u.pn * BM + wc * 32 + 4 * fq;
        f32x4 gv[2][2];
#pragma unroll
        for (int bj = 0; bj < 2; ++bj)
#pragma unroll
            for (int n = 0; n < 2; ++n) gv[bj][n] = *(const f32x4*)(gain + col0 + bj * HALF + n * 16);
#pragma unroll
        for (int ai = 0; ai < 2; ++ai)
#pragma unroll
            for (int m = 0; m < 4; ++m) { const int row = row0 + ai * HALF + m * 16; const size_t off = (size_t)row * ldc + col0; float ss = 0.f;
#pragma unroll
                for (int bj = 0; bj < 2; ++bj)
#pragma unroll
                    for (int n = 0; n < 2; ++n) { const f32x4 bs = *(const f32x4*)(base + off + bj * HALF + n * 16); const f32x4 v = bs + acc[ai][bj][m][n]; *(f32x4*)(out + off + bj * HALF + n * 16) = v;
                        ss += (v[0] * v[0] + v[1] * v[1]) + (v[2] * v[2] + v[3] * v[3]);
                        const f32x4 w = v * gv[bj][n]; unsigned long long pk = (unsigned long long)cvt_pk_bf16(w[0], w[1]) | ((unsigned long long)cvt_pk_bf16(w[2], w[3]) << 32);
                        *(unsigned long long*)(XB + off + bj * HALF + n * 16) = pk; }
                ss += __shfl_xor(ss, 16); ss += __shfl_xor(ss, 32);
                if (fq == 0) RS[(size_t)row * 64 + u.pn * 4 + wc] = ss; }
    }
};
template <bool BASE_BF16> struct EpiResB {
    static constexpr bool PERM = true, AFTER_DRAIN = false, CHAIN = false;
    const float* base; bf16_t* XB; int ldc; float* RS;
    __device__ __forceinline__ void operator()(const f32x4 (&acc)[2][2][4][2], const Unit& u, int wr, int wc, int fr, int fq) const {
        const int row0 = u.pm * BM + wr * 64 + fr, col0 = u.pn * BM + wc * 32 + 8 * fq;
#pragma unroll
        for (int ai = 0; ai < 2; ++ai) {
            u32x4 bw[4][2]; f32x4 bf[4][2][2];
#pragma unroll
            for (int m = 0; m < 4; ++m)
#pragma unroll
                for (int bj = 0; bj < 2; ++bj) { const size_t off = (size_t)(row0 + ai * HALF + m * 16) * ldc + col0 + bj * HALF;
                    if (BASE_BF16) bw[m][bj] = *(const u32x4*)(XB + off); else { bf[m][bj][0] = *(const f32x4*)(base + off); bf[m][bj][1] = *(const f32x4*)(base + off + 4); } }
            __builtin_amdgcn_sched_barrier(0);
#pragma unroll
            for (int m = 0; m < 4; ++m) { const int row = row0 + ai * HALF + m * 16; const size_t off = (size_t)row * ldc + col0; float ss = 0.f;
#pragma unroll
                for (int bj = 0; bj < 2; ++bj) { f32x4 v0 = acc[ai][bj][m][0], v1 = acc[ai][bj][m][1];
                    if (BASE_BF16) { const u32x4 w = bw[m][bj];
                        v0[0] += bf_lo(w.x); v0[1] += bf_hi(w.x); v0[2] += bf_lo(w.y); v0[3] += bf_hi(w.y); v1[0] += bf_lo(w.z); v1[1] += bf_hi(w.z); v1[2] += bf_lo(w.w); v1[3] += bf_hi(w.w); }
                    else { v0 += bf[m][bj][0]; v1 += bf[m][bj][1]; }
                    ss += ((v0[0] * v0[0] + v0[1] * v0[1]) + (v0[2] * v0[2] + v0[3] * v0[3])) + ((v1[0] * v1[0] + v1[1] * v1[1]) + (v1[2] * v1[2] + v1[3] * v1[3]));
                    u32x4 o; o.x = cvt_pk_bf16(v0[0], v0[1]); o.y = cvt_pk_bf16(v0[2], v0[3]); o.z = cvt_pk_bf16(v1[0], v1[1]); o.w = cvt_pk_bf16(v1[2], v1[3]);
                    *(u32x4*)(XB + off + bj * HALF) = o; }
                ss += __shfl_xor(ss, 16); ss += __shfl_xor(ss, 32);
                if (fq == 0) RS[(size_t)row * 64 + u.pn * 4 + wc] = ss; }
            __builtin_amdgcn_sched_barrier(0);
        }
    }
};
struct EpiRelu2R {
    static constexpr bool PERM = true, AFTER_DRAIN = false, CHAIN = false;
    bf16_t* O; int ldc; const float* rs2;
    __device__ __forceinline__ void operator()(const f32x4 (&acc)[2][2][4][2], const Unit& u, int wr, int wc, int fr, int fq) const {
        const int row0 = u.pm * BM + wr * 64 + fr, col0 = u.pn * BM + wc * 32 + 8 * fq;
        float r2v[2][4];
#pragma unroll
        for (int ai = 0; ai < 2; ++ai)
#pragma unroll
            for (int m = 0; m < 4; ++m) r2v[ai][m] = rs2[row0 + ai * HALF + m * 16];
        __builtin_amdgcn_sched_barrier(0);
#pragma unroll
        for (int ai = 0; ai < 2; ++ai)
#pragma unroll
            for (int m = 0; m < 4; ++m) { const int row = row0 + ai * HALF + m * 16; bf16_t* rowp = O + (size_t)row * ldc + col0; const float r2 = r2v[ai][m];
#pragma unroll
                for (int bj = 0; bj < 2; ++bj) { f32x4 v0 = acc[ai][bj][m][0], v1 = acc[ai][bj][m][1];
#pragma unroll
                    for (int j = 0; j < 4; ++j) { v0[j] = fmaxf(v0[j], 0.f); v1[j] = fmaxf(v1[j], 0.f); v0[j] = v0[j] * v0[j] * r2; v1[j] = v1[j] * v1[j] * r2; }
                    u32x4 w; w.x = cvt_pk_bf16(v0[0], v0[1]); w.y = cvt_pk_bf16(v0[2], v0[3]); w.z = cvt_pk_bf16(v1[0], v1[1]); w.w = cvt_pk_bf16(v1[2], v1[3]);
                    *(u32x4*)(rowp + bj * HALF) = w; } }
    }
};


typedef int v8i_t __attribute__((ext_vector_type(8)));
template <class Epi, class Sched, bool ALIGN_EPI = false, bool SP2 = false, bool F8 = false, bool HALFSEL = false>
__device__ __forceinline__ void gemm_phase(PG8_LAS unsigned char* lds, const Gemm g, const Sched& S, const Epi& E, const int wid_in) {
    int lane_; asm volatile("v_mbcnt_lo_u32_b32 %0, -1, 0\n\tv_mbcnt_hi_u32_b32 %0, -1, %0" : "=v"(lane_));
    const int wid = wid_in, lane = lane_, tid = wid * 64 + lane, wr = wid >> 2, wc = wid & 3, fr = lane & 15, fq = lane >> 4;
    const int K = g.K, nt = K / BK;
    unsigned voffA[2], voffB[2];
#pragma unroll
    for (int i = 0; i < 2; ++i) { int R, C; stage_rc(tid * 16 + i * 8192, R, C); const int Rb = Epi::PERM ? ((R & ~31) + perm32(R & 31)) : R;
        voffA[i] = (unsigned)(R * K + C) * 2u; voffB[i] = (unsigned)(Rb * K + C) * 2u; }
    const size_t kstep = (size_t)(BK * 2);
    const size_t hstep = (size_t)HALF * K * 2;
    const size_t tstep = 2 * hstep;
    const unsigned ldsw = (unsigned)wid * 1024u;
    const int aoff = lds_byte(wr * 64 + fr, fq * 8), boff = lds_byte(wc * 32 + fr, fq * 8);
#define PG8_SA(b, h) (((b) * 2 + (h)) * HTB)
#define PG8_SB(b, h) ((4 + (b) * 2 + (h)) * HTB)
#define PG8_STAGE(bufoff, gbase, voff) do { _Pragma("unroll") for (int _i = 0; _i < 2; ++_i) \
        __builtin_amdgcn_global_load_lds((const unsigned*)((const char*)(gbase) + (voff)[_i]), (PG8_LAS unsigned*)(lds + (bufoff) + ldsw + _i * 8192), 16, 0, 0); } while (0)
#define PG8_LDA(dst, b, h) do { _Pragma("unroll") for (int m = 0; m < 4; ++m) { if constexpr (F8) { dst##8[m] = __builtin_bit_cast(v8i_t, __builtin_shufflevector(*(const PG8_LAS bf16x8*)(lds + PG8_SA(b, h) + aoff + m * 2048), *(const PG8_LAS bf16x8*)(lds + PG8_SA(b, h) + aoff + m * 2048 + 1024), 0, 1, 2, 3, 4, 5, 6, 7, 8, 9, 10, 11, 12, 13, 14, 15)); } \
        else { _Pragma("unroll") for (int k = 0; k < 2; ++k) dst[m][k] = *(const PG8_LAS bf16x8*)(lds + PG8_SA(b, h) + aoff + m * 2048 + k * 1024); } } } while (0)
#define PG8_LDB(dst, b, h) do { _Pragma("unroll") for (int n = 0; n < 2; ++n) { if constexpr (F8) { dst##8[n] = __builtin_bit_cast(v8i_t, __builtin_shufflevector(*(const PG8_LAS bf16x8*)(lds + PG8_SB(b, h) + boff + n * 2048), *(const PG8_LAS bf16x8*)(lds + PG8_SB(b, h) + boff + n * 2048 + 1024), 0, 1, 2, 3, 4, 5, 6, 7, 8, 9, 10, 11, 12, 13, 14, 15)); } \
        else { _Pragma("unroll") for (int k = 0; k < 2; ++k) dst[n][k] = *(const PG8_LAS bf16x8*)(lds + PG8_SB(b, h) + boff + n * 2048 + k * 1024); } } } while (0)
#define PG8_MMA(ai, bj, At, Bt) do { if (HALFSEL && !((bjm >> (bj)) & 1)) break; __builtin_amdgcn_s_setprio(1); _Pragma("unroll") for (int m = 0; m < 4; ++m) _Pragma("unroll") for (int n = 0; n < 2; ++n) { \
        if constexpr (F8) { asm volatile("v_mfma_f32_16x16x128_f8f6f4 %0, %1, %2, %0" : "+v"(acc[ai][bj][m][n]) : "v"(Bt##8[n]), "v"(At##8[m])); } \
        else { _Pragma("unroll") for (int k = 0; k < 2; ++k) acc[ai][bj][m][n] = __builtin_amdgcn_mfma_f32_16x16x32_bf16(Bt[n][k], At[m][k], acc[ai][bj][m][n], 0, 0, 0); } } __builtin_amdgcn_s_setprio(0); } while (0)
#define PG8_WAIT_V(n) asm volatile("s_waitcnt vmcnt(" #n ")" ::: "memory")
#define PG8_WAIT_L(n) asm volatile("s_waitcnt lgkmcnt(" #n ")" ::: "memory")
#define PG8_BAR __builtin_amdgcn_s_barrier()
#define PG8_SCHED __builtin_amdgcn_sched_barrier(0)
    Unit cur, nxt; int ui = 0;
    if (!S.next(0, cur)) return;
    f32x4 acc[2][2][4][2];
#pragma unroll
    for (int a = 0; a < 2; ++a)
#pragma unroll
        for (int b = 0; b < 2; ++b)
#pragma unroll
            for (int m = 0; m < 4; ++m)
#pragma unroll
                for (int n = 0; n < 2; ++n) acc[a][b][m][n] = (f32x4){0.f, 0.f, 0.f, 0.f};
    bf16x8 At[4][2], B0[2][2], B1[2][2]; v8i_t At8[4], B08[2], B18[2]; (void)At; (void)B0; (void)B1; (void)At8; (void)B08; (void)B18;
    const char* cA = (const char*)(cur.part ? g.A2 : g.A) + (size_t)cur.pm * tstep; const char* cB = (const char*)(cur.part ? g.Bt2 : g.Bt) + (size_t)cur.pn * tstep;
    S.a_ready(cur);
    if constexpr (SP2) {
        PG8_STAGE(PG8_SB(0, 0), cB, voffB); PG8_STAGE(PG8_SB(0, 1), cB + hstep, voffB); PG8_STAGE(PG8_SA(0, 0), cA, voffA); PG8_STAGE(PG8_SA(0, 1), cA + hstep, voffA);
        if (wr == 1) PG8_BAR;
        PG8_WAIT_V(2); PG8_BAR;
        PG8_STAGE(PG8_SB(1, 0), cB + kstep, voffB); PG8_STAGE(PG8_SA(1, 0), cA + kstep, voffA); PG8_STAGE(PG8_SB(1, 1), cB + hstep + kstep, voffB);
        PG8_WAIT_V(6); PG8_BAR;
    } else {
        PG8_STAGE(PG8_SB(0, 0), cB, voffB); PG8_STAGE(PG8_SA(0, 0), cA, voffA); PG8_STAGE(PG8_SB(0, 1), cB + hstep, voffB); PG8_STAGE(PG8_SA(0, 1), cA + hstep, voffA);
        if (wr == 1) PG8_BAR;
        PG8_WAIT_V(4); PG8_BAR;
        PG8_STAGE(PG8_SB(1, 0), cB + kstep, voffB); PG8_STAGE(PG8_SA(1, 0), cA + kstep, voffA); PG8_STAGE(PG8_SB(1, 1), cB + hstep + kstep, voffB);
        PG8_WAIT_V(6); PG8_BAR;
    }
    for (;;) {
        const int bjm = HALFSEL ? ((2 * cur.pm < g.M / BM) ? 1 : 2) : 3; (void)bjm;
        const bool has_next = S.next(ui + 1, nxt);
        const char* nA = has_next ? (const char*)(nxt.part ? g.A2 : g.A) + (size_t)nxt.pm * tstep : cA; const char* nB = has_next ? (const char*)(nxt.part ? g.Bt2 : g.Bt) + (size_t)nxt.pn * tstep : cB;
        for (int t = 0; t < nt; t += 2) {
            const bool last = (t == nt - 2);
            const char* a1 = cA + (size_t)(t + 1) * kstep;
            const char* a2 = last ? nA : cA + (size_t)(t + 2) * kstep; const char* b2 = last ? nB : cB + (size_t)(t + 2) * kstep;
            const char* a3 = a2 + kstep; const char* b3 = b2 + kstep;
            if (last && has_next) S.a_ready(nxt);
            if constexpr (SP2) {
            PG8_LDB(B0, 0, 0); PG8_LDB(B1, 0, 1); PG8_SCHED; PG8_LDA(At, 0, 0); PG8_STAGE(PG8_SA(1, 1), a1 + hstep, voffA);
            PG8_WAIT_V(8); PG8_WAIT_L(0); PG8_BAR; PG8_MMA(0, 0, At, B0); PG8_MMA(0, 1, At, B1); PG8_BAR; PG8_SCHED;
            PG8_LDA(At, 0, 1); PG8_STAGE(PG8_SB(0, 0), b2, voffB); PG8_STAGE(PG8_SB(0, 1), b2 + hstep, voffB); PG8_STAGE(PG8_SA(0, 0), a2, voffA);
            PG8_WAIT_V(8); PG8_WAIT_L(0); PG8_BAR; PG8_MMA(1, 0, At, B0); PG8_MMA(1, 1, At, B1); PG8_BAR; PG8_SCHED;
            PG8_LDB(B0, 1, 0); PG8_LDB(B1, 1, 1); PG8_SCHED; PG8_LDA(At, 1, 0); PG8_STAGE(PG8_SA(0, 1), a2 + hstep, voffA);
            PG8_WAIT_V(8); PG8_WAIT_L(0); PG8_BAR; PG8_MMA(0, 0, At, B0); PG8_MMA(0, 1, At, B1); PG8_BAR; PG8_SCHED;
            PG8_LDA(At, 1, 1); PG8_STAGE(PG8_SB(1, 0), b3, voffB); PG8_STAGE(PG8_SB(1, 1), b3 + hstep, voffB); PG8_STAGE(PG8_SA(1, 0), a3, voffA);
            PG8_WAIT_V(8); PG8_WAIT_L(0); PG8_BAR; PG8_MMA(1, 0, At, B0); PG8_MMA(1, 1, At, B1); PG8_BAR; PG8_SCHED;
            } else {
            PG8_LDB(B0, 0, 0); PG8_SCHED; PG8_LDA(At, 0, 0); PG8_STAGE(PG8_SA(1, 1), a1 + hstep, voffA);
            PG8_WAIT_L(8); PG8_BAR; PG8_WAIT_L(0); PG8_MMA(0, 0, At, B0); PG8_BAR; PG8_SCHED;
            PG8_LDB(B1, 0, 1); PG8_STAGE(PG8_SB(0, 0), b2, voffB);
            PG8_BAR; PG8_WAIT_L(0); PG8_MMA(0, 1, At, B1); PG8_BAR;
            PG8_LDA(At, 0, 1); PG8_STAGE(PG8_SA(0, 0), a2, voffA);
            PG8_BAR; PG8_WAIT_L(0); PG8_MMA(1, 0, At, B0); PG8_BAR; PG8_SCHED;
            PG8_STAGE(PG8_SB(0, 1), b2 + hstep, voffB);
            PG8_WAIT_V(6); PG8_BAR; PG8_MMA(1, 1, At, B1); PG8_BAR;
            PG8_LDB(B0, 1, 0); PG8_SCHED; PG8_LDA(At, 1, 0); PG8_STAGE(PG8_SA(0, 1), a2 + hstep, voffA);
            PG8_WAIT_L(8); PG8_BAR; PG8_WAIT_L(0); PG8_MMA(0, 0, At, B0); PG8_BAR; PG8_SCHED;
            PG8_LDB(B1, 1, 1); PG8_STAGE(PG8_SB(1, 0), b3, voffB);
            PG8_BAR; PG8_WAIT_L(0); PG8_MMA(0, 1, At, B1); PG8_BAR;
            PG8_LDA(At, 1, 1); PG8_STAGE(PG8_SA(1, 0), a3, voffA);
            PG8_BAR; PG8_WAIT_L(0); PG8_MMA(1, 0, At, B0); PG8_BAR; PG8_SCHED;
            PG8_STAGE(PG8_SB(1, 1), b3 + hstep, voffB);
            PG8_WAIT_V(6); PG8_BAR; PG8_MMA(1, 1, At, B1); PG8_BAR;
            }
        }
        if constexpr (ALIGN_EPI) { if (wr == 0) PG8_BAR; }
        if constexpr (F8) {
            asm volatile("s_nop 15\n\ts_nop 15\n\ts_nop 7" : "+v"(acc[0][0][0][0]), "+v"(acc[0][0][0][1]), "+v"(acc[0][0][1][0]), "+v"(acc[0][0][1][1]), "+v"(acc[0][0][2][0]), "+v"(acc[0][0][2][1]), "+v"(acc[0][0][3][0]), "+v"(acc[0][0][3][1]), "+v"(acc[0][1][0][0]), "+v"(acc[0][1][0][1]), "+v"(acc[0][1][1][0]), "+v"(acc[0][1][1][1]), "+v"(acc[0][1][2][0]), "+v"(acc[0][1][2][1]), "+v"(acc[0][1][3][0]), "+v"(acc[0][1][3][1]));
            asm volatile("s_nop 0" : "+v"(acc[1][0][0][0]), "+v"(acc[1][0][0][1]), "+v"(acc[1][0][1][0]), "+v"(acc[1][0][1][1]), "+v"(acc[1][0][2][0]), "+v"(acc[1][0][2][1]), "+v"(acc[1][0][3][0]), "+v"(acc[1][0][3][1]), "+v"(acc[1][1][0][0]), "+v"(acc[1][1][0][1]), "+v"(acc[1][1][1][0]), "+v"(acc[1][1][1][1]), "+v"(acc[1][1][2][0]), "+v"(acc[1][1][2][1]), "+v"(acc[1][1][3][0]), "+v"(acc[1][1][3][1])); }
        bool keep_acc = false;
        if constexpr (Epi::CHAIN) { if (cur.part == 0) { E.mid(acc, cur, wr, wc, fr, fq); keep_acc = true; } else E(acc, cur, wr, wc, fr, fq); }
        else if constexpr (!Epi::AFTER_DRAIN) { E(acc, cur, wr, wc, fr, fq); S.done(cur); }
        if (!has_next) break;
        if (!keep_acc) {
#pragma unroll
        for (int a = 0; a < 2; ++a)
#pragma unroll
            for (int b = 0; b < 2; ++b)
#pragma unroll
                for (int m = 0; m < 4; ++m)
#pragma unroll
                    for (int n = 0; n < 2; ++n) acc[a][b][m][n] = (f32x4){0.f, 0.f, 0.f, 0.f};
        }
        cur = nxt; cA = nA; cB = nB; ++ui;
        if constexpr (ALIGN_EPI) { if (wr == 1) PG8_BAR; }
    }
    PG8_WAIT_V(0);
    if constexpr (!ALIGN_EPI) { if (wr == 0) PG8_BAR; }
    PG8_BAR;
    if constexpr (Epi::AFTER_DRAIN) { E.fused(acc, cur, wr, wc, fr, fq, lds, wid, lane); S.done(cur); }
#undef PG8_SA
#undef PG8_SB
#undef PG8_STAGE
#undef PG8_LDA
#undef PG8_LDB
#undef PG8_MMA
#undef PG8_WAIT_V
#undef PG8_WAIT_L
#undef PG8_BAR
#undef PG8_SCHED
}
}

constexpr int NWAVES = 8;
constexpr int N_LAUNCHES = MK_N_LAUNCHES;
constexpr int NPHASE = 12;
constexpr int BATCH = 4, SEQ = 4096, M = BATCH * SEQ, D = 4096, FF = 16384;
constexpr int NIN = 19520, LDU = 19712;
constexpr int GLA_H = 16, GLA_DK = 64, GLA_DV = 128;
constexpr int NSA_G = 4, NSA_R = 4, NSA_D = 128;
constexpr float NORM_EPS = 1e-6f;
constexpr int U_GQ = 0, U_GK = 1024, U_GV = 2048, U_GR = 4096, U_NQ = 6144, U_KC = 8192, U_VC = 8704, U_KSL = 9216, U_VSL = 9728, U_KW = 10240, U_VW = 10752,
              U_MG = 11264, U_MN = 15360, U_GA = 19456, U_NG = 19472;
__host__ __device__ __forceinline__ int orig_col(int n) {
    if (n < 4096) return n;
    if (n < 6144) return n - 4096 + 4112;
    if (n < 11264) return n - 6144 + 6160;
    if (n < 19456) return n - 11264 + 11328;
    if (n < 19472) return n - 19456 + 4096;
    if (n < 19520) return n - 19472 + 11280;
    return -1;
}
constexpr size_t MiB = 1u << 20;
constexpr size_t WS_CTL = 0, CTL_ZERO_BYTES = 1 * MiB;
constexpr size_t WS_W1C = 1 * MiB;
constexpr size_t WS_W2B = 3 * MiB;
constexpr size_t WS_HC = 4 * MiB;
constexpr size_t WS_OC = 8 * MiB;
constexpr size_t WS_RS = 12 * MiB;
constexpr size_t WS_RS2 = 3 * MiB + 256 * 1024;
constexpr size_t WS_U = 16 * MiB;
constexpr size_t WS_R2 = 632 * MiB;
constexpr size_t WS_WIN = WS_R2;
constexpr size_t WS_H = WS_R2 + 154 * MiB;
constexpr size_t WS_OGLA = WS_R2;
constexpr size_t WS_ONSA = WS_R2 + 64 * MiB;
constexpr size_t WS_MIX = WS_R2 + 128 * MiB;
constexpr size_t WS_ACMP = WS_R2 + 128 * MiB;
constexpr size_t WS_H2 = WS_R2;
constexpr size_t WS_WDOWN = WS_R2 + 128 * MiB;
constexpr size_t WS_WGLA = 914 * MiB, WS_WNSA = 930 * MiB, WS_WOUT = 946 * MiB, WS_WUP = 978 * MiB, WS_H8 = 1106 * MiB, WS_END = 1170 * MiB;
#ifndef GATE_FP8
#define GATE_FP8 1
#endif
constexpr int NB16 = GATE_FP8 ? 11520 : LDU;
constexpr int NG8 = 8192;
constexpr size_t WS_WG8 = WS_R2 + 90 * MiB;
constexpr int CW_TMO = 0, CW_BAR = 4096;
constexpr int RING_BYTES = 155648, LDSCTL_OFF = RING_BYTES, MISC_OFF = LDSCTL_OFF + 320, LDS_BYTES = 157696;

#define GAS __attribute__((address_space(1)))
#define LAS __attribute__((address_space(3)))
typedef unsigned short bf16;
typedef unsigned v4u __attribute__((ext_vector_type(4)));
typedef unsigned v2u __attribute__((ext_vector_type(2)));
typedef float f32x4 __attribute__((ext_vector_type(4)));
typedef GAS unsigned gu32;
#define RLX_AGENT __ATOMIC_RELAXED, __HIP_MEMORY_SCOPE_AGENT
#define LDS_WAIT() asm volatile("s_waitcnt lgkmcnt(0)" ::: "memory")
#define VM_WAIT() asm volatile("s_waitcnt vmcnt(0)" ::: "memory")
__device__ __forceinline__ unsigned f2bf(float f) { unsigned u = __builtin_bit_cast(unsigned, f); return (u + 0x7fffu + ((u >> 16) & 1u)) >> 16; }
__device__ __forceinline__ unsigned pk2(float lo, float hi) { return f2bf(lo) | (f2bf(hi) << 16); }
__device__ __forceinline__ float bfl(unsigned w) { return __uint_as_float(w << 16); }
__device__ __forceinline__ float bfh(unsigned w) { return __uint_as_float(w & 0xffff0000u); }

struct Args { const float* in[20]; float* out; unsigned char* ws; int ph_lo, ph_hi; };
typedef const __attribute__((address_space(4))) Args* KArgs;
__device__ __forceinline__ KArgs fresh_args() { KArgs p = (KArgs)__builtin_amdgcn_kernarg_segment_ptr(); asm volatile("" : "+s"(p)); return p; }
#define AIN ap->in

typedef short s16x4_t __attribute__((ext_vector_type(4)));
__device__ __forceinline__ s16x4_t tr_rd(LAS const unsigned char* p) { return __builtin_bit_cast(s16x4_t, __builtin_amdgcn_ds_read_tr16_b64_v4i16((LAS s16x4_t*)p)); }
#define XB_TMO      128
#define XB_XCNT(j)  (256  + 64 * (j))
#define XB_XSUB(j)  (1280 + 64 * (j))
#define XB_XGEN(j)  (2304 + 64 * (j))
#define XB_TOP      3328
#define XB_TOPGEN   3392
#define XCD_BAR_WORDS 3456
#define XB_SPIN_CAP (1u << 22)
__device__ __forceinline__ unsigned xb_ld(unsigned* p)              { return __hip_atomic_load(p, __ATOMIC_RELAXED, __HIP_MEMORY_SCOPE_AGENT); }
__device__ __forceinline__ unsigned xb_add(unsigned* p, unsigned v) { return __hip_atomic_fetch_add(p, v, __ATOMIC_RELAXED, __HIP_MEMORY_SCOPE_AGENT); }
__device__ __forceinline__ unsigned xb_xcc_id() { return (unsigned)__builtin_amdgcn_s_getreg((3 << 11) | 20) & 0xFu; }
#define XB_SPIN(cond, bar) do { unsigned _sp = 0; while (cond) { __builtin_amdgcn_s_sleep(1); \
    if ((++_sp & 255u) == 0u) { if (xb_ld(&(bar)[XB_TMO])) break; if (_sp > XB_SPIN_CAP) { atomicAdd(&(bar)[XB_TMO], 1u); break; } } } } while (0)

struct XcdBarrier {
    unsigned* bar; unsigned x;
    volatile LAS unsigned* st;
};

__device__ __forceinline__ XcdBarrier xcd_barrier_post(unsigned* bar, volatile LAS unsigned* st) {
    XcdBarrier b; b.bar = bar; b.x = xb_xcc_id(); b.st = st;
    if (threadIdx.x == 0) (void)xb_add(&bar[XB_XCNT(b.x)], 1u);
    return b;
}
__device__ __forceinline__ void xcd_barrier_complete(unsigned* bar, unsigned x, unsigned& nloc, unsigned& nx) {
    const unsigned G = gridDim.x * gridDim.y * gridDim.z;
    unsigned sum, cnt, mine, sp = 0u;
    for (;;) {
        sum = 0u; cnt = 0u; mine = 0u;
#pragma unroll
        for (unsigned j = 0; j < 16; ++j) { const unsigned c = xb_ld(&bar[XB_XCNT(j)]); sum += c; cnt += (c > 0u) ? 1u : 0u; mine = (j == x) ? c : mine; }
        if (sum == G) break;
        __builtin_amdgcn_s_sleep(1);
        if ((++sp & 255u) == 0u) { if (xb_ld(&bar[XB_TMO])) break; if (sp > XB_SPIN_CAP) { atomicAdd(&bar[XB_TMO], 1u); break; } }
    }
    nloc = mine > 0u ? mine : 1u; nx = cnt > 0u ? cnt : 1u;
}

__device__ __forceinline__ void xcd_barrier(const XcdBarrier& b, const int wave) {
    int lane_; asm volatile("v_mbcnt_lo_u32_b32 %0, -1, 0\n\tv_mbcnt_hi_u32_b32 %0, -1, %0" : "=v"(lane_)); const bool is_t0 = (wave == 0) && (lane_ == 0);
    asm volatile("s_waitcnt vmcnt(0)" ::: "memory");
    __syncthreads();
    if (is_t0) {
        unsigned* bar = b.bar;
        __builtin_amdgcn_s_waitcnt(0);
        unsigned nloc = b.st[0], nx = b.st[1];
        if (nloc == 0u) { xcd_barrier_complete(bar, b.x, nloc, nx); b.st[0] = nloc; b.st[1] = nx; }
        const unsigned old = xb_add(&bar[XB_XSUB(b.x)], 1u);
        const unsigned gen = old / nloc;
        if (old + 1u == (gen + 1u) * nloc) {
            __builtin_amdgcn_fence(__ATOMIC_RELEASE, "agent");
            asm volatile("s_waitcnt vmcnt(0)" ::: "memory");
            const unsigned og = xb_add(&bar[XB_TOP], 1u);
            const unsigned tg = og / nx;
            if (og + 1u == (tg + 1u) * nx) xb_add(&bar[XB_TOPGEN], 1u);
            else XB_SPIN(xb_ld(&bar[XB_TOPGEN]) == tg, bar);
            __builtin_amdgcn_fence(__ATOMIC_ACQUIRE, "agent");
            xb_add(&bar[XB_XGEN(b.x)], 1u);
            asm volatile("s_waitcnt vmcnt(0)" ::: "memory");
        } else {
            XB_SPIN(xb_ld(&bar[XB_XGEN(b.x)]) == gen, bar);
            __builtin_amdgcn_fence(__ATOMIC_ACQUIRE, "agent");
            asm volatile("s_waitcnt vmcnt(0)" ::: "memory");
        }
    }
    __syncthreads();
}

struct Frame {
    LAS unsigned char* lds;
    volatile LAS unsigned* MISC;
    int tid, lane, wave, G, blk;
};
__device__ __forceinline__ float wave_sum(float v) {
#pragma unroll
    for (int o = 1; o < 64; o <<= 1) v += __shfl_xor(v, o);
    return v;
}
__device__ __forceinline__ float wave_max(float v) {
#pragma unroll
    for (int o = 1; o < 64; o <<= 1) v = fmaxf(v, __shfl_xor(v, o));
    return v;
}
__device__ const unsigned char REL_LUT[128] = {0,1,2,3,4,5,6,7,8,9,10,11,12,13,14,15,16,16,16,17,17,18,18,18,19,19,19,20,20,20,20,21,21,21,21,22,22,22,22,22,23,23,23,23,23,23,24,24,24,24,24,24,25,25,25,25,25,25,25,
    26,26,26,26,26,26,26,26,27,27,27,27,27,27,27,27,27,27,28,28,28,28,28,28,28,28,28,28,29,29,29,29,29,29,29,29,29,29,29,29,30,30,30,30,30,30,30,30,30,30,30,30,30,30,31,31,31,31,31,31,31,31,31,31,31,31,31,31,31};

__device__ __forceinline__ float fp8_rt(float v) { const int p = __builtin_amdgcn_cvt_pk_fp8_f32(v, v, 0, false); return __builtin_amdgcn_cvt_f32_fp8(p, 0); }
__device__ __forceinline__ unsigned pk4_fp8(float a, float b, float c, float d) { int p = __builtin_amdgcn_cvt_pk_fp8_f32(a, b, 0, false); p = __builtin_amdgcn_cvt_pk_fp8_f32(c, d, p, true); return (unsigned)p; }
__device__ __forceinline__ void transpose_item_fp8(const float* W, int K, int ldw, unsigned char* WT8, int dst_row0, int src_col, int k0, LAS float* scr, int lane, float mul) {
#pragma unroll 8
    for (int i = 0; i < 32; ++i) { const int kk = 2 * i + (lane >> 5); scr[kk * 33 + (lane & 31)] = W[(size_t)(k0 + kk) * ldw + src_col] * mul; }
    LDS_WAIT(); asm volatile("" ::: "memory");
    const int c = lane & 7;
#pragma unroll
    for (int j = 0; j < 4; ++j) { const int n = (lane >> 3) + 8 * j; const LAS float* s = scr + (8 * c) * 33 + n;
        v2u o; o.x = pk4_fp8(s[0 * 33], s[1 * 33], s[2 * 33], s[3 * 33]); o.y = pk4_fp8(s[4 * 33], s[5 * 33], s[6 * 33], s[7 * 33]);
        *(GAS v2u*)(WT8 + (size_t)(dst_row0 + n) * K + k0 + 8 * c) = o; }
    LDS_WAIT(); asm volatile("" ::: "memory");
}
__device__ __forceinline__ void transpose_item(const float* W, int K, int ldw, bf16* WT, int dst_row0, int src_col, int k0, LAS float* scr, int lane, bool q8 = false) {
#pragma unroll 8
    for (int i = 0; i < 32; ++i) { const int kk = 2 * i + (lane >> 5); float wv = src_col >= 0 ? W[(size_t)(k0 + kk) * ldw + src_col] : 0.f; if (q8) wv = fp8_rt(wv * 64.f) * (1.f / 64.f); scr[kk * 33 + (lane & 31)] = wv; }
    LDS_WAIT(); asm volatile("" ::: "memory");
    const int c = lane & 7;
#pragma unroll
    for (int j = 0; j < 4; ++j) { const int n = (lane >> 3) + 8 * j; const LAS float* s = scr + (8 * c) * 33 + n;
        v4u o; o.x = pk2(s[0 * 33], s[1 * 33]); o.y = pk2(s[2 * 33], s[3 * 33]); o.z = pk2(s[4 * 33], s[5 * 33]); o.w = pk2(s[6 * 33], s[7 * 33]);
        *(GAS v4u*)(WT + (size_t)(dst_row0 + n) * K + k0 + 8 * c) = o; }
    LDS_WAIT(); asm volatile("" ::: "memory");
}
__device__ __forceinline__ void transpose_plain(const float* W, int K, int N, bf16* WT, int row_off, int item, LAS float* scr, int lane) {
    const int nblk = N / 32, kb = item / nblk, nb = item % nblk;
    transpose_item(W, K, N, WT, row_off + 32 * nb, 32 * nb + (lane & 31), 64 * kb, scr, lane);
}
__device__ __forceinline__ void rms_row_to_bf16(const float* xrow, const float* gain, bf16* orow, int lane, bool q8 = false, unsigned char* o8row = nullptr) {
    const GAS f32x4* xr = (const GAS f32x4*)xrow + lane; const GAS f32x4* gr = (const GAS f32x4*)gain + lane;
    f32x4 v[16]; float s = 0.f;
#pragma unroll
    for (int j = 0; j < 16; ++j) { v[j] = xr[64 * j]; s += (v[j].x * v[j].x + v[j].y * v[j].y) + (v[j].z * v[j].z + v[j].w * v[j].w); }
    const float rstd = 1.f / sqrtf(wave_sum(s) * (1.f / D) + NORM_EPS);
    GAS v2u* o8 = (GAS v2u*)orow + lane;
#pragma unroll
    for (int j = 0; j < 16; ++j) { const f32x4 g = gr[64 * j]; float a0 = v[j].x * rstd * g.x, a1 = v[j].y * rstd * g.y, a2 = v[j].z * rstd * g.z, a3 = v[j].w * rstd * g.w;
        if (q8) { a0 = fp8_rt(a0); a1 = fp8_rt(a1); a2 = fp8_rt(a2); a3 = fp8_rt(a3); }
        v2u o; o.x = pk2(a0, a1); o.y = pk2(a2, a3); o8[64 * j] = o;
        if (o8row) ((GAS unsigned*)o8row)[lane + 64 * j] = pk4_fp8(a0, a1, a2, a3); }
}
__device__ __forceinline__ void rms_row_inplace(float* xrow, const float* gain, int lane) {
    GAS f32x4* xr = (GAS f32x4*)xrow + lane; const GAS f32x4* gr = (const GAS f32x4*)gain + lane;
    f32x4 v[16]; float s = 0.f;
#pragma unroll
    for (int j = 0; j < 16; ++j) { v[j] = xr[64 * j]; s += (v[j].x * v[j].x + v[j].y * v[j].y) + (v[j].z * v[j].z + v[j].w * v[j].w); }
    const float rstd = 1.f / sqrtf(wave_sum(s) * (1.f / D) + NORM_EPS);
#pragma unroll
    for (int j = 0; j < 16; ++j) { const f32x4 g = gr[64 * j]; xr[64 * j] = (f32x4){v[j].x * rstd * g.x, v[j].y * rstd * g.y, v[j].z * rstd * g.z, v[j].w * rstd * g.w}; }
}

#ifndef FP8_EMU_W
#define FP8_EMU_W false
#endif
#ifndef FP8_EMU_H
#define FP8_EMU_H false
#endif
__device__ __forceinline__ void rms_rows(Frame& F, const float* X, const float* gain, bf16* H, unsigned char* H8, float* OUT, const int gw, const int NGW) {
    f32x4 v[16], gv[16];
    { const GAS f32x4* gr = (const GAS f32x4*)gain + F.lane;
#pragma unroll
      for (int j = 0; j < 16; ++j) gv[j] = gr[64 * j]; }
    if (gw < M) { const GAS f32x4* xr = (const GAS f32x4*)(X + (size_t)gw * D) + F.lane;
#pragma unroll
        for (int j = 0; j < 16; ++j) v[j] = xr[64 * j]; }
    for (int m = gw; m < M; m += NGW) { f32x4 vn[16]; const bool has = m + NGW < M;
        if (has) { const GAS f32x4* xr = (const GAS f32x4*)(X + (size_t)(m + NGW) * D) + F.lane;
#pragma unroll
            for (int j = 0; j < 16; ++j) vn[j] = xr[64 * j]; }
        float ssum = 0.f;
#pragma unroll
        for (int j = 0; j < 16; ++j) ssum += (v[j].x * v[j].x + v[j].y * v[j].y) + (v[j].z * v[j].z + v[j].w * v[j].w);
        const float rstd = 1.f / sqrtf(wave_sum(ssum) * (1.f / D) + NORM_EPS);
#pragma unroll
        for (int j = 0; j < 16; ++j) { const f32x4 g = gv[j]; const float a0 = v[j].x * rstd * g.x, a1 = v[j].y * rstd * g.y, a2 = v[j].z * rstd * g.z, a3 = v[j].w * rstd * g.w;
            if (OUT) ((GAS f32x4*)(OUT + (size_t)m * D) + F.lane)[64 * j] = (f32x4){a0, a1, a2, a3};
            if (H) { v2u o; o.x = pk2(a0, a1); o.y = pk2(a2, a3); ((GAS v2u*)(H + (size_t)m * D) + F.lane)[64 * j] = o; }
            if (H8) ((GAS unsigned*)(H8 + (size_t)m * D))[F.lane + 64 * j] = pk4_fp8(a0, a1, a2, a3); }
        if (has) {
#pragma unroll
            for (int j = 0; j < 16; ++j) v[j] = vn[j]; } }
}
struct TD { const float* W; unsigned char* WT; int K, ldw, drow, k0, scol, f8; const float* rs; };
#ifndef TR_DEPTH
#define TR_DEPTH 1
#endif
#ifndef TR_SK
#define TR_SK 1
#endif
#ifndef TR_SN
#define TR_SN 8
#endif
#define TR_MAP(r_, nblk_, kb_, nb_) do { if ((nblk_) < TR_SN || (TR_SK == 1 && TR_SN == 8)) { kb_ = (r_) / (nblk_); nb_ = (r_) % (nblk_); } else { const int g_ = (r_) / (TR_SK * TR_SN), s_ = (r_) % (TR_SK * TR_SN), ng_ = (nblk_) / TR_SN; kb_ = (g_ / ng_) * TR_SK + s_ / TR_SN; nb_ = (g_ % ng_) * TR_SN + s_ % TR_SN; } } while (0)
template <class Dec> __device__ __forceinline__ void transpose_stream(Frame& F, const Dec& decode, const int NITEMS, LAS float* scr, const int gw, const int NGW) {
    float tv[32];
#if TR_DEPTH == 2
    float tm[32];
#endif
    f32x4 ga = (f32x4){1.f, 1.f, 1.f, 1.f}, gb = ga;
    static_assert(TR_DEPTH == 1 || TR_DEPTH == 2, "TR_DEPTH");
    if (gw < NITEMS) { const TD d = decode(gw);
        if (d.rs) { ga = *(const GAS f32x4*)(d.rs + d.k0 + 8 * (F.lane & 7)); gb = *(const GAS f32x4*)(d.rs + d.k0 + 8 * (F.lane & 7) + 4); }
#pragma unroll
        for (int i = 0; i < 32; ++i) tv[i] = d.scol >= 0 ? d.W[(size_t)(d.k0 + 2 * i + (F.lane >> 5)) * d.ldw + d.scol] : 0.f; }
#if TR_DEPTH == 2
    if (gw + NGW < NITEMS) { const TD d = decode(gw + NGW);
#pragma unroll
        for (int i = 0; i < 32; ++i) tm[i] = d.scol >= 0 ? d.W[(size_t)(d.k0 + 2 * i + (F.lane >> 5)) * d.ldw + d.scol] : 0.f; }
#endif
    for (int it = gw; it < NITEMS; it += NGW) {
        const TD d = decode(it); const bool has = it + TR_DEPTH * NGW < NITEMS; float tn[32]; f32x4 gna = (f32x4){1.f, 1.f, 1.f, 1.f}, gnb = gna;
        if (it + NGW < NITEMS) { const TD e1 = decode(it + NGW); if (e1.rs) { gna = *(const GAS f32x4*)(e1.rs + e1.k0 + 8 * (F.lane & 7)); gnb = *(const GAS f32x4*)(e1.rs + e1.k0 + 8 * (F.lane & 7) + 4); } }
        if (has) { const TD e = decode(it + TR_DEPTH * NGW);
#pragma unroll
            for (int i = 0; i < 32; ++i) tn[i] = e.scol >= 0 ? e.W[(size_t)(e.k0 + 2 * i + (F.lane >> 5)) * e.ldw + e.scol] : 0.f; }
        const float mul = d.f8 ? 64.f : 1.f;
#pragma unroll
        for (int i = 0; i < 32; ++i) scr[(2 * i + (F.lane >> 5)) * 33 + (F.lane & 31)] = tv[i] * mul;
        LDS_WAIT(); asm volatile("" ::: "memory");
        const int c = F.lane & 7;
#pragma unroll
        for (int j = 0; j < 4; ++j) { const int n = (F.lane >> 3) + 8 * j; const LAS float* sp = scr + (8 * c) * 33 + n;
            if (d.f8) { v2u o; o.x = pk4_fp8(sp[0 * 33], sp[1 * 33], sp[2 * 33], sp[3 * 33]); o.y = pk4_fp8(sp[4 * 33], sp[5 * 33], sp[6 * 33], sp[7 * 33]); *(GAS v2u*)(d.WT + (size_t)(d.drow + n) * d.K + d.k0 + 8 * c) = o; }
            else { v4u o; o.x = pk2(sp[0 * 33] * ga.x, sp[1 * 33] * ga.y); o.y = pk2(sp[2 * 33] * ga.z, sp[3 * 33] * ga.w); o.z = pk2(sp[4 * 33] * gb.x, sp[5 * 33] * gb.y); o.w = pk2(sp[6 * 33] * gb.z, sp[7 * 33] * gb.w); *(GAS v4u*)((bf16*)d.WT + (size_t)(d.drow + n) * d.K + d.k0 + 8 * c) = o; } }
        LDS_WAIT(); asm volatile("" ::: "memory");
        ga = gna; gb = gnb;
#if TR_DEPTH == 2
#pragma unroll
        for (int i = 0; i < 32; ++i) { tv[i] = tm[i]; tm[i] = tn[i]; }
#else
        if (has) {
#pragma unroll
            for (int i = 0; i < 32; ++i) tv[i] = tn[i]; }
#endif
    }
}
#ifndef P0_DEFER
#define P0_DEFER 1
#endif
#ifndef P0_DEFER_UP
#define P0_DEFER_UP 16384
#endif
__device__ __forceinline__ void p0_prologue(Frame& F, KArgs ap, bool first = true, int gw2 = 0, int ngw2 = 1) {
    unsigned char* ws_ = ap->ws;
    LAS float* scr = (LAS float*)(F.lds + F.wave * 16384);
    const int gw = F.blk * NWAVES + F.wave, NGW = F.G * NWAVES;
    bf16* WinT = (bf16*)(ws_ + WS_WIN); bf16* WglaT = (bf16*)(ws_ + WS_WGLA); bf16* WnsaT = (bf16*)(ws_ + WS_WNSA); bf16* WoutT = (bf16*)(ws_ + WS_WOUT); bf16* WupT = (bf16*)(ws_ + WS_WUP);
    bf16* W1cT = (bf16*)(ws_ + WS_W1C); bf16* W2bT = (bf16*)(ws_ + WS_W2B);
    constexpr int I_IN = (D / 64) * (NB16 / 32), I_G8 = GATE_FP8 ? (D / 64) * (NG8 / 32) : 0, I_GLA = (2048 / 64) * (D / 32), I_NSA = I_GLA, I_OUT = (D / 64) * (D / 32), I_UP = (D / 64) * (FF / 32), I_PHI = (4096 / 64) * (128 / 32);
    constexpr int NITEMS = I_IN + I_G8 + I_GLA + I_NSA + I_OUT + I_UP + 2 * I_PHI;
    constexpr int NITEMS0 = P0_DEFER ? NITEMS - (I_GLA + I_NSA + I_OUT) - P0_DEFER_UP : NITEMS;
    auto decode = [&](int it) -> TD { TD d; int r = it; d.f8 = 0; d.rs = nullptr;
        if (r < I_IN) { const int nblk = NB16 / 32; int kb, nb; TR_MAP(r, nblk, kb, nb); const int ucol = (!GATE_FP8 || 32 * nb < 11264) ? 32 * nb : 32 * nb - 11264 + 19456;
            d.W = AIN[2]; d.WT = (unsigned char*)WinT; d.K = D; d.ldw = NIN; d.drow = 32 * nb; d.k0 = 64 * kb; d.scol = orig_col(ucol + (F.lane & 31)); return d; } r -= I_IN;
        if (r < I_G8) { const int nblk = NG8 / 32; int kb, nb; TR_MAP(r, nblk, kb, nb);
            d.W = AIN[2]; d.WT = ws_ + WS_WG8; d.K = D; d.ldw = NIN; d.drow = 32 * nb; d.k0 = 64 * kb; d.scol = orig_col(11264 + 32 * nb + (F.lane & 31)); d.f8 = 1; return d; } r -= I_G8;
        const float* W; bf16* WT; int K, N, roff = 0;
        if (r < I_PHI) { W = AIN[8]; WT = W1cT; K = 4096; N = 128; } else if ((r -= I_PHI) < I_PHI) { W = AIN[10]; WT = W1cT; K = 4096; N = 128; roff = 128; }
        else if ((r -= I_PHI) < I_UP) { W = AIN[17]; WT = WupT; K = D; N = FF; d.rs = AIN[16];   }
        else if ((r -= I_UP) < I_GLA) { W = AIN[13]; WT = WglaT; K = 2048; N = D; } else if ((r -= I_GLA) < I_NSA) { W = AIN[14]; WT = WnsaT; K = 2048; N = D; } else { r -= I_NSA; W = AIN[15]; WT = WoutT; K = D; N = D; }
        const int nblk = N / 32; int kb, nb; TR_MAP(r, nblk, kb, nb);
        d.W = W; d.WT = (unsigned char*)WT; d.K = K; d.ldw = N; d.drow = roff + 32 * nb; d.k0 = 64 * kb; d.scol = 32 * nb + (F.lane & 31); return d; };
    if (first) transpose_stream(F, decode, NITEMS0, scr, gw, NGW);
    else { transpose_stream(F, decode, NITEMS, scr, NITEMS0 + gw2, ngw2); return; }
    for (int i = gw * 64 + F.lane; i < 256 * 256; i += NGW * 64) { const int n = i >> 8, k = i & 255; float v = 0.f;
        if (n < 128 && k < 128) v = AIN[9][k * 128 + n]; else if (n >= 128 && k >= 128) v = AIN[11][(k - 128) * 128 + (n - 128)];
        W2bT[i] = (bf16)f2bf(v); }
    bf16* H = (bf16*)(ws_ + WS_H);
    rms_rows(F, AIN[0], AIN[1], H, GATE_FP8 ? ws_ + WS_H8 : nullptr, nullptr, gw, NGW);
}
__device__ __forceinline__ void p2_im2col(Frame& F, KArgs ap, int row_lo = 0, int row_hi = 8192, int gw_in = -1, int ngw_in = 0) {
    unsigned char* ws_ = ap->ws;
    const int gw = gw_in >= 0 ? gw_in : F.blk * NWAVES + F.wave, NGW = gw_in >= 0 ? ngw_in : F.G * NWAVES;
    const bf16* U = (const bf16*)(ws_ + WS_U); bf16* A = (bf16*)(ws_ + WS_ACMP);
    const int tq = F.lane >> 4, dc = (F.lane & 15) * 8;
    for (int row = row_lo + gw; row < row_hi; row += NGW) {
        const int kv = row >> 12, bg = (row >> 8) & 15, c = row & 255, b = bg >> 2, g = bg & 3;
        const float* pos = AIN[6 + kv]; const int ucol = (kv ? U_VC : U_KC) + g * 128 + dc;
#pragma unroll
        for (int i = 0; i < 8; ++i) { const int t = 4 * i + tq; v4u o = (v4u){0u, 0u, 0u, 0u};
            if (c < 255) { const v4u w = *(const GAS v4u*)(U + (size_t)(b * SEQ + 16 * c + t) * LDU + ucol);
                const f32x4 p0 = *(const GAS f32x4*)(pos + t * 128 + dc), p1 = *(const GAS f32x4*)(pos + t * 128 + dc + 4);
                o.x = pk2(bfl(w.x) + p0.x, bfh(w.x) + p0.y); o.y = pk2(bfl(w.y) + p0.z, bfh(w.y) + p0.w); o.z = pk2(bfl(w.z) + p1.x, bfh(w.z) + p1.y); o.w = pk2(bfl(w.w) + p1.z, bfh(w.w) + p1.w); }
            *(GAS v4u*)(A + (size_t)row * 4096 + t * 128 + dc) = o; }
    }
}
__device__ __forceinline__ void gla_chain(Frame& F, KArgs ap, int bh) {
    unsigned char* ws_ = ap->ws;
    const int b = bh >> 4, h = bh & 15, tid = F.tid, lane = F.lane, wave = F.wave;
    LAS float* A = (LAS float*)F.lds; LAS float* Kf = A + 4096; LAS float* Qf = Kf + 4096; LAS float* V = Qf + 4096; LAS float* O = V + 8192; LAS float* W2 = O + 8192; LAS float* Bal = W2 + 1024;
    const bf16* U = (const bf16*)(ws_ + WS_U); bf16* OG = (bf16*)(ws_ + WS_OGLA);
    for (int i = tid; i < 1024; i += 512) W2[i] = AIN[3][(i >> 6) * 1024 + h * 64 + (i & 63)];
    if (tid < 64) Bal[tid] = AIN[4][h * 64 + tid];
    const int grp = tid & 3, e = tid >> 2;
    float st[16];
#pragma unroll
    for (int j = 0; j < 16; ++j) st[j] = 0.f;
    const float g0 = AIN[5][h * 128 + 2 * lane], g1 = AIN[5][h * 128 + 2 * lane + 1];
    __syncthreads();
    for (int n = 0; n < 64; ++n) {
        const size_t tok0 = (size_t)b * SEQ + n * 64;
        { const int t = tid >> 3, dd = (tid & 7) * 8; const bf16* ur = U + (tok0 + t) * LDU;
          const v4u a0 = *(const GAS v4u*)(ur + U_GA), a1 = *(const GAS v4u*)(ur + U_GA + 8);
          float alr[16]; alr[0] = bfl(a0.x); alr[1] = bfh(a0.x); alr[2] = bfl(a0.y); alr[3] = bfh(a0.y); alr[4] = bfl(a0.z); alr[5] = bfh(a0.z); alr[6] = bfl(a0.w); alr[7] = bfh(a0.w);
          alr[8] = bfl(a1.x); alr[9] = bfh(a1.x); alr[10] = bfl(a1.y); alr[11] = bfh(a1.y); alr[12] = bfl(a1.z); alr[13] = bfh(a1.z); alr[14] = bfl(a1.w); alr[15] = bfh(a1.w);
#pragma unroll
          for (int j = 0; j < 8; ++j) { const int d = dd + j; float pre = Bal[d];
#pragma unroll
              for (int i = 0; i < 16; ++i) pre += alr[i] * W2[i * 64 + d];
              const float ls = fminf(pre, 0.f) - log1pf(expf(-fabsf(pre)));
              A[t * 64 + d] = expf(ls * (1.f / 16.f)); }
          const v4u qw = *(const GAS v4u*)(ur + U_GQ + h * 64 + dd), kw = *(const GAS v4u*)(ur + U_GK + h * 64 + dd);
          LAS float* qd = Qf + t * 64 + dd; LAS float* kd = Kf + t * 64 + dd;
          qd[0] = bfl(qw.x) * 0.125f; qd[1] = bfh(qw.x) * 0.125f; qd[2] = bfl(qw.y) * 0.125f; qd[3] = bfh(qw.y) * 0.125f; qd[4] = bfl(qw.z) * 0.125f; qd[5] = bfh(qw.z) * 0.125f; qd[6] = bfl(qw.w) * 0.125f; qd[7] = bfh(qw.w) * 0.125f;
          kd[0] = bfl(kw.x); kd[1] = bfh(kw.x); kd[2] = bfl(kw.y); kd[3] = bfh(kw.y); kd[4] = bfl(kw.z); kd[5] = bfh(kw.z); kd[6] = bfl(kw.w); kd[7] = bfh(kw.w);
          const int e0 = (tid & 7) * 16; const v4u v0 = *(const GAS v4u*)(ur + U_GV + h * 128 + e0), v1 = *(const GAS v4u*)(ur + U_GV + h * 128 + e0 + 8);
          LAS float* vd = V + t * 128 + e0;
          vd[0] = bfl(v0.x); vd[1] = bfh(v0.x); vd[2] = bfl(v0.y); vd[3] = bfh(v0.y); vd[4] = bfl(v0.z); vd[5] = bfh(v0.z); vd[6] = bfl(v0.w); vd[7] = bfh(v0.w);
          vd[8] = bfl(v1.x); vd[9] = bfh(v1.x); vd[10] = bfl(v1.y); vd[11] = bfh(v1.y); vd[12] = bfl(v1.z); vd[13] = bfh(v1.z); vd[14] = bfl(v1.w); vd[15] = bfh(v1.w); }
        __syncthreads();
        for (int t = 0; t < 64; ++t) {
            const LAS f32x4* ap = (const LAS f32x4*)(A + t * 64 + grp * 16); const LAS f32x4* kp = (const LAS f32x4*)(Kf + t * 64 + grp * 16); const LAS f32x4* qp = (const LAS f32x4*)(Qf + t * 64 + grp * 16);
            const float v = V[t * 128 + e]; float o = 0.f;
#pragma unroll
            for (int j4 = 0; j4 < 4; ++j4) { const f32x4 a = ap[j4], k = kp[j4], q = qp[j4];
                st[4 * j4 + 0] = a.x * st[4 * j4 + 0] + k.x * v; st[4 * j4 + 1] = a.y * st[4 * j4 + 1] + k.y * v; st[4 * j4 + 2] = a.z * st[4 * j4 + 2] + k.z * v; st[4 * j4 + 3] = a.w * st[4 * j4 + 3] + k.w * v;
                o += q.x * st[4 * j4 + 0] + q.y * st[4 * j4 + 1] + q.z * st[4 * j4 + 2] + q.w * st[4 * j4 + 3]; }
            o += __shfl_xor(o, 1); o += __shfl_xor(o, 2);
            if (grp == 0) O[t * 128 + e] = o;
        }
        __syncthreads();
#pragma unroll 2
        for (int i = 0; i < 8; ++i) { const int t = wave * 8 + i; const float o0 = O[t * 128 + 2 * lane], o1 = O[t * 128 + 2 * lane + 1];
            const float rstd = 1.f / sqrtf(wave_sum(o0 * o0 + o1 * o1) * (1.f / 128.f) + NORM_EPS);
            const unsigned rw = *(const GAS unsigned*)(U + (tok0 + t) * LDU + U_GR + h * 128 + 2 * lane);
            *(GAS unsigned*)(OG + (tok0 + t) * 2048 + h * 128 + 2 * lane) = pk2(o0 * rstd * g0 * bfl(rw), o1 * rstd * g1 * bfh(rw)); }
    }
    __syncthreads();
}

__device__ __forceinline__ void qk4(const bf16* krow, const LAS float* qs, float (&sc)[4]) {
#pragma unroll
    for (int r = 0; r < 4; ++r) sc[r] = 0.f;
#pragma unroll 4
    for (int d8 = 0; d8 < 16; ++d8) { const v4u w = *(const GAS v4u*)(krow + 8 * d8);
        const float k0 = bfl(w.x), k1 = bfh(w.x), k2 = bfl(w.y), k3 = bfh(w.y), k4 = bfl(w.z), k5 = bfh(w.z), k6 = bfl(w.w), k7 = bfh(w.w);
#pragma unroll
        for (int r = 0; r < 4; ++r) { const f32x4 qa = *(const LAS f32x4*)(qs + r * 128 + 8 * d8), qb = *(const LAS f32x4*)(qs + r * 128 + 8 * d8 + 4);
            sc[r] += (k0 * qa.x + k1 * qa.y) + (k2 * qa.z + k3 * qa.w) + (k4 * qb.x + k5 * qb.y) + (k6 * qb.z + k7 * qb.w); } }
}
__device__ __forceinline__ void pv4(const bf16* vbase, size_t vstride, const LAS float* pT, int nk, int lane, float (&o)[4][2]) {
#pragma unroll 4
    for (int key = 0; key < nk; ++key) { const unsigned w = *(const GAS unsigned*)(vbase + (size_t)key * vstride + 2 * lane); const float v0 = bfl(w), v1 = bfh(w);
        const f32x4 p = *(const LAS f32x4*)(pT + 4 * key);
        o[0][0] += p.x * v0; o[0][1] += p.x * v1; o[1][0] += p.y * v0; o[1][1] += p.y * v1; o[2][0] += p.z * v0; o[2][1] += p.z * v1; o[3][0] += p.w * v0; o[3][1] += p.w * v1; }
}
__device__ __forceinline__ void attend64(const bf16* Ub, int kb, bool valid, int dist, int koff, int voff, const LAS float* qs, LAS float* pT, const LAS float* bias, float (&m)[4], float (&l)[4], float (&o)[4][2], int lane) {
    float sc[4]; qk4(Ub + (size_t)(kb + lane) * LDU + koff, qs, sc);
    const int dd = dist < 0 ? 0 : (dist > 127 ? 127 : dist); const int bk = REL_LUT[dd];
    const f32x4 bv = *(const LAS f32x4*)(bias + 4 * bk);
    float p[4];
#pragma unroll
    for (int r = 0; r < 4; ++r) { const float x = sc[r] + bv[r]; const float bm = wave_max(valid ? x : -1e30f); const float mn = fmaxf(m[r], bm); const float al = __expf(m[r] - mn);
        p[r] = valid ? __expf(x - mn) : 0.f; l[r] = l[r] * al + wave_sum(p[r]); o[r][0] *= al; o[r][1] *= al; m[r] = mn; }
    asm volatile("" ::: "memory");
    *(LAS f32x4*)(pT + 4 * lane) = (f32x4){p[0], p[1], p[2], p[3]};
    LDS_WAIT(); __builtin_amdgcn_wave_barrier(); asm volatile("" ::: "memory");
    pv4(Ub + (size_t)kb * LDU + voff, LDU, pT, 64, lane, o);
    asm volatile("" ::: "memory");
}
__device__ __forceinline__ void nsa_item(Frame& F, KArgs ap, int item, LAS float* wl) {
    unsigned char* ws_ = ap->ws;
    const int lane = F.lane; const int s = item & (SEQ - 1), g = (item >> 12) & 3, b = item >> 14;
    LAS float* qs = wl; LAS float* pT = wl + 512; LAS float* bias = wl + 512 + 1024;
    const bf16* U = (const bf16*)(ws_ + WS_U); const bf16* Ub = U + (size_t)b * SEQ * LDU; const bf16* OC = (const bf16*)(ws_ + WS_OC);
    const size_t tok = (size_t)b * SEQ + s; const float scale = 0.08838834764831845f;
    asm volatile("" ::: "memory");
#pragma unroll
    for (int r = 0; r < 4; ++r) { const unsigned w = *(const GAS unsigned*)(U + tok * LDU + U_NQ + (g * 4 + r) * 128 + 2 * lane); qs[r * 128 + 2 * lane] = bfl(w) * scale; qs[r * 128 + 2 * lane + 1] = bfh(w) * scale; }
    for (int i = lane; i < 128; i += 64) bias[i] = AIN[12][(i >> 2) * 16 + g * 4 + (i & 3)];
    LDS_WAIT(); __builtin_amdgcn_wave_barrier(); asm volatile("" ::: "memory");
    float sc[4][4];
    const bf16* kc = OC + (size_t)((b * 4 + g) * 256) * 256; const bf16* vc = OC + (size_t)(4096 + (b * 4 + g) * 256) * 256 + 128;
    float mx[4] = {-1e30f, -1e30f, -1e30f, -1e30f};
#pragma unroll
    for (int i = 0; i < 4; ++i) { const int c = 64 * i + lane; qk4(kc + (size_t)c * 256, qs, sc[i]); const int dist = s - (16 * c + 31); const bool valid = (c < 255) && dist >= 0;
        const int dd = dist < 0 ? 0 : (dist > 127 ? 127 : dist); const f32x4 bv = *(const LAS f32x4*)(bias + 4 * REL_LUT[dd]);
#pragma unroll
        for (int r = 0; r < 4; ++r) { sc[i][r] = valid ? sc[i][r] + bv[r] : -1e30f; mx[r] = fmaxf(mx[r], sc[i][r]); } }
    float inv[4];
#pragma unroll
    for (int r = 0; r < 4; ++r) { mx[r] = wave_max(mx[r]); float sum = 0.f;
#pragma unroll
        for (int i = 0; i < 4; ++i) { sc[i][r] = sc[i][r] > -1e29f ? __expf(sc[i][r] - mx[r]) : 0.f; sum += sc[i][r]; }
        sum = wave_sum(sum); inv[r] = sum > 0.f ? 1.f / sum : 0.f; }
#pragma unroll
    for (int i = 0; i < 4; ++i) *(LAS f32x4*)(pT + 4 * (64 * i + lane)) = (f32x4){sc[i][0] * inv[0], sc[i][1] * inv[1], sc[i][2] * inv[2], sc[i][3] * inv[3]};
    LDS_WAIT(); __builtin_amdgcn_wave_barrier(); asm volatile("" ::: "memory");
    float ocmp[4][2];
#pragma unroll
    for (int r = 0; r < 4; ++r) { ocmp[r][0] = 0.f; ocmp[r][1] = 0.f; }
    const int nvalid = s >= 31 ? ((s - 31) >> 4) + 1 : 0;
    pv4(vc, 256, pT, nvalid, lane, ocmp);
    float imp = 0.f;
#pragma unroll
    for (int dc = -1; dc <= 3; ++dc) { const int c = 4 * lane + dc; if (c >= 0 && c < 255) { const f32x4 p = *(const LAS f32x4*)(pT + 4 * c); const float w = (dc == -1 || dc == 3) ? 1.f : 2.f; imp += w * ((p.x + p.y) + (p.z + p.w)); } }
    const int cur = s >> 6; const bool forced = (lane == 0) || (lane <= cur && lane > cur - 2); const bool reach = lane <= cur;
    const float score = forced ? 1e4f : (reach ? imp : -1e4f);
    int rank = 0;
#pragma unroll
    for (int jp = 0; jp < 64; ++jp) { const float sj = __int_as_float(__builtin_amdgcn_readlane(__float_as_int(score), jp)); rank += (sj > score || (sj == score && jp < lane)) ? 1 : 0; }
    unsigned long long mask = __ballot(rank < 16 && reach);
    asm volatile("" ::: "memory");
    float ms[4], ls[4], osel[4][2];
#pragma unroll
    for (int r = 0; r < 4; ++r) { ms[r] = -1e30f; ls[r] = 0.f; osel[r][0] = 0.f; osel[r][1] = 0.f; }
    while (mask) { const int j = __builtin_ctzll(mask); mask &= mask - 1; const int kpos = 64 * j + lane;
        attend64(Ub, 64 * j, kpos <= s, s - kpos, U_KSL + g * 128, U_VSL + g * 128, qs, pT, bias, ms, ls, osel, lane); }
    float mw[4], lw[4], owin[4][2];
#pragma unroll
    for (int r = 0; r < 4; ++r) { mw[r] = -1e30f; lw[r] = 0.f; owin[r][0] = 0.f; owin[r][1] = 0.f; }
    const int lo = s - 511 > 0 ? s - 511 : 0;
    for (int kb = lo & ~63; kb <= s; kb += 64) { const int kpos = kb + lane;
        attend64(Ub, kb, kpos >= lo && kpos <= s, s - kpos, U_KW + g * 128, U_VW + g * 128, qs, pT, bias, mw, lw, owin, lane); }
    bf16* ON = (bf16*)(ws_ + WS_ONSA);
#pragma unroll
    for (int r = 0; r < 4; ++r) { const bf16* gp = U + tok * LDU + U_NG + (g * 4 + r) * 3;
        const float g0 = __uint_as_float((unsigned)gp[0] << 16), g1 = __uint_as_float((unsigned)gp[1] << 16), g2 = __uint_as_float((unsigned)gp[2] << 16);
        const float is = g1 / ls[r], iw = g2 / lw[r];
        *(GAS unsigned*)(ON + tok * 2048 + (g * 4 + r) * 128 + 2 * lane) = pk2(g0 * ocmp[r][0] + is * osel[r][0] + iw * owin[r][0], g0 * ocmp[r][1] + is * osel[r][1] + iw * owin[r][1]); }
    asm volatile("" ::: "memory");
}
#ifndef NSA_QREG
#define NSA_QREG 1
#endif
#ifndef NSA_DMA
#define NSA_DMA 1
#endif
#ifndef NSA_PAIR
#define NSA_PAIR 1
#endif
#ifndef NSA_DMA0
#define NSA_DMA0 0
#endif
#ifndef NSA_TRASM
#define NSA_TRASM 0
#endif
#ifndef NSA_PFK
#define NSA_PFK 1
#endif
#ifndef NSA_PFV
#define NSA_PFV 1
#endif
#ifndef NSA_DUPSEL
#define NSA_DUPSEL 1
#endif
#ifndef NSA_DUPWIN
#define NSA_DUPWIN 1
#endif
#ifndef NSA_ACT3ONLY
#define NSA_ACT3ONLY 1
#endif
#ifndef NSA_HALF
#define NSA_HALF 0
#endif
#ifndef NSA_IGL_N
#define NSA_IGL_N 6
#endif
#define NSA_IGL() do { _Pragma("unroll") for (int i_ = 0; i_ < 16; ++i_) { __builtin_amdgcn_sched_group_barrier(0x008, 1, 0); __builtin_amdgcn_sched_group_barrier(0x002, NSA_IGL_N, 0); } } while (0)
#ifndef NSA_SWAPSEL
#define NSA_SWAPSEL(w) ((w) >> 2)
#endif
#ifndef NSA_HSB
#define NSA_HSB() __builtin_amdgcn_sched_barrier(0)
#endif
#ifndef NSA_BIASASM
#define NSA_BIASASM 1
#endif
#ifndef NSA_BIASASM_MASK
#define NSA_BIASASM_MASK 0
#endif
#ifndef NSA_QREG_KS
#define NSA_QREG_KS 4
#endif
#ifndef NSA_PRIO
#define NSA_PRIO(x)
#endif
#ifndef NSA_SB2
#define NSA_SB2()
#endif
#ifndef NSA_SB
#define NSA_SB() __builtin_amdgcn_sched_barrier(0)
#endif
typedef short bf16x8_t __attribute__((ext_vector_type(8)));
constexpr int NT_ROWB = 288;
constexpr int NT_TILEB = 64 * NT_ROWB;
constexpr int NL_K = 0, NL_V = 2 * NT_TILEB, NL_Q = 4 * NT_TILEB, NL_BIAS = NL_Q + 256 * NT_ROWB, NL_SELM = NL_BIAS + 2048, NL_WUN = NL_SELM + 512, NL_JL = NL_WUN + 64, NL_END = NL_JL + 64, NL_IMP = NL_K;
static_assert(NL_END <= RING_BYTES, "NSA LDS map");
__device__ __forceinline__ unsigned cvtpk(float lo, float hi) { unsigned r; asm volatile("v_cvt_pk_bf16_f32 %0, %1, %2" : "=v"(r) : "v"(lo), "v"(hi)); return r; }
__device__ __forceinline__ float xrow16_max(float x) {
    auto s = __builtin_amdgcn_permlane16_swap(__float_as_uint(x), __float_as_uint(x), false, false); x = fmaxf(__uint_as_float(s[0]), __uint_as_float(s[1]));
    auto t = __builtin_amdgcn_permlane32_swap(__float_as_uint(x), __float_as_uint(x), false, false); return fmaxf(__uint_as_float(t[0]), __uint_as_float(t[1])); }
__device__ __forceinline__ float xrow16_sum(float x) {
    auto s = __builtin_amdgcn_permlane16_swap(__float_as_uint(x), __float_as_uint(x), false, false); x = __uint_as_float(s[0]) + __uint_as_float(s[1]);
    auto t = __builtin_amdgcn_permlane32_swap(__float_as_uint(x), __float_as_uint(x), false, false); return __uint_as_float(t[0]) + __uint_as_float(t[1]); }
template <int CTRL> __device__ __forceinline__ float dppf(float x) { return __builtin_bit_cast(float, __builtin_amdgcn_mov_dpp(__builtin_bit_cast(int, x), CTRL, 0xf, 0xf, true)); }
__device__ __forceinline__ float quad_sum(float x) { x += dppf<0xB1>(x); x += dppf<0x4E>(x); return x; }
#ifndef NSA_THR
#define NSA_THR 8.0f
#endif


struct NsaTileSrc { const unsigned char* k; const unsigned char* v; unsigned stride; };
struct NsaRegs { v4u k0, k1, v0, v1; };
__device__ __forceinline__ void nsa_ld(const NsaTileSrc& s, int tid_in, NsaRegs& r) {
    int tid = tid_in; asm volatile("" : "+v"(tid));
    const int row = tid >> 4, c16 = (tid & 15) * 16;
    r.k0 = *(const GAS v4u*)(s.k + (size_t)row * s.stride + c16); r.k1 = *(const GAS v4u*)(s.k + (size_t)(row + 32) * s.stride + c16);
    r.v0 = *(const GAS v4u*)(s.v + (size_t)row * s.stride + c16); r.v1 = *(const GAS v4u*)(s.v + (size_t)(row + 32) * s.stride + c16);
}
__device__ __forceinline__ void nsa_st(LAS unsigned char* lds, int buf, int tid_in, const NsaRegs& r) {
    int tid = tid_in; asm volatile("" : "+v"(tid));
    const int row = tid >> 4, c16 = (tid & 15) * 16; LAS unsigned char* kb = lds + NL_K + buf * NT_TILEB + row * NT_ROWB + c16; LAS unsigned char* vb = lds + NL_V + buf * NT_TILEB + row * NT_ROWB + c16;
    *(LAS v4u*)kb = r.k0; *(LAS v4u*)(kb + 32 * NT_ROWB) = r.k1; *(LAS v4u*)vb = r.v0; *(LAS v4u*)(vb + 32 * NT_ROWB) = r.v1;
}
struct NsaAcc { f32x4 o[8][2]; float m[2], l[2]; };
__device__ __forceinline__ constexpr int nsa_koff(int buf) { return NSA_PAIR ? buf * 32768 : NL_K + buf * NT_TILEB; }
__device__ __forceinline__ constexpr int nsa_voff(int buf) { return NSA_PAIR ? buf * 32768 + 16384 : NL_V + buf * NT_TILEB; }
#if NSA_PAIR
static_assert(NSA_QREG && NSA_QREG_KS == 4 && NSA_DMA && !NSA_DMA0 && 4 * 32768 <= NL_BIAS, "NSA_PAIR needs every Q fragment in registers and the DMA staging");
#endif
__device__ __forceinline__ void nsa_dma(LAS unsigned char* lds, int buf, int wave, int lane_in, const NsaTileSrc& s) {
    int lane = lane_in; asm volatile("" : "+v"(lane));
#pragma unroll
    for (int i = 0; i < 2; ++i) { const int r = (wave * 2 + i) * 4 + (lane >> 4); const int c = (lane & 15) ^ ((r & 7) << 1);
        const size_t go = (size_t)r * s.stride + (size_t)(c * 16);
        __builtin_amdgcn_global_load_lds((const unsigned*)(s.k + go), (LAS unsigned*)(lds + nsa_koff(buf) + (wave * 2 + i) * 1024), 16, 0, 0);
        __builtin_amdgcn_global_load_lds((const unsigned*)(s.v + go), (LAS unsigned*)(lds + nsa_voff(buf) + (wave * 2 + i) * 1024), 16, 0, 0); }
}
#define NSA_DMA_WAIT() asm volatile("s_waitcnt vmcnt(0)" ::: "memory")
__device__ __forceinline__ unsigned cvtpk_nv(float lo, float hi) { unsigned r; asm("v_cvt_pk_bf16_f32 %0, %1, %2" : "=v"(r) : "v"(lo), "v"(hi)); return r; }
#define NSA_SMH(S_, PF_, AL_) do { _Pragma("unroll") for (int t = 0; t < 2; ++t) { const bool rv = (BR == 1) ? selbit[t] : true; \
        float m0 = fmaxf(fmaxf(fmaxf(S_[0][t][0], S_[0][t][1]), fmaxf(S_[0][t][2], S_[0][t][3])), fmaxf(fmaxf(S_[1][t][0], S_[1][t][1]), fmaxf(S_[1][t][2], S_[1][t][3]))); \
        float mx = rv ? m0 * C1 + bfar : -1e30f; mx = xrow16_max(mx); \
        const bool upd = __builtin_amdgcn_ballot_w64(mx - A.m[t] > NSA_THR) != 0ull; \
        const float mn = upd ? fmaxf(A.m[t], mx) : A.m[t]; AL_[t] = upd ? __builtin_amdgcn_exp2f(A.m[t] - mn) : 1.0f; A.m[t] = mn; \
        const float sh = rv ? bfar - mn : -__builtin_inff(); float pp[2][4]; float ps = 0.f; \
        _Pragma("unroll") for (int k1 = 0; k1 < 2; ++k1) _Pragma("unroll") for (int i = 0; i < 4; ++i) { pp[k1][i] = __builtin_amdgcn_exp2f(S_[k1][t][i] * C1 + sh); ps += pp[k1][i]; } \
        A.l[t] = A.l[t] * AL_[t] + ps; \
        v4u w; w.x = cvtpk_nv(pp[0][0], pp[0][1]); w.y = cvtpk_nv(pp[0][2], pp[0][3]); w.z = cvtpk_nv(pp[1][0], pp[1][1]); w.w = cvtpk_nv(pp[1][2], pp[1][3]); PF_[t] = __builtin_bit_cast(bf16x8_t, w); } } while (0)
#define NSA_QKH(S_, H_) do { _Pragma("unroll") for (int k1 = 0; k1 < 2; ++k1) { S_[k1][0] = (f32x4){0.f, 0.f, 0.f, 0.f}; S_[k1][1] = (f32x4){0.f, 0.f, 0.f, 0.f}; } \
        _Pragma("unroll") for (int ks = 0; ks < 4; ++ks) { \
            const bf16x8_t q0 = (NSA_QREG && ks < NSA_QREG_KS) ? qr[ks][0] : *(LAS const bf16x8_t*)(qb + ks * 64), q1 = (NSA_QREG && ks < NSA_QREG_KS) ? qr[ks][1] : *(LAS const bf16x8_t*)(qb + 16 * NT_ROWB + ks * 64); \
            bf16x8_t kf[2]; _Pragma("unroll") for (int k1 = 0; k1 < 2; ++k1) kf[k1] = *(LAS const bf16x8_t*)(kb + (2 * (H_) + k1) * 4096 + (((g + 4 * ks) ^ ksw) << 4)); \
            _Pragma("unroll") for (int k1 = 0; k1 < 2; ++k1) { S_[k1][0] = __builtin_amdgcn_mfma_f32_16x16x32_bf16(kf[k1], q0, S_[k1][0], 0, 0, 0); S_[k1][1] = __builtin_amdgcn_mfma_f32_16x16x32_bf16(kf[k1], q1, S_[k1][1], 0, 0, 0); } } } while (0)
#define NSA_PVH(PF_, H_) do { _Pragma("unroll") for (int d4 = 0; d4 < 2; ++d4) { bf16x8_t vf[4]; \
        _Pragma("unroll") for (int q = 0; q < 4; ++q) { const int dt = 4 * d4 + q; const s16x4_t lo = tr_rd(vb + (32 * (H_)) * 256 + ((dt * 32) ^ vsw)), hi = tr_rd(vb + (32 * (H_) + 16) * 256 + ((dt * 32) ^ vsw)); \
            vf[q] = __builtin_shufflevector(lo, hi, 0, 1, 2, 3, 4, 5, 6, 7); } \
        _Pragma("unroll") for (int q = 0; q < 4; ++q) { const int dt = 4 * d4 + q; \
            A.o[dt][0] = __builtin_amdgcn_mfma_f32_16x16x32_bf16(vf[q], PF_[0], A.o[dt][0], 0, 0, 0); A.o[dt][1] = __builtin_amdgcn_mfma_f32_16x16x32_bf16(vf[q], PF_[1], A.o[dt][1], 0, 0, 0); } } } while (0)
#define NSA_RESC(AL_) do { if (__builtin_amdgcn_ballot_w64(AL_[0] != 1.0f || AL_[1] != 1.0f) != 0ull) { _Pragma("unroll") for (int dt = 0; dt < 8; ++dt) { A.o[dt][0] *= AL_[0]; A.o[dt][1] *= AL_[1]; } } } while (0)
template <int BR>
__device__ __forceinline__ void nsa_fast_half(LAS const unsigned char* lds, int buf, int wave, NsaAcc& A, const bool (&selbit)[2], int rhead, int lane_in, const bf16x8_t (&qr)[4][2]) {
    int lane = lane_in; asm volatile("" : "+v"(lane));
    const int n = lane & 15, g = lane >> 4;
    LAS const unsigned char* kb = lds + NL_K + buf * NT_TILEB + n * 256; const int ksw = (n & 7) << 1;
    LAS const unsigned char* qb = lds + NL_Q + (32 * wave + n) * NT_ROWB + g * 16;
    LAS const unsigned char* vb = lds + NL_V + buf * NT_TILEB + (4 * g + (n >> 2)) * 256 + (n & 3) * 8; const int vsw = ((4 * g + (n >> 2)) & 7) << 5;
    const float C1 = 0.08838834764831845f * 1.4426950408889634f;
    const float bfar = ((LAS const float*)(lds + NL_BIAS))[rhead * 128 + 127];
    f32x4 sa[2][2], sb[2][2]; bf16x8_t pfa[2], pfb[2]; float ala[2], alb[2];
    NSA_QKH(sa, 0);
    NSA_HSB();
    const bool swp = (NSA_SWAPSEL(__builtin_amdgcn_readfirstlane(wave)) & 1) != 0;
    pfa[0] = pfa[1] = pfb[0] = pfb[1] = (bf16x8_t){0, 0, 0, 0, 0, 0, 0, 0}; ala[0] = ala[1] = alb[0] = alb[1] = 1.0f;
#pragma nounroll
    for (int st = 0; st < 2; ++st) { if ((st != 0) == swp) { NSA_QKH(sb, 1); } else { NSA_SMH(sa, pfa, ala); } NSA_HSB(); }
    NSA_HSB();
    NSA_RESC(ala);
#pragma nounroll
    for (int st = 0; st < 2; ++st) { if ((st != 0) == swp) { NSA_PVH(pfa, 0); } else { NSA_SMH(sb, pfb, alb); } NSA_HSB(); }
    NSA_HSB();
    NSA_RESC(alb);
    NSA_PVH(pfb, 1);
}
template <int BR, int ACT = 3>
__device__ __forceinline__ void nsa_tile(LAS const unsigned char* lds, int buf, int wave, NsaAcc& A, f32x4 (&imp)[4][2], int pos0, const int (&qpos)[2], const bool (&selbit)[2], bool far, bool FAST, int rhead, int lane_in, bool pre, const NsaTileSrc& nsrc, int tid, NsaRegs& R, const bf16x8_t (&qr)[4][2]) {
    int lane = lane_in; asm volatile("" : "+v"(lane));
    const int n = lane & 15, g = lane >> 4;
    if (BR != 0 && pre) { if (NSA_DMA) nsa_dma((LAS unsigned char*)lds, buf ^ 1, wave, lane, nsrc); else nsa_ld(nsrc, tid, R); }
#if NSA_HALF
    if constexpr (BR != 0 && ACT == 3 && NSA_DMA) { if (FAST) { nsa_fast_half<BR>(lds, buf, wave, A, selbit, rhead, lane, qr); return; } }
#endif
    constexpr bool SWZ = NSA_DMA && BR != 0;
    LAS const unsigned char* kb = SWZ ? lds + nsa_koff(buf) + n * 256 : lds + NL_K + buf * NT_TILEB + n * NT_ROWB + g * 16;
    const int ksw = (n & 7) << 1;
    LAS const unsigned char* qb = lds + NL_Q + (32 * wave + n) * NT_ROWB + g * 16;
    constexpr bool act0 = (ACT & 1) != 0, act1 = (ACT & 2) != 0;
    f32x4 s[4][2];
#pragma unroll
    for (int kt = 0; kt < 4; ++kt) { s[kt][0] = (f32x4){0.f, 0.f, 0.f, 0.f}; s[kt][1] = (f32x4){0.f, 0.f, 0.f, 0.f}; }
    NSA_PRIO(1);
#if NSA_PFK
    if constexpr (SWZ) {
        bf16x8_t kfa[4][4], qa[4][2];
#pragma unroll
        for (int ks = 0; ks < 4; ++ks) {
            if (!(NSA_QREG && ks < NSA_QREG_KS)) { qa[ks][0] = *(LAS const bf16x8_t*)(qb + ks * 64); qa[ks][1] = *(LAS const bf16x8_t*)(qb + 16 * NT_ROWB + ks * 64); }
#pragma unroll
            for (int kt = 0; kt < 4; ++kt) kfa[ks][kt] = *(LAS const bf16x8_t*)(kb + kt * 4096 + (((g + 4 * ks) ^ ksw) << 4)); }
        __builtin_amdgcn_sched_barrier(0);
#pragma unroll
        for (int ks = 0; ks < 4; ++ks) { const bf16x8_t q0 = (NSA_QREG && ks < NSA_QREG_KS) ? qr[ks][0] : qa[ks][0], q1 = (NSA_QREG && ks < NSA_QREG_KS) ? qr[ks][1] : qa[ks][1];
#pragma unroll
            for (int kt = 0; kt < 4; ++kt) {
                if (act0) s[kt][0] = __builtin_amdgcn_mfma_f32_16x16x32_bf16(kfa[ks][kt], q0, s[kt][0], 0, 0, 0);
                if (act1) s[kt][1] = __builtin_amdgcn_mfma_f32_16x16x32_bf16(kfa[ks][kt], q1, s[kt][1], 0, 0, 0); } }
        __builtin_amdgcn_sched_barrier(0);
    } else
#endif
#pragma unroll
    for (int ks = 0; ks < 4; ++ks) { bf16x8_t kf[4];
        const bf16x8_t q0 = (NSA_QREG && BR != 0 && ks < NSA_QREG_KS) ? qr[ks][0] : *(LAS const bf16x8_t*)(qb + ks * 64), q1 = (NSA_QREG && BR != 0 && ks < NSA_QREG_KS) ? qr[ks][1] : *(LAS const bf16x8_t*)(qb + 16 * NT_ROWB + ks * 64);
#pragma unroll
        for (int kt = 0; kt < 4; ++kt) kf[kt] = SWZ ? *(LAS const bf16x8_t*)(kb + kt * 4096 + (((g + 4 * ks) ^ ksw) << 4)) : *(LAS const bf16x8_t*)(kb + kt * 16 * NT_ROWB + ks * 64);
#pragma unroll
        for (int kt = 0; kt < 4; ++kt) {
            if (act0) s[kt][0] = __builtin_amdgcn_mfma_f32_16x16x32_bf16(kf[kt], q0, s[kt][0], 0, 0, 0);
            if (act1) s[kt][1] = __builtin_amdgcn_mfma_f32_16x16x32_bf16(kf[kt], q1, s[kt][1], 0, 0, 0); }
        NSA_SB(); }
    NSA_PRIO(0);
    const float C1 = 0.08838834764831845f * 1.4426950408889634f;
    LAS const float* bl = (LAS const float*)(lds + NL_BIAS) + rhead * 128;
    const float bfar = bl[127];
    bf16x8_t pf[2][2];
#pragma unroll
    for (int t = 0; t < 2; ++t) {
        NSA_SB2();
        if (!(t == 0 ? act0 : act1)) { pf[0][t] = (bf16x8_t){0, 0, 0, 0, 0, 0, 0, 0}; pf[1][t] = pf[0][t]; continue; }
        float x[4][4]; bool vld[4][4]; float mx = -1e30f; float ps = 0.f; float p[4][4]; float mn, al;
        if (FAST) {
            const bool rv = (BR == 1) ? selbit[t] : true;
            float m0 = fmaxf(fmaxf(s[0][t][0], s[0][t][1]), fmaxf(s[0][t][2], s[0][t][3]));
#pragma unroll
            for (int kt = 1; kt < 4; ++kt) m0 = fmaxf(m0, fmaxf(fmaxf(s[kt][t][0], s[kt][t][1]), fmaxf(s[kt][t][2], s[kt][t][3])));
            mx = rv ? m0 * C1 + bfar : -1e30f;
            mx = xrow16_max(mx);
            if (__builtin_amdgcn_ballot_w64(mx - A.m[t] > NSA_THR) != 0ull) { mn = fmaxf(A.m[t], mx); al = __builtin_amdgcn_exp2f(A.m[t] - mn); A.m[t] = mn; } else { mn = A.m[t]; al = 1.0f; }
            const float sh = rv ? bfar - mn : -__builtin_inff();
#pragma unroll
            for (int kt = 0; kt < 4; ++kt)
#pragma unroll
                for (int i = 0; i < 4; ++i) { p[kt][i] = __builtin_amdgcn_exp2f(s[kt][t][i] * C1 + sh); ps += p[kt][i]; }
        } else {
#if NSA_BIASASM
        if (((NSA_BIASASM_MASK >> BR) & 1) && !far) {
            const unsigned blb = (unsigned)(unsigned long)bl;
#pragma unroll
            for (int h2 = 0; h2 < 2; ++h2) { float bb[2][4];
#pragma unroll
                for (int k1 = 0; k1 < 2; ++k1)
#pragma unroll
                    for (int i = 0; i < 4; ++i) { const int kk = 16 * (2 * h2 + k1) + 4 * g + i; const int dist = (BR == 0) ? qpos[t] - (16 * (pos0 + kk) + 31) : qpos[t] - (pos0 + kk);
                        const int dd = dist < 0 ? 0 : (dist > 127 ? 127 : dist); const unsigned a = blb + 4u * (unsigned)dd;
                        asm volatile("ds_read_b32 %0, %1" : "=v"(bb[k1][i]) : "v"(a)); }
                asm volatile("s_waitcnt lgkmcnt(0)" : "+v"(bb[0][0]), "+v"(bb[0][1]), "+v"(bb[0][2]), "+v"(bb[0][3]), "+v"(bb[1][0]), "+v"(bb[1][1]), "+v"(bb[1][2]), "+v"(bb[1][3]));
#pragma unroll
                for (int k1 = 0; k1 < 2; ++k1)
#pragma unroll
                    for (int i = 0; i < 4; ++i) { const int kt = 2 * h2 + k1; const int kk = 16 * kt + 4 * g + i; int dist; bool v;
                        if (BR == 0) { const int c = pos0 + kk; dist = qpos[t] - (16 * c + 31); v = dist >= 0 && c < 255; }
                        else if (BR == 1) { dist = qpos[t] - (pos0 + kk); v = dist >= 0 && selbit[t]; }
                        else { dist = qpos[t] - (pos0 + kk); v = dist >= 0 && dist < 512; }
                        x[kt][i] = s[kt][t][i] * C1 + bb[k1][i]; vld[kt][i] = v; mx = fmaxf(mx, v ? x[kt][i] : -1e30f); } }
        } else
#endif
        {
#pragma unroll
        for (int kt = 0; kt < 4; ++kt)
#pragma unroll
            for (int i = 0; i < 4; ++i) { const int kk = 16 * kt + 4 * g + i; int dist; bool v;
                if (BR == 0) { const int c = pos0 + kk; dist = qpos[t] - (16 * c + 31); v = dist >= 0 && c < 255; }
                else if (BR == 1) { dist = qpos[t] - (pos0 + kk); v = dist >= 0 && selbit[t]; }
                else { dist = qpos[t] - (pos0 + kk); v = dist >= 0 && dist < 512; }
                float b2 = bfar; if (!far) { const int dd = dist < 0 ? 0 : (dist > 127 ? 127 : dist); b2 = bl[dd]; }
                x[kt][i] = s[kt][t][i] * C1 + b2; vld[kt][i] = v; mx = fmaxf(mx, v ? x[kt][i] : -1e30f); }
        }
        mx = xrow16_max(mx);
        if (__builtin_amdgcn_ballot_w64(mx - A.m[t] > NSA_THR) != 0ull) { mn = fmaxf(A.m[t], mx); al = __builtin_amdgcn_exp2f(A.m[t] - mn); A.m[t] = mn; } else { mn = A.m[t]; al = 1.0f; }
#pragma unroll
        for (int kt = 0; kt < 4; ++kt)
#pragma unroll
            for (int i = 0; i < 4; ++i) { p[kt][i] = vld[kt][i] ? __builtin_amdgcn_exp2f(x[kt][i] - mn) : 0.f; ps += p[kt][i]; }
        }
        A.l[t] = A.l[t] * al + ps;
        if (__builtin_amdgcn_ballot_w64(al != 1.0f) != 0ull) {
#pragma unroll
            for (int dt = 0; dt < 8; ++dt) A.o[dt][t] *= al;
            if (BR == 0) {
#pragma unroll
                for (int jt = 0; jt < 4; ++jt) imp[jt][t] *= al; } }
#pragma unroll
        for (int k2 = 0; k2 < 2; ++k2) { v4u w; w.x = cvtpk(p[2 * k2][0], p[2 * k2][1]); w.y = cvtpk(p[2 * k2][2], p[2 * k2][3]); w.z = cvtpk(p[2 * k2 + 1][0], p[2 * k2 + 1][1]); w.w = cvtpk(p[2 * k2 + 1][2], p[2 * k2 + 1][3]);
            pf[k2][t] = __builtin_bit_cast(bf16x8_t, w); }
    }
    NSA_SB2();
    if (BR == 0 && pre) nsa_ld(nsrc, tid, R);
    NSA_SB2();
    NSA_PRIO(1);
    LAS const unsigned char* vb = SWZ ? lds + nsa_voff(buf) + (4 * g + (n >> 2)) * 256 + (n & 3) * 8 : lds + NL_V + buf * NT_TILEB + (4 * g + (n >> 2)) * NT_ROWB + (n & 3) * 8;
    const int vsw = ((4 * g + (n >> 2)) & 7) << 5;
#if NSA_PFV
    if constexpr (SWZ) {
#pragma unroll
        for (int k2 = 0; k2 < 2; ++k2) { bf16x8_t vfa[8];
#if NSA_TRASM
            s16x4_t lo_[8], hi_[8];
#pragma unroll
            for (int dt = 0; dt < 8; ++dt) { const unsigned a0 = (unsigned)(unsigned long)(vb + (32 * k2) * 256) + (unsigned)((dt * 32) ^ vsw);
                asm volatile("ds_read_b64_tr_b16 %0, %1" : "=v"(lo_[dt]) : "v"(a0)); asm volatile("ds_read_b64_tr_b16 %0, %1 offset:4096" : "=v"(hi_[dt]) : "v"(a0)); }
            asm volatile("s_waitcnt lgkmcnt(0)" : "+v"(lo_[0]), "+v"(lo_[1]), "+v"(lo_[2]), "+v"(lo_[3]), "+v"(lo_[4]), "+v"(lo_[5]), "+v"(lo_[6]), "+v"(lo_[7]),
                         "+v"(hi_[0]), "+v"(hi_[1]), "+v"(hi_[2]), "+v"(hi_[3]), "+v"(hi_[4]), "+v"(hi_[5]), "+v"(hi_[6]), "+v"(hi_[7]));
#pragma unroll
            for (int dt = 0; dt < 8; ++dt) vfa[dt] = __builtin_shufflevector(lo_[dt], hi_[dt], 0, 1, 2, 3, 4, 5, 6, 7);
#else
#pragma unroll
            for (int dt = 0; dt < 8; ++dt) { const s16x4_t lo = tr_rd(vb + (32 * k2) * 256 + ((dt * 32) ^ vsw)), hi = tr_rd(vb + (32 * k2 + 16) * 256 + ((dt * 32) ^ vsw)); vfa[dt] = __builtin_shufflevector(lo, hi, 0, 1, 2, 3, 4, 5, 6, 7); }
#endif
            __builtin_amdgcn_sched_barrier(0);
#pragma unroll
            for (int dt = 0; dt < 8; ++dt) {
                if (act0) A.o[dt][0] = __builtin_amdgcn_mfma_f32_16x16x32_bf16(vfa[dt], pf[k2][0], A.o[dt][0], 0, 0, 0);
                if (act1) A.o[dt][1] = __builtin_amdgcn_mfma_f32_16x16x32_bf16(vfa[dt], pf[k2][1], A.o[dt][1], 0, 0, 0); }
            __builtin_amdgcn_sched_barrier(0); }
    } else
#endif
#pragma unroll
    for (int k2 = 0; k2 < 2; ++k2)
#pragma unroll
        for (int d4 = 0; d4 < 2; ++d4) { bf16x8_t vf[4];
#pragma unroll
            for (int q = 0; q < 4; ++q) { const int dt = 4 * d4 + q; const s16x4_t lo = SWZ ? tr_rd(vb + (32 * k2) * 256 + ((dt * 32) ^ vsw)) : tr_rd(vb + (32 * k2) * NT_ROWB + dt * 32), hi = SWZ ? tr_rd(vb + (32 * k2 + 16) * 256 + ((dt * 32) ^ vsw)) : tr_rd(vb + (32 * k2 + 16) * NT_ROWB + dt * 32);
                vf[q] = __builtin_shufflevector(lo, hi, 0, 1, 2, 3, 4, 5, 6, 7); }
#pragma unroll
            for (int q = 0; q < 4; ++q) { const int dt = 4 * d4 + q;
                if (act0) A.o[dt][0] = __builtin_amdgcn_mfma_f32_16x16x32_bf16(vf[q], pf[k2][0], A.o[dt][0], 0, 0, 0);
                if (act1) A.o[dt][1] = __builtin_amdgcn_mfma_f32_16x16x32_bf16(vf[q], pf[k2][1], A.o[dt][1], 0, 0, 0); }
            NSA_SB(); }
    NSA_PRIO(0);
    if (BR == 0) {
#pragma unroll
        for (int jt = 0; jt < 4; ++jt) { if (16 * jt > (pos0 >> 2) + 16 || 16 * jt + 15 < (pos0 >> 2)) continue;
            const int jb = 16 * jt + n;
#pragma unroll
            for (int k2 = 0; k2 < 2; ++k2) { unsigned short e[8];
#pragma unroll
                for (int q = 0; q < 8; ++q) { const int c = pos0 + 32 * k2 + (q < 4 ? 4 * g + q : 16 + 4 * g + (q - 4)); const int dz = c - 4 * jb;
                    e[q] = (c < 255) ? ((dz == -1 || dz == 3) ? 0x3F80 : ((dz >= 0 && dz <= 2) ? 0x4000 : 0)) : 0; }
                v4u w; w.x = e[0] | ((unsigned)e[1] << 16); w.y = e[2] | ((unsigned)e[3] << 16); w.z = e[4] | ((unsigned)e[5] << 16); w.w = e[6] | ((unsigned)e[7] << 16);
                const bf16x8_t mf = __builtin_bit_cast(bf16x8_t, w);
                imp[jt][0] = __builtin_amdgcn_mfma_f32_16x16x32_bf16(mf, pf[k2][0], imp[jt][0], 0, 0, 0);
                imp[jt][1] = __builtin_amdgcn_mfma_f32_16x16x32_bf16(mf, pf[k2][1], imp[jt][1], 0, 0, 0); } }
    }
}
template <bool ACCUM>
__device__ __forceinline__ void nsa_flush(NsaAcc& A, bf16* ON, const bf16* U, int b, int q0, int gk, int wave, int br, int lane_in) {
    int lane = lane_in; asm volatile("" : "+v"(lane)); const int n = lane & 15, g = lane >> 4, rhead = n & 3;
    unsigned short gw_[2]; v2u old_[2][8];
#pragma unroll
    for (int t = 0; t < 2; ++t) { const size_t tok = (size_t)b * SEQ + q0 + ((32 * wave + 16 * t + n) >> 2);
        gw_[t] = U[tok * LDU + U_NG + (gk * 4 + rhead) * 3 + br];
        if (ACCUM) { const bf16* orow_t = ON + tok * 2048 + (gk * 4 + rhead) * 128;
#pragma unroll
            for (int dt = 0; dt < 8; ++dt) old_[t][dt] = *(const GAS v2u*)(orow_t + 16 * dt + 4 * g); } }
    __builtin_amdgcn_sched_barrier(0);
#pragma unroll
    for (int t = 0; t < 2; ++t) { const float l = xrow16_sum(A.l[t]); A.l[t] = l;
        const size_t tok = (size_t)b * SEQ + q0 + ((32 * wave + 16 * t + n) >> 2);
        const float gate = __uint_as_float((unsigned)gw_[t] << 16); const float sc = l > 0.f ? gate / l : 0.f;
        bf16* orow_t = ON + tok * 2048 + (gk * 4 + rhead) * 128;
#pragma unroll
        for (int dt = 0; dt < 8; ++dt) { GAS v2u* p = (GAS v2u*)(orow_t + 16 * dt + 4 * g); f32x4 v = A.o[dt][t] * sc;
            if (ACCUM) { const v2u w = old_[t][dt]; v[0] += bfl(w.x); v[1] += bfh(w.x); v[2] += bfl(w.y); v[3] += bfh(w.y); }
            v2u w; w.x = cvtpk(v[0], v[1]); w.y = cvtpk(v[2], v[3]); *p = w; } }
}
__device__ __forceinline__ void nsa_acc_reset(NsaAcc& A) {
#pragma unroll
    for (int t = 0; t < 2; ++t) { A.m[t] = -1e30f; A.l[t] = 0.f;
#pragma unroll
        for (int dt = 0; dt < 8; ++dt) A.o[dt][t] = (f32x4){0.f, 0.f, 0.f, 0.f}; }
}
__device__ __forceinline__ void nsa_wg_item(Frame& F, KArgs ap, int item, size_t on_off) {
    unsigned char* ws_ = ap->ws;
    const int qt = item & 63, gk = (item >> 6) & 3, b = item >> 8;
    int lane = F.lane; asm volatile("" : "+v"(lane));
    const int wave = F.wave, tid = wave * 64 + lane, n = lane & 15, g = lane >> 4;
    LAS unsigned char* lds = F.lds;
    const bf16* U = (const bf16*)(ws_ + WS_U); const bf16* OC = (const bf16*)(ws_ + WS_OC); bf16* ON = (bf16*)(ws_ + on_off);
    const int q0 = 64 * qt, rhead = n & 3;
    int qpos[2];
#pragma unroll
    for (int t = 0; t < 2; ++t) qpos[t] = q0 + ((32 * wave + 16 * t + n) >> 2);
#pragma unroll
    for (int i = 0; i < 8; ++i) { const int cid = tid + 512 * i, row = cid >> 4, c16 = cid & 15;
        const v4u w = *(const GAS v4u*)(U + ((size_t)b * SEQ + q0 + (row >> 2)) * LDU + U_NQ + (gk * 4 + (row & 3)) * 128 + c16 * 8);
        *(LAS v4u*)(lds + NL_Q + row * NT_ROWB + c16 * 16) = w; }
    { LAS float* bl = (LAS float*)(lds + NL_BIAS); const int r = tid >> 7, dd = tid & 127; bl[tid] = ap->in[12][REL_LUT[dd] * 16 + gk * 4 + r] * 1.4426950408889634f; }
    NsaAcc A; f32x4 imp[4][2]; NsaRegs R; const bool nosel[2] = {true, true}; bf16x8_t qr[4][2];
    nsa_acc_reset(A);
#pragma unroll
    for (int jt = 0; jt < 4; ++jt) { imp[jt][0] = (f32x4){0.f, 0.f, 0.f, 0.f}; imp[jt][1] = (f32x4){0.f, 0.f, 0.f, 0.f}; }
    { const unsigned char* kbase = (const unsigned char*)(OC + (size_t)((b * 4 + gk) * 256) * 256); const unsigned char* vbase = (const unsigned char*)(OC + (size_t)(4096 + (b * 4 + gk) * 256) * 256 + 128);
      const int ntile = (q0 + 63 >= 31) ? (((q0 + 63 - 31) >> 4) >> 6) + 1 : 0;
      NsaTileSrc src{kbase, vbase, 512u};
      if (ntile > 0) { nsa_ld(src, tid, R); nsa_st(lds, 0, tid, R); }
      __syncthreads();
      for (int i = 0; i < ntile; ++i) {
          const NsaTileSrc s2{kbase + (size_t)(i + 1) * 64 * 512, vbase + (size_t)(i + 1) * 64 * 512, 512u};
          const bool far = (q0 - (16 * (64 * i + 63) + 31)) >= 128;
          nsa_tile<0>(lds, i & 1, wave, A, imp, 64 * i, qpos, nosel, far, far, rhead, lane, i + 1 < ntile, s2, tid, R, qr);
          if (i + 1 < ntile) nsa_st(lds, (i + 1) & 1, tid, R);
          __syncthreads();
      }
      nsa_flush<false>(A, ON, U, b, q0, gk, wave, 0, lane);
    }
    unsigned long long mymask[2];
    { LAS float* ib = (LAS float*)(lds + NL_IMP) + wave * 512;
#pragma unroll
      for (int t = 0; t < 2; ++t) { const float inv = A.l[t] > 0.f ? 1.f / A.l[t] : 0.f;
#pragma unroll
          for (int jt = 0; jt < 4; ++jt) { f32x4 v = imp[jt][t] * inv;
#pragma unroll
              for (int i = 0; i < 4; ++i) v[i] = quad_sum(v[i]);
              if (rhead == 0) *(LAS f32x4*)(ib + (4 * t + (n >> 2)) * 64 + 16 * jt + 4 * g) = v; } }
      LDS_WAIT(); __builtin_amdgcn_wave_barrier(); asm volatile("" ::: "memory");
      const int qw = lane >> 3, js = lane & 7; const int cur = qt;
      unsigned lo = 0u, hi = 0u;
      if (cur < 16) { const unsigned long long all = (cur >= 63) ? ~0ull : ((1ull << (cur + 1)) - 1ull); lo = (unsigned)all; hi = (unsigned)(all >> 32); }
      else {
          float sc[64];
#pragma unroll
          for (int j4 = 0; j4 < 16; ++j4) { const f32x4 v = *(LAS const f32x4*)(ib + qw * 64 + 4 * j4);
#pragma unroll
              for (int i = 0; i < 4; ++i) { const int j = 4 * j4 + i; const bool forced = (j == 0) || (j <= cur && j > cur - 2); sc[j] = forced ? 1e4f : (j <= cur ? v[i] : -1e4f); } }
#pragma unroll
          for (int k = 0; k < 8; ++k) { const int j = js + 8 * k; const bool forced = (j == 0) || (j <= cur && j > cur - 2); const float mine = forced ? 1e4f : (j <= cur ? ib[qw * 64 + j] : -1e4f);
              int rank = 0;
#pragma unroll
              for (int jp = 0; jp < 64; ++jp) rank += (sc[jp] > mine || (sc[jp] == mine && jp < j)) ? 1 : 0;
              const bool sel = rank < 16 && j <= cur;
              if (k < 4) lo |= sel ? (1u << (js + 8 * k)) : 0u; else hi |= sel ? (1u << (js + 8 * (k - 4))) : 0u; }
          lo |= __shfl_xor(lo, 1); lo |= __shfl_xor(lo, 2); lo |= __shfl_xor(lo, 4); hi |= __shfl_xor(hi, 1); hi |= __shfl_xor(hi, 2); hi |= __shfl_xor(hi, 4);
      }
      LAS unsigned* sm = (LAS unsigned*)(lds + NL_SELM) + wave * 16;
      if (js == 0) { sm[2 * qw] = lo; sm[2 * qw + 1] = hi; }
      unsigned ulo = lo, uhi = hi;
      ulo |= __shfl_xor(ulo, 8); ulo |= __shfl_xor(ulo, 16); ulo |= __shfl_xor(ulo, 32); uhi |= __shfl_xor(uhi, 8); uhi |= __shfl_xor(uhi, 16); uhi |= __shfl_xor(uhi, 32);
      LAS unsigned* wu = (LAS unsigned*)(lds + NL_WUN);
      if (lane == 0) { wu[2 * wave] = ulo; wu[2 * wave + 1] = uhi; }
      LDS_WAIT(); __builtin_amdgcn_wave_barrier(); asm volatile("" ::: "memory");
#pragma unroll
      for (int t = 0; t < 2; ++t) { const int qi = 4 * t + (n >> 2); mymask[t] = (unsigned long long)sm[2 * qi] | ((unsigned long long)sm[2 * qi + 1] << 32); }
    }
    __syncthreads();
    unsigned long long wgmask = 0ull, wvmask;
    { LAS const unsigned* wu = (LAS const unsigned*)(lds + NL_WUN);
#pragma unroll
      for (int w = 0; w < 8; ++w) wgmask |= (unsigned long long)wu[2 * w] | ((unsigned long long)wu[2 * w + 1] << 32);
      wvmask = (unsigned long long)wu[2 * wave] | ((unsigned long long)wu[2 * wave + 1] << 32);
      wgmask = ((unsigned long long)__builtin_amdgcn_readfirstlane((unsigned)(wgmask >> 32)) << 32) | (unsigned)__builtin_amdgcn_readfirstlane((unsigned)wgmask);
      wvmask = ((unsigned long long)__builtin_amdgcn_readfirstlane((unsigned)(wvmask >> 32)) << 32) | (unsigned)__builtin_amdgcn_readfirstlane((unsigned)wvmask); }
    nsa_acc_reset(A);
#if NSA_QREG
    { int l2 = lane; asm volatile("" : "+v"(l2)); LAS const unsigned char* qb = lds + NL_Q + (32 * wave + (l2 & 15)) * NT_ROWB + (l2 >> 4) * 16;
#pragma unroll
      for (int ks = 0; ks < NSA_QREG_KS; ++ks) { qr[ks][0] = *(LAS const bf16x8_t*)(qb + ks * 64); qr[ks][1] = *(LAS const bf16x8_t*)(qb + 16 * NT_ROWB + ks * 64); } }
#endif
    { const unsigned char* kbase = (const unsigned char*)(U + (size_t)b * SEQ * LDU + U_KSL + gk * 128); const unsigned char* vbase = (const unsigned char*)(U + (size_t)b * SEQ * LDU + U_VSL + gk * 128);
      for (int dup_ = 0; dup_ < NSA_DUPSEL; ++dup_) { if (NSA_DUPSEL > 1) { int one_ = 1; asm volatile("" : "+s"(one_)); if (one_) nsa_acc_reset(A); }
#if NSA_PAIR
      { LAS unsigned char* jl = lds + NL_JL;
        if (tid < 64 && ((wgmask >> tid) & 1ull)) jl[__builtin_popcountll(wgmask & ((1ull << tid) - 1ull))] = (unsigned char)tid;
        const int nsel = __builtin_popcountll(wgmask);
        __syncthreads();
#pragma unroll
        for (int e = 0; e < 2; ++e) if (e < nsel) { const int j = jl[e]; const NsaTileSrc src{kbase + (size_t)j * 64 * LDU * 2, vbase + (size_t)j * 64 * LDU * 2, (unsigned)(LDU * 2)}; nsa_dma(lds, e, wave, lane, src); }
        NSA_DMA_WAIT(); __syncthreads();
        for (int it = 0; 2 * it < nsel; ++it) { const int st = it & 1;
#pragma unroll
            for (int e = 0; e < 2; ++e) { const int idx = 2 * (it + 1) + e; if (idx < nsel) { const int j = jl[idx]; const NsaTileSrc src{kbase + (size_t)j * 64 * LDU * 2, vbase + (size_t)j * 64 * LDU * 2, (unsigned)(LDU * 2)}; nsa_dma(lds, (st ^ 1) * 2 + e, wave, lane, src); } }
            const NsaTileSrc s2{kbase, vbase, (unsigned)(LDU * 2)};
#pragma unroll
            for (int e = 0; e < 2; ++e) { const int idx = 2 * it + e; if (idx >= nsel) break; const int j = jl[idx];
                if ((wvmask >> j) & 1ull) { const bool sb[2] = {(bool)((mymask[0] >> j) & 1ull), (bool)((mymask[1] >> j) & 1ull)}; const bool far = (q0 - (64 * j + 63)) >= 128;
                    const bool a0 = __builtin_amdgcn_ballot_w64(sb[0]) != 0ull, a1 = __builtin_amdgcn_ballot_w64(sb[1]) != 0ull;
                    if (NSA_ACT3ONLY || (a0 && a1)) nsa_tile<1, 3>(lds, st * 2 + e, wave, A, imp, 64 * j, qpos, sb, far, far, rhead, lane, false, s2, tid, R, qr);
                    else if (a0) nsa_tile<1, 1>(lds, st * 2 + e, wave, A, imp, 64 * j, qpos, sb, far, far, rhead, lane, false, s2, tid, R, qr);
                    else nsa_tile<1, 2>(lds, st * 2 + e, wave, A, imp, 64 * j, qpos, sb, far, far, rhead, lane, false, s2, tid, R, qr); } }
            NSA_DMA_WAIT(); __syncthreads(); } }
      }
#else
      unsigned long long rem = wgmask; int j = __builtin_ctzll(rem); rem &= rem - 1;
      { NsaTileSrc src{kbase + (size_t)j * 64 * LDU * 2, vbase + (size_t)j * 64 * LDU * 2, (unsigned)(LDU * 2)};
        if (NSA_DMA) { nsa_dma(lds, 0, wave, lane, src); NSA_DMA_WAIT(); } else { nsa_ld(src, tid, R); nsa_st(lds, 0, tid, R); } }
      __syncthreads();
      for (int i = 0;; ++i) {
          const bool more = rem != 0ull; int jn = 0;
          if (more) { jn = __builtin_ctzll(rem); rem &= rem - 1; }
          const NsaTileSrc s2{kbase + (size_t)jn * 64 * LDU * 2, vbase + (size_t)jn * 64 * LDU * 2, (unsigned)(LDU * 2)};
          if ((wvmask >> j) & 1ull) { const bool sb[2] = {(bool)((mymask[0] >> j) & 1ull), (bool)((mymask[1] >> j) & 1ull)}; const bool far = (q0 - (64 * j + 63)) >= 128;
              const bool a0 = __builtin_amdgcn_ballot_w64(sb[0]) != 0ull, a1 = __builtin_amdgcn_ballot_w64(sb[1]) != 0ull;
              if (NSA_ACT3ONLY || (a0 && a1)) nsa_tile<1, 3>(lds, i & 1, wave, A, imp, 64 * j, qpos, sb, far, far, rhead, lane, more, s2, tid, R, qr);
              else if (a0) nsa_tile<1, 1>(lds, i & 1, wave, A, imp, 64 * j, qpos, sb, far, far, rhead, lane, more, s2, tid, R, qr);
              else nsa_tile<1, 2>(lds, i & 1, wave, A, imp, 64 * j, qpos, sb, far, far, rhead, lane, more, s2, tid, R, qr); }
          else if (more) { if (NSA_DMA) nsa_dma(lds, (i + 1) & 1, wave, lane, s2); else nsa_ld(s2, tid, R); }
          if (NSA_DMA) NSA_DMA_WAIT(); else if (more) nsa_st(lds, (i + 1) & 1, tid, R);
          __syncthreads();
          if (!more) break;
          j = jn;
      }
      }
#endif
      nsa_flush<true>(A, ON, U, b, q0, gk, wave, 1, lane);
    }
    nsa_acc_reset(A);
    { const unsigned char* kbase = (const unsigned char*)(U + (size_t)b * SEQ * LDU + U_KW + gk * 128); const unsigned char* vbase = (const unsigned char*)(U + (size_t)b * SEQ * LDU + U_VW + gk * 128);
      const int j0 = qt >= 8 ? qt - 8 : 0, ntile = qt - j0 + 1;
      for (int dup_ = 0; dup_ < NSA_DUPWIN; ++dup_) { if (NSA_DUPWIN > 1) { int one_ = 1; asm volatile("" : "+s"(one_)); if (one_) nsa_acc_reset(A); }
#if NSA_PAIR
      {
#pragma unroll
        for (int e = 0; e < 2; ++e) if (e < ntile) { const int j = j0 + e; const NsaTileSrc src{kbase + (size_t)j * 64 * LDU * 2, vbase + (size_t)j * 64 * LDU * 2, (unsigned)(LDU * 2)}; nsa_dma(lds, e, wave, lane, src); }
        NSA_DMA_WAIT(); __syncthreads();
        for (int it = 0; 2 * it < ntile; ++it) { const int st = it & 1;
#pragma unroll
            for (int e = 0; e < 2; ++e) { const int idx = 2 * (it + 1) + e; if (idx < ntile) { const int j = j0 + idx; const NsaTileSrc src{kbase + (size_t)j * 64 * LDU * 2, vbase + (size_t)j * 64 * LDU * 2, (unsigned)(LDU * 2)}; nsa_dma(lds, (st ^ 1) * 2 + e, wave, lane, src); } }
            const NsaTileSrc s2{kbase, vbase, (unsigned)(LDU * 2)};
#pragma unroll
            for (int e = 0; e < 2; ++e) { const int idx = 2 * it + e; if (idx >= ntile) break; const int j = j0 + idx; const bool far = (q0 - (64 * j + 63)) >= 128;
                nsa_tile<2>(lds, st * 2 + e, wave, A, imp, 64 * j, qpos, nosel, far, far && j > qt - 8, rhead, lane, false, s2, tid, R, qr); }
            NSA_DMA_WAIT(); __syncthreads(); } }
      }
#else
      { NsaTileSrc src{kbase + (size_t)j0 * 64 * LDU * 2, vbase + (size_t)j0 * 64 * LDU * 2, (unsigned)(LDU * 2)};
        if (NSA_DMA) { nsa_dma(lds, 0, wave, lane, src); NSA_DMA_WAIT(); } else { nsa_ld(src, tid, R); nsa_st(lds, 0, tid, R); } }
      __syncthreads();
      for (int i = 0; i < ntile; ++i) { const int j = j0 + i;
          const NsaTileSrc s2{kbase + (size_t)(j + 1) * 64 * LDU * 2, vbase + (size_t)(j + 1) * 64 * LDU * 2, (unsigned)(LDU * 2)};
          const bool far = (q0 - (64 * j + 63)) >= 128;
          nsa_tile<2>(lds, i & 1, wave, A, imp, 64 * j, qpos, nosel, far, far && j > qt - 8, rhead, lane, i + 1 < ntile, s2, tid, R, qr);
          if (NSA_DMA) NSA_DMA_WAIT(); else if (i + 1 < ntile) nsa_st(lds, (i + 1) & 1, tid, R);
          __syncthreads();
      }
      }
#endif
      nsa_flush<true>(A, ON, U, b, q0, gk, wave, 2, lane);
    }
    __syncthreads();
}

constexpr int GP = 288;
constexpr int GL_QE = 0, GL_KE = 64 * GP, GL_KD = 2 * 64 * GP, GL_V = 3 * 64 * GP, GL_ST = 4 * 64 * GP, GL_W2 = GL_ST + 128 * GP, GL_BAL = GL_W2 + 4096, GL_ALR = GL_BAL + 256, GL_WT = GL_ALR + 4096,
              GL_DEC = GL_WT + 2048, GL_SSQ = GL_DEC + 256, GL_END = GL_SSQ + 512;
static_assert(GL_END <= RING_BYTES, "GLA LDS map");
__device__ __forceinline__ bf16x8_t tr2(LAS const unsigned char* p) { const s16x4_t lo = tr_rd(p), hi = tr_rd(p + 16 * GP); return __builtin_shufflevector(lo, hi, 0, 1, 2, 3, 4, 5, 6, 7); }
__device__ __forceinline__ void gla_chain_mfma(Frame& F, KArgs ap, int bh, size_t og_off = WS_OGLA) {
    unsigned char* ws_ = ap->ws;
    const int b = bh >> 4, h = bh & 15;
    int lane = F.lane; asm volatile("" : "+v"(lane));
    const int wave = F.wave, tid = wave * 64 + lane, n = lane & 15, g = lane >> 4;
    LAS unsigned char* lds = F.lds;
    const bf16* U = (const bf16*)(ws_ + WS_U); bf16* OG = (bf16*)(ws_ + og_off);
    LAS float* W2 = (LAS float*)(lds + GL_W2); LAS float* Bal = (LAS float*)(lds + GL_BAL); LAS float* ALR = (LAS float*)(lds + GL_ALR); LAS float* WT = (LAS float*)(lds + GL_WT);
    LAS float* DEC = (LAS float*)(lds + GL_DEC); LAS float* SSQ = (LAS float*)(lds + GL_SSQ);
    for (int i = tid; i < 1024; i += 512) W2[i] = ap->in[3][(i >> 6) * 1024 + h * 64 + (i & 63)];
    if (tid < 64) Bal[tid] = ap->in[4][h * 64 + tid];
    for (int i = tid; i < 128 * GP / 4; i += 512) ((LAS unsigned*)(lds + GL_ST))[i] = 0u;
    const int tt = wave & 3, eh = wave >> 2;
    f32x4 Sr[4];
#pragma unroll
    for (int el = 0; el < 4; ++el) Sr[el] = (f32x4){0.f, 0.f, 0.f, 0.f};
    f32x4 gain[4];
#pragma unroll
    for (int el = 0; el < 4; ++el) gain[el] = *(const GAS f32x4*)(ap->in[5] + h * 128 + 16 * (4 * eh + el) + 4 * g);
    __syncthreads();
    float w2r[16];
#pragma unroll
    for (int j = 0; j < 16; ++j) w2r[j] = W2[j * 64 + lane];
    const float balr = Bal[lane];
    const int st_t = tid >> 3, st_p = tid & 7;
    unsigned p_aw; v4u p_q, p_k, p_v0, p_v1; v2u p_r[4];
#define GLA_LOAD(cc) do { const size_t tk = (size_t)b * SEQ + (cc) * 64; const bf16* ur = U + (tk + st_t) * LDU; \
        p_aw = *(const GAS unsigned*)(ur + U_GA + 2 * st_p); p_q = *(const GAS v4u*)(ur + U_GQ + h * 64 + st_p * 8); p_k = *(const GAS v4u*)(ur + U_GK + h * 64 + st_p * 8); \
        p_v0 = *(const GAS v4u*)(ur + U_GV + h * 128 + st_p * 16); p_v1 = *(const GAS v4u*)(ur + U_GV + h * 128 + st_p * 16 + 8); \
        _Pragma("unroll") for (int el = 0; el < 4; ++el) p_r[el] = *(const GAS v2u*)(U + (tk + 16 * tt + n) * LDU + U_GR + h * 128 + 16 * (4 * eh + el) + 4 * g); } while (0)
    GLA_LOAD(0);
    for (int c = 0; c < 64; ++c) {
        const size_t tok0 = (size_t)b * SEQ + c * 64;
        ALR[st_t * 16 + 2 * st_p] = bfl(p_aw); ALR[st_t * 16 + 2 * st_p + 1] = bfh(p_aw);
        *(LAS v4u*)(lds + GL_V + st_t * GP + st_p * 32) = p_v0; *(LAS v4u*)(lds + GL_V + st_t * GP + st_p * 32 + 16) = p_v1;
        *(LAS v4u*)(lds + GL_QE + st_t * GP + st_p * 16) = p_q; *(LAS v4u*)(lds + GL_KE + st_t * GP + st_p * 16) = p_k;
        v2u rcur[4];
#pragma unroll
        for (int el = 0; el < 4; ++el) rcur[el] = p_r[el];
        if (c + 1 < 64) GLA_LOAD(c + 1);
        __syncthreads();
        float bc[8]; float run = 0.f;
#pragma unroll
        for (int i = 0; i < 8; ++i) { const LAS f32x4* ar = (const LAS f32x4*)(ALR + (8 * wave + i) * 16); float pre = balr;
#pragma unroll
            for (int j4 = 0; j4 < 4; ++j4) { const f32x4 a = ar[j4]; pre += a.x * w2r[4 * j4] + a.y * w2r[4 * j4 + 1] + a.z * w2r[4 * j4 + 2] + a.w * w2r[4 * j4 + 3]; }
            const float ls = fminf(pre, 0.f) - __logf(1.f + __expf(-fabsf(pre)));
            run += ls * (1.f / 16.f); bc[i] = run; }
        WT[wave * 64 + lane] = run;
        __syncthreads();
        float off = 0.f, tot = 0.f; float qv[8], kv[8];
#pragma unroll
        for (int i = 0; i < 8; ++i) { const int t = 8 * wave + i; qv[i] = __uint_as_float((unsigned)*(LAS const unsigned short*)(lds + GL_QE + t * GP + 2 * lane) << 16); kv[i] = __uint_as_float((unsigned)*(LAS const unsigned short*)(lds + GL_KE + t * GP + 2 * lane) << 16); }
#pragma unroll
        for (int s = 0; s < 8; ++s) { const float wv = WT[s * 64 + lane]; tot += wv; off += (s < wave) ? wv : 0.f; }
#pragma unroll
        for (int i = 0; i < 8; ++i) { const float bcum = bc[i] + off; const int t = 8 * wave + i;
            *(LAS unsigned short*)(lds + GL_QE + t * GP + 2 * lane) = (unsigned short)f2bf(qv[i] * 0.125f * __expf(bcum));
            *(LAS unsigned short*)(lds + GL_KE + t * GP + 2 * lane) = (unsigned short)f2bf(kv[i] * __expf(-bcum));
            *(LAS unsigned short*)(lds + GL_KD + t * GP + 2 * lane) = (unsigned short)f2bf(kv[i] * __expf(tot - bcum)); }
        if (wave == 0) DEC[lane] = __expf(tot);
        __syncthreads();
        f32x4 at[4]; bf16x8_t qfr[2];
#pragma unroll
        for (int st = 0; st < 4; ++st) at[st] = (f32x4){0.f, 0.f, 0.f, 0.f};
#pragma unroll
        for (int ks = 0; ks < 2; ++ks) { qfr[ks] = *(LAS const bf16x8_t*)(lds + GL_QE + (16 * tt + n) * GP + 64 * ks + 16 * g);
#pragma unroll
            for (int st = 0; st < 4; ++st) if (st <= tt) { const bf16x8_t kf = *(LAS const bf16x8_t*)(lds + GL_KE + (16 * st + n) * GP + 64 * ks + 16 * g);
                at[st] = __builtin_amdgcn_mfma_f32_16x16x32_bf16(kf, qfr[ks], at[st], 0, 0, 0); } }
#pragma unroll
        for (int st = 0; st < 4; ++st) if (st == tt) {
#pragma unroll
            for (int i = 0; i < 4; ++i) if (4 * g + i > n) at[st][i] = 0.f; }
        bf16x8_t pf[2];
#pragma unroll
        for (int k2 = 0; k2 < 2; ++k2) { v4u w; w.x = cvtpk(at[2 * k2][0], at[2 * k2][1]); w.y = cvtpk(at[2 * k2][2], at[2 * k2][3]); w.z = cvtpk(at[2 * k2 + 1][0], at[2 * k2 + 1][1]); w.w = cvtpk(at[2 * k2 + 1][2], at[2 * k2 + 1][3]);
            pf[k2] = __builtin_bit_cast(bf16x8_t, w); }
        f32x4 o[4];
#pragma unroll
        for (int el = 0; el < 4; ++el) o[el] = (f32x4){0.f, 0.f, 0.f, 0.f};
        const float dec = DEC[16 * tt + n];
#pragma unroll
        for (int el = 0; el < 4; ++el) Sr[el] *= dec;
        LAS const unsigned char* trb = lds + (4 * g + (n >> 2)) * GP + (n & 3) * 8;
#pragma unroll
        for (int k2 = 0; k2 < 2; ++k2) { const bf16x8_t kdf = tr2(trb + GL_KD + 32 * k2 * GP + 32 * tt);
#pragma unroll
            for (int el = 0; el < 4; ++el) { const bf16x8_t vf = tr2(trb + GL_V + 32 * k2 * GP + 32 * (4 * eh + el));
                if (2 * k2 <= tt) o[el] = __builtin_amdgcn_mfma_f32_16x16x32_bf16(vf, pf[k2], o[el], 0, 0, 0);
                Sr[el] = __builtin_amdgcn_mfma_f32_16x16x32_bf16(vf, kdf, Sr[el], 0, 0, 0); } }
#pragma unroll
        for (int ks = 0; ks < 2; ++ks)
#pragma unroll
            for (int el = 0; el < 4; ++el) { const bf16x8_t sf = *(LAS const bf16x8_t*)(lds + GL_ST + (16 * (4 * eh + el) + n) * GP + 64 * ks + 16 * g);
                o[el] = __builtin_amdgcn_mfma_f32_16x16x32_bf16(sf, qfr[ks], o[el], 0, 0, 0); }
        float ss = 0.f;
#pragma unroll
        for (int el = 0; el < 4; ++el) ss += (o[el][0] * o[el][0] + o[el][1] * o[el][1]) + (o[el][2] * o[el][2] + o[el][3] * o[el][3]);
        ss += __shfl_xor(ss, 16); ss += __shfl_xor(ss, 32);
        if (g == 0) SSQ[(16 * tt + n) * 2 + eh] = ss;
        __syncthreads();
#pragma unroll
        for (int el = 0; el < 4; ++el)
#pragma unroll
            for (int i = 0; i < 4; ++i) *(LAS unsigned short*)(lds + GL_ST + (16 * (4 * eh + el) + 4 * g + i) * GP + 2 * (16 * tt + n)) = (unsigned short)f2bf(Sr[el][i]);
        const int t = 16 * tt + n; const float rstd = 1.f / sqrtf((SSQ[2 * t] + SSQ[2 * t + 1]) * (1.f / 128.f) + NORM_EPS);
#pragma unroll
        for (int el = 0; el < 4; ++el) { const int e0 = 16 * (4 * eh + el) + 4 * g; const v2u rw = rcur[el];
            v2u ow; ow.x = cvtpk(o[el][0] * rstd * gain[el][0] * bfl(rw.x), o[el][1] * rstd * gain[el][1] * bfh(rw.x)); ow.y = cvtpk(o[el][2] * rstd * gain[el][2] * bfl(rw.y), o[el][3] * rstd * gain[el][3] * bfh(rw.y));
            *(GAS v2u*)(OG + (tok0 + t) * 2048 + h * 128 + e0) = ow; }
    }
    __syncthreads();
#undef GLA_LOAD
}
constexpr size_t WS_KD = WS_R2 + 192 * MiB;
constexpr size_t WS_DEC = WS_R2 + 224 * MiB;
constexpr int GQ_ALR = 0, GQ_WT = 4096, GQ_QRAW = 8192, GQ_KRAW = GQ_QRAW + 64 * GP, GQ_QE = GQ_KRAW + 64 * GP, GQ_KE = GQ_QE + 64 * GP, GQ_KD = GQ_KE + 64 * GP, GQ_END = GQ_KD + 64 * GP;
static_assert(GQ_END <= RING_BYTES, "GLA pre-pass LDS map");
__device__ __forceinline__ void gla_pre_items(Frame& F, KArgs ap, int it0, int nw) {
    unsigned char* ws_ = ap->ws;
    int lane = F.lane; asm volatile("" : "+v"(lane));
    const int wave = F.wave, tid = wave * 64 + lane, st_t = tid >> 3, st_p = tid & 7;
    LAS unsigned char* lds = F.lds; LAS float* ALR = (LAS float*)(lds + GQ_ALR); LAS float* WT = (LAS float*)(lds + GQ_WT);
    bf16* U = (bf16*)(ws_ + WS_U); bf16* KD = (bf16*)(ws_ + WS_KD); float* DEC = (float*)(ws_ + WS_DEC);
    const int h = it0 & 15, slot = it0 >> 4, ns = (nw - h + 15) >> 4;
    float w2r[16];
#pragma unroll
    for (int j = 0; j < 16; ++j) w2r[j] = ap->in[3][j * 1024 + h * 64 + lane];
    const float balr = ap->in[4][h * 64 + lane];
    unsigned p_aw; v4u p_q, p_k;
#define GLA_PLOAD(px) do { const bf16* ur = U + ((size_t)((px) >> 6) * SEQ + ((px) & 63) * 64 + st_t) * LDU; \
        p_aw = *(const GAS unsigned*)(ur + U_GA + 2 * st_p); p_q = *(const GAS v4u*)(ur + U_GQ + h * 64 + st_p * 8); p_k = *(const GAS v4u*)(ur + U_GK + h * 64 + st_p * 8); } while (0)
    if (slot < 256) GLA_PLOAD(slot);
    for (int pr = slot; pr < 256; pr += ns) {
        const int b = pr >> 6, c = pr & 63, bh = b * 16 + h; const size_t tok0 = (size_t)b * SEQ + c * 64;
        ALR[st_t * 16 + 2 * st_p] = bfl(p_aw); ALR[st_t * 16 + 2 * st_p + 1] = bfh(p_aw);
        *(LAS v4u*)(lds + GQ_QRAW + st_t * GP + st_p * 16) = p_q; *(LAS v4u*)(lds + GQ_KRAW + st_t * GP + st_p * 16) = p_k;
        if (pr + ns < 256) GLA_PLOAD(pr + ns);
        __syncthreads();
        float bc[8]; float run = 0.f;
#pragma unroll
        for (int i = 0; i < 8; ++i) { const LAS f32x4* ar = (const LAS f32x4*)(ALR + (8 * wave + i) * 16); float pre = balr;
#pragma unroll
            for (int j4 = 0; j4 < 4; ++j4) { const f32x4 a = ar[j4]; pre += a.x * w2r[4 * j4] + a.y * w2r[4 * j4 + 1] + a.z * w2r[4 * j4 + 2] + a.w * w2r[4 * j4 + 3]; }
            const float ls = fminf(pre, 0.f) - __logf(1.f + __expf(-fabsf(pre)));
            run += ls * (1.f / 16.f); bc[i] = run; }
        WT[wave * 64 + lane] = run;
        __syncthreads();
        float off = 0.f, tot = 0.f;
#pragma unroll
        for (int s = 0; s < 8; ++s) { const float wv = WT[s * 64 + lane]; tot += wv; off += (s < wave) ? wv : 0.f; }
#pragma unroll
        for (int i = 0; i < 8; ++i) { const float bcum = bc[i] + off; const int t = 8 * wave + i;
            const float qv = __uint_as_float((unsigned)*(LAS const unsigned short*)(lds + GQ_QRAW + t * GP + 2 * lane) << 16), kv = __uint_as_float((unsigned)*(LAS const unsigned short*)(lds + GQ_KRAW + t * GP + 2 * lane) << 16);
            const unsigned wq = cvtpk(qv * 0.125f * __expf(bcum), kv * __expf(-bcum)); const unsigned wk = cvtpk(kv * __expf(tot - bcum), 0.f);
            *(LAS unsigned short*)(lds + GQ_QE + t * GP + 2 * lane) = (unsigned short)wq; *(LAS unsigned short*)(lds + GQ_KE + t * GP + 2 * lane) = (unsigned short)(wq >> 16);
            *(LAS unsigned short*)(lds + GQ_KD + t * GP + 2 * lane) = (unsigned short)wk; }
        if (wave == 0) DEC[(size_t)(bh * 64 + c) * 64 + lane] = __expf(tot);
        __syncthreads();
        { const v4u a = *(LAS const v4u*)(lds + GQ_QE + st_t * GP + st_p * 16), k2 = *(LAS const v4u*)(lds + GQ_KE + st_t * GP + st_p * 16), k3 = *(LAS const v4u*)(lds + GQ_KD + st_t * GP + st_p * 16);
          bf16* ur = U + (tok0 + st_t) * LDU; *(GAS v4u*)(ur + U_GQ + h * 64 + st_p * 8) = a; *(GAS v4u*)(ur + U_GK + h * 64 + st_p * 8) = k2; *(GAS v4u*)(KD + (tok0 + st_t) * 1024 + h * 64 + st_p * 8) = k3; }
    }
    __syncthreads();
#undef GLA_PLOAD
}
__device__ __forceinline__ void gla_chain_mfma2(Frame& F, KArgs ap, int bh) {
    unsigned char* ws_ = ap->ws;
    const int b = bh >> 4, h = bh & 15;
    int lane = F.lane; asm volatile("" : "+v"(lane));
    const int wave = F.wave, tid = wave * 64 + lane, n = lane & 15, g = lane >> 4;
    LAS unsigned char* lds = F.lds;
    const bf16* U = (const bf16*)(ws_ + WS_U); const bf16* KDg = (const bf16*)(ws_ + WS_KD); const float* DECg = (const float*)(ws_ + WS_DEC); bf16* OG = (bf16*)(ws_ + WS_OGLA);
    LAS float* DEC = (LAS float*)(lds + GL_DEC); LAS float* SSQ = (LAS float*)(lds + GL_SSQ);
    for (int i = tid; i < 128 * GP / 4; i += 512) ((LAS unsigned*)(lds + GL_ST))[i] = 0u;
    const int tt = wave & 3, eh = wave >> 2;
    f32x4 Sr[4];
#pragma unroll
    for (int el = 0; el < 4; ++el) Sr[el] = (f32x4){0.f, 0.f, 0.f, 0.f};
    f32x4 gain[4];
#pragma unroll
    for (int el = 0; el < 4; ++el) gain[el] = *(const GAS f32x4*)(ap->in[5] + h * 128 + 16 * (4 * eh + el) + 4 * g);
    const int st_t = tid >> 3, st_p = tid & 7;
    v4u p_q, p_k, p_kd, p_v0, p_v1; v2u p_r[4]; float p_dec;
#define GLA_LOAD2(cc) do { const size_t tk = (size_t)b * SEQ + (cc) * 64; const bf16* ur = U + (tk + st_t) * LDU; \
        p_q = *(const GAS v4u*)(ur + U_GQ + h * 64 + st_p * 8); p_k = *(const GAS v4u*)(ur + U_GK + h * 64 + st_p * 8); p_kd = *(const GAS v4u*)(KDg + (tk + st_t) * 1024 + h * 64 + st_p * 8); \
        p_v0 = *(const GAS v4u*)(ur + U_GV + h * 128 + st_p * 16); p_v1 = *(const GAS v4u*)(ur + U_GV + h * 128 + st_p * 16 + 8); \
        p_dec = DECg[(size_t)(bh * 64 + (cc)) * 64 + (tid & 63)]; \
        _Pragma("unroll") for (int el = 0; el < 4; ++el) p_r[el] = *(const GAS v2u*)(U + (tk + 16 * tt + n) * LDU + U_GR + h * 128 + 16 * (4 * eh + el) + 4 * g); } while (0)
    GLA_LOAD2(0);
    __syncthreads();
    for (int c = 0; c < 64; ++c) {
        const size_t tok0 = (size_t)b * SEQ + c * 64;
        *(LAS v4u*)(lds + GL_V + st_t * GP + st_p * 32) = p_v0; *(LAS v4u*)(lds + GL_V + st_t * GP + st_p * 32 + 16) = p_v1;
        *(LAS v4u*)(lds + GL_QE + st_t * GP + st_p * 16) = p_q; *(LAS v4u*)(lds + GL_KE + st_t * GP + st_p * 16) = p_k; *(LAS v4u*)(lds + GL_KD + st_t * GP + st_p * 16) = p_kd;
        if (wave == 0) DEC[lane] = p_dec;
        v2u rcur[4];
#pragma unroll
        for (int el = 0; el < 4; ++el) rcur[el] = p_r[el];
        if (c + 1 < 64) GLA_LOAD2(c + 1);
        __syncthreads();
        f32x4 at[4]; bf16x8_t qfr[2];
#pragma unroll
        for (int st = 0; st < 4; ++st) at[st] = (f32x4){0.f, 0.f, 0.f, 0.f};
#pragma unroll
        for (int ks = 0; ks < 2; ++ks) { qfr[ks] = *(LAS const bf16x8_t*)(lds + GL_QE + (16 * tt + n) * GP + 64 * ks + 16 * g);
#pragma unroll
            for (int st = 0; st < 4; ++st) if (st <= tt) { const bf16x8_t kf = *(LAS const bf16x8_t*)(lds + GL_KE + (16 * st + n) * GP + 64 * ks + 16 * g);
                at[st] = __builtin_amdgcn_mfma_f32_16x16x32_bf16(kf, qfr[ks], at[st], 0, 0, 0); } }
#pragma unroll
        for (int st = 0; st < 4; ++st) if (st == tt) {
#pragma unroll
            for (int i = 0; i < 4; ++i) if (4 * g + i > n) at[st][i] = 0.f; }
        bf16x8_t pf[2];
#pragma unroll
        for (int k2 = 0; k2 < 2; ++k2) { v4u w; w.x = cvtpk(at[2 * k2][0], at[2 * k2][1]); w.y = cvtpk(at[2 * k2][2], at[2 * k2][3]); w.z = cvtpk(at[2 * k2 + 1][0], at[2 * k2 + 1][1]); w.w = cvtpk(at[2 * k2 + 1][2], at[2 * k2 + 1][3]);
            pf[k2] = __builtin_bit_cast(bf16x8_t, w); }
        f32x4 o[4];
#pragma unroll
        for (int el = 0; el < 4; ++el) o[el] = (f32x4){0.f, 0.f, 0.f, 0.f};
        const float dec = DEC[16 * tt + n];
#pragma unroll
        for (int el = 0; el < 4; ++el) Sr[el] *= dec;
        LAS const unsigned char* trb = lds + (4 * g + (n >> 2)) * GP + (n & 3) * 8;
#pragma unroll
        for (int k2 = 0; k2 < 2; ++k2) { const bf16x8_t kdf = tr2(trb + GL_KD + 32 * k2 * GP + 32 * tt);
#pragma unroll
            for (int el = 0; el < 4; ++el) { const bf16x8_t vf = tr2(trb + GL_V + 32 * k2 * GP + 32 * (4 * eh + el));
                if (2 * k2 <= tt) o[el] = __builtin_amdgcn_mfma_f32_16x16x32_bf16(vf, pf[k2], o[el], 0, 0, 0);
                Sr[el] = __builtin_amdgcn_mfma_f32_16x16x32_bf16(vf, kdf, Sr[el], 0, 0, 0); } }
#pragma unroll
        for (int ks = 0; ks < 2; ++ks)
#pragma unroll
            for (int el = 0; el < 4; ++el) { const bf16x8_t sf = *(LAS const bf16x8_t*)(lds + GL_ST + (16 * (4 * eh + el) + n) * GP + 64 * ks + 16 * g);
                o[el] = __builtin_amdgcn_mfma_f32_16x16x32_bf16(sf, qfr[ks], o[el], 0, 0, 0); }
        float ss = 0.f;
#pragma unroll
        for (int el = 0; el < 4; ++el) ss += (o[el][0] * o[el][0] + o[el][1] * o[el][1]) + (o[el][2] * o[el][2] + o[el][3] * o[el][3]);
        ss = xrow16_sum(ss);
        if (g == 0) SSQ[(16 * tt + n) * 2 + eh] = ss;
        __syncthreads();
#pragma unroll
        for (int el = 0; el < 4; ++el) { const unsigned w0 = cvtpk(Sr[el][0], Sr[el][1]), w1 = cvtpk(Sr[el][2], Sr[el][3]); LAS unsigned char* sp = lds + GL_ST + (16 * (4 * eh + el) + 4 * g) * GP + 2 * (16 * tt + n);
            *(LAS unsigned short*)(sp) = (unsigned short)w0; *(LAS unsigned short*)(sp + GP) = (unsigned short)(w0 >> 16); *(LAS unsigned short*)(sp + 2 * GP) = (unsigned short)w1; *(LAS unsigned short*)(sp + 3 * GP) = (unsigned short)(w1 >> 16); }
        const int t = 16 * tt + n; const float rstd = 1.f / sqrtf((SSQ[2 * t] + SSQ[2 * t + 1]) * (1.f / 128.f) + NORM_EPS);
#pragma unroll
        for (int el = 0; el < 4; ++el) { const int e0 = 16 * (4 * eh + el) + 4 * g; const v2u rw = rcur[el];
            v2u ow; ow.x = cvtpk(o[el][0] * rstd * gain[el][0] * bfl(rw.x), o[el][1] * rstd * gain[el][1] * bfh(rw.x)); ow.y = cvtpk(o[el][2] * rstd * gain[el][2] * bfl(rw.y), o[el][3] * rstd * gain[el][3] * bfh(rw.y));
            *(GAS v2u*)(OG + (tok0 + t) * 2048 + h * 128 + e0) = ow; }
    }
    __syncthreads();
#undef GLA_LOAD2
}
__device__ __forceinline__ void nsa_wg_all(Frame& F, KArgs ap, int w, int nw, size_t on_off) {
    for (int k = 0;; ++k) { const int idx = (k & 1) ? k * nw + (nw - 1 - w) : k * nw + w; if (k * nw >= 1024) break; if (idx >= 1024) continue;
        const int qt = 63 - (idx >> 4), bg = idx & 15; nsa_wg_item(F, ap, ((bg >> 2) << 8) | ((bg & 3) << 6) | qt, on_off); }
}
constexpr int CW_QHEAD = 3072;
__device__ __forceinline__ void nsa_wg_queue(Frame& F, KArgs ap, size_t on_off, int hq) {
    unsigned* head = (unsigned*)(ap->ws + WS_CTL) + CW_QHEAD + hq; volatile LAS unsigned* slot = F.MISC + 16;
    for (;;) {
        if (F.tid == 0) slot[0] = __hip_atomic_fetch_add(head, 1u, __ATOMIC_RELAXED, __HIP_MEMORY_SCOPE_AGENT);
        __syncthreads();
        const int idx = (int)slot[0];
        __syncthreads();
        if (idx >= 1024) break;
        const int qt = 63 - (idx >> 4), bg = idx & 15; nsa_wg_item(F, ap, ((bg >> 2) << 8) | ((bg & 3) << 6) | qt, on_off);
    }
}
#ifndef GLA_IMPL
#define GLA_IMPL 2
#endif
#if GLA_IMPL == 0
#define GLA_CHAIN gla_chain
#elif GLA_IMPL == 1
#define GLA_CHAIN gla_chain_mfma
#else
#define GLA_CHAIN gla_chain_mfma2
#endif
#ifndef NSA_IMPL
#define NSA_IMPL 2
#endif
__device__ __forceinline__ void p5_mixers(Frame& F, KArgs ap, int rep = 0) {
    const int nG = F.G >= 128 ? 64 : (F.G >= 8 ? F.G / 4 : 1);
#if NSA_IMPL == 2
    if (F.blk < nG) { for (int bh = F.blk; bh < BATCH * GLA_H; bh += nG) GLA_CHAIN(F, ap, bh); }
    nsa_wg_queue(F, ap, WS_ONSA, 64 * rep);
#else
    if (F.blk < nG) { for (int bh = F.blk; bh < BATCH * GLA_H; bh += nG) GLA_CHAIN(F, ap, bh); }
    else if (F.G > nG) {
#if NSA_IMPL == 0
        LAS float* wl = (LAS float*)F.lds + F.wave * 2048;
        const int nw = (F.G - nG) * NWAVES; for (int it = (F.blk - nG) * NWAVES + F.wave; it < BATCH * NSA_G * SEQ; it += nw) nsa_item(F, ap, it, wl);
#else
        nsa_wg_all(F, ap, F.blk - nG, F.G - nG, WS_ONSA);
#endif
    }
#endif
}

#if defined(NSA_CHECK)
#define CHECK_AMP NSA_CHECK
#elif defined(GLA_CHECK)
#define CHECK_AMP GLA_CHECK
#endif
#ifndef PHM
#define PHM 0xFFF
#endif
__global__ void __launch_bounds__(NWAVES * 64, 2) hybrid_fwd(Args args) {
    extern __shared__ __attribute__((aligned(16))) unsigned char lds[];
    Frame F;
    F.lds = (LAS unsigned char*)lds; F.MISC = (volatile LAS unsigned*)(F.lds + MISC_OFF);
    F.tid = threadIdx.x; F.lane = F.tid & 63; F.wave = __builtin_amdgcn_readfirstlane(F.tid >> 6);
    F.G = gridDim.x; F.blk = blockIdx.x;
    for (int u = F.tid; u < (LDS_BYTES - LDSCTL_OFF) / 4; u += NWAVES * 64) ((LAS unsigned*)(F.lds + LDSCTL_OFF))[u] = 0u;
    __syncthreads();
    const int lo = args.ph_lo, hi = args.ph_hi;
    if (hi - lo > 1 && F.tid == 0) { unsigned* bw = (unsigned*)(args.ws + WS_CTL) + CW_BAR; (void)xb_add(&bw[XB_XCNT(xb_xcc_id())], 1u); }
#define IN(k) (((PHM >> (k)) & 1) && lo <= (k) && (k) < hi)
#ifndef PH_REP
#define PH_REP 0
#endif
#ifndef PH_REPN
#define PH_REPN 2
#endif
#define NREP(k) (((PH_REP >> (k)) & 1) ? PH_REPN : 1)
#define FRESH() KArgs ap = fresh_args(); unsigned char* ws = ap->ws; (void)ws; { int _l; asm volatile("v_mbcnt_lo_u32_b32 %0, -1, 0\n\tv_mbcnt_hi_u32_b32 %0, -1, %0" : "=v"(_l)); F.lane = _l; F.tid = F.wave * 64 + _l; }
#ifndef WGM_UP
#define WGM_UP 8
#endif
#ifndef WGM_DOWN
#define WGM_DOWN 8
#endif
#ifndef DEPH9
#define DEPH9 1
#endif
#ifndef STAG_TICKS
#define STAG_TICKS 0
#endif
#ifndef STAG_MASK
#define STAG_MASK 0
#endif
#define STAGGER_P(k) do { if ((STAG_MASK >> (k)) & 1) STAGGER(); } while (0)
#define STAGGER() do { const unsigned long long t0_ = __builtin_amdgcn_s_memrealtime(); const unsigned long long dl_ = (unsigned long long)xb_xcc_id() * STAG_TICKS; while (__builtin_amdgcn_s_memrealtime() - t0_ < dl_) __builtin_amdgcn_s_sleep(8); } while (0)
#define SEAM(k) do { if (IN(k) && IN((k) + 1)) { XcdBarrier bar; bar.bar = (unsigned*)(ws + WS_CTL) + CW_BAR; bar.x = xb_xcc_id(); bar.st = F.MISC + 8; xcd_barrier(bar, F.wave); } } while (0)
    LAS unsigned char* ring = F.lds;

    if (IN(0)) for (int rep_ = 0; rep_ < NREP(0); ++rep_) { FRESH(); p0_prologue(F, ap); SEAM(0); }
#ifdef EXTRA_SEAMS
    for (int xs_ = 0; xs_ < EXTRA_SEAMS; ++xs_) { FRESH(); SEAM(0); }
#endif
    if (IN(1)) for (int rep_ = 0; rep_ < NREP(1); ++rep_) {
        FRESH();
        { pg8::Gemm g{(const pg8::bf16_t*)(ws + WS_H), (const pg8::bf16_t*)(ws + WS_WIN), M, NB16, D}; pg8::StaticOrder S; S.init(M, NB16, F.G, F.blk);
          pg8::EpiU E{(pg8::bf16_t*)(ws + WS_U), LDU, 0, 1.f, GATE_FP8 != 0};
          STAGGER_P(1);
          pg8::gemm_phase<pg8::EpiU, pg8::StaticOrder, true, true>(ring, g, S, E, F.wave); }
#if GATE_FP8
        { FRESH();
          pg8::Gemm g{(const pg8::bf16_t*)(ws + WS_H8), (const pg8::bf16_t*)(ws + WS_WG8), M, NG8, D / 2};
          pg8::EpiU E{(pg8::bf16_t*)(ws + WS_U), LDU, 44, 1.f / 64.f, false};
          if (F.G == 256) { pg8::LateOrder S; S.init2(M, NG8, F.G, F.blk, 64, 2);
              pg8::gemm_phase<pg8::EpiU, pg8::LateOrder, true, true, true>(ring, g, S, E, F.wave); }
          else { pg8::StaticOrder S; S.init(M, NG8, F.G, F.blk); pg8::gemm_phase<pg8::EpiU, pg8::StaticOrder, true, true, true>(ring, g, S, E, F.wave); } }
#endif
        SEAM(1);
    }
    if (IN(2)) for (int rep_ = 0; rep_ < NREP(2); ++rep_) { FRESH(); p2_im2col(F, ap); SEAM(2); }
    if (IN(3)) for (int rep_ = 0; rep_ < NREP(3); ++rep_) {
        FRESH();
        pg8::Gemm g{(const pg8::bf16_t*)(ws + WS_ACMP), (const pg8::bf16_t*)(ws + WS_W1C), 8192, 256, 4096}; pg8::StaticOrder S; S.init(8192, 256, F.G, F.blk);
        pg8::EpiAct<1> E{(pg8::bf16_t*)(ws + WS_HC), 256};
        pg8::gemm_phase<pg8::EpiAct<1>, pg8::StaticOrder, true, true, false, true>(ring, g, S, E, F.wave);
        VM_WAIT(); __syncthreads();
        { FRESH();
          pg8::Gemm g2{(const pg8::bf16_t*)(ws + WS_HC), (const pg8::bf16_t*)(ws + WS_W2B), 8192, 256, 256}; pg8::StaticOrder S2; S2.init(8192, 256, F.G, F.blk);
          pg8::EpiAct<0> E2{(pg8::bf16_t*)(ws + WS_OC), 256};
          pg8::gemm_phase<pg8::EpiAct<0>, pg8::StaticOrder, true, true>(ring, g2, S2, E2, F.wave); }
#if GLA_IMPL == 2
        if (F.blk >= 32 && F.G > 32) { FRESH(); gla_pre_items(F, ap, F.blk - 32, F.G - 32);
            if (P0_DEFER) p0_prologue(F, ap, false, (F.blk - 32) * NWAVES + F.wave, (F.G - 32) * NWAVES); }
#endif
        SEAM(3);
    }
#if defined(NSA_CHECK)
    if (IN(5)) {
        { FRESH(); const int nG = 64; if (F.blk < nG) gla_chain(F, ap, F.blk); else { LAS float* wl = (LAS float*)F.lds + F.wave * 2048; const int nw = (F.G - nG) * NWAVES; for (int it = (F.blk - nG) * NWAVES + F.wave; it < BATCH * NSA_G * SEQ; it += nw) nsa_item(F, ap, it, wl); }
          XcdBarrier bar; bar.bar = (unsigned*)(ws + WS_CTL) + CW_BAR; bar.x = xb_xcc_id(); bar.st = F.MISC + 8; xcd_barrier(bar, F.wave); }
        { FRESH(); nsa_wg_all(F, ap, F.blk, F.G, WS_R2 + 192 * MiB);
          XcdBarrier bar; bar.bar = (unsigned*)(ws + WS_CTL) + CW_BAR; bar.x = xb_xcc_id(); bar.st = F.MISC + 8; xcd_barrier(bar, F.wave); }
        { FRESH(); const bf16* a = (const bf16*)(ws + WS_ONSA); const bf16* c = (const bf16*)(ws + WS_R2 + 192 * MiB); float num = 0.f, den = 0.f;
          for (size_t i = (size_t)F.blk * 512 + F.tid; i < (size_t)M * 2048; i += (size_t)F.G * 512) { const float x = __uint_as_float((unsigned)a[i] << 16), y = __uint_as_float((unsigned)c[i] << 16); num += (x - y) * (x - y); den += x * x; }
          num = wave_sum(num); den = wave_sum(den); float* cw = (float*)(ws + WS_CTL) + 2048; if (F.lane == 0) { atomicAdd(cw, num); atomicAdd(cw + 64, den); }
          SEAM(5); } }
#elif defined(GLA_CHECK)
    if (IN(5)) {
        { FRESH(); if (F.blk < 64) gla_chain(F, ap, F.blk); else if (F.blk < 128) gla_chain_mfma(F, ap, F.blk - 64, WS_R2 + 192 * MiB); else nsa_wg_all(F, ap, F.blk - 128, F.G - 128, WS_ONSA);
          XcdBarrier bar; bar.bar = (unsigned*)(ws + WS_CTL) + CW_BAR; bar.x = xb_xcc_id(); bar.st = F.MISC + 8; xcd_barrier(bar, F.wave); }
        { FRESH(); const bf16* a = (const bf16*)(ws + WS_OGLA); const bf16* c = (const bf16*)(ws + WS_R2 + 192 * MiB); float num = 0.f, den = 0.f;
          for (size_t i = (size_t)F.blk * 512 + F.tid; i < (size_t)M * 2048; i += (size_t)F.G * 512) { const float x = __uint_as_float((unsigned)a[i] << 16), y = __uint_as_float((unsigned)c[i] << 16); num += (x - y) * (x - y); den += x * x; }
          num = wave_sum(num); den = wave_sum(den); float* cw = (float*)(ws + WS_CTL) + 2048; if (F.lane == 0) { atomicAdd(cw, num); atomicAdd(cw + 64, den); }
          SEAM(5); } }
#else
    if (IN(5)) for (int rep_ = 0; rep_ < NREP(5); ++rep_) { FRESH(); p5_mixers(F, ap, rep_); SEAM(5); }
#endif
    if (IN(6)) for (int rep_ = 0; rep_ < NREP(6); ++rep_) {
        { FRESH();
          pg8::Gemm g{(const pg8::bf16_t*)(ws + WS_OGLA), (const pg8::bf16_t*)(ws + WS_WGLA), M, D, 2048, (const pg8::bf16_t*)(ws + WS_ONSA), (const pg8::bf16_t*)(ws + WS_WNSA)};
          pg8::ChainOrder S; S.init(M, D, F.G, F.blk);
          pg8::EpiMixC E{(pg8::bf16_t*)(ws + WS_MIX), D, (const pg8::bf16_t*)(ws + WS_U) + U_MG, (const pg8::bf16_t*)(ws + WS_U) + U_MN, LDU};
          STAGGER_P(6);
          pg8::gemm_phase<pg8::EpiMixC, pg8::ChainOrder, true, true>(ring, g, S, E, F.wave);
          SEAM(6); }
    }
    if (IN(7)) for (int rep_ = 0; rep_ < NREP(7); ++rep_) {
        FRESH();
        pg8::Gemm g{(const pg8::bf16_t*)(ws + WS_MIX), (const pg8::bf16_t*)(ws + WS_WOUT), M, D, D}; pg8::StaticOrder S; S.init(M, D, F.G, F.blk);
        pg8::EpiResB<false> E{ap->in[0], (pg8::bf16_t*)(ws + WS_H2), D, (float*)(ws + WS_RS)};
        STAGGER_P(7);
        pg8::gemm_phase<pg8::EpiResB<false>, pg8::StaticOrder, true, true>(ring, g, S, E, F.wave);
        SEAM(7);
    }
    if (IN(8)) for (int rep_ = 0; rep_ < NREP(8); ++rep_) {
        FRESH();
        const int gw = F.blk * NWAVES + F.wave, NGW = F.G * NWAVES; LAS float* scr = (LAS float*)(F.lds + F.wave * 16384);
        bf16* H2 = (bf16*)(ws + WS_H2); bf16* WdT = (bf16*)(ws + WS_WDOWN); const float* x1 = ap->out;
#if !DEPH9
        { const float* Wd = ap->in[18]; const int lane_ = F.lane;
          auto dec = [&](int r) -> TD { TD d; const int nblk = D / 32; int kb, nb; TR_MAP(r, nblk, kb, nb); d.W = Wd; d.WT = (unsigned char*)WdT; d.K = FF; d.ldw = D; d.drow = 32 * nb; d.k0 = 64 * kb; d.scol = 32 * nb + (lane_ & 31); d.f8 = 0; d.rs = nullptr; return d; };
          transpose_stream(F, dec, (FF / 64) * (D / 32), scr, gw, NGW); }
#endif
        { const float* RS = (const float*)(ws + WS_RS); float* RS2 = (float*)(ws + WS_RS2);
          for (int m = gw; m < M; m += NGW) { const float t = wave_sum(RS[(size_t)m * 64 + F.lane]); if (F.lane == 0) RS2[m] = 1.f / (t * (1.f / D) + NORM_EPS); } }
        SEAM(8);
    }
    if (IN(9)) for (int rep_ = 0; rep_ < NREP(9); ++rep_) {
        FRESH();
        pg8::Gemm g{(const pg8::bf16_t*)(ws + WS_H2), (const pg8::bf16_t*)(ws + WS_WUP), M, FF, D}; pg8::StaticOrder S; S.init(M, FF, F.G, F.blk, WGM_UP);
        pg8::EpiRelu2R E{(pg8::bf16_t*)(ws + WS_U), FF, (const float*)(ws + WS_RS2)};
        STAGGER_P(9);
#if DEPH9
        const bool grpA = (F.G % 8 == 0) ? ((F.blk & 7) < 4) : true; const int nhalf = (F.G % 8 == 0) ? 2 : 1;
        const int gidx = (F.G % 8 == 0) ? ((F.blk >> 3) * 4 + (F.blk & 3)) : F.blk, gcnt = (F.G % 8 == 0) ? F.G / 2 : F.G;
        const int NIT9 = (FF / 64) * (D / 32);
#define DEPH9_COPY(lo_, hi_) do { FRESH(); const float* Wd = ap->in[18]; bf16* WdT = (bf16*)(ws + WS_WDOWN); const int lane_ = F.lane; LAS float* scr = (LAS float*)(F.lds + F.wave * 16384); const int lo9 = (lo_); \
          auto dec = [&](int r0) -> TD { TD d; const int r = r0 + lo9; const int nblk = D / 32; int kb, nb; TR_MAP(r, nblk, kb, nb); d.W = Wd; d.WT = (unsigned char*)WdT; d.K = FF; d.ldw = D; d.drow = 32 * nb; d.k0 = 64 * kb; d.scol = 32 * nb + (lane_ & 31); d.f8 = 0; d.rs = nullptr; return d; }; \
          transpose_stream(F, dec, (hi_) - (lo_), scr, gidx * NWAVES + F.wave, gcnt * NWAVES); LDS_WAIT(); __syncthreads(); } while (0)
        if (grpA) DEPH9_COPY(0, NIT9 / nhalf);
#endif
        pg8::gemm_phase<pg8::EpiRelu2R, pg8::StaticOrder, true, true>(ring, g, S, E, F.wave);
#if DEPH9
        if (!grpA) { VM_WAIT(); __syncthreads(); DEPH9_COPY(NIT9 / 2, NIT9); }
#endif
        SEAM(9);
    }
    if (IN(10)) {
        FRESH();
        pg8::Gemm g{(const pg8::bf16_t*)(ws + WS_U), (const pg8::bf16_t*)(ws + WS_WDOWN), M, D, FF}; pg8::StaticOrder S; S.init(M, D, F.G, F.blk, WGM_DOWN);
        pg8::EpiResB<true> E{nullptr, (pg8::bf16_t*)(ws + WS_H2), D, (float*)(ws + WS_RS)};
        STAGGER_P(10);
        pg8::gemm_phase<pg8::EpiResB<true>, pg8::StaticOrder, true, true>(ring, g, S, E, F.wave);
        SEAM(10);
    }
    if (IN(11)) {
        FRESH();
        const int gw = F.blk * NWAVES + F.wave, NGW = F.G * NWAVES; float* xo = ap->out;
        { const bf16* X2 = (const bf16*)(ws + WS_H2); const float* RS = (const float*)(ws + WS_RS); const float* gf = ap->in[19];
          f32x4 gq[8][2]; { const GAS f32x4* gr = (const GAS f32x4*)gf + 2 * F.lane;
#pragma unroll
            for (int j = 0; j < 8; ++j) { gq[j][0] = gr[128 * j]; gq[j][1] = gr[128 * j + 1]; } }
          v4u wv[8]; float rsv = 0.f;
          if (gw < M) { const GAS v4u* xr = (const GAS v4u*)(X2 + (size_t)gw * D) + F.lane; rsv = RS[(size_t)gw * 64 + F.lane];
#pragma unroll
            for (int j = 0; j < 8; ++j) wv[j] = xr[64 * j]; }
          for (int m = gw; m < M; m += NGW) { v4u wn[8]; float rsn = 0.f; const bool has = m + NGW < M;
              if (has) { const GAS v4u* xr = (const GAS v4u*)(X2 + (size_t)(m + NGW) * D) + F.lane; rsn = RS[(size_t)(m + NGW) * 64 + F.lane];
#pragma unroll
                  for (int j = 0; j < 8; ++j) wn[j] = xr[64 * j]; }
              const float rstd = 1.f / sqrtf(wave_sum(rsv) * (1.f / D) + NORM_EPS);
              GAS f32x4* orow = (GAS f32x4*)(xo + (size_t)m * D) + 2 * F.lane;
#pragma unroll
              for (int j = 0; j < 8; ++j) { const v4u w = wv[j]; const f32x4 g0 = gq[j][0], g1 = gq[j][1];
                  orow[128 * j] = (f32x4){bfl(w.x) * rstd * g0.x, bfh(w.x) * rstd * g0.y, bfl(w.y) * rstd * g0.z, bfh(w.y) * rstd * g0.w};
                  orow[128 * j + 1] = (f32x4){bfl(w.z) * rstd * g1.x, bfh(w.z) * rstd * g1.y, bfl(w.w) * rstd * g1.z, bfh(w.w) * rstd * g1.w}; }
              if (has) { rsv = rsn;
#pragma unroll
                  for (int j = 0; j < 8; ++j) wv[j] = wn[j]; } } }
#if defined(NSA_CHECK) || defined(GLA_CHECK)
        { const float* cw = (const float*)(ws + WS_CTL) + 2048; const float e = sqrtf(cw[0] / cw[64]); const float sc = 1.f + CHECK_AMP * e;
          for (int m = gw; m < M; m += NGW) { GAS f32x4* xr = (GAS f32x4*)(xo + (size_t)m * D) + F.lane; for (int j = 0; j < 16; ++j) xr[64 * j] = xr[64 * j] * sc; } }
#endif
    }
#undef IN
#undef SEAM
#undef FRESH
}

extern "C" void kernel_launch(void* const* d_in, const int* in_sizes, int n_in, void* d_out, int out_size, void* d_ws, size_t ws_size, hipStream_t stream) {
    static int grid = 0;
    if (grid == 0) {
        if (n_in != 20 || in_sizes[0] != M * D || out_size != M * D || ws_size < WS_END) { fprintf(stderr, "kernel_launch: unexpected shapes (n_in %d, in0 %d, out %d, ws %zu); nothing launched\n", n_in, n_in > 0 ? in_sizes[0] : -1, out_size, ws_size); grid = -1; return; }
        int dev = 0, cus = 0, per_cu = 0;
        if (hipGetDevice(&dev) != hipSuccess || hipDeviceGetAttribute(&cus, hipDeviceAttributeMultiprocessorCount, dev) != hipSuccess) { grid = -1; return; }
        if (hipFuncSetAttribute((const void*)hybrid_fwd, hipFuncAttributeMaxDynamicSharedMemorySize, LDS_BYTES) != hipSuccess) { fprintf(stderr, "kernel_launch: hipFuncSetAttribute failed\n"); grid = -1; return; }
        if (hipOccupancyMaxActiveBlocksPerMultiprocessor(&per_cu, (const void*)hybrid_fwd, NWAVES * 64, LDS_BYTES) != hipSuccess || per_cu < 1) { fprintf(stderr, "kernel_launch: occupancy query says %d blocks per CU\n", per_cu); }
        (void)hipGetLastError();
        grid = cus;
    }
    if (grid < 0) return;
    if (hipMemsetAsync((char*)d_ws + WS_CTL, 0, CTL_ZERO_BYTES, stream) != hipSuccess) return;
    Args a{};
    for (int i = 0; i < 20; ++i) a.in[i] = (const float*)d_in[i];
    a.out = (float*)d_out; a.ws = (unsigned char*)d_ws;
    if (N_LAUNCHES == 1) { a.ph_lo = 0; a.ph_hi = NPHASE; hipLaunchKernelGGL(hybrid_fwd, dim3(grid), dim3(NWAVES * 64), LDS_BYTES, stream, a); }
    else for (int p = 0; p < NPHASE; ++p) { a.ph_lo = p; a.ph_hi = p + 1; hipLaunchKernelGGL(hybrid_fwd, dim3(grid), dim3(NWAVES * 64), LDS_BYTES, stream, a); }
}
```

```cpp
#include <hip/hip_runtime.h>
#include <cstdio>
#include <cstdint>
#ifndef MK_N_LAUNCHES
#define MK_N_LAUNCHES 1
#endif
#ifndef NSA_SB
#define NSA_SB()
#endif
namespace pg8 {
#define PG8_LAS __attribute__((address_space(3)))
typedef unsigned short bf16_t;
typedef short bf16x8 __attribute__((ext_vector_type(8)));
typedef float f32x4 __attribute__((ext_vector_type(4)));
typedef unsigned u32x4 __attribute__((ext_vector_type(4)));
constexpr int BM = 256, BK = 64, HALF = 128, HTB = HALF * BK * 2  , STAGE_BYTES = 8 * HTB, NXCD = 8, WGM = 8;

__host__ __device__ __forceinline__ int lds_byte(int r, int c) { const int st = (r >> 4) * 2 + (c >> 5), rr = r & 15, cc = c & 31, ob = rr * 64 + cc * 2; return st * 1024 + (ob ^ (((ob >> 9) & 1) << 5)); }
__host__ __device__ __forceinline__ void stage_rc(int b, int& R, int& C) { const int st = b / 1024, sb = b % 1024, swz = sb ^ (((sb >> 9) & 1) << 5); R = (st >> 1) * 16 + swz / 64; C = (st & 1) * 32 + (swz % 64) / 2; }
__host__ __device__ __forceinline__ int perm32(int rho) { const int n = rho >> 4, i = rho & 15; return 8 * (i >> 2) + 4 * n + (i & 3); }

struct Unit { int pm, pn, part; };
struct Gemm { const bf16_t* A; const bf16_t* Bt; int M, N, K; const bf16_t* A2; const bf16_t* Bt2; };

struct StaticOrder {
    int nM, nN, nwg, G, c, wgm;
    __host__ __device__ void init(int M, int N, int G_, int c_, int wgm_ = WGM) { nM = M / BM; nN = N / BM; nwg = nM * nN; G = G_; c = c_; wgm = wgm_; }
    __host__ __device__ bool next(int i, Unit& u) const {
        const long L = (long)i * G + c; if (L >= nwg) return false;
        int wgid = (int)L; { const int q = nwg / NXCD, r = nwg % NXCD, xcd = wgid % NXCD, off = wgid / NXCD; wgid = (xcd < r ? xcd * (q + 1) : r * (q + 1) + (xcd - r) * q) + off; }
        const int nig = wgm * nN, gid = wgid / nig, fm = gid * wgm, gsz = (nM - fm) < wgm ? (nM - fm) : wgm;
        u.pm = fm + ((wgid % nig) % gsz); u.pn = (wgid % nig) / gsz; u.part = 0; return true;
    }
    __device__ __forceinline__ void a_ready(const Unit&) const {}
    __device__ __forceinline__ void done(const Unit&) const {}
};
struct LateOrder : StaticOrder {
    int nlate, cut, nfull;
    __host__ __device__ void init2(int M, int N, int G_, int c_, int nlate_, int cut_) { init(M, N, G_, c_); nlate = nlate_; cut = cut_; nfull = nwg / G_; }
    __host__ __device__ bool next(int i, Unit& u) const {
        long L;
        if (c < nlate) { if (i >= nfull - cut) return false; L = (long)i * G + c; }
        else if (i < nfull) L = (long)i * G + c;
        else { const int e = c - nlate; if (i > nfull || e >= nlate * cut) return false; L = (long)(nfull - cut + e / nlate) * G + (e % nlate); }
        int wgid = (int)L; { const int q = nwg / NXCD, r = nwg % NXCD, xcd = wgid % NXCD, off = wgid / NXCD; wgid = (xcd < r ? xcd * (q + 1) : r * (q + 1) + (xcd - r) * q) + off; }
        const int nig = wgm * nN, gid = wgid / nig, fm = gid * wgm, gsz = (nM - fm) < wgm ? (nM - fm) : wgm;
        u.pm = fm + ((wgid % nig) % gsz); u.pn = (wgid % nig) / gsz; u.part = 0; return true;
    }
};
struct ChainOrder : StaticOrder {
    __host__ __device__ bool next(int i, Unit& u) const { if (!StaticOrder::next(i >> 1, u)) return false; u.part = i & 1; return true; }
};


__device__ __forceinline__ unsigned cvt_pk_bf16(float lo, float hi) { unsigned r; asm volatile("v_cvt_pk_bf16_f32 %0, %1, %2" : "=v"(r) : "v"(lo), "v"(hi)); return r; }
typedef float f32x2 __attribute__((ext_vector_type(2)));
__device__ __forceinline__ float sigmoid_f(float x) { return __builtin_amdgcn_rcpf(1.0f + __expf(-x)); }
__device__ __forceinline__ float bf_lo(unsigned w) { return __uint_as_float(w << 16); }
__device__ __forceinline__ float bf_hi(unsigned w) { return __uint_as_float(w & 0xffff0000u); }

struct EpiU {
    static constexpr bool PERM = true, AFTER_DRAIN = false, CHAIN = false;
    bf16_t* O; int ldc; int pn_off; float scl; bool remap;
    __device__ __forceinline__ void operator()(const f32x4 (&acc)[2][2][4][2], const Unit& u, int wr, int wc, int fr, int fq) const {
        const int ct = (remap && u.pn == 44) ? 76 : u.pn + pn_off;
        const int row0 = u.pm * BM + wr * 64 + fr, col0 = ct * BM + wc * 32 + 8 * fq;
        const int mode = (ct >= 16 && ct < 24) ? 1 : ((ct >= 44 && ct < 76) ? 2 : (ct == 76 ? 3 : 0));
#pragma unroll
        for (int ai = 0; ai < 2; ++ai)
#pragma unroll
            for (int m = 0; m < 4; ++m) { bf16_t* rowp = O + (size_t)(row0 + ai * HALF + m * 16) * ldc + col0;
#pragma unroll
                for (int bj = 0; bj < 2; ++bj) { f32x4 v0 = acc[ai][bj][m][0] * scl, v1 = acc[ai][bj][m][1] * scl;
                    if (mode == 1) {
#pragma unroll
                        for (int j = 0; j < 4; ++j) { v0[j] = v0[j] * sigmoid_f(v0[j]); v1[j] = v1[j] * sigmoid_f(v1[j]); } }
                    else if (mode == 2 || (mode == 3 && (bj * HALF + wc * 32 + 8 * fq) >= 16)) {
#pragma unroll
                        for (int j = 0; j < 4; ++j) { v0[j] = sigmoid_f(v0[j]); v1[j] = sigmoid_f(v1[j]); } }
                    u32x4 w; w.x = cvt_pk_bf16(v0[0], v0[1]); w.y = cvt_pk_bf16(v0[2], v0[3]); w.z = cvt_pk_bf16(v1[0], v1[1]); w.w = cvt_pk_bf16(v1[2], v1[3]);
                    *(u32x4*)(rowp + bj * HALF) = w; } }
    }
};
template <int ACT> struct EpiAct {
    static constexpr bool PERM = true, AFTER_DRAIN = false, CHAIN = false;
    bf16_t* O; int ldc;
    __device__ __forceinline__ void operator()(const f32x4 (&acc)[2][2][4][2], const Unit& u, int wr, int wc, int fr, int fq) const {
        const int row0 = u.pm * BM + wr * 64 + fr, col0 = u.pn * BM + wc * 32 + 8 * fq;
#pragma unroll
        for (int ai = 0; ai < 2; ++ai)
#pragma unroll
            for (int m = 0; m < 4; ++m) { bf16_t* rowp = O + (size_t)(row0 + ai * HALF + m * 16) * ldc + col0;
#pragma unroll
                for (int bj = 0; bj < 2; ++bj) { f32x4 v0 = acc[ai][bj][m][0], v1 = acc[ai][bj][m][1];
                    if (ACT >= 1) {
#pragma unroll
                        for (int j = 0; j < 4; ++j) { v0[j] = fmaxf(v0[j], 0.f); v1[j] = fmaxf(v1[j], 0.f); if (ACT == 2) { v0[j] *= v0[j]; v1[j] *= v1[j]; } } }
                    u32x4 w; w.x = cvt_pk_bf16(v0[0], v0[1]); w.y = cvt_pk_bf16(v0[2], v0[3]); w.z = cvt_pk_bf16(v1[0], v1[1]); w.w = cvt_pk_bf16(v1[2], v1[3]);
                    *(u32x4*)(rowp + bj * HALF) = w; } }
    }
};
template <bool ACCUM> struct EpiMix {
    static constexpr bool PERM = true, AFTER_DRAIN = false, CHAIN = false;
    bf16_t* O; int ldc; const bf16_t* Gt; int ldg;
    __device__ __forceinline__ void operator()(const f32x4 (&acc)[2][2][4][2], const Unit& u, int wr, int wc, int fr, int fq) const {
        const int row0 = u.pm * BM + wr * 64 + fr, col0 = u.pn * BM + wc * 32 + 8 * fq;
#pragma unroll
        for (int ai = 0; ai < 2; ++ai)
#pragma unroll
            for (int m = 0; m < 4; ++m) { const size_t r = (size_t)(row0 + ai * HALF + m * 16); bf16_t* rowp = O + r * ldc + col0; const bf16_t* gp = Gt + r * ldg + col0;
#pragma unroll
                for (int bj = 0; bj < 2; ++bj) { f32x4 v0 = acc[ai][bj][m][0], v1 = acc[ai][bj][m][1];
                    const u32x4 gw = *(const u32x4*)(gp + bj * HALF);
                    v0[0] *= bf_lo(gw.x); v0[1] *= bf_hi(gw.x); v0[2] *= bf_lo(gw.y); v0[3] *= bf_hi(gw.y); v1[0] *= bf_lo(gw.z); v1[1] *= bf_hi(gw.z); v1[2] *= bf_lo(gw.w); v1[3] *= bf_hi(gw.w);
                    if (ACCUM) { const u32x4 ow = *(const u32x4*)(rowp + bj * HALF);
                        v0[0] += bf_lo(ow.x); v0[1] += bf_hi(ow.x); v0[2] += bf_lo(ow.y); v0[3] += bf_hi(ow.y); v1[0] += bf_lo(ow.z); v1[1] += bf_hi(ow.z); v1[2] += bf_lo(ow.w); v1[3] += bf_hi(ow.w); }
                    u32x4 w; w.x = cvt_pk_bf16(v0[0], v0[1]); w.y = cvt_pk_bf16(v0[2], v0[3]); w.z = cvt_pk_bf16(v1[0], v1[1]); w.w = cvt_pk_bf16(v1[2], v1[3]);
                    *(u32x4*)(rowp + bj * HALF) = w; } }
    }
};
struct EpiMixC {
    static constexpr bool PERM = true, AFTER_DRAIN = false, CHAIN = true;
    bf16_t* O; int ldc; const bf16_t* G1; const bf16_t* G2; int ldg;
    __device__ __forceinline__ void mid(f32x4 (&acc)[2][2][4][2], const Unit& u, int wr, int wc, int fr, int fq) const {
        const int row0 = u.pm * BM + wr * 64 + fr, col0 = u.pn * BM + wc * 32 + 8 * fq;
#pragma unroll
        for (int ai = 0; ai < 2; ++ai) { u32x4 av[4][2], bv[4][2];
#pragma unroll
            for (int m = 0; m < 4; ++m)
#pragma unroll
                for (int bj = 0; bj < 2; ++bj) { const size_t r = (size_t)(row0 + ai * HALF + m * 16); av[m][bj] = *(const u32x4*)(G1 + r * ldg + col0 + bj * HALF); bv[m][bj] = *(const u32x4*)(G2 + r * ldg + col0 + bj * HALF); }
            __builtin_amdgcn_sched_barrier(0);
#pragma unroll
            for (int m = 0; m < 4; ++m)
#pragma unroll
                for (int bj = 0; bj < 2; ++bj) { const u32x4 a = av[m][bj], b = bv[m][bj];
                    f32x4& v0 = acc[ai][bj][m][0]; f32x4& v1 = acc[ai][bj][m][1];
                    v0[0] *= bf_lo(a.x) * __builtin_amdgcn_rcpf(fmaxf(bf_lo(b.x), 1e-30f)); v0[1] *= bf_hi(a.x) * __builtin_amdgcn_rcpf(fmaxf(bf_hi(b.x), 1e-30f)); v0[2] *= bf_lo(a.y) * __builtin_amdgcn_rcpf(fmaxf(bf_lo(b.y), 1e-30f)); v0[3] *= bf_hi(a.y) * __builtin_amdgcn_rcpf(fmaxf(bf_hi(b.y), 1e-30f));
                    v1[0] *= bf_lo(a.z) * __builtin_amdgcn_rcpf(fmaxf(bf_lo(b.z), 1e-30f)); v1[1] *= bf_hi(a.z) * __builtin_amdgcn_rcpf(fmaxf(bf_hi(b.z), 1e-30f)); v1[2] *= bf_lo(a.w) * __builtin_amdgcn_rcpf(fmaxf(bf_lo(b.w), 1e-30f)); v1[3] *= bf_hi(a.w) * __builtin_amdgcn_rcpf(fmaxf(bf_hi(b.w), 1e-30f)); }
            __builtin_amdgcn_sched_barrier(0); }
    }
    __device__ __forceinline__ void operator()(const f32x4 (&acc)[2][2][4][2], const Unit& u, int wr, int wc, int fr, int fq) const {
        const int row0 = u.pm * BM + wr * 64 + fr, col0 = u.pn * BM + wc * 32 + 8 * fq;
        u32x4 gv[2][4][2];
#pragma unroll
        for (int ai = 0; ai < 2; ++ai)
#pragma unroll
            for (int m = 0; m < 4; ++m)
#pragma unroll
                for (int bj = 0; bj < 2; ++bj) gv[ai][m][bj] = *(const u32x4*)(G2 + (size_t)(row0 + ai * HALF + m * 16) * ldg + col0 + bj * HALF);
        __builtin_amdgcn_sched_barrier(0);
#pragma unroll
        for (int ai = 0; ai < 2; ++ai)
#pragma unroll
            for (int m = 0; m < 4; ++m) { const size_t r = (size_t)(row0 + ai * HALF + m * 16); bf16_t* rowp = O + r * ldc + col0;
#pragma unroll
                for (int bj = 0; bj < 2; ++bj) { f32x4 v0 = acc[ai][bj][m][0], v1 = acc[ai][bj][m][1]; const u32x4 gw = gv[ai][m][bj];
                    v0[0] *= bf_lo(gw.x); v0[1] *= bf_hi(gw.x); v0[2] *= bf_lo(gw.y); v0[3] *= bf_hi(gw.y); v1[0] *= bf_lo(gw.z); v1[1] *= bf_hi(gw.z); v1[2] *= bf_lo(gw.w); v1[3] *= bf_hi(gw.w);
                    u32x4 w; w.x = cvt_pk_bf16(v0[0], v0[1]); w.y = cvt_pk_bf16(v0[2], v0[3]); w.z = cvt_pk_bf16(v1[0], v1[1]); w.w = cvt_pk_bf16(v1[2], v1[3]);
                    *(u32x4*)(rowp + bj * HALF) = w; } }
    }
};
struct EpiRes {
    static constexpr bool PERM = false, AFTER_DRAIN = false, CHAIN = false;
    const float* base; float* out; int ldc;
    __device__ __forceinline__ void operator()(const f32x4 (&acc)[2][2][4][2], const Unit& u, int wr, int wc, int fr, int fq) const {
        const int row0 = u.pm * BM + wr * 64 + fr, col0 = u.pn * BM + wc * 32 + 4 * fq;
#pragma unroll
        for (int ai = 0; ai < 2; ++ai)
#pragma unroll
            for (int m = 0; m < 4; ++m) { const size_t off = (size_t)(row0 + ai * HALF + m * 16) * ldc + col0;
#pragma unroll
                for (int bj = 0; bj < 2; ++bj)
#pragma unroll
                    for (int n = 0; n < 2; ++n) { const f32x4 bs = *(const f32x4*)(base + off + bj * HALF + n * 16); *(f32x4*)(out + off + bj * HALF + n * 16) = bs + acc[ai][bj][m][n]; } }
    }
};
struct EpiResN {
    static constexpr bool PERM = false, AFTER_DRAIN = false, CHAIN = false;
    const float* base; float* out; int ldc; const float* gain; bf16_t* XB; float* RS;
    __device__ __forceinline__ void operator()(const f32x4 (&acc)[2][2][4][2], const Unit& u, int wr, int wc, int fr, int fq) const {
        const int row0 = u.pm * BM + wr * 64 + fr, col0 = u.pn * BM + wc * 32 + 4 * fq;
        f32x4 gv[2][2];
#pragma unroll
        for (int bj = 0; bj < 2; ++bj)
#pragma unroll
            for (int n = 0; n < 2; ++n) gv[bj][n] = *(const f32x4*)(gain + col0 + bj * HALF + n * 16);
#pragma unroll
        for (int ai = 0; ai < 2; ++ai)
#pragma unroll
            for (int m = 0; m < 4; ++m) { const int row = row0 + ai * HALF + m * 16; const size_t off = (size_t)row * ldc + col0; float ss = 0.f;
#pragma unroll
                for (int bj = 0; bj < 2; ++bj)
#pragma unroll
                    for (int n = 0; n < 2; ++n) { const f32x4 bs = *(const f32x4*)(base + off + bj * HALF + n * 16); const f32x4 v = bs + acc[ai][bj][m][n]; *(f32x4*)(out + off + bj * HALF + n * 16) = v;
                        ss += (v[0] * v[0] + v[1] * v[1]) + (v[2] * v[2] + v[3] * v[3]);
                        const f32x4 w = v * gv[bj][n]; unsigned long long pk = (unsigned long long)cvt_pk_bf16(w[0], w[1]) | ((unsigned long long)cvt_pk_bf16(w[2], w[3]) << 32);
                        *(unsigned long long*)(XB + off + bj * HALF + n * 16) = pk; }
                ss += __shfl_xor(ss, 16); ss += __shfl_xor(ss, 32);
                if (fq == 0) RS[(size_t)row * 64 + u.pn * 4 + wc] = ss; }
    }
};
template <bool BASE_BF16> struct EpiResB {
    static constexpr bool PERM = true, AFTER_DRAIN = false, CHAIN = false;
    const float* base; bf16_t* XB; int ldc; float* RS;
    __device__ __forceinline__ void operator()(const f32x4 (&acc)[2][2][4][2], const Unit& u, int wr, int wc, int fr, int fq) const {
        const int row0 = u.pm * BM + wr * 64 + fr, col0 = u.pn * BM + wc * 32 + 8 * fq;
#pragma unroll
        for (int ai = 0; ai < 2; ++ai) {
            u32x4 bw[4][2]; f32x4 bf[4][2][2];
#pragma unroll
            for (int m = 0; m < 4; ++m)
#pragma unroll
                for (int bj = 0; bj < 2; ++bj) { const size_t off = (size_t)(row0 + ai * HALF + m * 16) * ldc + col0 + bj * HALF;
                    if (BASE_BF16) bw[m][bj] = *(const u32x4*)(XB + off); else { bf[m][bj][0] = *(const f32x4*)(base + off); bf[m][bj][1] = *(const f32x4*)(base + off + 4); } }
            __builtin_amdgcn_sched_barrier(0);
#pragma unroll
            for (int m = 0; m < 4; ++m) { const int row = row0 + ai * HALF + m * 16; const size_t off = (size_t)row * ldc + col0; float ss = 0.f;
#pragma unroll
                for (int bj = 0; bj < 2; ++bj) { f32x4 v0 = acc[ai][bj][m][0], v1 = acc[ai][bj][m][1];
                    if (BASE_BF16) { const u32x4 w = bw[m][bj];
                        v0[0] += bf_lo(w.x); v0[1] += bf_hi(w.x); v0[2] += bf_lo(w.y); v0[3] += bf_hi(w.y); v1[0] += bf_lo(w.z); v1[1] += bf_hi(w.z); v1[2] += bf_lo(w.w); v1[3] += bf_hi(w.w); }
                    else { v0 += bf[m][bj][0]; v1 += bf[m][bj][1]; }
                    ss += ((v0[0] * v0[0] + v0[1] * v0[1]) + (v0[2] * v0[2] + v0[3] * v0[3])) + ((v1[0] * v1[0] + v1[1] * v1[1]) + (v1[2] * v1[2] + v1[3] * v1[3]));
                    u32x4 o; o.x = cvt_pk_bf16(v0[0], v0[1]); o.y = cvt_pk_bf16(v0[2], v0[3]); o.z = cvt_pk_bf16(v1[0], v1[1]); o.w = cvt_pk_bf16(v1[2], v1[3]);
                    *(u32x4*)(XB + off + bj * HALF) = o; }
                ss += __shfl_xor(ss, 16); ss += __shfl_xor(ss, 32);
                if (fq == 0) RS[(size_t)row * 64 + u.pn * 4 + wc] = ss; }
            __builtin_amdgcn_sched_barrier(0);
        }
    }
};
struct EpiRelu2R {
    static constexpr bool PERM = true, AFTER_DRAIN = false, CHAIN = false;
    bf16_t* O; int ldc; const float* rs2;
    __device__ __forceinline__ void operator()(const f32x4 (&acc)[2][2][4][2], const Unit& u, int wr, int wc, int fr, int fq) const {
        const int row0 = u.pm * BM + wr * 64 + fr, col0 = u.pn * BM + wc * 32 + 8 * fq;
        float r2v[2][4];
#pragma unroll
        for (int ai = 0; ai < 2; ++ai)
#pragma unroll
            for (int m = 0; m < 4; ++m) r2v[ai][m] = rs2[row0 + ai * HALF + m * 16];
        __builtin_amdgcn_sched_barrier(0);
#pragma unroll
        for (int ai = 0; ai < 2; ++ai)
#pragma unroll
            for (int m = 0; m < 4; ++m) { const int row = row0 + ai * HALF + m * 16; bf16_t* rowp = O + (size_t)row * ldc + col0; const float r2 = r2v[ai][m];
#pragma unroll
                for (int bj = 0; bj < 2; ++bj) { f32x4 v0 = acc[ai][bj][m][0], v1 = acc[ai][bj][m][1];
#pragma unroll
                    for (int j = 0; j < 4; ++j) { v0[j] = fmaxf(v0[j], 0.f); v1[j] = fmaxf(v1[j], 0.f); v0[j] = v0[j] * v0[j] * r2; v1[j] = v1[j] * v1[j] * r2; }
                    u32x4 w; w.x = cvt_pk_bf16(v0[0], v0[1]); w.y = cvt_pk_bf16(v0[2], v0[3]); w.z = cvt_pk_bf16(v1[0], v1[1]); w.w = cvt_pk_bf16(v1[2], v1[3]);
                    *(u32x4*)(rowp + bj * HALF) = w; } }
    }
};


typedef int v8i_t __attribute__((ext_vector_type(8)));
template <class Epi, class Sched, bool ALIGN_EPI = false, bool SP2 = false, bool F8 = false, bool HALFSEL = false>
__device__ __forceinline__ void gemm_phase(PG8_LAS unsigned char* lds, const Gemm g, const Sched& S, const Epi& E, const int wid_in) {
    int lane_; asm volatile("v_mbcnt_lo_u32_b32 %0, -1, 0\n\tv_mbcnt_hi_u32_b32 %0, -1, %0" : "=v"(lane_));
    const int wid = wid_in, lane = lane_, tid = wid * 64 + lane, wr = wid >> 2, wc = wid & 3, fr = lane & 15, fq = lane >> 4;
    const int K = g.K, nt = K / BK;
    unsigned voffA[2], voffB[2];
#pragma unroll
    for (int i = 0; i < 2; ++i) { int R, C; stage_rc(tid * 16 + i * 8192, R, C); const int Rb = Epi::PERM ? ((R & ~31) + perm32(R & 31)) : R;
        voffA[i] = (unsigned)(R * K + C) * 2u; voffB[i] = (unsigned)(Rb * K + C) * 2u; }
    const size_t kstep = (size_t)(BK * 2);
    const size_t hstep = (size_t)HALF * K * 2;
    const size_t tstep = 2 * hstep;
    const unsigned ldsw = (unsigned)wid * 1024u;
    const int aoff = lds_byte(wr * 64 + fr, fq * 8), boff = lds_byte(wc * 32 + fr, fq * 8);
#define PG8_SA(b, h) (((b) * 2 + (h)) * HTB)
#define PG8_SB(b, h) ((4 + (b) * 2 + (h)) * HTB)
#define PG8_STAGE(bufoff, gbase, voff) do { _Pragma("unroll") for (int _i = 0; _i < 2; ++_i) \
        __builtin_amdgcn_global_load_lds((const unsigned*)((const char*)(gbase) + (voff)[_i]), (PG8_LAS unsigned*)(lds + (bufoff) + ldsw + _i * 8192), 16, 0, 0); } while (0)
#define PG8_LDA(dst, b, h) do { _Pragma("unroll") for (int m = 0; m < 4; ++m) { if constexpr (F8) { dst##8[m] = __builtin_bit_cast(v8i_t, __builtin_shufflevector(*(const PG8_LAS bf16x8*)(lds + PG8_SA(b, h) + aoff + m * 2048), *(const PG8_LAS bf16x8*)(lds + PG8_SA(b, h) + aoff + m * 2048 + 1024), 0, 1, 2, 3, 4, 5, 6, 7, 8, 9, 10, 11, 12, 13, 14, 15)); } \
        else { _Pragma("unroll") for (int k = 0; k < 2; ++k) dst[m][k] = *(const PG8_LAS bf16x8*)(lds + PG8_SA(b, h) + aoff + m * 2048 + k * 1024); } } } while (0)
#define PG8_LDB(dst, b, h) do { _Pragma("unroll") for (int n = 0; n < 2; ++n) { if constexpr (F8) { dst##8[n] = __builtin_bit_cast(v8i_t, __builtin_shufflevector(*(const PG8_LAS bf16x8*)(lds + PG8_SB(b, h) + boff + n * 2048), *(const PG8_LAS bf16x8*)(lds + PG8_SB(b, h) + boff + n * 2048 + 1024), 0, 1, 2, 3, 4, 5, 6, 7, 8, 9, 10, 11, 12, 13, 14, 15)); } \
        else { _Pragma("unroll") for (int k = 0; k < 2; ++k) dst[n][k] = *(const PG8_LAS bf16x8*)(lds + PG8_SB(b, h) + boff + n * 2048 + k * 1024); } } } while (0)
#define PG8_MMA(ai, bj, At, Bt) do { if (HALFSEL && !((bjm >> (bj)) & 1)) break; __builtin_amdgcn_s_setprio(1); _Pragma("unroll") for (int m = 0; m < 4; ++m) _Pragma("unroll") for (int n = 0; n < 2; ++n) { \
        if constexpr (F8) { asm volatile("v_mfma_f32_16x16x128_f8f6f4 %0, %1, %2, %0" : "+v"(acc[ai][bj][m][n]) : "v"(Bt##8[n]), "v"(At##8[m])); } \
        else { _Pragma("unroll") for (int k = 0; k < 2; ++k) acc[ai][bj][m][n] = __builtin_amdgcn_mfma_f32_16x16x32_bf16(Bt[n][k], At[m][k], acc[ai][bj][m][n], 0, 0, 0); } } __builtin_amdgcn_s_setprio(0); } while (0)
#define PG8_WAIT_V(n) asm volatile("s_waitcnt vmcnt(" #n ")" ::: "memory")
#define PG8_WAIT_L(n) asm volatile("s_waitcnt lgkmcnt(" #n ")" ::: "memory")
#define PG8_BAR __builtin_amdgcn_s_barrier()
#define PG8_SCHED __builtin_amdgcn_sched_barrier(0)
    Unit cur, nxt; int ui = 0;
    if (!S.next(0, cur)) return;
    f32x4 acc[2][2][4][2];
#pragma unroll
    for (int a = 0; a < 2; ++a)
#pragma unroll
        for (int b = 0; b < 2; ++b)
#pragma unroll
            for (int m = 0; m < 4; ++m)
#pragma unroll
                for (int n = 0; n < 2; ++n) acc[a][b][m][n] = (f32x4){0.f, 0.f, 0.f, 0.f};
    bf16x8 At[4][2], B0[2][2], B1[2][2]; v8i_t At8[4], B08[2], B18[2]; (void)At; (void)B0; (void)B1; (void)At8; (void)B08; (void)B18;
    const char* cA = (const char*)(cur.part ? g.A2 : g.A) + (size_t)cur.pm * tstep; const char* cB = (const char*)(cur.part ? g.Bt2 : g.Bt) + (size_t)cur.pn * tstep;
    S.a_ready(cur);
    if constexpr (SP2) {
        PG8_STAGE(PG8_SB(0, 0), cB, voffB); PG8_STAGE(PG8_SB(0, 1), cB + hstep, voffB); PG8_STAGE(PG8_SA(0, 0), cA, voffA); PG8_STAGE(PG8_SA(0, 1), cA + hstep, voffA);
        if (wr == 1) PG8_BAR;
        PG8_WAIT_V(2); PG8_BAR;
        PG8_STAGE(PG8_SB(1, 0), cB + kstep, voffB); PG8_STAGE(PG8_SA(1, 0), cA + kstep, voffA); PG8_STAGE(PG8_SB(1, 1), cB + hstep + kstep, voffB);
        PG8_WAIT_V(6); PG8_BAR;
    } else {
        PG8_STAGE(PG8_SB(0, 0), cB, voffB); PG8_STAGE(PG8_SA(0, 0), cA, voffA); PG8_STAGE(PG8_SB(0, 1), cB + hstep, voffB); PG8_STAGE(PG8_SA(0, 1), cA + hstep, voffA);
        if (wr == 1) PG8_BAR;
        PG8_WAIT_V(4); PG8_BAR;
        PG8_STAGE(PG8_SB(1, 0), cB + kstep, voffB); PG8_STAGE(PG8_SA(1, 0), cA + kstep, voffA); PG8_STAGE(PG8_SB(1, 1), cB + hstep + kstep, voffB);
        PG8_WAIT_V(6); PG8_BAR;
    }
    for (;;) {
        const int bjm = HALFSEL ? ((2 * cur.pm < g.M / BM) ? 1 : 2) : 3; (void)bjm;
        const bool has_next = S.next(ui + 1, nxt);
        const char* nA = has_next ? (const char*)(nxt.part ? g.A2 : g.A) + (size_t)nxt.pm * tstep : cA; const char* nB = has_next ? (const char*)(nxt.part ? g.Bt2 : g.Bt) + (size_t)nxt.pn * tstep : cB;
        for (int t = 0; t < nt; t += 2) {
            const bool last = (t == nt - 2);
            const char* a1 = cA + (size_t)(t + 1) * kstep;
            const char* a2 = last ? nA : cA + (size_t)(t + 2) * kstep; const char* b2 = last ? nB : cB + (size_t)(t + 2) * kstep;
            const char* a3 = a2 + kstep; const char* b3 = b2 + kstep;
            if (last && has_next) S.a_ready(nxt);
            if constexpr (SP2) {
            PG8_LDB(B0, 0, 0); PG8_LDB(B1, 0, 1); PG8_SCHED; PG8_LDA(At, 0, 0); PG8_STAGE(PG8_SA(1, 1), a1 + hstep, voffA);
            PG8_WAIT_V(8); PG8_WAIT_L(0); PG8_BAR; PG8_MMA(0, 0, At, B0); PG8_MMA(0, 1, At, B1); PG8_BAR; PG8_SCHED;
            PG8_LDA(At, 0, 1); PG8_STAGE(PG8_SB(0, 0), b2, voffB); PG8_STAGE(PG8_SB(0, 1), b2 + hstep, voffB); PG8_STAGE(PG8_SA(0, 0), a2, voffA);
            PG8_WAIT_V(8); PG8_WAIT_L(0); PG8_BAR; PG8_MMA(1, 0, At, B0); PG8_MMA(1, 1, At, B1); PG8_BAR; PG8_SCHED;
            PG8_LDB(B0, 1, 0); PG8_LDB(B1, 1, 1); PG8_SCHED; PG8_LDA(At, 1, 0); PG8_STAGE(PG8_SA(0, 1), a2 + hstep, voffA);
            PG8_WAIT_V(8); PG8_WAIT_L(0); PG8_BAR; PG8_MMA(0, 0, At, B0); PG8_MMA(0, 1, At, B1); PG8_BAR; PG8_SCHED;
            PG8_LDA(At, 1, 1); PG8_STAGE(PG8_SB(1, 0), b3, voffB); PG8_STAGE(PG8_SB(1, 1), b3 + hstep, voffB); PG8_STAGE(PG8_SA(1, 0), a3, voffA);
            PG8_WAIT_V(8); PG8_WAIT_L(0); PG8_BAR; PG8_MMA(1, 0, At, B0); PG8_MMA(1, 1, At, B1); PG8_BAR; PG8_SCHED;
            } else {
            PG8_LDB(B0, 0, 0); PG8_SCHED; PG8_LDA(At, 0, 0); PG8_STAGE(PG8_SA(1, 1), a1 + hstep, voffA);
            PG8_WAIT_L(8); PG8_BAR; PG8_WAIT_L(0); PG8_MMA(0, 0, At, B0); PG8_BAR; PG8_SCHED;
            PG8_LDB(B1, 0, 1); PG8_STAGE(PG8_SB(0, 0), b2, voffB);
            PG8_BAR; PG8_WAIT_L(0); PG8_MMA(0, 1, At, B1); PG8_BAR;
            PG8_LDA(At, 0, 1); PG8_STAGE(PG8_SA(0, 0), a2, voffA);
            PG8_BAR; PG8_WAIT_L(0); PG8_MMA(1, 0, At, B0); PG8_BAR; PG8_SCHED;
            PG8_STAGE(PG8_SB(0, 1), b2 + hstep, voffB);
            PG8_WAIT_V(6); PG8_BAR; PG8_MMA(1, 1, At, B1); PG8_BAR;
            PG8_LDB(B0, 1, 0); PG8_SCHED; PG8_LDA(At, 1, 0); PG8_STAGE(PG8_SA(0, 1), a2 + hstep, voffA);
            PG8_WAIT_L(8); PG8_BAR; PG8_WAIT_L(0); PG8_MMA(0, 0, At, B0); PG8_BAR; PG8_SCHED;
            PG8_LDB(B1, 1, 1); PG8_STAGE(PG8_SB(1, 0), b3, voffB);
            PG8_BAR; PG8_WAIT_L(0); PG8_MMA(0, 1, At, B1); PG8_BAR;
            PG8_LDA(At, 1, 1); PG8_STAGE(PG8_SA(1, 0), a3, voffA);
            PG8_BAR; PG8_WAIT_L(0); PG8_MMA(1, 0, At, B0); PG8_BAR; PG8_SCHED;
            PG8_STAGE(PG8_SB(1, 1), b3 + hstep, voffB);
            PG8_WAIT_V(6); PG8_BAR; PG8_MMA(1, 1, At, B1); PG8_BAR;
            }
        }
        if constexpr (ALIGN_EPI) { if (wr == 0) PG8_BAR; }
        if constexpr (F8) {
            asm volatile("s_nop 15\n\ts_nop 15\n\ts_nop 7" : "+v"(acc[0][0][0][0]), "+v"(acc[0][0][0][1]), "+v"(acc[0][0][1][0]), "+v"(acc[0][0][1][1]), "+v"(acc[0][0][2][0]), "+v"(acc[0][0][2][1]), "+v"(acc[0][0][3][0]), "+v"(acc[0][0][3][1]), "+v"(acc[0][1][0][0]), "+v"(acc[0][1][0][1]), "+v"(acc[0][1][1][0]), "+v"(acc[0][1][1][1]), "+v"(acc[0][1][2][0]), "+v"(acc[0][1][2][1]), "+v"(acc[0][1][3][0]), "+v"(acc[0][1][3][1]));
            asm volatile("s_nop 0" : "+v"(acc[1][0][0][0]), "+v"(acc[1][0][0][1]), "+v"(acc[1][0][1][0]), "+v"(acc[1][0][1][1]), "+v"(acc[1][0][2][0]), "+v"(acc[1][0][2][1]), "+v"(acc[1][0][3][0]), "+v"(acc[1][0][3][1]), "+v"(acc[1][1][0][0]), "+v"(acc[1][1][0][1]), "+v"(acc[1][1][1][0]), "+v"(acc[1][1][1][1]), "+v"(acc[1][1][2][0]), "+v"(acc[1][1][2][1]), "+v"(acc[1][1][3][0]), "+v"(acc[1][1][3][1])); }
        bool keep_acc = false;
        if constexpr (Epi::CHAIN) { if (cur.part == 0) { E.mid(acc, cur, wr, wc, fr, fq); keep_acc = true; } else E(acc, cur, wr, wc, fr, fq); }
        else if constexpr (!Epi::AFTER_DRAIN) { E(acc, cur, wr, wc, fr, fq); S.done(cur); }
        if (!has_next) break;
        if (!keep_acc) {
#pragma unroll
        for (int a = 0; a < 2; ++a)
#pragma unroll
            for (int b = 0; b < 2; ++b)
#pragma unroll
                for (int m = 0; m < 4; ++m)
#pragma unroll
                    for (int n = 0; n < 2; ++n) acc[a][b][m][n] = (f32x4){0.f, 0.f, 0.f, 0.f};
        }
        cur = nxt; cA = nA; cB = nB; ++ui;
        if constexpr (ALIGN_EPI) { if (wr == 1) PG8_BAR; }
    }
    PG8_WAIT_V(0);
    if constexpr (!ALIGN_EPI) { if (wr == 0) PG8_BAR; }
    PG8_BAR;
    if constexpr (Epi::AFTER_DRAIN) { E.fused(acc, cur, wr, wc, fr, fq, lds, wid, lane); S.done(cur); }
#undef PG8_SA
#undef PG8_SB
#undef PG8_STAGE
#undef PG8_LDA
#undef PG8_LDB
#undef PG8_MMA
#undef PG8_WAIT_V
#undef PG8_WAIT_L
#undef PG8_BAR
#undef PG8_SCHED
}
}

constexpr int NWAVES = 8;
constexpr int N_LAUNCHES = MK_N_LAUNCHES;
constexpr int NPHASE = 12;
constexpr int BATCH = 4, SEQ = 4096, M = BATCH * SEQ, D = 4096, FF = 16384;
constexpr int NIN = 19520, LDU = 19712;
constexpr int GLA_H = 16, GLA_DK = 64, GLA_DV = 128;
constexpr int NSA_G = 4, NSA_R = 4, NSA_D = 128;
constexpr float NORM_EPS = 1e-6f;
constexpr int U_GQ = 0, U_GK = 1024, U_GV = 2048, U_GR = 4096, U_NQ = 6144, U_KC = 8192, U_VC = 8704, U_KSL = 9216, U_VSL = 9728, U_KW = 10240, U_VW = 10752,
              U_MG = 11264, U_MN = 15360, U_GA = 19456, U_NG = 19472;
__host__ __device__ __forceinline__ int orig_col(int n) {
    if (n < 4096) return n;
    if (n < 6144) return n - 4096 + 4112;
    if (n < 11264) return n - 6144 + 6160;
    if (n < 19456) return n - 11264 + 11328;
    if (n < 19472) return n - 19456 + 4096;
    if (n < 19520) return n - 19472 + 11280;
    return -1;
}
constexpr size_t MiB = 1u << 20;
constexpr size_t WS_CTL = 0, CTL_ZERO_BYTES = 1 * MiB;
constexpr size_t WS_W1C = 1 * MiB;
constexpr size_t WS_W2B = 3 * MiB;
constexpr size_t WS_HC = 4 * MiB;
constexpr size_t WS_OC = 8 * MiB;
constexpr size_t WS_RS = 12 * MiB;
constexpr size_t WS_RS2 = 3 * MiB + 256 * 1024;
constexpr size_t WS_U = 16 * MiB;
constexpr size_t WS_R2 = 632 * MiB;
constexpr size_t WS_WIN = WS_R2;
constexpr size_t WS_H = WS_R2 + 154 * MiB;
constexpr size_t WS_OGLA = WS_R2;
constexpr size_t WS_ONSA = WS_R2 + 64 * MiB;
constexpr size_t WS_MIX = WS_R2 + 128 * MiB;
constexpr size_t WS_ACMP = WS_R2 + 128 * MiB;
constexpr size_t WS_H2 = WS_R2;
constexpr size_t WS_WDOWN = WS_R2 + 128 * MiB;
constexpr size_t WS_WGLA = 914 * MiB, WS_WNSA = 930 * MiB, WS_WOUT = 946 * MiB, WS_WUP = 978 * MiB, WS_H8 = 1106 * MiB, WS_END = 1170 * MiB;
#ifndef GATE_FP8
#define GATE_FP8 1
#endif
constexpr int NB16 = GATE_FP8 ? 11520 : LDU;
constexpr int NG8 = 8192;
constexpr size_t WS_WG8 = WS_R2 + 90 * MiB;
constexpr int CW_TMO = 0, CW_BAR = 4096;
constexpr int RING_BYTES = 155648, LDSCTL_OFF = RING_BYTES, MISC_OFF = LDSCTL_OFF + 320, LDS_BYTES = 157696;

#define GAS __attribute__((address_space(1)))
#define LAS __attribute__((address_space(3)))
typedef unsigned short bf16;
typedef unsigned v4u __attribute__((ext_vector_type(4)));
typedef unsigned v2u __attribute__((ext_vector_type(2)));
typedef float f32x4 __attribute__((ext_vector_type(4)));
typedef GAS unsigned gu32;
#define RLX_AGENT __ATOMIC_RELAXED, __HIP_MEMORY_SCOPE_AGENT
#define LDS_WAIT() asm volatile("s_waitcnt lgkmcnt(0)" ::: "memory")
#define VM_WAIT() asm volatile("s_waitcnt vmcnt(0)" ::: "memory")
__device__ __forceinline__ unsigned f2bf(float f) { unsigned u = __builtin_bit_cast(unsigned, f); return (u + 0x7fffu + ((u >> 16) & 1u)) >> 16; }
__device__ __forceinline__ unsigned pk2(float lo, float hi) { return f2bf(lo) | (f2bf(hi) << 16); }
__device__ __forceinline__ float bfl(unsigned w) { return __uint_as_float(w << 16); }
__device__ __forceinline__ float bfh(unsigned w) { return __uint_as_float(w & 0xffff0000u); }

struct Args { const float* in[20]; float* out; unsigned char* ws; int ph_lo, ph_hi; };
typedef const __attribute__((address_space(4))) Args* KArgs;
__device__ __forceinline__ KArgs fresh_args() { KArgs p = (KArgs)__builtin_amdgcn_kernarg_segment_ptr(); asm volatile("" : "+s"(p)); return p; }
#define AIN ap->in

typedef short s16x4_t __attribute__((ext_vector_type(4)));
__device__ __forceinline__ s16x4_t tr_rd(LAS const unsigned char* p) { return __builtin_bit_cast(s16x4_t, __builtin_amdgcn_ds_read_tr16_b64_v4i16((LAS s16x4_t*)p)); }
#define XB_TMO      128
#define XB_XCNT(j)  (256  + 64 * (j))
#define XB_XSUB(j)  (1280 + 64 * (j))
#define XB_XGEN(j)  (2304 + 64 * (j))
#define XB_TOP      3328
#define XB_TOPGEN   3392
#define XCD_BAR_WORDS 3456
#define XB_SPIN_CAP (1u << 22)
__device__ __forceinline__ unsigned xb_ld(unsigned* p)              { return __hip_atomic_load(p, __ATOMIC_RELAXED, __HIP_MEMORY_SCOPE_AGENT); }
__device__ __forceinline__ unsigned xb_add(unsigned* p, unsigned v) { return __hip_atomic_fetch_add(p, v, __ATOMIC_RELAXED, __HIP_MEMORY_SCOPE_AGENT); }
__device__ __forceinline__ unsigned xb_xcc_id() { return (unsigned)__builtin_amdgcn_s_getreg((3 << 11) | 20) & 0xFu; }
#define XB_SPIN(cond, bar) do { unsigned _sp = 0; while (cond) { __builtin_amdgcn_s_sleep(1); \
    if ((++_sp & 255u) == 0u) { if (xb_ld(&(bar)[XB_TMO])) break; if (_sp > XB_SPIN_CAP) { atomicAdd(&(bar)[XB_TMO], 1u); break; } } } } while (0)

struct XcdBarrier {
    unsigned* bar; unsigned x;
    volatile LAS unsigned* st;
};

__device__ __forceinline__ XcdBarrier xcd_barrier_post(unsigned* bar, volatile LAS unsigned* st) {
    XcdBarrier b; b.bar = bar; b.x = xb_xcc_id(); b.st = st;
    if (threadIdx.x == 0) (void)xb_add(&bar[XB_XCNT(b.x)], 1u);
    return b;
}
__device__ __forceinline__ void xcd_barrier_complete(unsigned* bar, unsigned x, unsigned& nloc, unsigned& nx) {
    const unsigned G = gridDim.x * gridDim.y * gridDim.z;
    unsigned sum, cnt, mine, sp = 0u;
    for (;;) {
        sum = 0u; cnt = 0u; mine = 0u;
#pragma unroll
        for (unsigned j = 0; j < 16; ++j) { const unsigned c = xb_ld(&bar[XB_XCNT(j)]); sum += c; cnt += (c > 0u) ? 1u : 0u; mine = (j == x) ? c : mine; }
        if (sum == G) break;
        __builtin_amdgcn_s_sleep(1);
        if ((++sp & 255u) == 0u) { if (xb_ld(&bar[XB_TMO])) break; if (sp > XB_SPIN_CAP) { atomicAdd(&bar[XB_TMO], 1u); break; } }
    }
    nloc = mine > 0u ? mine : 1u; nx = cnt > 0u ? cnt : 1u;
}

__device__ __forceinline__ void xcd_barrier(const XcdBarrier& b, const int wave) {
    int lane_; asm volatile("v_mbcnt_lo_u32_b32 %0, -1, 0\n\tv_mbcnt_hi_u32_b32 %0, -1, %0" : "=v"(lane_)); const bool is_t0 = (wave == 0) && (lane_ == 0);
    asm volatile("s_waitcnt vmcnt(0)" ::: "memory");
    __syncthreads();
    if (is_t0) {
        unsigned* bar = b.bar;
        __builtin_amdgcn_s_waitcnt(0);
        unsigned nloc = b.st[0], nx = b.st[1];
        if (nloc == 0u) { xcd_barrier_complete(bar, b.x, nloc, nx); b.st[0] = nloc; b.st[1] = nx; }
        const unsigned old = xb_add(&bar[XB_XSUB(b.x)], 1u);
        const unsigned gen = old / nloc;
        if (old + 1u == (gen + 1u) * nloc) {
            __builtin_amdgcn_fence(__ATOMIC_RELEASE, "agent");
            asm volatile("s_waitcnt vmcnt(0)" ::: "memory");
            const unsigned og = xb_add(&bar[XB_TOP], 1u);
            const unsigned tg = og / nx;
            if (og + 1u == (tg + 1u) * nx) xb_add(&bar[XB_TOPGEN], 1u);
            else XB_SPIN(xb_ld(&bar[XB_TOPGEN]) == tg, bar);
            __builtin_amdgcn_fence(__ATOMIC_ACQUIRE, "agent");
            xb_add(&bar[XB_XGEN(b.x)], 1u);
            asm volatile("s_waitcnt vmcnt(0)" ::: "memory");
        } else {
            XB_SPIN(xb_ld(&bar[XB_XGEN(b.x)]) == gen, bar);
            __builtin_amdgcn_fence(__ATOMIC_ACQUIRE, "agent");
            asm volatile("s_waitcnt vmcnt(0)" ::: "memory");
        }
    }
    __syncthreads();
}

struct Frame {
    LAS unsigned char* lds;
    volatile LAS unsigned* MISC;
    int tid, lane, wave, G, blk;
};
__device__ __forceinline__ float wave_sum(float v) {
#pragma unroll
    for (int o = 1; o < 64; o <<= 1) v += __shfl_xor(v, o);
    return v;
}
__device__ __forceinline__ float wave_max(float v) {
#pragma unroll
    for (int o = 1; o < 64; o <<= 1) v = fmaxf(v, __shfl_xor(v, o));
    return v;
}
__device__ const unsigned char REL_LUT[128] = {0,1,2,3,4,5,6,7,8,9,10,11,12,13,14,15,16,16,16,17,17,18,18,18,19,19,19,20,20,20,20,21,21,21,21,22,22,22,22,22,23,23,23,23,23,23,24,24,24,24,24,24,25,25,25,25,25,25,25,
    26,26,26,26,26,26,26,26,27,27,27,27,27,27,27,27,27,27,28,28,28,28,28,28,28,28,28,28,29,29,29,29,29,29,29,29,29,29,29,29,30,30,30,30,30,30,30,30,30,30,30,30,30,30,31,31,31,31,31,31,31,31,31,31,31,31,31,31,31};

__device__ __forceinline__ float fp8_rt(float v) { const int p = __builtin_amdgcn_cvt_pk_fp8_f32(v, v, 0, false); return __builtin_amdgcn_cvt_f32_fp8(p, 0); }
__device__ __forceinline__ unsigned pk4_fp8(float a, float b, float c, float d) { int p = __builtin_amdgcn_cvt_pk_fp8_f32(a, b, 0, false); p = __builtin_amdgcn_cvt_pk_fp8_f32(c, d, p, true); return (unsigned)p; }
__device__ __forceinline__ void transpose_item_fp8(const float* W, int K, int ldw, unsigned char* WT8, int dst_row0, int src_col, int k0, LAS float* scr, int lane, float mul) {
#pragma unroll 8
    for (int i = 0; i < 32; ++i) { const int kk = 2 * i + (lane >> 5); scr[kk * 33 + (lane & 31)] = W[(size_t)(k0 + kk) * ldw + src_col] * mul; }
    LDS_WAIT(); asm volatile("" ::: "memory");
    const int c = lane & 7;
#pragma unroll
    for (int j = 0; j < 4; ++j) { const int n = (lane >> 3) + 8 * j; const LAS float* s = scr + (8 * c) * 33 + n;
        v2u o; o.x = pk4_fp8(s[0 * 33], s[1 * 33], s[2 * 33], s[3 * 33]); o.y = pk4_fp8(s[4 * 33], s[5 * 33], s[6 * 33], s[7 * 33]);
        *(GAS v2u*)(WT8 + (size_t)(dst_row0 + n) * K + k0 + 8 * c) = o; }
    LDS_WAIT(); asm volatile("" ::: "memory");
}
__device__ __forceinline__ void transpose_item(const float* W, int K, int ldw, bf16* WT, int dst_row0, int src_col, int k0, LAS float* scr, int lane, bool q8 = false) {
#pragma unroll 8
    for (int i = 0; i < 32; ++i) { const int kk = 2 * i + (lane >> 5); float wv = src_col >= 0 ? W[(size_t)(k0 + kk) * ldw + src_col] : 0.f; if (q8) wv = fp8_rt(wv * 64.f) * (1.f / 64.f); scr[kk * 33 + (lane & 31)] = wv; }
    LDS_WAIT(); asm volatile("" ::: "memory");
    const int c = lane & 7;
#pragma unroll
    for (int j = 0; j < 4; ++j) { const int n = (lane >> 3) + 8 * j; const LAS float* s = scr + (8 * c) * 33 + n;
        v4u o; o.x = pk2(s[0 * 33], s[1 * 33]); o.y = pk2(s[2 * 33], s[3 * 33]); o.z = pk2(s[4 * 33], s[5 * 33]); o.w = pk2(s[6 * 33], s[7 * 33]);
        *(GAS v4u*)(WT + (size_t)(dst_row0 + n) * K + k0 + 8 * c) = o; }
    LDS_WAIT(); asm volatile("" ::: "memory");
}
__device__ __forceinline__ void transpose_plain(const float* W, int K, int N, bf16* WT, int row_off, int item, LAS float* scr, int lane) {
    const int nblk = N / 32, kb = item / nblk, nb = item % nblk;
    transpose_item(W, K, N, WT, row_off + 32 * nb, 32 * nb + (lane & 31), 64 * kb, scr, lane);
}
__device__ __forceinline__ void rms_row_to_bf16(const float* xrow, const float* gain, bf16* orow, int lane, bool q8 = false, unsigned char* o8row = nullptr) {
    const GAS f32x4* xr = (const GAS f32x4*)xrow + lane; const GAS f32x4* gr = (const GAS f32x4*)gain + lane;
    f32x4 v[16]; float s = 0.f;
#pragma unroll
    for (int j = 0; j < 16; ++j) { v[j] = xr[64 * j]; s += (v[j].x * v[j].x + v[j].y * v[j].y) + (v[j].z * v[j].z + v[j].w * v[j].w); }
    const float rstd = 1.f / sqrtf(wave_sum(s) * (1.f / D) + NORM_EPS);
    GAS v2u* o8 = (GAS v2u*)orow + lane;
#pragma unroll
    for (int j = 0; j < 16; ++j) { const f32x4 g = gr[64 * j]; float a0 = v[j].x * rstd * g.x, a1 = v[j].y * rstd * g.y, a2 = v[j].z * rstd * g.z, a3 = v[j].w * rstd * g.w;
        if (q8) { a0 = fp8_rt(a0); a1 = fp8_rt(a1); a2 = fp8_rt(a2); a3 = fp8_rt(a3); }
        v2u o; o.x = pk2(a0, a1); o.y = pk2(a2, a3); o8[64 * j] = o;
        if (o8row) ((GAS unsigned*)o8row)[lane + 64 * j] = pk4_fp8(a0, a1, a2, a3); }
}
__device__ __forceinline__ void rms_row_inplace(float* xrow, const float* gain, int lane) {
    GAS f32x4* xr = (GAS f32x4*)xrow + lane; const GAS f32x4* gr = (const GAS f32x4*)gain + lane;
    f32x4 v[16]; float s = 0.f;
#pragma unroll
    for (int j = 0; j < 16; ++j) { v[j] = xr[64 * j]; s += (v[j].x * v[j].x + v[j].y * v[j].y) + (v[j].z * v[j].z + v[j].w * v[j].w); }
    const float rstd = 1.f / sqrtf(wave_sum(s) * (1.f / D) + NORM_EPS);
#pragma unroll
    for (int j = 0; j < 16; ++j) { const f32x4 g = gr[64 * j]; xr[64 * j] = (f32x4){v[j].x * rstd * g.x, v[j].y * rstd * g.y, v[j].z * rstd * g.z, v[j].w * rstd * g.w}; }
}

#ifndef FP8_EMU_W
#define FP8_EMU_W false
#endif
#ifndef FP8_EMU_H
#define FP8_EMU_H false
#endif
__device__ __forceinline__ void rms_rows(Frame& F, const float* X, const float* gain, bf16* H, unsigned char* H8, float* OUT, const int gw, const int NGW) {
    f32x4 v[16], gv[16];
    { const GAS f32x4* gr = (const GAS f32x4*)gain + F.lane;
#pragma unroll
      for (int j = 0; j < 16; ++j) gv[j] = gr[64 * j]; }
    if (gw < M) { const GAS f32x4* xr = (const GAS f32x4*)(X + (size_t)gw * D) + F.lane;
#pragma unroll
        for (int j = 0; j < 16; ++j) v[j] = xr[64 * j]; }
    for (int m = gw; m < M; m += NGW) { f32x4 vn[16]; const bool has = m + NGW < M;
        if (has) { const GAS f32x4* xr = (const GAS f32x4*)(X + (size_t)(m + NGW) * D) + F.lane;
#pragma unroll
            for (int j = 0; j < 16; ++j) vn[j] = xr[64 * j]; }
        float ssum = 0.f;
#pragma unroll
        for (int j = 0; j < 16; ++j) ssum += (v[j].x * v[j].x + v[j].y * v[j].y) + (v[j].z * v[j].z + v[j].w * v[j].w);
        const float rstd = 1.f / sqrtf(wave_sum(ssum) * (1.f / D) + NORM_EPS);
#pragma unroll
        for (int j = 0; j < 16; ++j) { const f32x4 g = gv[j]; const float a0 = v[j].x * rstd * g.x, a1 = v[j].y * rstd * g.y, a2 = v[j].z * rstd * g.z, a3 = v[j].w * rstd * g.w;
            if (OUT) ((GAS f32x4*)(OUT + (size_t)m * D) + F.lane)[64 * j] = (f32x4){a0, a1, a2, a3};
            if (H) { v2u o; o.x = pk2(a0, a1); o.y = pk2(a2, a3); ((GAS v2u*)(H + (size_t)m * D) + F.lane)[64 * j] = o; }
            if (H8) ((GAS unsigned*)(H8 + (size_t)m * D))[F.lane + 64 * j] = pk4_fp8(a0, a1, a2, a3); }
        if (has) {
#pragma unroll
            for (int j = 0; j < 16; ++j) v[j] = vn[j]; } }
}
struct TD { const float* W; unsigned char* WT; int K, ldw, drow, k0, scol, f8; const float* rs; };
#ifndef TR_DEPTH
#define TR_DEPTH 1
#endif
#ifndef TR_SK
#define TR_SK 1
#endif
#ifndef TR_SN
#define TR_SN 8
#endif
#define TR_MAP(r_, nblk_, kb_, nb_) do { if ((nblk_) < TR_SN || (TR_SK == 1 && TR_SN == 8)) { kb_ = (r_) / (nblk_); nb_ = (r_) % (nblk_); } else { const int g_ = (r_) / (TR_SK * TR_SN), s_ = (r_) % (TR_SK * TR_SN), ng_ = (nblk_) / TR_SN; kb_ = (g_ / ng_) * TR_SK + s_ / TR_SN; nb_ = (g_ % ng_) * TR_SN + s_ % TR_SN; } } while (0)
template <class Dec> __device__ __forceinline__ void transpose_stream(Frame& F, const Dec& decode, const int NITEMS, LAS float* scr, const int gw, const int NGW) {
    float tv[32];
#if TR_DEPTH == 2
    float tm[32];
#endif
    f32x4 ga = (f32x4){1.f, 1.f, 1.f, 1.f}, gb = ga;
    static_assert(TR_DEPTH == 1 || TR_DEPTH == 2, "TR_DEPTH");
    if (gw < NITEMS) { const TD d = decode(gw);
        if (d.rs) { ga = *(const GAS f32x4*)(d.rs + d.k0 + 8 * (F.lane & 7)); gb = *(const GAS f32x4*)(d.rs + d.k0 + 8 * (F.lane & 7) + 4); }
#pragma unroll
        for (int i = 0; i < 32; ++i) tv[i] = d.scol >= 0 ? d.W[(size_t)(d.k0 + 2 * i + (F.lane >> 5)) * d.ldw + d.scol] : 0.f; }
#if TR_DEPTH == 2
    if (gw + NGW < NITEMS) { const TD d = decode(gw + NGW);
#pragma unroll
        for (int i = 0; i < 32; ++i) tm[i] = d.scol >= 0 ? d.W[(size_t)(d.k0 + 2 * i + (F.lane >> 5)) * d.ldw + d.scol] : 0.f; }
#endif
    for (int it = gw; it < NITEMS; it += NGW) {
        const TD d = decode(it); const bool has = it + TR_DEPTH * NGW < NITEMS; float tn[32]; f32x4 gna = (f32x4){1.f, 1.f, 1.f, 1.f}, gnb = gna;
        if (it + NGW < NITEMS) { const TD e1 = decode(it + NGW); if (e1.rs) { gna = *(const GAS f32x4*)(e1.rs + e1.k0 + 8 * (F.lane & 7)); gnb = *(const GAS f32x4*)(e1.rs + e1.k0 + 8 * (F.lane & 7) + 4); } }
        if (has) { const TD e = decode(it + TR_DEPTH * NGW);
#pragma unroll
            for (int i = 0; i < 32; ++i) tn[i] = e.scol >= 0 ? e.W[(size_t)(e.k0 + 2 * i + (F.lane >> 5)) * e.ldw + e.scol] : 0.f; }
        const float mul = d.f8 ? 64.f : 1.f;
#pragma unroll
        for (int i = 0; i < 32; ++i) scr[(2 * i + (F.lane >> 5)) * 33 + (F.lane & 31)] = tv[i] * mul;
        LDS_WAIT(); asm volatile("" ::: "memory");
        const int c = F.lane & 7;
#pragma unroll
        for (int j = 0; j < 4; ++j) { const int n = (F.lane >> 3) + 8 * j; const LAS float* sp = scr + (8 * c) * 33 + n;
            if (d.f8) { v2u o; o.x = pk4_fp8(sp[0 * 33], sp[1 * 33], sp[2 * 33], sp[3 * 33]); o.y = pk4_fp8(sp[4 * 33], sp[5 * 33], sp[6 * 33], sp[7 * 33]); *(GAS v2u*)(d.WT + (size_t)(d.drow + n) * d.K + d.k0 + 8 * c) = o; }
            else { v4u o; o.x = pk2(sp[0 * 33] * ga.x, sp[1 * 33] * ga.y); o.y = pk2(sp[2 * 33] * ga.z, sp[3 * 33] * ga.w); o.z = pk2(sp[4 * 33] * gb.x, sp[5 * 33] * gb.y); o.w = pk2(sp[6 * 33] * gb.z, sp[7 * 33] * gb.w); *(GAS v4u*)((bf16*)d.WT + (size_t)(d.drow + n) * d.K + d.k0 + 8 * c) = o; } }
        LDS_WAIT(); asm volatile("" ::: "memory");
        ga = gna; gb = gnb;
#if TR_DEPTH == 2
#pragma unroll
        for (int i = 0; i < 32; ++i) { tv[i] = tm[i]; tm[i] = tn[i]; }
#else
        if (has) {
#pragma unroll
            for (int i = 0; i < 32; ++i) tv[i] = tn[i]; }
#endif
    }
}
#ifndef P0_DEFER
#define P0_DEFER 1
#endif
#ifndef P0_DEFER_UP
#define P0_DEFER_UP 16384
#endif
__device__ __forceinline__ void p0_prologue(Frame& F, KArgs ap, bool first = true, int gw2 = 0, int ngw2 = 1) {
    unsigned char* ws_ = ap->ws;
    LAS float* scr = (LAS float*)(F.lds + F.wave * 16384);
    const int gw = F.blk * NWAVES + F.wave, NGW = F.G * NWAVES;
    bf16* WinT = (bf16*)(ws_ + WS_WIN); bf16* WglaT = (bf16*)(ws_ + WS_WGLA); bf16* WnsaT = (bf16*)(ws_ + WS_WNSA); bf16* WoutT = (bf16*)(ws_ + WS_WOUT); bf16* WupT = (bf16*)(ws_ + WS_WUP);
    bf16* W1cT = (bf16*)(ws_ + WS_W1C); bf16* W2bT = (bf16*)(ws_ + WS_W2B);
    constexpr int I_IN = (D / 64) * (NB16 / 32), I_G8 = GATE_FP8 ? (D / 64) * (NG8 / 32) : 0, I_GLA = (2048 / 64) * (D / 32), I_NSA = I_GLA, I_OUT = (D / 64) * (D / 32), I_UP = (D / 64) * (FF / 32), I_PHI = (4096 / 64) * (128 / 32);
    constexpr int NITEMS = I_IN + I_G8 + I_GLA + I_NSA + I_OUT + I_UP + 2 * I_PHI;
    constexpr int NITEMS0 = P0_DEFER ? NITEMS - (I_GLA + I_NSA + I_OUT) - P0_DEFER_UP : NITEMS;
    auto decode = [&](int it) -> TD { TD d; int r = it; d.f8 = 0; d.rs = nullptr;
        if (r < I_IN) { const int nblk = NB16 / 32; int kb, nb; TR_MAP(r, nblk, kb, nb); const int ucol = (!GATE_FP8 || 32 * nb < 11264) ? 32 * nb : 32 * nb - 11264 + 19456;
            d.W = AIN[2]; d.WT = (unsigned char*)WinT; d.K = D; d.ldw = NIN; d.drow = 32 * nb; d.k0 = 64 * kb; d.scol = orig_col(ucol + (F.lane & 31)); return d; } r -= I_IN;
        if (r < I_G8) { const int nblk = NG8 / 32; int kb, nb; TR_MAP(r, nblk, kb, nb);
            d.W = AIN[2]; d.WT = ws_ + WS_WG8; d.K = D; d.ldw = NIN; d.drow = 32 * nb; d.k0 = 64 * kb; d.scol = orig_col(11264 + 32 * nb + (F.lane & 31)); d.f8 = 1; return d; } r -= I_G8;
        const float* W; bf16* WT; int K, N, roff = 0;
        if (r < I_PHI) { W = AIN[8]; WT = W1cT; K = 4096; N = 128; } else if ((r -= I_PHI) < I_PHI) { W = AIN[10]; WT = W1cT; K = 4096; N = 128; roff = 128; }
        else if ((r -= I_PHI) < I_UP) { W = AIN[17]; WT = WupT; K = D; N = FF; d.rs = AIN[16];   }
        else if ((r -= I_UP) < I_GLA) { W = AIN[13]; WT = WglaT; K = 2048; N = D; } else if ((r -= I_GLA) < I_NSA) { W = AIN[14]; WT = WnsaT; K = 2048; N = D; } else { r -= I_NSA; W = AIN[15]; WT = WoutT; K = D; N = D; }
        const int nblk = N / 32; int kb, nb; TR_MAP(r, nblk, kb, nb);
        d.W = W; d.WT = (unsigned char*)WT; d.K = K; d.ldw = N; d.drow = roff + 32 * nb; d.k0 = 64 * kb; d.scol = 32 * nb + (F.lane & 31); return d; };
    if (first) transpose_stream(F, decode, NITEMS0, scr, gw, NGW);
    else { transpose_stream(F, decode, NITEMS, scr, NITEMS0 + gw2, ngw2); return; }
    for (int i = gw * 64 + F.lane; i < 256 * 256; i += NGW * 64) { const int n = i >> 8, k = i & 255; float v = 0.f;
        if (n < 128 && k < 128) v = AIN[9][k * 128 + n]; else if (n >= 128 && k >= 128) v = AIN[11][(k - 128) * 128 + (n - 128)];
        W2bT[i] = (bf16)f2bf(v); }
    bf16* H = (bf16*)(ws_ + WS_H);
    rms_rows(F, AIN[0], AIN[1], H, GATE_FP8 ? ws_ + WS_H8 : nullptr, nullptr, gw, NGW);
}
__device__ __forceinline__ void p2_im2col(Frame& F, KArgs ap, int row_lo = 0, int row_hi = 8192, int gw_in = -1, int ngw_in = 0) {
    unsigned char* ws_ = ap->ws;
    const int gw = gw_in >= 0 ? gw_in : F.blk * NWAVES + F.wave, NGW = gw_in >= 0 ? ngw_in : F.G * NWAVES;
    const bf16* U = (const bf16*)(ws_ + WS_U); bf16* A = (bf16*)(ws_ + WS_ACMP);
    const int tq = F.lane >> 4, dc = (F.lane & 15) * 8;
    for (int row = row_lo + gw; row < row_hi; row += NGW) {
        const int kv = row >> 12, bg = (row >> 8) & 15, c = row & 255, b = bg >> 2, g = bg & 3;
        const float* pos = AIN[6 + kv]; const int ucol = (kv ? U_VC : U_KC) + g * 128 + dc;
#pragma unroll
        for (int i = 0; i < 8; ++i) { const int t = 4 * i + tq; v4u o = (v4u){0u, 0u, 0u, 0u};
            if (c < 255) { const v4u w = *(const GAS v4u*)(U + (size_t)(b * SEQ + 16 * c + t) * LDU + ucol);
                const f32x4 p0 = *(const GAS f32x4*)(pos + t * 128 + dc), p1 = *(const GAS f32x4*)(pos + t * 128 + dc + 4);
                o.x = pk2(bfl(w.x) + p0.x, bfh(w.x) + p0.y); o.y = pk2(bfl(w.y) + p0.z, bfh(w.y) + p0.w); o.z = pk2(bfl(w.z) + p1.x, bfh(w.z) + p1.y); o.w = pk2(bfl(w.w) + p1.z, bfh(w.w) + p1.w); }
            *(GAS v4u*)(A + (size_t)row * 4096 + t * 128 + dc) = o; }
    }
}
__device__ __forceinline__ void gla_chain(Frame& F, KArgs ap, int bh) {
    unsigned char* ws_ = ap->ws;
    const int b = bh >> 4, h = bh & 15, tid = F.tid, lane = F.lane, wave = F.wave;
    LAS float* A = (LAS float*)F.lds; LAS float* Kf = A + 4096; LAS float* Qf = Kf + 4096; LAS float* V = Qf + 4096; LAS float* O = V + 8192; LAS float* W2 = O + 8192; LAS float* Bal = W2 + 1024;
    const bf16* U = (const bf16*)(ws_ + WS_U); bf16* OG = (bf16*)(ws_ + WS_OGLA);
    for (int i = tid; i < 1024; i += 512) W2[i] = AIN[3][(i >> 6) * 1024 + h * 64 + (i & 63)];
    if (tid < 64) Bal[tid] = AIN[4][h * 64 + tid];
    const int grp = tid & 3, e = tid >> 2;
    float st[16];
#pragma unroll
    for (int j = 0; j < 16; ++j) st[j] = 0.f;
    const float g0 = AIN[5][h * 128 + 2 * lane], g1 = AIN[5][h * 128 + 2 * lane + 1];
    __syncthreads();
    for (int n = 0; n < 64; ++n) {
        const size_t tok0 = (size_t)b * SEQ + n * 64;
        { const int t = tid >> 3, dd = (tid & 7) * 8; const bf16* ur = U + (tok0 + t) * LDU;
          const v4u a0 = *(const GAS v4u*)(ur + U_GA), a1 = *(const GAS v4u*)(ur + U_GA + 8);
          float alr[16]; alr[0] = bfl(a0.x); alr[1] = bfh(a0.x); alr[2] = bfl(a0.y); alr[3] = bfh(a0.y); alr[4] = bfl(a0.z); alr[5] = bfh(a0.z); alr[6] = bfl(a0.w); alr[7] = bfh(a0.w);
          alr[8] = bfl(a1.x); alr[9] = bfh(a1.x); alr[10] = bfl(a1.y); alr[11] = bfh(a1.y); alr[12] = bfl(a1.z); alr[13] = bfh(a1.z); alr[14] = bfl(a1.w); alr[15] = bfh(a1.w);
#pragma unroll
          for (int j = 0; j < 8; ++j) { const int d = dd + j; float pre = Bal[d];
#pragma unroll
              for (int i = 0; i < 16; ++i) pre += alr[i] * W2[i * 64 + d];
              const float ls = fminf(pre, 0.f) - log1pf(expf(-fabsf(pre)));
              A[t * 64 + d] = expf(ls * (1.f / 16.f)); }
          const v4u qw = *(const GAS v4u*)(ur + U_GQ + h * 64 + dd), kw = *(const GAS v4u*)(ur + U_GK + h * 64 + dd);
          LAS float* qd = Qf + t * 64 + dd; LAS float* kd = Kf + t * 64 + dd;
          qd[0] = bfl(qw.x) * 0.125f; qd[1] = bfh(qw.x) * 0.125f; qd[2] = bfl(qw.y) * 0.125f; qd[3] = bfh(qw.y) * 0.125f; qd[4] = bfl(qw.z) * 0.125f; qd[5] = bfh(qw.z) * 0.125f; qd[6] = bfl(qw.w) * 0.125f; qd[7] = bfh(qw.w) * 0.125f;
          kd[0] = bfl(kw.x); kd[1] = bfh(kw.x); kd[2] = bfl(kw.y); kd[3] = bfh(kw.y); kd[4] = bfl(kw.z); kd[5] = bfh(kw.z); kd[6] = bfl(kw.w); kd[7] = bfh(kw.w);
          const int e0 = (tid & 7) * 16; const v4u v0 = *(const GAS v4u*)(ur + U_GV + h * 128 + e0), v1 = *(const GAS v4u*)(ur + U_GV + h * 128 + e0 + 8);
          LAS float* vd = V + t * 128 + e0;
          vd[0] = bfl(v0.x); vd[1] = bfh(v0.x); vd[2] = bfl(v0.y); vd[3] = bfh(v0.y); vd[4] = bfl(v0.z); vd[5] = bfh(v0.z); vd[6] = bfl(v0.w); vd[7] = bfh(v0.w);
          vd[8] = bfl(v1.x); vd[9] = bfh(v1.x); vd[10] = bfl(v1.y); vd[11] = bfh(v1.y); vd[12] = bfl(v1.z); vd[13] = bfh(v1.z); vd[14] = bfl(v1.w); vd[15] = bfh(v1.w); }
        __syncthreads();
        for (int t = 0; t < 64; ++t) {
            const LAS f32x4* ap = (const LAS f32x4*)(A + t * 64 + grp * 16); const LAS f32x4* kp = (const LAS f32x4*)(Kf + t * 64 + grp * 16); const LAS f32x4* qp = (const LAS f32x4*)(Qf + t * 64 + grp * 16);
            const float v = V[t * 128 + e]; float o = 0.f;
#pragma unroll
            for (int j4 = 0; j4 < 4; ++j4) { const f32x4 a = ap[j4], k = kp[j4], q = qp[j4];
                st[4 * j4 + 0] = a.x * st[4 * j4 + 0] + k.x * v; st[4 * j4 + 1] = a.y * st[4 * j4 + 1] + k.y * v; st[4 * j4 + 2] = a.z * st[4 * j4 + 2] + k.z * v; st[4 * j4 + 3] = a.w * st[4 * j4 + 3] + k.w * v;
                o += q.x * st[4 * j4 + 0] + q.y * st[4 * j4 + 1] + q.z * st[4 * j4 + 2] + q.w * st[4 * j4 + 3]; }
            o += __shfl_xor(o, 1); o += __shfl_xor(o, 2);
            if (grp == 0) O[t * 128 + e] = o;
        }
        __syncthreads();
#pragma unroll 2
        for (int i = 0; i < 8; ++i) { const int t = wave * 8 + i; const float o0 = O[t * 128 + 2 * lane], o1 = O[t * 128 + 2 * lane + 1];
            const float rstd = 1.f / sqrtf(wave_sum(o0 * o0 + o1 * o1) * (1.f / 128.f) + NORM_EPS);
            const unsigned rw = *(const GAS unsigned*)(U + (tok0 + t) * LDU + U_GR + h * 128 + 2 * lane);
            *(GAS unsigned*)(OG + (tok0 + t) * 2048 + h * 128 + 2 * lane) = pk2(o0 * rstd * g0 * bfl(rw), o1 * rstd * g1 * bfh(rw)); }
    }
    __syncthreads();
}

__device__ __forceinline__ void qk4(const bf16* krow, const LAS float* qs, float (&sc)[4]) {
#pragma unroll
    for (int r = 0; r < 4; ++r) sc[r] = 0.f;
#pragma unroll 4
    for (int d8 = 0; d8 < 16; ++d8) { const v4u w = *(const GAS v4u*)(krow + 8 * d8);
        const float k0 = bfl(w.x), k1 = bfh(w.x), k2 = bfl(w.y), k3 = bfh(w.y), k4 = bfl(w.z), k5 = bfh(w.z), k6 = bfl(w.w), k7 = bfh(w.w);
#pragma unroll
        for (int r = 0; r < 4; ++r) { const f32x4 qa = *(const LAS f32x4*)(qs + r * 128 + 8 * d8), qb = *(const LAS f32x4*)(qs + r * 128 + 8 * d8 + 4);
            sc[r] += (k0 * qa.x + k1 * qa.y) + (k2 * qa.z + k3 * qa.w) + (k4 * qb.x + k5 * qb.y) + (k6 * qb.z + k7 * qb.w); } }
}
__device__ __forceinline__ void pv4(const bf16* vbase, size_t vstride, const LAS float* pT, int nk, int lane, float (&o)[4][2]) {
#pragma unroll 4
    for (int key = 0; key < nk; ++key) { const unsigned w = *(const GAS unsigned*)(vbase + (size_t)key * vstride + 2 * lane); const float v0 = bfl(w), v1 = bfh(w);
        const f32x4 p = *(const LAS f32x4*)(pT + 4 * key);
        o[0][0] += p.x * v0; o[0][1] += p.x * v1; o[1][0] += p.y * v0; o[1][1] += p.y * v1; o[2][0] += p.z * v0; o[2][1] += p.z * v1; o[3][0] += p.w * v0; o[3][1] += p.w * v1; }
}
__device__ __forceinline__ void attend64(const bf16* Ub, int kb, bool valid, int dist, int koff, int voff, const LAS float* qs, LAS float* pT, const LAS float* bias, float (&m)[4], float (&l)[4], float (&o)[4][2], int lane) {
    float sc[4]; qk4(Ub + (size_t)(kb + lane) * LDU + koff, qs, sc);
    const int dd = dist < 0 ? 0 : (dist > 127 ? 127 : dist); const int bk = REL_LUT[dd];
    const f32x4 bv = *(const LAS f32x4*)(bias + 4 * bk);
    float p[4];
#pragma unroll
    for (int r = 0; r < 4; ++r) { const float x = sc[r] + bv[r]; const float bm = wave_max(valid ? x : -1e30f); const float mn = fmaxf(m[r], bm); const float al = __expf(m[r] - mn);
        p[r] = valid ? __expf(x - mn) : 0.f; l[r] = l[r] * al + wave_sum(p[r]); o[r][0] *= al; o[r][1] *= al; m[r] = mn; }
    asm volatile("" ::: "memory");
    *(LAS f32x4*)(pT + 4 * lane) = (f32x4){p[0], p[1], p[2], p[3]};
    LDS_WAIT(); __builtin_amdgcn_wave_barrier(); asm volatile("" ::: "memory");
    pv4(Ub + (size_t)kb * LDU + voff, LDU, pT, 64, lane, o);
    asm volatile("" ::: "memory");
}
__device__ __forceinline__ void nsa_item(Frame& F, KArgs ap, int item, LAS float* wl) {
    unsigned char* ws_ = ap->ws;
    const int lane = F.lane; const int s = item & (SEQ - 1), g = (item >> 12) & 3, b = item >> 14;
    LAS float* qs = wl; LAS float* pT = wl + 512; LAS float* bias = wl + 512 + 1024;
    const bf16* U = (const bf16*)(ws_ + WS_U); const bf16* Ub = U + (size_t)b * SEQ * LDU; const bf16* OC = (const bf16*)(ws_ + WS_OC);
    const size_t tok = (size_t)b * SEQ + s; const float scale = 0.08838834764831845f;
    asm volatile("" ::: "memory");
#pragma unroll
    for (int r = 0; r < 4; ++r) { const unsigned w = *(const GAS unsigned*)(U + tok * LDU + U_NQ + (g * 4 + r) * 128 + 2 * lane); qs[r * 128 + 2 * lane] = bfl(w) * scale; qs[r * 128 + 2 * lane + 1] = bfh(w) * scale; }
    for (int i = lane; i < 128; i += 64) bias[i] = AIN[12][(i >> 2) * 16 + g * 4 + (i & 3)];
    LDS_WAIT(); __builtin_amdgcn_wave_barrier(); asm volatile("" ::: "memory");
    float sc[4][4];
    const bf16* kc = OC + (size_t)((b * 4 + g) * 256) * 256; const bf16* vc = OC + (size_t)(4096 + (b * 4 + g) * 256) * 256 + 128;
    float mx[4] = {-1e30f, -1e30f, -1e30f, -1e30f};
#pragma unroll
    for (int i = 0; i < 4; ++i) { const int c = 64 * i + lane; qk4(kc + (size_t)c * 256, qs, sc[i]); const int dist = s - (16 * c + 31); const bool valid = (c < 255) && dist >= 0;
        const int dd = dist < 0 ? 0 : (dist > 127 ? 127 : dist); const f32x4 bv = *(const LAS f32x4*)(bias + 4 * REL_LUT[dd]);
#pragma unroll
        for (int r = 0; r < 4; ++r) { sc[i][r] = valid ? sc[i][r] + bv[r] : -1e30f; mx[r] = fmaxf(mx[r], sc[i][r]); } }
    float inv[4];
#pragma unroll
    for (int r = 0; r < 4; ++r) { mx[r] = wave_max(mx[r]); float sum = 0.f;
#pragma unroll
        for (int i = 0; i < 4; ++i) { sc[i][r] = sc[i][r] > -1e29f ? __expf(sc[i][r] - mx[r]) : 0.f; sum += sc[i][r]; }
        sum = wave_sum(sum); inv[r] = sum > 0.f ? 1.f / sum : 0.f; }
#pragma unroll
    for (int i = 0; i < 4; ++i) *(LAS f32x4*)(pT + 4 * (64 * i + lane)) = (f32x4){sc[i][0] * inv[0], sc[i][1] * inv[1], sc[i][2] * inv[2], sc[i][3] * inv[3]};
    LDS_WAIT(); __builtin_amdgcn_wave_barrier(); asm volatile("" ::: "memory");
    float ocmp[4][2];
#pragma unroll
    for (int r = 0; r < 4; ++r) { ocmp[r][0] = 0.f; ocmp[r][1] = 0.f; }
    const int nvalid = s >= 31 ? ((s - 31) >> 4) + 1 : 0;
    pv4(vc, 256, pT, nvalid, lane, ocmp);
    float imp = 0.f;
#pragma unroll
    for (int dc = -1; dc <= 3; ++dc) { const int c = 4 * lane + dc; if (c >= 0 && c < 255) { const f32x4 p = *(const LAS f32x4*)(pT + 4 * c); const float w = (dc == -1 || dc == 3) ? 1.f : 2.f; imp += w * ((p.x + p.y) + (p.z + p.w)); } }
    const int cur = s >> 6; const bool forced = (lane == 0) || (lane <= cur && lane > cur - 2); const bool reach = lane <= cur;
    const float score = forced ? 1e4f : (reach ? imp : -1e4f);
    int rank = 0;
#pragma unroll
    for (int jp = 0; jp < 64; ++jp) { const float sj = __int_as_float(__builtin_amdgcn_readlane(__float_as_int(score), jp)); rank += (sj > score || (sj == score && jp < lane)) ? 1 : 0; }
    unsigned long long mask = __ballot(rank < 16 && reach);
    asm volatile("" ::: "memory");
    float ms[4], ls[4], osel[4][2];
#pragma unroll
    for (int r = 0; r < 4; ++r) { ms[r] = -1e30f; ls[r] = 0.f; osel[r][0] = 0.f; osel[r][1] = 0.f; }
    while (mask) { const int j = __builtin_ctzll(mask); mask &= mask - 1; const int kpos = 64 * j + lane;
        attend64(Ub, 64 * j, kpos <= s, s - kpos, U_KSL + g * 128, U_VSL + g * 128, qs, pT, bias, ms, ls, osel, lane); }
    float mw[4], lw[4], owin[4][2];
#pragma unroll
    for (int r = 0; r < 4; ++r) { mw[r] = -1e30f; lw[r] = 0.f; owin[r][0] = 0.f; owin[r][1] = 0.f; }
    const int lo = s - 511 > 0 ? s - 511 : 0;
    for (int kb = lo & ~63; kb <= s; kb += 64) { const int kpos = kb + lane;
        attend64(Ub, kb, kpos >= lo && kpos <= s, s - kpos, U_KW + g * 128, U_VW + g * 128, qs, pT, bias, mw, lw, owin, lane); }
    bf16* ON = (bf16*)(ws_ + WS_ONSA);
#pragma unroll
    for (int r = 0; r < 4; ++r) { const bf16* gp = U + tok * LDU + U_NG + (g * 4 + r) * 3;
        const float g0 = __uint_as_float((unsigned)gp[0] << 16), g1 = __uint_as_float((unsigned)gp[1] << 16), g2 = __uint_as_float((unsigned)gp[2] << 16);
        const float is = g1 / ls[r], iw = g2 / lw[r];
        *(GAS unsigned*)(ON + tok * 2048 + (g * 4 + r) * 128 + 2 * lane) = pk2(g0 * ocmp[r][0] + is * osel[r][0] + iw * owin[r][0], g0 * ocmp[r][1] + is * osel[r][1] + iw * owin[r][1]); }
    asm volatile("" ::: "memory");
}
#ifndef NSA_QREG
#define NSA_QREG 1
#endif
#ifndef NSA_DMA
#define NSA_DMA 1
#endif
#ifndef NSA_PAIR
#define NSA_PAIR 1
#endif
#ifndef NSA_DMA0
#define NSA_DMA0 0
#endif
#ifndef NSA_TRASM
#define NSA_TRASM 0
#endif
#ifndef NSA_PFK
#define NSA_PFK 1
#endif
#ifndef NSA_PFV
#define NSA_PFV 1
#endif
#ifndef NSA_DUPSEL
#define NSA_DUPSEL 1
#endif
#ifndef NSA_DUPWIN
#define NSA_DUPWIN 1
#endif
#ifndef NSA_ACT3ONLY
#define NSA_ACT3ONLY 1
#endif
#ifndef NSA_HALF
#define NSA_HALF 0
#endif
#ifndef NSA_IGL_N
#define NSA_IGL_N 6
#endif
#define NSA_IGL() do { _Pragma("unroll") for (int i_ = 0; i_ < 16; ++i_) { __builtin_amdgcn_sched_group_barrier(0x008, 1, 0); __builtin_amdgcn_sched_group_barrier(0x002, NSA_IGL_N, 0); } } while (0)
#ifndef NSA_SWAPSEL
#define NSA_SWAPSEL(w) ((w) >> 2)
#endif
#ifndef NSA_HSB
#define NSA_HSB() __builtin_amdgcn_sched_barrier(0)
#endif
#ifndef NSA_BIASASM
#define NSA_BIASASM 1
#endif
#ifndef NSA_BIASASM_MASK
#define NSA_BIASASM_MASK 0
#endif
#ifndef NSA_QREG_KS
#define NSA_QREG_KS 4
#endif
#ifndef NSA_PRIO
#define NSA_PRIO(x)
#endif
#ifndef NSA_SB2
#define NSA_SB2()
#endif
#ifndef NSA_SB
#define NSA_SB() __builtin_amdgcn_sched_barrier(0)
#endif
typedef short bf16x8_t __attribute__((ext_vector_type(8)));
constexpr int NT_ROWB = 288;
constexpr int NT_TILEB = 64 * NT_ROWB;
constexpr int NL_K = 0, NL_V = 2 * NT_TILEB, NL_Q = 4 * NT_TILEB, NL_BIAS = NL_Q + 256 * NT_ROWB, NL_SELM = NL_BIAS + 2048, NL_WUN = NL_SELM + 512, NL_JL = NL_WUN + 64, NL_END = NL_JL + 64, NL_IMP = NL_K;
static_assert(NL_END <= RING_BYTES, "NSA LDS map");
__device__ __forceinline__ unsigned cvtpk(float lo, float hi) { unsigned r; asm volatile("v_cvt_pk_bf16_f32 %0, %1, %2" : "=v"(r) : "v"(lo), "v"(hi)); return r; }
__device__ __forceinline__ float xrow16_max(float x) {
    auto s = __builtin_amdgcn_permlane16_swap(__float_as_uint(x), __float_as_uint(x), false, false); x = fmaxf(__uint_as_float(s[0]), __uint_as_float(s[1]));
    auto t = __builtin_amdgcn_permlane32_swap(__float_as_uint(x), __float_as_uint(x), false, false); return fmaxf(__uint_as_float(t[0]), __uint_as_float(t[1])); }
__device__ __forceinline__ float xrow16_sum(float x) {
    auto s = __builtin_amdgcn_permlane16_swap(__float_as_uint(x), __float_as_uint(x), false, false); x = __uint_as_float(s[0]) + __uint_as_float(s[1]);
    auto t = __builtin_amdgcn_permlane32_swap(__float_as_uint(x), __float_as_uint(x), false, false); return __uint_as_float(t[0]) + __uint_as_float(t[1]); }
template <int CTRL> __device__ __forceinline__ float dppf(float x) { return __builtin_bit_cast(float, __builtin_amdgcn_mov_dpp(__builtin_bit_cast(int, x), CTRL, 0xf, 0xf, true)); }
__device__ __forceinline__ float quad_sum(float x) { x += dppf<0xB1>(x); x += dppf<0x4E>(x); return x; }
#ifndef NSA_THR
#define NSA_THR 8.0f
#endif


struct NsaTileSrc { const unsigned char* k; const unsigned char* v; unsigned stride; };
struct NsaRegs { v4u k0, k1, v0, v1; };
__device__ __forceinline__ void nsa_ld(const NsaTileSrc& s, int tid_in, NsaRegs& r) {
    int tid = tid_in; asm volatile("" : "+v"(tid));
    const int row = tid >> 4, c16 = (tid & 15) * 16;
    r.k0 = *(const GAS v4u*)(s.k + (size_t)row * s.stride + c16); r.k1 = *(const GAS v4u*)(s.k + (size_t)(row + 32) * s.stride + c16);
    r.v0 = *(const GAS v4u*)(s.v + (size_t)row * s.stride + c16); r.v1 = *(const GAS v4u*)(s.v + (size_t)(row + 32) * s.stride + c16);
}
__device__ __forceinline__ void nsa_st(LAS unsigned char* lds, int buf, int tid_in, const NsaRegs& r) {
    int tid = tid_in; asm volatile("" : "+v"(tid));
    const int row = tid >> 4, c16 = (tid & 15) * 16; LAS unsigned char* kb = lds + NL_K + buf * NT_TILEB + row * NT_ROWB + c16; LAS unsigned char* vb = lds + NL_V + buf * NT_TILEB + row * NT_ROWB + c16;
    *(LAS v4u*)kb = r.k0; *(LAS v4u*)(kb + 32 * NT_ROWB) = r.k1; *(LAS v4u*)vb = r.v0; *(LAS v4u*)(vb + 32 * NT_ROWB) = r.v1;
}
struct NsaAcc { f32x4 o[8][2]; float m[2], l[2]; };
__device__ __forceinline__ constexpr int nsa_koff(int buf) { return NSA_PAIR ? buf * 32768 : NL_K + buf * NT_TILEB; }
__device__ __forceinline__ constexpr int nsa_voff(int buf) { return NSA_PAIR ? buf * 32768 + 16384 : NL_V + buf * NT_TILEB; }
#if NSA_PAIR
static_assert(NSA_QREG && NSA_QREG_KS == 4 && NSA_DMA && !NSA_DMA0 && 4 * 32768 <= NL_BIAS, "NSA_PAIR needs every Q fragment in registers and the DMA staging");
#endif
__device__ __forceinline__ void nsa_dma(LAS unsigned char* lds, int buf, int wave, int lane_in, const NsaTileSrc& s) {
    int lane = lane_in; asm volatile("" : "+v"(lane));
#pragma unroll
    for (int i = 0; i < 2; ++i) { const int r = (wave * 2 + i) * 4 + (lane >> 4); const int c = (lane & 15) ^ ((r & 7) << 1);
        const size_t go = (size_t)r * s.stride + (size_t)(c * 16);
        __builtin_amdgcn_global_load_lds((const unsigned*)(s.k + go), (LAS unsigned*)(lds + nsa_koff(buf) + (wave * 2 + i) * 1024), 16, 0, 0);
        __builtin_amdgcn_global_load_lds((const unsigned*)(s.v + go), (LAS unsigned*)(lds + nsa_voff(buf) + (wave * 2 + i) * 1024), 16, 0, 0); }
}
#define NSA_DMA_WAIT() asm volatile("s_waitcnt vmcnt(0)" ::: "memory")
__device__ __forceinline__ unsigned cvtpk_nv(float lo, float hi) { unsigned r; asm("v_cvt_pk_bf16_f32 %0, %1, %2" : "=v"(r) : "v"(lo), "v"(hi)); return r; }
#define NSA_SMH(S_, PF_, AL_) do { _Pragma("unroll") for (int t = 0; t < 2; ++t) { const bool rv = (BR == 1) ? selbit[t] : true; \
        float m0 = fmaxf(fmaxf(fmaxf(S_[0][t][0], S_[0][t][1]), fmaxf(S_[0][t][2], S_[0][t][3])), fmaxf(fmaxf(S_[1][t][0], S_[1][t][1]), fmaxf(S_[1][t][2], S_[1][t][3]))); \
        float mx = rv ? m0 * C1 + bfar : -1e30f; mx = xrow16_max(mx); \
        const bool upd = __builtin_amdgcn_ballot_w64(mx - A.m[t] > NSA_THR) != 0ull; \
        const float mn = upd ? fmaxf(A.m[t], mx) : A.m[t]; AL_[t] = upd ? __builtin_amdgcn_exp2f(A.m[t] - mn) : 1.0f; A.m[t] = mn; \
        const float sh = rv ? bfar - mn : -__builtin_inff(); float pp[2][4]; float ps = 0.f; \
        _Pragma("unroll") for (int k1 = 0; k1 < 2; ++k1) _Pragma("unroll") for (int i = 0; i < 4; ++i) { pp[k1][i] = __builtin_amdgcn_exp2f(S_[k1][t][i] * C1 + sh); ps += pp[k1][i]; } \
        A.l[t] = A.l[t] * AL_[t] + ps; \
        v4u w; w.x = cvtpk_nv(pp[0][0], pp[0][1]); w.y = cvtpk_nv(pp[0][2], pp[0][3]); w.z = cvtpk_nv(pp[1][0], pp[1][1]); w.w = cvtpk_nv(pp[1][2], pp[1][3]); PF_[t] = __builtin_bit_cast(bf16x8_t, w); } } while (0)
#define NSA_QKH(S_, H_) do { _Pragma("unroll") for (int k1 = 0; k1 < 2; ++k1) { S_[k1][0] = (f32x4){0.f, 0.f, 0.f, 0.f}; S_[k1][1] = (f32x4){0.f, 0.f, 0.f, 0.f}; } \
        _Pragma("unroll") for (int ks = 0; ks < 4; ++ks) { \
            const bf16x8_t q0 = (NSA_QREG && ks < NSA_QREG_KS) ? qr[ks][0] : *(LAS const bf16x8_t*)(qb + ks * 64), q1 = (NSA_QREG && ks < NSA_QREG_KS) ? qr[ks][1] : *(LAS const bf16x8_t*)(qb + 16 * NT_ROWB + ks * 64); \
            bf16x8_t kf[2]; _Pragma("unroll") for (int k1 = 0; k1 < 2; ++k1) kf[k1] = *(LAS const bf16x8_t*)(kb + (2 * (H_) + k1) * 4096 + (((g + 4 * ks) ^ ksw) << 4)); \
            _Pragma("unroll") for (int k1 = 0; k1 < 2; ++k1) { S_[k1][0] = __builtin_amdgcn_mfma_f32_16x16x32_bf16(kf[k1], q0, S_[k1][0], 0, 0, 0); S_[k1][1] = __builtin_amdgcn_mfma_f32_16x16x32_bf16(kf[k1], q1, S_[k1][1], 0, 0, 0); } } } while (0)
#define NSA_PVH(PF_, H_) do { _Pragma("unroll") for (int d4 = 0; d4 < 2; ++d4) { bf16x8_t vf[4]; \
        _Pragma("unroll") for (int q = 0; q < 4; ++q) { const int dt = 4 * d4 + q; const s16x4_t lo = tr_rd(vb + (32 * (H_)) * 256 + ((dt * 32) ^ vsw)), hi = tr_rd(vb + (32 * (H_) + 16) * 256 + ((dt * 32) ^ vsw)); \
            vf[q] = __builtin_shufflevector(lo, hi, 0, 1, 2, 3, 4, 5, 6, 7); } \
        _Pragma("unroll") for (int q = 0; q < 4; ++q) { const int dt = 4 * d4 + q; \
            A.o[dt][0] = __builtin_amdgcn_mfma_f32_16x16x32_bf16(vf[q], PF_[0], A.o[dt][0], 0, 0, 0); A.o[dt][1] = __builtin_amdgcn_mfma_f32_16x16x32_bf16(vf[q], PF_[1], A.o[dt][1], 0, 0, 0); } } } while (0)
#define NSA_RESC(AL_) do { if (__builtin_amdgcn_ballot_w64(AL_[0] != 1.0f || AL_[1] != 1.0f) != 0ull) { _Pragma("unroll") for (int dt = 0; dt < 8; ++dt) { A.o[dt][0] *= AL_[0]; A.o[dt][1] *= AL_[1]; } } } while (0)
template <int BR>
__device__ __forceinline__ void nsa_fast_half(LAS const unsigned char* lds, int buf, int wave, NsaAcc& A, const bool (&selbit)[2], int rhead, int lane_in, const bf16x8_t (&qr)[4][2]) {
    int lane = lane_in; asm volatile("" : "+v"(lane));
    const int n = lane & 15, g = lane >> 4;
    LAS const unsigned char* kb = lds + NL_K + buf * NT_TILEB + n * 256; const int ksw = (n & 7) << 1;
    LAS const unsigned char* qb = lds + NL_Q + (32 * wave + n) * NT_ROWB + g * 16;
    LAS const unsigned char* vb = lds + NL_V + buf * NT_TILEB + (4 * g + (n >> 2)) * 256 + (n & 3) * 8; const int vsw = ((4 * g + (n >> 2)) & 7) << 5;
    const float C1 = 0.08838834764831845f * 1.4426950408889634f;
    const float bfar = ((LAS const float*)(lds + NL_BIAS))[rhead * 128 + 127];
    f32x4 sa[2][2], sb[2][2]; bf16x8_t pfa[2], pfb[2]; float ala[2], alb[2];
    NSA_QKH(sa, 0);
    NSA_HSB();
    const bool swp = (NSA_SWAPSEL(__builtin_amdgcn_readfirstlane(wave)) & 1) != 0;
    pfa[0] = pfa[1] = pfb[0] = pfb[1] = (bf16x8_t){0, 0, 0, 0, 0, 0, 0, 0}; ala[0] = ala[1] = alb[0] = alb[1] = 1.0f;
#pragma nounroll
    for (int st = 0; st < 2; ++st) { if ((st != 0) == swp) { NSA_QKH(sb, 1); } else { NSA_SMH(sa, pfa, ala); } NSA_HSB(); }
    NSA_HSB();
    NSA_RESC(ala);
#pragma nounroll
    for (int st = 0; st < 2; ++st) { if ((st != 0) == swp) { NSA_PVH(pfa, 0); } else { NSA_SMH(sb, pfb, alb); } NSA_HSB(); }
    NSA_HSB();
    NSA_RESC(alb);
    NSA_PVH(pfb, 1);
}
template <int BR, int ACT = 3>
__device__ __forceinline__ void nsa_tile(LAS const unsigned char* lds, int buf, int wave, NsaAcc& A, f32x4 (&imp)[4][2], int pos0, const int (&qpos)[2], const bool (&selbit)[2], bool far, bool FAST, int rhead, int lane_in, bool pre, const NsaTileSrc& nsrc, int tid, NsaRegs& R, const bf16x8_t (&qr)[4][2]) {
    int lane = lane_in; asm volatile("" : "+v"(lane));
    const int n = lane & 15, g = lane >> 4;
    if (BR != 0 && pre) { if (NSA_DMA) nsa_dma((LAS unsigned char*)lds, buf ^ 1, wave, lane, nsrc); else nsa_ld(nsrc, tid, R); }
#if NSA_HALF
    if constexpr (BR != 0 && ACT == 3 && NSA_DMA) { if (FAST) { nsa_fast_half<BR>(lds, buf, wave, A, selbit, rhead, lane, qr); return; } }
#endif
    constexpr bool SWZ = NSA_DMA && BR != 0;
    LAS const unsigned char* kb = SWZ ? lds + nsa_koff(buf) + n * 256 : lds + NL_K + buf * NT_TILEB + n * NT_ROWB + g * 16;
    const int ksw = (n & 7) << 1;
    LAS const unsigned char* qb = lds + NL_Q + (32 * wave + n) * NT_ROWB + g * 16;
    constexpr bool act0 = (ACT & 1) != 0, act1 = (ACT & 2) != 0;
    f32x4 s[4][2];
#pragma unroll
    for (int kt = 0; kt < 4; ++kt) { s[kt][0] = (f32x4){0.f, 0.f, 0.f, 0.f}; s[kt][1] = (f32x4){0.f, 0.f, 0.f, 0.f}; }
    NSA_PRIO(1);
#if NSA_PFK
    if constexpr (SWZ) {
        bf16x8_t kfa[4][4], qa[4][2];
#pragma unroll
        for (int ks = 0; ks < 4; ++ks) {
            if (!(NSA_QREG && ks < NSA_QREG_KS)) { qa[ks][0] = *(LAS const bf16x8_t*)(qb + ks * 64); qa[ks][1] = *(LAS const bf16x8_t*)(qb + 16 * NT_ROWB + ks * 64); }
#pragma unroll
            for (int kt = 0; kt < 4; ++kt) kfa[ks][kt] = *(LAS const bf16x8_t*)(kb + kt * 4096 + (((g + 4 * ks) ^ ksw) << 4)); }
        __builtin_amdgcn_sched_barrier(0);
#pragma unroll
        for (int ks = 0; ks < 4; ++ks) { const bf16x8_t q0 = (NSA_QREG && ks < NSA_QREG_KS) ? qr[ks][0] : qa[ks][0], q1 = (NSA_QREG && ks < NSA_QREG_KS) ? qr[ks][1] : qa[ks][1];
#pragma unroll
            for (int kt = 0; kt < 4; ++kt) {
                if (act0) s[kt][0] = __builtin_amdgcn_mfma_f32_16x16x32_bf16(kfa[ks][kt], q0, s[kt][0], 0, 0, 0);
                if (act1) s[kt][1] = __builtin_amdgcn_mfma_f32_16x16x32_bf16(kfa[ks][kt], q1, s[kt][1], 0, 0, 0); } }
        __builtin_amdgcn_sched_barrier(0);
    } else
#endif
#pragma unroll
    for (int ks = 0; ks < 4; ++ks) { bf16x8_t kf[4];
        const bf16x8_t q0 = (NSA_QREG && BR != 0 && ks < NSA_QREG_KS) ? qr[ks][0] : *(LAS const bf16x8_t*)(qb + ks * 64), q1 = (NSA_QREG && BR != 0 && ks < NSA_QREG_KS) ? qr[ks][1] : *(LAS const bf16x8_t*)(qb + 16 * NT_ROWB + ks * 64);
#pragma unroll
        for (int kt = 0; kt < 4; ++kt) kf[kt] = SWZ ? *(LAS const bf16x8_t*)(kb + kt * 4096 + (((g + 4 * ks) ^ ksw) << 4)) : *(LAS const bf16x8_t*)(kb + kt * 16 * NT_ROWB + ks * 64);
#pragma unroll
        for (int kt = 0; kt < 4; ++kt) {
            if (act0) s[kt][0] = __builtin_amdgcn_mfma_f32_16x16x32_bf16(kf[kt], q0, s[kt][0], 0, 0, 0);
            if (act1) s[kt][1] = __builtin_amdgcn_mfma_f32_16x16x32_bf16(kf[kt], q1, s[kt][1], 0, 0, 0); }
        NSA_SB(); }
    NSA_PRIO(0);
    const float C1 = 0.08838834764831845f * 1.4426950408889634f;
    LAS const float* bl = (LAS const float*)(lds + NL_BIAS) + rhead * 128;
    const float bfar = bl[127];
    bf16x8_t pf[2][2];
#pragma unroll
    for (int t = 0; t < 2; ++t) {
        NSA_SB2();
        if (!(t == 0 ? act0 : act1)) { pf[0][t] = (bf16x8_t){0, 0, 0, 0, 0, 0, 0, 0}; pf[1][t] = pf[0][t]; continue; }
        float x[4][4]; bool vld[4][4]; float mx = -1e30f; float ps = 0.f; float p[4][4]; float mn, al;
        if (FAST) {
            const bool rv = (BR == 1) ? selbit[t] : true;
            float m0 = fmaxf(fmaxf(s[0][t][0], s[0][t][1]), fmaxf(s[0][t][2], s[0][t][3]));
#pragma unroll
            for (int kt = 1; kt < 4; ++kt) m0 = fmaxf(m0, fmaxf(fmaxf(s[kt][t][0], s[kt][t][1]), fmaxf(s[kt][t][2], s[kt][t][3])));
            mx = rv ? m0 * C1 + bfar : -1e30f;
            mx = xrow16_max(mx);
            if (__builtin_amdgcn_ballot_w64(mx - A.m[t] > NSA_THR) != 0ull) { mn = fmaxf(A.m[t], mx); al = __builtin_amdgcn_exp2f(A.m[t] - mn); A.m[t] = mn; } else { mn = A.m[t]; al = 1.0f; }
            const float sh = rv ? bfar - mn : -__builtin_inff();
#pragma unroll
            for (int kt = 0; kt < 4; ++kt)
#pragma unroll
                for (int i = 0; i < 4; ++i) { p[kt][i] = __builtin_amdgcn_exp2f(s[kt][t][i] * C1 + sh); ps += p[kt][i]; }
        } else {
#if NSA_BIASASM
        if (((NSA_BIASASM_MASK >> BR) & 1) && !far) {
            const unsigned blb = (unsigned)(unsigned long)bl;
#pragma unroll
            for (int h2 = 0; h2 < 2; ++h2) { float bb[2][4];
#pragma unroll
                for (int k1 = 0; k1 < 2; ++k1)
#pragma unroll
                    for (int i = 0; i < 4; ++i) { const int kk = 16 * (2 * h2 + k1) + 4 * g + i; const int dist = (BR == 0) ? qpos[t] - (16 * (pos0 + kk) + 31) : qpos[t] - (pos0 + kk);
                        const int dd = dist < 0 ? 0 : (dist > 127 ? 127 : dist); const unsigned a = blb + 4u * (unsigned)dd;
                        asm volatile("ds_read_b32 %0, %1" : "=v"(bb[k1][i]) : "v"(a)); }
                asm volatile("s_waitcnt lgkmcnt(0)" : "+v"(bb[0][0]), "+v"(bb[0][1]), "+v"(bb[0][2]), "+v"(bb[0][3]), "+v"(bb[1][0]), "+v"(bb[1][1]), "+v"(bb[1][2]), "+v"(bb[1][3]));
#pragma unroll
                for (int k1 = 0; k1 < 2; ++k1)
#pragma unroll
                    for (int i = 0; i < 4; ++i) { const int kt = 2 * h2 + k1; const int kk = 16 * kt + 4 * g + i; int dist; bool v;
                        if (BR == 0) { const int c = pos0 + kk; dist = qpos[t] - (16 * c + 31); v = dist >= 0 && c < 255; }
                        else if (BR == 1) { dist = qpos[t] - (pos0 + kk); v = dist >= 0 && selbit[t]; }
                        else { dist = qpos[t] - (pos0 + kk); v = dist >= 0 && dist < 512; }
                        x[kt][i] = s[kt][t][i] * C1 + bb[k1][i]; vld[kt][i] = v; mx = fmaxf(mx, v ? x[kt][i] : -1e30f); } }
        } else
#endif
        {
#pragma unroll
        for (int kt = 0; kt < 4; ++kt)
#pragma unroll
            for (int i = 0; i < 4; ++i) { const int kk = 16 * kt + 4 * g + i; int dist; bool v;
                if (BR == 0) { const int c = pos0 + kk; dist = qpos[t] - (16 * c + 31); v = dist >= 0 && c < 255; }
                else if (BR == 1) { dist = qpos[t] - (pos0 + kk); v = dist >= 0 && selbit[t]; }
                else { dist = qpos[t] - (pos0 + kk); v = dist >= 0 && dist < 512; }
                float b2 = bfar; if (!far) { const int dd = dist < 0 ? 0 : (dist > 127 ? 127 : dist); b2 = bl[dd]; }
                x[kt][i] = s[kt][t][i] * C1 + b2; vld[kt][i] = v; mx = fmaxf(mx, v ? x[kt][i] : -1e30f); }
        }
        mx = xrow16_max(mx);
        if (__builtin_amdgcn_ballot_w64(mx - A.m[t] > NSA_THR) != 0ull) { mn = fmaxf(A.m[t], mx); al = __builtin_amdgcn_exp2f(A.m[t] - mn); A.m[t] = mn; } else { mn = A.m[t]; al = 1.0f; }
#pragma unroll
        for (int kt = 0; kt < 4; ++kt)
#pragma unroll
            for (int i = 0; i < 4; ++i) { p[kt][i] = vld[kt][i] ? __builtin_amdgcn_exp2f(x[kt][i] - mn) : 0.f; ps += p[kt][i]; }
        }
        A.l[t] = A.l[t] * al + ps;
        if (__builtin_amdgcn_ballot_w64(al != 1.0f) != 0ull) {
#pragma unroll
            for (int dt = 0; dt < 8; ++dt) A.o[dt][t] *= al;
            if (BR == 0) {
#pragma unroll
                for (int jt = 0; jt < 4; ++jt) imp[jt][t] *= al; } }
#pragma unroll
        for (int k2 = 0; k2 < 2; ++k2) { v4u w; w.x = cvtpk(p[2 * k2][0], p[2 * k2][1]); w.y = cvtpk(p[2 * k2][2], p[2 * k2][3]); w.z = cvtpk(p[2 * k2 + 1][0], p[2 * k2 + 1][1]); w.w = cvtpk(p[2 * k2 + 1][2], p[2 * k2 + 1][3]);
            pf[k2][t] = __builtin_bit_cast(bf16x8_t, w); }
    }
    NSA_SB2();
    if (BR == 0 && pre) nsa_ld(nsrc, tid, R);
    NSA_SB2();
    NSA_PRIO(1);
    LAS const unsigned char* vb = SWZ ? lds + nsa_voff(buf) + (4 * g + (n >> 2)) * 256 + (n & 3) * 8 : lds + NL_V + buf * NT_TILEB + (4 * g + (n >> 2)) * NT_ROWB + (n & 3) * 8;
    const int vsw = ((4 * g + (n >> 2)) & 7) << 5;
#if NSA_PFV
    if constexpr (SWZ) {
#pragma unroll
        for (int k2 = 0; k2 < 2; ++k2) { bf16x8_t vfa[8];
#if NSA_TRASM
            s16x4_t lo_[8], hi_[8];
#pragma unroll
            for (int dt = 0; dt < 8; ++dt) { const unsigned a0 = (unsigned)(unsigned long)(vb + (32 * k2) * 256) + (unsigned)((dt * 32) ^ vsw);
                asm volatile("ds_read_b64_tr_b16 %0, %1" : "=v"(lo_[dt]) : "v"(a0)); asm volatile("ds_read_b64_tr_b16 %0, %1 offset:4096" : "=v"(hi_[dt]) : "v"(a0)); }
            asm volatile("s_waitcnt lgkmcnt(0)" : "+v"(lo_[0]), "+v"(lo_[1]), "+v"(lo_[2]), "+v"(lo_[3]), "+v"(lo_[4]), "+v"(lo_[5]), "+v"(lo_[6]), "+v"(lo_[7]),
                         "+v"(hi_[0]), "+v"(hi_[1]), "+v"(hi_[2]), "+v"(hi_[3]), "+v"(hi_[4]), "+v"(hi_[5]), "+v"(hi_[6]), "+v"(hi_[7]));
#pragma unroll
            for (int dt = 0; dt < 8; ++dt) vfa[dt] = __builtin_shufflevector(lo_[dt], hi_[dt], 0, 1, 2, 3, 4, 5, 6, 7);
#else
#pragma unroll
            for (int dt = 0; dt < 8; ++dt) { const s16x4_t lo = tr_rd(vb + (32 * k2) * 256 + ((dt * 32) ^ vsw)), hi = tr_rd(vb + (32 * k2 + 16) * 256 + ((dt * 32) ^ vsw)); vfa[dt] = __builtin_shufflevector(lo, hi, 0, 1, 2, 3, 4, 5, 6, 7); }
#endif
            __builtin_amdgcn_sched_barrier(0);
#pragma unroll
            for (int dt = 0; dt < 8; ++dt) {
                if (act0) A.o[dt][0] = __builtin_amdgcn_mfma_f32_16x16x32_bf16(vfa[dt], pf[k2][0], A.o[dt][0], 0, 0, 0);
                if (act1) A.o[dt][1] = __builtin_amdgcn_mfma_f32_16x16x32_bf16(vfa[dt], pf[k2][1], A.o[dt][1], 0, 0, 0); }
            __builtin_amdgcn_sched_barrier(0); }
    } else
#endif
#pragma unroll
    for (int k2 = 0; k2 < 2; ++k2)
#pragma unroll
        for (int d4 = 0; d4 < 2; ++d4) { bf16x8_t vf[4];
#pragma unroll
            for (int q = 0; q < 4; ++q) { const int dt = 4 * d4 + q; const s16x4_t lo = SWZ ? tr_rd(vb + (32 * k2) * 256 + ((dt * 32) ^ vsw)) : tr_rd(vb + (32 * k2) * NT_ROWB + dt * 32), hi = SWZ ? tr_rd(vb + (32 * k2 + 16) * 256 + ((dt * 32) ^ vsw)) : tr_rd(vb + (32 * k2 + 16) * NT_ROWB + dt * 32);
                vf[q] = __builtin_shufflevector(lo, hi, 0, 1, 2, 3, 4, 5, 6, 7); }
#pragma unroll
            for (int q = 0; q < 4; ++q) { const int dt = 4 * d4 + q;
                if (act0) A.o[dt][0] = __builtin_amdgcn_mfma_f32_16x16x32_bf16(vf[q], pf[k2][0], A.o[dt][0], 0, 0, 0);
                if (act1) A.o[dt][1] = __builtin_amdgcn_mfma_f32_16x16x32_bf16(vf[q], pf[k2][1], A.o[dt][1], 0, 0, 0); }
            NSA_SB(); }
    NSA_PRIO(0);
    if (BR == 0) {
#pragma unroll
        for (int jt = 0; jt < 4; ++jt) { if (16 * jt > (pos0 >> 2) + 16 || 16 * jt + 15 < (pos0 >> 2)) continue;
            const int jb = 16 * jt + n;
#pragma unroll
            for (int k2 = 0; k2 < 2; ++k2) { unsigned short e[8];
#pragma unroll
                for (int q = 0; q < 8; ++q) { const int c = pos0 + 32 * k2 + (q < 4 ? 4 * g + q : 16 + 4 * g + (q - 4)); const int dz = c - 4 * jb;
                    e[q] = (c < 255) ? ((dz == -1 || dz == 3) ? 0x3F80 : ((dz >= 0 && dz <= 2) ? 0x4000 : 0)) : 0; }
                v4u w; w.x = e[0] | ((unsigned)e[1] << 16); w.y = e[2] | ((unsigned)e[3] << 16); w.z = e[4] | ((unsigned)e[5] << 16); w.w = e[6] | ((unsigned)e[7] << 16);
                const bf16x8_t mf = __builtin_bit_cast(bf16x8_t, w);
                imp[jt][0] = __builtin_amdgcn_mfma_f32_16x16x32_bf16(mf, pf[k2][0], imp[jt][0], 0, 0, 0);
                imp[jt][1] = __builtin_amdgcn_mfma_f32_16x16x32_bf16(mf, pf[k2][1], imp[jt][1], 0, 0, 0); } }
    }
}
template <bool ACCUM>
__device__ __forceinline__ void nsa_flush(NsaAcc& A, bf16* ON, const bf16* U, int b, int q0, int gk, int wave, int br, int lane_in) {
    int lane = lane_in; asm volatile("" : "+v"(lane)); const int n = lane & 15, g = lane >> 4, rhead = n & 3;
    unsigned short gw_[2]; v2u old_[2][8];
#pragma unroll
    for (int t = 0; t < 2; ++t) { const size_t tok = (size_t)b * SEQ + q0 + ((32 * wave + 16 * t + n) >> 2);
        gw_[t] = U[tok * LDU + U_NG + (gk * 4 + rhead) * 3 + br];
        if (ACCUM) { const bf16* orow_t = ON + tok * 2048 + (gk * 4 + rhead) * 128;
#pragma unroll
            for (int dt = 0; dt < 8; ++dt) old_[t][dt] = *(const GAS v2u*)(orow_t + 16 * dt + 4 * g); } }
    __builtin_amdgcn_sched_barrier(0);
#pragma unroll
    for (int t = 0; t < 2; ++t) { const float l = xrow16_sum(A.l[t]); A.l[t] = l;
        const size_t tok = (size_t)b * SEQ + q0 + ((32 * wave + 16 * t + n) >> 2);
        const float gate = __uint_as_float((unsigned)gw_[t] << 16); const float sc = l > 0.f ? gate / l : 0.f;
        bf16* orow_t = ON + tok * 2048 + (gk * 4 + rhead) * 128;
#pragma unroll
        for (int dt = 0; dt < 8; ++dt) { GAS v2u* p = (GAS v2u*)(orow_t + 16 * dt + 4 * g); f32x4 v = A.o[dt][t] * sc;
            if (ACCUM) { const v2u w = old_[t][dt]; v[0] += bfl(w.x); v[1] += bfh(w.x); v[2] += bfl(w.y); v[3] += bfh(w.y); }
            v2u w; w.x = cvtpk(v[0], v[1]); w.y = cvtpk(v[2], v[3]); *p = w; } }
}
__device__ __forceinline__ void nsa_acc_reset(NsaAcc& A) {
#pragma unroll
    for (int t = 0; t < 2; ++t) { A.m[t] = -1e30f; A.l[t] = 0.f;
#pragma unroll
        for (int dt = 0; dt < 8; ++dt) A.o[dt][t] = (f32x4){0.f, 0.f, 0.f, 0.f}; }
}
__device__ __forceinline__ void nsa_wg_item(Frame& F, KArgs ap, int item, size_t on_off) {
    unsigned char* ws_ = ap->ws;
    const int qt = item & 63, gk = (item >> 6) & 3, b = item >> 8;
    int lane = F.lane; asm volatile("" : "+v"(lane));
    const int wave = F.wave, tid = wave * 64 + lane, n = lane & 15, g = lane >> 4;
    LAS unsigned char* lds = F.lds;
    const bf16* U = (const bf16*)(ws_ + WS_U); const bf16* OC = (const bf16*)(ws_ + WS_OC); bf16* ON = (bf16*)(ws_ + on_off);
    const int q0 = 64 * qt, rhead = n & 3;
    int qpos[2];
#pragma unroll
    for (int t = 0; t < 2; ++t) qpos[t] = q0 + ((32 * wave + 16 * t + n) >> 2);
#pragma unroll
    for (int i = 0; i < 8; ++i) { const int cid = tid + 512 * i, row = cid >> 4, c16 = cid & 15;
        const v4u w = *(const GAS v4u*)(U + ((size_t)b * SEQ + q0 + (row >> 2)) * LDU + U_NQ + (gk * 4 + (row & 3)) * 128 + c16 * 8);
        *(LAS v4u*)(lds + NL_Q + row * NT_ROWB + c16 * 16) = w; }
    { LAS float* bl = (LAS float*)(lds + NL_BIAS); const int r = tid >> 7, dd = tid & 127; bl[tid] = ap->in[12][REL_LUT[dd] * 16 + gk * 4 + r] * 1.4426950408889634f; }
    NsaAcc A; f32x4 imp[4][2]; NsaRegs R; const bool nosel[2] = {true, true}; bf16x8_t qr[4][2];
    nsa_acc_reset(A);
#pragma unroll
    for (int jt = 0; jt < 4; ++jt) { imp[jt][0] = (f32x4){0.f, 0.f, 0.f, 0.f}; imp[jt][1] = (f32x4){0.f, 0.f, 0.f, 0.f}; }
    { const unsigned char* kbase = (const unsigned char*)(OC + (size_t)((b * 4 + gk) * 256) * 256); const unsigned char* vbase = (const unsigned char*)(OC + (size_t)(4096 + (b * 4 + gk) * 256) * 256 + 128);
      const int ntile = (q0 + 63 >= 31) ? (((q0 + 63 - 31) >> 4) >> 6) + 1 : 0;
      NsaTileSrc src{kbase, vbase, 512u};
      if (ntile > 0) { nsa_ld(src, tid, R); nsa_st(lds, 0, tid, R); }
      __syncthreads();
      for (int i = 0; i < ntile; ++i) {
          const NsaTileSrc s2{kbase + (size_t)(i + 1) * 64 * 512, vbase + (size_t)(i + 1) * 64 * 512, 512u};
          const bool far = (q0 - (16 * (64 * i + 63) + 31)) >= 128;
          nsa_tile<0>(lds, i & 1, wave, A, imp, 64 * i, qpos, nosel, far, far, rhead, lane, i + 1 < ntile, s2, tid, R, qr);
          if (i + 1 < ntile) nsa_st(lds, (i + 1) & 1, tid, R);
          __syncthreads();
      }
      nsa_flush<false>(A, ON, U, b, q0, gk, wave, 0, lane);
    }
    unsigned long long mymask[2];
    { LAS float* ib = (LAS float*)(lds + NL_IMP) + wave * 512;
#pragma unroll
      for (int t = 0; t < 2; ++t) { const float inv = A.l[t] > 0.f ? 1.f / A.l[t] : 0.f;
#pragma unroll
          for (int jt = 0; jt < 4; ++jt) { f32x4 v = imp[jt][t] * inv;
#pragma unroll
              for (int i = 0; i < 4; ++i) v[i] = quad_sum(v[i]);
              if (rhead == 0) *(LAS f32x4*)(ib + (4 * t + (n >> 2)) * 64 + 16 * jt + 4 * g) = v; } }
      LDS_WAIT(); __builtin_amdgcn_wave_barrier(); asm volatile("" ::: "memory");
      const int qw = lane >> 3, js = lane & 7; const int cur = qt;
      unsigned lo = 0u, hi = 0u;
      if (cur < 16) { const unsigned long long all = (cur >= 63) ? ~0ull : ((1ull << (cur + 1)) - 1ull); lo = (unsigned)all; hi = (unsigned)(all >> 32); }
      else {
          float sc[64];
#pragma unroll
          for (int j4 = 0; j4 < 16; ++j4) { const f32x4 v = *(LAS const f32x4*)(ib + qw * 64 + 4 * j4);
#pragma unroll
              for (int i = 0; i < 4; ++i) { const int j = 4 * j4 + i; const bool forced = (j == 0) || (j <= cur && j > cur - 2); sc[j] = forced ? 1e4f : (j <= cur ? v[i] : -1e4f); } }
#pragma unroll
          for (int k = 0; k < 8; ++k) { const int j = js + 8 * k; const bool forced = (j == 0) || (j <= cur && j > cur - 2); const float mine = forced ? 1e4f : (j <= cur ? ib[qw * 64 + j] : -1e4f);
              int rank = 0;
#pragma unroll
              for (int jp = 0; jp < 64; ++jp) rank += (sc[jp] > mine || (sc[jp] == mine && jp < j)) ? 1 : 0;
              const bool sel = rank < 16 && j <= cur;
              if (k < 4) lo |= sel ? (1u << (js + 8 * k)) : 0u; else hi |= sel ? (1u << (js + 8 * (k - 4))) : 0u; }
          lo |= __shfl_xor(lo, 1); lo |= __shfl_xor(lo, 2); lo |= __shfl_xor(lo, 4); hi |= __shfl_xor(hi, 1); hi |= __shfl_xor(hi, 2); hi |= __shfl_xor(hi, 4);
      }
      LAS unsigned* sm = (LAS unsigned*)(lds + NL_SELM) + wave * 16;
      if (js == 0) { sm[2 * qw] = lo; sm[2 * qw + 1] = hi; }
      unsigned ulo = lo, uhi = hi;
      ulo |= __shfl_xor(ulo, 8); ulo |= __shfl_xor(ulo, 16); ulo |= __shfl_xor(ulo, 32); uhi |= __shfl_xor(uhi, 8); uhi |= __shfl_xor(uhi, 16); uhi |= __shfl_xor(uhi, 32);
      LAS unsigned* wu = (LAS unsigned*)(lds + NL_WUN);
      if (lane == 0) { wu[2 * wave] = ulo; wu[2 * wave + 1] = uhi; }
      LDS_WAIT(); __builtin_amdgcn_wave_barrier(); asm volatile("" ::: "memory");
#pragma unroll
      for (int t = 0; t < 2; ++t) { const int qi = 4 * t + (n >> 2); mymask[t] = (unsigned long long)sm[2 * qi] | ((unsigned long long)sm[2 * qi + 1] << 32); }
    }
    __syncthreads();
    unsigned long long wgmask = 0ull, wvmask;
    { LAS const unsigned* wu = (LAS const unsigned*)(lds + NL_WUN);
#pragma unroll
      for (int w = 0; w < 8; ++w) wgmask |= (unsigned long long)wu[2 * w] | ((unsigned long long)wu[2 * w + 1] << 32);
      wvmask = (unsigned long long)wu[2 * wave] | ((unsigned long long)wu[2 * wave + 1] << 32);
      wgmask = ((unsigned long long)__builtin_amdgcn_readfirstlane((unsigned)(wgmask >> 32)) << 32) | (unsigned)__builtin_amdgcn_readfirstlane((unsigned)wgmask);
      wvmask = ((unsigned long long)__builtin_amdgcn_readfirstlane((unsigned)(wvmask >> 32)) << 32) | (unsigned)__builtin_amdgcn_readfirstlane((unsigned)wvmask); }
    nsa_acc_reset(A);
#if NSA_QREG
    { int l2 = lane; asm volatile("" : "+v"(l2)); LAS const unsigned char* qb = lds + NL_Q + (32 * wave + (l2 & 15)) * NT_ROWB + (l2 >> 4) * 16;
#pragma unroll
      for (int ks = 0; ks < NSA_QREG_KS; ++ks) { qr[ks][0] = *(LAS const bf16x8_t*)(qb + ks * 64); qr[ks][1] = *(LAS const bf16x8_t*)(qb + 16 * NT_ROWB + ks * 64); } }
#endif
    { const unsigned char* kbase = (const unsigned char*)(U + (size_t)b * SEQ * LDU + U_KSL + gk * 128); const unsigned char* vbase = (const unsigned char*)(U + (size_t)b * SEQ * LDU + U_VSL + gk * 128);
      for (int dup_ = 0; dup_ < NSA_DUPSEL; ++dup_) { if (NSA_DUPSEL > 1) { int one_ = 1; asm volatile("" : "+s"(one_)); if (one_) nsa_acc_reset(A); }
#if NSA_PAIR
      { LAS unsigned char* jl = lds + NL_JL;
        if (tid < 64 && ((wgmask >> tid) & 1ull)) jl[__builtin_popcountll(wgmask & ((1ull << tid) - 1ull))] = (unsigned char)tid;
        const int nsel = __builtin_popcountll(wgmask);
        __syncthreads();
#pragma unroll
        for (int e = 0; e < 2; ++e) if (e < nsel) { const int j = jl[e]; const NsaTileSrc src{kbase + (size_t)j * 64 * LDU * 2, vbase + (size_t)j * 64 * LDU * 2, (unsigned)(LDU * 2)}; nsa_dma(lds, e, wave, lane, src); }
        NSA_DMA_WAIT(); __syncthreads();
        for (int it = 0; 2 * it < nsel; ++it) { const int st = it & 1;
#pragma unroll
            for (int e = 0; e < 2; ++e) { const int idx = 2 * (it + 1) + e; if (idx < nsel) { const int j = jl[idx]; const NsaTileSrc src{kbase + (size_t)j * 64 * LDU * 2, vbase + (size_t)j * 64 * LDU * 2, (unsigned)(LDU * 2)}; nsa_dma(lds, (st ^ 1) * 2 + e, wave, lane, src); } }
            const NsaTileSrc s2{kbase, vbase, (unsigned)(LDU * 2)};
#pragma unroll
            for (int e = 0; e < 2; ++e) { const int idx = 2 * it + e; if (idx >= nsel) break; const int j = jl[idx];
                if ((wvmask >> j) & 1ull) { const bool sb[2] = {(bool)((mymask[0] >> j) & 1ull), (bool)((mymask[1] >> j) & 1ull)}; const bool far = (q0 - (64 * j + 63)) >= 128;
                    const bool a0 = __builtin_amdgcn_ballot_w64(sb[0]) != 0ull, a1 = __builtin_amdgcn_ballot_w64(sb[1]) != 0ull;
                    if (NSA_ACT3ONLY || (a0 && a1)) nsa_tile<1, 3>(lds, st * 2 + e, wave, A, imp, 64 * j, qpos, sb, far, far, rhead, lane, false, s2, tid, R, qr);
                    else if (a0) nsa_tile<1, 1>(lds, st * 2 + e, wave, A, imp, 64 * j, qpos, sb, far, far, rhead, lane, false, s2, tid, R, qr);
                    else nsa_tile<1, 2>(lds, st * 2 + e, wave, A, imp, 64 * j, qpos, sb, far, far, rhead, lane, false, s2, tid, R, qr); } }
            NSA_DMA_WAIT(); __syncthreads(); } }
      }
#else
      unsigned long long rem = wgmask; int j = __builtin_ctzll(rem); rem &= rem - 1;
      { NsaTileSrc src{kbase + (size_t)j * 64 * LDU * 2, vbase + (size_t)j * 64 * LDU * 2, (unsigned)(LDU * 2)};
        if (NSA_DMA) { nsa_dma(lds, 0, wave, lane, src); NSA_DMA_WAIT(); } else { nsa_ld(src, tid, R); nsa_st(lds, 0, tid, R); } }
      __syncthreads();
      for (int i = 0;; ++i) {
          const bool more = rem != 0ull; int jn = 0;
          if (more) { jn = __builtin_ctzll(rem); rem &= rem - 1; }
          const NsaTileSrc s2{kbase + (size_t)jn * 64 * LDU * 2, vbase + (size_t)jn * 64 * LDU * 2, (unsigned)(LDU * 2)};
          if ((wvmask >> j) & 1ull) { const bool sb[2] = {(bool)((mymask[0] >> j) & 1ull), (bool)((mymask[1] >> j) & 1ull)}; const bool far = (q0 - (64 * j + 63)) >= 128;
              const bool a0 = __builtin_amdgcn_ballot_w64(sb[0]) != 0ull, a1 = __builtin_amdgcn_ballot_w64(sb[1]) != 0ull;
              if (NSA_ACT3ONLY || (a0 && a1)) nsa_tile<1, 3>(lds, i & 1, wave, A, imp, 64 * j, qpos, sb, far, far, rhead, lane, more, s2, tid, R, qr);
              else if (a0) nsa_tile<1, 1>(lds, i & 1, wave, A, imp, 64 * j, qpos, sb, far, far, rhead, lane, more, s2, tid, R, qr);
              else nsa_tile<1, 2>(lds, i & 1, wave, A, imp, 64 * j, qpos, sb, far, far, rhead, lane, more, s2, tid, R, qr); }
          else if (more) { if (NSA_DMA) nsa_dma(lds, (i + 1) & 1, wave, lane, s2); else nsa_ld(s2, tid, R); }
          if (NSA_DMA) NSA_DMA_WAIT(); else if (more) nsa_st(lds, (i + 1) & 1, tid, R);
          __syncthreads();
          if (!more) break;
          j = jn;
      }
      }
#endif
      nsa_flush<true>(A, ON, U, b, q0, gk, wave, 1, lane);
    }
    nsa_acc_reset(A);
    { const unsigned char* kbase = (const unsigned char*)(U + (size_t)b * SEQ * LDU + U_KW + gk * 128); const unsigned char* vbase = (const unsigned char*)(U + (size_t)b * SEQ * LDU + U_VW + gk * 128);
      const int j0 = qt >= 8 ? qt - 8 : 0, ntile = qt - j0 + 1;
      for (int dup_ = 0; dup_ < NSA_DUPWIN; ++dup_) { if (NSA_DUPWIN > 1) { int one_ = 1; asm volatile("" : "+s"(one_)); if (one_) nsa_acc_reset(A); }
#if NSA_PAIR
      {
#pragma unroll
        for (int e = 0; e < 2; ++e) if (e < ntile) { const int j = j0 + e; const NsaTileSrc src{kbase + (size_t)j * 64 * LDU * 2, vbase + (size_t)j * 64 * LDU * 2, (unsigned)(LDU * 2)}; nsa_dma(lds, e, wave, lane, src); }
        NSA_DMA_WAIT(); __syncthreads();
        for (int it = 0; 2 * it < ntile; ++it) { const int st = it & 1;
#pragma unroll
            for (int e = 0; e < 2; ++e) { const int idx = 2 * (it + 1) + e; if (idx < ntile) { const int j = j0 + idx; const NsaTileSrc src{kbase + (size_t)j * 64 * LDU * 2, vbase + (size_t)j * 64 * LDU * 2, (unsigned)(LDU * 2)}; nsa_dma(lds, (st ^ 1) * 2 + e, wave, lane, src); } }
            const NsaTileSrc s2{kbase, vbase, (unsigned)(LDU * 2)};
#pragma unroll
            for (int e = 0; e < 2; ++e) { const int idx = 2 * it + e; if (idx >= ntile) break; const int j = j0 + idx; const bool far = (q0 - (64 * j + 63)) >= 128;
                nsa_tile<2>(lds, st * 2 + e, wave, A, imp, 64 * j, qpos, nosel, far, far && j > qt - 8, rhead, lane, false, s2, tid, R, qr); }
            NSA_DMA_WAIT(); __syncthreads(); } }
      }
#else
      { NsaTileSrc src{kbase + (size_t)j0 * 64 * LDU * 2, vbase + (size_t)j0 * 64 * LDU * 2, (unsigned)(LDU * 2)};
        if (NSA_DMA) { nsa_dma(lds, 0, wave, lane, src); NSA_DMA_WAIT(); } else { nsa_ld(src, tid, R); nsa_st(lds, 0, tid, R); } }
      __syncthreads();
      for (int i = 0; i < ntile; ++i) { const int j = j0 + i;
          const NsaTileSrc s2{kbase + (size_t)(j + 1) * 64 * LDU * 2, vbase + (size_t)(j + 1) * 64 * LDU * 2, (unsigned)(LDU * 2)};
          const bool far = (q0 - (64 * j + 63)) >= 128;
          nsa_tile<2>(lds, i & 1, wave, A, imp, 64 * j, qpos, nosel, far, far && j > qt - 8, rhead, lane, i + 1 < ntile, s2, tid, R, qr);
          if (NSA_DMA) NSA_DMA_WAIT(); else if (i + 1 < ntile) nsa_st(lds, (i + 1) & 1, tid, R);
          __syncthreads();
      }
      }
#endif
      nsa_flush<true>(A, ON, U, b, q0, gk, wave, 2, lane);
    }
    __syncthreads();
}

constexpr int GP = 288;
constexpr int GL_QE = 0, GL_KE = 64 * GP, GL_KD = 2 * 64 * GP, GL_V = 3 * 64 * GP, GL_ST = 4 * 64 * GP, GL_W2 = GL_ST + 128 * GP, GL_BAL = GL_W2 + 4096, GL_ALR = GL_BAL + 256, GL_WT = GL_ALR + 4096,
              GL_DEC = GL_WT + 2048, GL_SSQ = GL_DEC + 256, GL_END = GL_SSQ + 512;
static_assert(GL_END <= RING_BYTES, "GLA LDS map");
__device__ __forceinline__ bf16x8_t tr2(LAS const unsigned char* p) { const s16x4_t lo = tr_rd(p), hi = tr_rd(p + 16 * GP); return __builtin_shufflevector(lo, hi, 0, 1, 2, 3, 4, 5, 6, 7); }
__device__ __forceinline__ void gla_chain_mfma(Frame& F, KArgs ap, int bh, size_t og_off = WS_OGLA) {
    unsigned char* ws_ = ap->ws;
    const int b = bh >> 4, h = bh & 15;
    int lane = F.lane; asm volatile("" : "+v"(lane));
    const int wave = F.wave, tid = wave * 64 + lane, n = lane & 15, g = lane >> 4;
    LAS unsigned char* lds = F.lds;
    const bf16* U = (const bf16*)(ws_ + WS_U); bf16* OG = (bf16*)(ws_ + og_off);
    LAS float* W2 = (LAS float*)(lds + GL_W2); LAS float* Bal = (LAS float*)(lds + GL_BAL); LAS float* ALR = (LAS float*)(lds + GL_ALR); LAS float* WT = (LAS float*)(lds + GL_WT);
    LAS float* DEC = (LAS float*)(lds + GL_DEC); LAS float* SSQ = (LAS float*)(lds + GL_SSQ);
    for (int i = tid; i < 1024; i += 512) W2[i] = ap->in[3][(i >> 6) * 1024 + h * 64 + (i & 63)];
    if (tid < 64) Bal[tid] = ap->in[4][h * 64 + tid];
    for (int i = tid; i < 128 * GP / 4; i += 512) ((LAS unsigned*)(lds + GL_ST))[i] = 0u;
    const int tt = wave & 3, eh = wave >> 2;
    f32x4 Sr[4];
#pragma unroll
    for (int el = 0; el < 4; ++el) Sr[el] = (f32x4){0.f, 0.f, 0.f, 0.f};
    f32x4 gain[4];
#pragma unroll
    for (int el = 0; el < 4; ++el) gain[el] = *(const GAS f32x4*)(ap->in[5] + h * 128 + 16 * (4 * eh + el) + 4 * g);
    __syncthreads();
    float w2r[16];
#pragma unroll
    for (int j = 0; j < 16; ++j) w2r[j] = W2[j * 64 + lane];
    const float balr = Bal[lane];
    const int st_t = tid >> 3, st_p = tid & 7;
    unsigned p_aw; v4u p_q, p_k, p_v0, p_v1; v2u p_r[4];
#define GLA_LOAD(cc) do { const size_t tk = (size_t)b * SEQ + (cc) * 64; const bf16* ur = U + (tk + st_t) * LDU; \
        p_aw = *(const GAS unsigned*)(ur + U_GA + 2 * st_p); p_q = *(const GAS v4u*)(ur + U_GQ + h * 64 + st_p * 8); p_k = *(const GAS v4u*)(ur + U_GK + h * 64 + st_p * 8); \
        p_v0 = *(const GAS v4u*)(ur + U_GV + h * 128 + st_p * 16); p_v1 = *(const GAS v4u*)(ur + U_GV + h * 128 + st_p * 16 + 8); \
        _Pragma("unroll") for (int el = 0; el < 4; ++el) p_r[el] = *(const GAS v2u*)(U + (tk + 16 * tt + n) * LDU + U_GR + h * 128 + 16 * (4 * eh + el) + 4 * g); } while (0)
    GLA_LOAD(0);
    for (int c = 0; c < 64; ++c) {
        const size_t tok0 = (size_t)b * SEQ + c * 64;
        ALR[st_t * 16 + 2 * st_p] = bfl(p_aw); ALR[st_t * 16 + 2 * st_p + 1] = bfh(p_aw);
        *(LAS v4u*)(lds + GL_V + st_t * GP + st_p * 32) = p_v0; *(LAS v4u*)(lds + GL_V + st_t * GP + st_p * 32 + 16) = p_v1;
        *(LAS v4u*)(lds + GL_QE + st_t * GP + st_p * 16) = p_q; *(LAS v4u*)(lds + GL_KE + st_t * GP + st_p * 16) = p_k;
        v2u rcur[4];
#pragma unroll
        for (int el = 0; el < 4; ++el) rcur[el] = p_r[el];
        if (c + 1 < 64) GLA_LOAD(c + 1);
        __syncthreads();
        float bc[8]; float run = 0.f;
#pragma unroll
        for (int i = 0; i < 8; ++i) { const LAS f32x4* ar = (const LAS f32x4*)(ALR + (8 * wave + i) * 16); float pre = balr;
#pragma unroll
            for (int j4 = 0; j4 < 4; ++j4) { const f32x4 a = ar[j4]; pre += a.x * w2r[4 * j4] + a.y * w2r[4 * j4 + 1] + a.z * w2r[4 * j4 + 2] + a.w * w2r[4 * j4 + 3]; }
            const float ls = fminf(pre, 0.f) - __logf(1.f + __expf(-fabsf(pre)));
            run += ls * (1.f / 16.f); bc[i] = run; }
        WT[wave * 64 + lane] = run;
        __syncthreads();
        float off = 0.f, tot = 0.f; float qv[8], kv[8];
#pragma unroll
        for (int i = 0; i < 8; ++i) { const int t = 8 * wave + i; qv[i] = __uint_as_float((unsigned)*(LAS const unsigned short*)(lds + GL_QE + t * GP + 2 * lane) << 16); kv[i] = __uint_as_float((unsigned)*(LAS const unsigned short*)(lds + GL_KE + t * GP + 2 * lane) << 16); }
#pragma unroll
        for (int s = 0; s < 8; ++s) { const float wv = WT[s * 64 + lane]; tot += wv; off += (s < wave) ? wv : 0.f; }
#pragma unroll
        for (int i = 0; i < 8; ++i) { const float bcum = bc[i] + off; const int t = 8 * wave + i;
            *(LAS unsigned short*)(lds + GL_QE + t * GP + 2 * lane) = (unsigned short)f2bf(qv[i] * 0.125f * __expf(bcum));
            *(LAS unsigned short*)(lds + GL_KE + t * GP + 2 * lane) = (unsigned short)f2bf(kv[i] * __expf(-bcum));
            *(LAS unsigned short*)(lds + GL_KD + t * GP + 2 * lane) = (unsigned short)f2bf(kv[i] * __expf(tot - bcum)); }
        if (wave == 0) DEC[lane] = __expf(tot);
        __syncthreads();
        f32x4 at[4]; bf16x8_t qfr[2];
#pragma unroll
        for (int st = 0; st < 4; ++st) at[st] = (f32x4){0.f, 0.f, 0.f, 0.f};
#pragma unroll
        for (int ks = 0; ks < 2; ++ks) { qfr[ks] = *(LAS const bf16x8_t*)(lds + GL_QE + (16 * tt + n) * GP + 64 * ks + 16 * g);
#pragma unroll
            for (int st = 0; st < 4; ++st) if (st <= tt) { const bf16x8_t kf = *(LAS const bf16x8_t*)(lds + GL_KE + (16 * st + n) * GP + 64 * ks + 16 * g);
                at[st] = __builtin_amdgcn_mfma_f32_16x16x32_bf16(kf, qfr[ks], at[st], 0, 0, 0); } }
#pragma unroll
        for (int st = 0; st < 4; ++st) if (st == tt) {
#pragma unroll
            for (int i = 0; i < 4; ++i) if (4 * g + i > n) at[st][i] = 0.f; }
        bf16x8_t pf[2];
#pragma unroll
        for (int k2 = 0; k2 < 2; ++k2) { v4u w; w.x = cvtpk(at[2 * k2][0], at[2 * k2][1]); w.y = cvtpk(at[2 * k2][2], at[2 * k2][3]); w.z = cvtpk(at[2 * k2 + 1][0], at[2 * k2 + 1][1]); w.w = cvtpk(at[2 * k2 + 1][2], at[2 * k2 + 1][3]);
            pf[k2] = __builtin_bit_cast(bf16x8_t, w); }
        f32x4 o[4];
#pragma unroll
        for (int el = 0; el < 4; ++el) o[el] = (f32x4){0.f, 0.f, 0.f, 0.f};
        const float dec = DEC[16 * tt + n];
#pragma unroll
        for (int el = 0; el < 4; ++el) Sr[el] *= dec;
        LAS const unsigned char* trb = lds + (4 * g + (n >> 2)) * GP + (n & 3) * 8;
#pragma unroll
        for (int k2 = 0; k2 < 2; ++k2) { const bf16x8_t kdf = tr2(trb + GL_KD + 32 * k2 * GP + 32 * tt);
#pragma unroll
            for (int el = 0; el < 4; ++el) { const bf16x8_t vf = tr2(trb + GL_V + 32 * k2 * GP + 32 * (4 * eh + el));
                if (2 * k2 <= tt) o[el] = __builtin_amdgcn_mfma_f32_16x16x32_bf16(vf, pf[k2], o[el], 0, 0, 0);
                Sr[el] = __builtin_amdgcn_mfma_f32_16x16x32_bf16(vf, kdf, Sr[el], 0, 0, 0); } }
#pragma unroll
        for (int ks = 0; ks < 2; ++ks)
#pragma unroll
            for (int el = 0; el < 4; ++el) { const bf16x8_t sf = *(LAS const bf16x8_t*)(lds + GL_ST + (16 * (4 * eh + el) + n) * GP + 64 * ks + 16 * g);
                o[el] = __builtin_amdgcn_mfma_f32_16x16x32_bf16(sf, qfr[ks], o[el], 0, 0, 0); }
        float ss = 0.f;
#pragma unroll
        for (int el = 0; el < 4; ++el) ss += (o[el][0] * o[el][0] + o[el][1] * o[el][1]) + (o[el][2] * o[el][2] + o[el][3] * o[el][3]);
        ss += __shfl_xor(ss, 16); ss += __shfl_xor(ss, 32);
        if (g == 0) SSQ[(16 * tt + n) * 2 + eh] = ss;
        __syncthreads();
#pragma unroll
        for (int el = 0; el < 4; ++el)
#pragma unroll
            for (int i = 0; i < 4; ++i) *(LAS unsigned short*)(lds + GL_ST + (16 * (4 * eh + el) + 4 * g + i) * GP + 2 * (16 * tt + n)) = (unsigned short)f2bf(Sr[el][i]);
        const int t = 16 * tt + n; const float rstd = 1.f / sqrtf((SSQ[2 * t] + SSQ[2 * t + 1]) * (1.f / 128.f) + NORM_EPS);
#pragma unroll
        for (int el = 0; el < 4; ++el) { const int e0 = 16 * (4 * eh + el) + 4 * g; const v2u rw = rcur[el];
            v2u ow; ow.x = cvtpk(o[el][0] * rstd * gain[el][0] * bfl(rw.x), o[el][1] * rstd * gain[el][1] * bfh(rw.x)); ow.y = cvtpk(o[el][2] * rstd * gain[el][2] * bfl(rw.y), o[el][3] * rstd * gain[el][3] * bfh(rw.y));
            *(GAS v2u*)(OG + (tok0 + t) * 2048 + h * 128 + e0) = ow; }
    }
    __syncthreads();
#undef GLA_LOAD
}
constexpr size_t WS_KD = WS_R2 + 192 * MiB;
constexpr size_t WS_DEC = WS_R2 + 224 * MiB;
constexpr int GQ_ALR = 0, GQ_WT = 4096, GQ_QRAW = 8192, GQ_KRAW = GQ_QRAW + 64 * GP, GQ_QE = GQ_KRAW + 64 * GP, GQ_KE = GQ_QE + 64 * GP, GQ_KD = GQ_KE + 64 * GP, GQ_END = GQ_KD + 64 * GP;
static_assert(GQ_END <= RING_BYTES, "GLA pre-pass LDS map");
__device__ __forceinline__ void gla_pre_items(Frame& F, KArgs ap, int it0, int nw) {
    unsigned char* ws_ = ap->ws;
    int lane = F.lane; asm volatile("" : "+v"(lane));
    const int wave = F.wave, tid = wave * 64 + lane, st_t = tid >> 3, st_p = tid & 7;
    LAS unsigned char* lds = F.lds; LAS float* ALR = (LAS float*)(lds + GQ_ALR); LAS float* WT = (LAS float*)(lds + GQ_WT);
    bf16* U = (bf16*)(ws_ + WS_U); bf16* KD = (bf16*)(ws_ + WS_KD); float* DEC = (float*)(ws_ + WS_DEC);
    const int h = it0 & 15, slot = it0 >> 4, ns = (nw - h + 15) >> 4;
    float w2r[16];
#pragma unroll
    for (int j = 0; j < 16; ++j) w2r[j] = ap->in[3][j * 1024 + h * 64 + lane];
    const float balr = ap->in[4][h * 64 + lane];
    unsigned p_aw; v4u p_q, p_k;
#define GLA_PLOAD(px) do { const bf16* ur = U + ((size_t)((px) >> 6) * SEQ + ((px) & 63) * 64 + st_t) * LDU; \
        p_aw = *(const GAS unsigned*)(ur + U_GA + 2 * st_p); p_q = *(const GAS v4u*)(ur + U_GQ + h * 64 + st_p * 8); p_k = *(const GAS v4u*)(ur + U_GK + h * 64 + st_p * 8); } while (0)
    if (slot < 256) GLA_PLOAD(slot);
    for (int pr = slot; pr < 256; pr += ns) {
        const int b = pr >> 6, c = pr & 63, bh = b * 16 + h; const size_t tok0 = (size_t)b * SEQ + c * 64;
        ALR[st_t * 16 + 2 * st_p] = bfl(p_aw); ALR[st_t * 16 + 2 * st_p + 1] = bfh(p_aw);
        *(LAS v4u*)(lds + GQ_QRAW + st_t * GP + st_p * 16) = p_q; *(LAS v4u*)(lds + GQ_KRAW + st_t * GP + st_p * 16) = p_k;
        if (pr + ns < 256) GLA_PLOAD(pr + ns);
        __syncthreads();
        float bc[8]; float run = 0.f;
#pragma unroll
        for (int i = 0; i < 8; ++i) { const LAS f32x4* ar = (const LAS f32x4*)(ALR + (8 * wave + i) * 16); float pre = balr;
#pragma unroll
            for (int j4 = 0; j4 < 4; ++j4) { const f32x4 a = ar[j4]; pre += a.x * w2r[4 * j4] + a.y * w2r[4 * j4 + 1] + a.z * w2r[4 * j4 + 2] + a.w * w2r[4 * j4 + 3]; }
            const float ls = fminf(pre, 0.f) - __logf(1.f + __expf(-fabsf(pre)));
            run += ls * (1.f / 16.f); bc[i] = run; }
        WT[wave * 64 + lane] = run;
        __syncthreads();
        float off = 0.f, tot = 0.f;
#pragma unroll
        for (int s = 0; s < 8; ++s) { const float wv = WT[s * 64 + lane]; tot += wv; off += (s < wave) ? wv : 0.f; }
#pragma unroll
        for (int i = 0; i < 8; ++i) { const float bcum = bc[i] + off; const int t = 8 * wave + i;
            const float qv = __uint_as_float((unsigned)*(LAS const unsigned short*)(lds + GQ_QRAW + t * GP + 2 * lane) << 16), kv = __uint_as_float((unsigned)*(LAS const unsigned short*)(lds + GQ_KRAW + t * GP + 2 * lane) << 16);
            const unsigned wq = cvtpk(qv * 0.125f * __expf(bcum), kv * __expf(-bcum)); const unsigned wk = cvtpk(kv * __expf(tot - bcum), 0.f);
            *(LAS unsigned short*)(lds + GQ_QE + t * GP + 2 * lane) = (unsigned short)wq; *(LAS unsigned short*)(lds + GQ_KE + t * GP + 2 * lane) = (unsigned short)(wq >> 16);
            *(LAS unsigned short*)(lds + GQ_KD + t * GP + 2 * lane) = (unsigned short)wk; }
        if (wave == 0) DEC[(size_t)(bh * 64 + c) * 64 + lane] = __expf(tot);
        __syncthreads();
        { const v4u a = *(LAS const v4u*)(lds + GQ_QE + st_t * GP + st_p * 16), k2 = *(LAS const v4u*)(lds + GQ_KE + st_t * GP + st_p * 16), k3 = *(LAS const v4u*)(lds + GQ_KD + st_t * GP + st_p * 16);
          bf16* ur = U + (tok0 + st_t) * LDU; *(GAS v4u*)(ur + U_GQ + h * 64 + st_p * 8) = a; *(GAS v4u*)(ur + U_GK + h * 64 + st_p * 8) = k2; *(GAS v4u*)(KD + (tok0 + st_t) * 1024 + h * 64 + st_p * 8) = k3; }
    }
    __syncthreads();
#undef GLA_PLOAD
}
__device__ __forceinline__ void gla_chain_mfma2(Frame& F, KArgs ap, int bh) {
    unsigned char* ws_ = ap->ws;
    const int b = bh >> 4, h = bh & 15;
    int lane = F.lane; asm volatile("" : "+v"(lane));
    const int wave = F.wave, tid = wave * 64 + lane, n = lane & 15, g = lane >> 4;
    LAS unsigned char* lds = F.lds;
    const bf16* U = (const bf16*)(ws_ + WS_U); const bf16* KDg = (const bf16*)(ws_ + WS_KD); const float* DECg = (const float*)(ws_ + WS_DEC); bf16* OG = (bf16*)(ws_ + WS_OGLA);
    LAS float* DEC = (LAS float*)(lds + GL_DEC); LAS float* SSQ = (LAS float*)(lds + GL_SSQ);
    for (int i = tid; i < 128 * GP / 4; i += 512) ((LAS unsigned*)(lds + GL_ST))[i] = 0u;
    const int tt = wave & 3, eh = wave >> 2;
    f32x4 Sr[4];
#pragma unroll
    for (int el = 0; el < 4; ++el) Sr[el] = (f32x4){0.f, 0.f, 0.f, 0.f};
    f32x4 gain[4];
#pragma unroll
    for (int el = 0; el < 4; ++el) gain[el] = *(const GAS f32x4*)(ap->in[5] + h * 128 + 16 * (4 * eh + el) + 4 * g);
    const int st_t = tid >> 3, st_p = tid & 7;
    v4u p_q, p_k, p_kd, p_v0, p_v1; v2u p_r[4]; float p_dec;
#define GLA_LOAD2(cc) do { const size_t tk = (size_t)b * SEQ + (cc) * 64; const bf16* ur = U + (tk + st_t) * LDU; \
        p_q = *(const GAS v4u*)(ur + U_GQ + h * 64 + st_p * 8); p_k = *(const GAS v4u*)(ur + U_GK + h * 64 + st_p * 8); p_kd = *(const GAS v4u*)(KDg + (tk + st_t) * 1024 + h * 64 + st_p * 8); \
        p_v0 = *(const GAS v4u*)(ur + U_GV + h * 128 + st_p * 16); p_v1 = *(const GAS v4u*)(ur + U_GV + h * 128 + st_p * 16 + 8); \
        p_dec = DECg[(size_t)(bh * 64 + (cc)) * 64 + (tid & 63)]; \
        _Pragma("unroll") for (int el = 0; el < 4; ++el) p_r[el] = *(const GAS v2u*)(U + (tk + 16 * tt + n) * LDU + U_GR + h * 128 + 16 * (4 * eh + el) + 4 * g); } while (0)
    GLA_LOAD2(0);
    __syncthreads();
    for (int c = 0; c < 64; ++c) {
        const size_t tok0 = (size_t)b * SEQ + c * 64;
        *(LAS v4u*)(lds + GL_V + st_t * GP + st_p * 32) = p_v0; *(LAS v4u*)(lds + GL_V + st_t * GP + st_p * 32 + 16) = p_v1;
        *(LAS v4u*)(lds + GL_QE + st_t * GP + st_p * 16) = p_q; *(LAS v4u*)(lds + GL_KE + st_t * GP + st_p * 16) = p_k; *(LAS v4u*)(lds + GL_KD + st_t * GP + st_p * 16) = p_kd;
        if (wave == 0) DEC[lane] = p_dec;
        v2u rcur[4];
#pragma unroll
        for (int el = 0; el < 4; ++el) rcur[el] = p_r[el];
        if (c + 1 < 64) GLA_LOAD2(c + 1);
        __syncthreads();
        f32x4 at[4]; bf16x8_t qfr[2];
#pragma unroll
        for (int st = 0; st < 4; ++st) at[st] = (f32x4){0.f, 0.f, 0.f, 0.f};
#pragma unroll
        for (int ks = 0; ks < 2; ++ks) { qfr[ks] = *(LAS const bf16x8_t*)(lds + GL_QE + (16 * tt + n) * GP + 64 * ks + 16 * g);
#pragma unroll
            for (int st = 0; st < 4; ++st) if (st <= tt) { const bf16x8_t kf = *(LAS const bf16x8_t*)(lds + GL_KE + (16 * st + n) * GP + 64 * ks + 16 * g);
                at[st] = __builtin_amdgcn_mfma_f32_16x16x32_bf16(kf, qfr[ks], at[st], 0, 0, 0); } }
#pragma unroll
        for (int st = 0; st < 4; ++st) if (st == tt) {
#pragma unroll
            for (int i = 0; i < 4; ++i) if (4 * g + i > n) at[st][i] = 0.f; }
        bf16x8_t pf[2];
#pragma unroll
        for (int k2 = 0; k2 < 2; ++k2) { v4u w; w.x = cvtpk(at[2 * k2][0], at[2 * k2][1]); w.y = cvtpk(at[2 * k2][2], at[2 * k2][3]); w.z = cvtpk(at[2 * k2 + 1][0], at[2 * k2 + 1][1]); w.w = cvtpk(at[2 * k2 + 1][2], at[2 * k2 + 1][3]);
            pf[k2] = __builtin_bit_cast(bf16x8_t, w); }
        f32x4 o[4];
#pragma unroll
        for (int el = 0; el < 4; ++el) o[el] = (f32x4){0.f, 0.f, 0.f, 0.f};
        const float dec = DEC[16 * tt + n];
#pragma unroll
        for (int el = 0; el < 4; ++el) Sr[el] *= dec;
        LAS const unsigned char* trb = lds + (4 * g + (n >> 2)) * GP + (n & 3) * 8;
#pragma unroll
        for (int k2 = 0; k2 < 2; ++k2) { const bf16x8_t kdf = tr2(trb + GL_KD + 32 * k2 * GP + 32 * tt);
#pragma unroll
            for (int el = 0; el < 4; ++el) { const bf16x8_t vf = tr2(trb + GL_V + 32 * k2 * GP + 32 * (4 * eh + el));
                if (2 * k2 <= tt) o[el] = __builtin_amdgcn_mfma_f32_16x16x32_bf16(vf, pf[k2], o[el], 0, 0, 0);
                Sr[el] = __builtin_amdgcn_mfma_f32_16x16x32_bf16(vf, kdf, Sr[el], 0, 0, 0); } }
#pragma unroll
        for (int ks = 0; ks < 2; ++ks)
#pragma unroll
            for (int el = 0; el < 4; ++el) { const bf16x8_t sf = *(LAS const bf16x8_t*)(lds + GL_ST + (16 * (4 * eh + el) + n) * GP + 64 * ks + 16 * g);
                o[el] = __builtin_amdgcn_mfma_f32_16x16x32_bf16(sf, qfr[ks], o[el], 0, 0, 0); }
        float ss = 0.f;
#pragma unroll
        for (int el = 0; el < 4; ++el) ss += (o[el][0] * o[el][0] + o[el][1] * o[el][1]) + (o[el][2] * o[el][2] + o[el][3] * o[el][3]);
        ss = xrow16_sum(ss);
        if (g == 0) SSQ[(16 * tt + n) * 2 + eh] = ss;
        __syncthreads();
#pragma unroll
        for (int el = 0; el < 4; ++el) { const unsigned w0 = cvtpk(Sr[el][0], Sr[el][1]), w1 = cvtpk(Sr[el][2], Sr[el][3]); LAS unsigned char* sp = lds + GL_ST + (16 * (4 * eh + el) + 4 * g) * GP + 2 * (16 * tt + n);
            *(LAS unsigned short*)(sp) = (unsigned short)w0; *(LAS unsigned short*)(sp + GP) = (unsigned short)(w0 >> 16); *(LAS unsigned short*)(sp + 2 * GP) = (unsigned short)w1; *(LAS unsigned short*)(sp + 3 * GP) = (unsigned short)(w1 >> 16); }
        const int t = 16 * tt + n; const float rstd = 1.f / sqrtf((SSQ[2 * t] + SSQ[2 * t + 1]) * (1.f / 128.f) + NORM_EPS);
#pragma unroll
        for (int el = 0; el < 4; ++el) { const int e0 = 16 * (4 * eh + el) + 4 * g; const v2u rw = rcur[el];
            v2u ow; ow.x = cvtpk(o[el][0] * rstd * gain[el][0] * bfl(rw.x), o[el][1] * rstd * gain[el][1] * bfh(rw.x)); ow.y = cvtpk(o[el][2] * rstd * gain[el][2] * bfl(rw.y), o[el][3] * rstd * gain[el][3] * bfh(rw.y));
            *(GAS v2u*)(OG + (tok0 + t) * 2048 + h * 128 + e0) = ow; }
    }
    __syncthreads();
#undef GLA_LOAD2
}
__device__ __forceinline__ void nsa_wg_all(Frame& F, KArgs ap, int w, int nw, size_t on_off) {
    for (int k = 0;; ++k) { const int idx = (k & 1) ? k * nw + (nw - 1 - w) : k * nw + w; if (k * nw >= 1024) break; if (idx >= 1024) continue;
        const int qt = 63 - (idx >> 4), bg = idx & 15; nsa_wg_item(F, ap, ((bg >> 2) << 8) | ((bg & 3) << 6) | qt, on_off); }
}
#ifndef NSA_XCDQ
#define NSA_XCDQ 1
#endif
constexpr int CW_QHEAD = 3072;
__device__ __forceinline__ void nsa_wg_queue(Frame& F, KArgs ap, size_t on_off, int hq) {
    unsigned* head = (unsigned*)(ap->ws + WS_CTL) + CW_QHEAD + hq; volatile LAS unsigned* slot = F.MISC + 16;
#if NSA_XCDQ
    const int x0 = F.blk & 7;
    for (int s = 0; s < 8; ++s) { const int x = (x0 + s) & 7; unsigned* hx = head + 16 * x;
        for (;;) {
            if (F.tid == 0) slot[0] = __hip_atomic_fetch_add(hx, 1u, __ATOMIC_RELAXED, __HIP_MEMORY_SCOPE_AGENT);
            __syncthreads();
            const int k = (int)slot[0];
            __syncthreads();
            if (k >= 128) break;
            const int qt = NSA_XCDQ == 2 ? 63 - (k & 63) : 63 - (k >> 1), bg = NSA_XCDQ == 2 ? 2 * x + (k >> 6) : 2 * x + (k & 1); nsa_wg_item(F, ap, ((bg >> 2) << 8) | ((bg & 3) << 6) | qt, on_off);
        } }
#else
    for (;;) {
        if (F.tid == 0) slot[0] = __hip_atomic_fetch_add(head, 1u, __ATOMIC_RELAXED, __HIP_MEMORY_SCOPE_AGENT);
        __syncthreads();
        const int idx = (int)slot[0];
        __syncthreads();
        if (idx >= 1024) break;
        const int qt = 63 - (idx >> 4), bg = idx & 15; nsa_wg_item(F, ap, ((bg >> 2) << 8) | ((bg & 3) << 6) | qt, on_off);
    }
#endif
}
#ifndef GLA_IMPL
#define GLA_IMPL 2
#endif
#if GLA_IMPL == 0
#define GLA_CHAIN gla_chain
#elif GLA_IMPL == 1
#define GLA_CHAIN gla_chain_mfma
#else
#define GLA_CHAIN gla_chain_mfma2
#endif
#ifndef NSA_IMPL
#define NSA_IMPL 2
#endif
__device__ __forceinline__ void p5_mixers(Frame& F, KArgs ap, int rep = 0) {
    const int nG = F.G >= 128 ? 64 : (F.G >= 8 ? F.G / 4 : 1);
#if NSA_IMPL == 2
    if (F.blk < nG) { for (int bh = F.blk; bh < BATCH * GLA_H; bh += nG) GLA_CHAIN(F, ap, bh); }
    nsa_wg_queue(F, ap, WS_ONSA, 128 * rep);
#else
    if (F.blk < nG) { for (int bh = F.blk; bh < BATCH * GLA_H; bh += nG) GLA_CHAIN(F, ap, bh); }
    else if (F.G > nG) {
#if NSA_IMPL == 0
        LAS float* wl = (LAS float*)F.lds + F.wave * 2048;
        const int nw = (F.G - nG) * NWAVES; for (int it = (F.blk - nG) * NWAVES + F.wave; it < BATCH * NSA_G * SEQ; it += nw) nsa_item(F, ap, it, wl);
#else
        nsa_wg_all(F, ap, F.blk - nG, F.G - nG, WS_ONSA);
#endif
    }
#endif
}

#if defined(NSA_CHECK)
#define CHECK_AMP NSA_CHECK
#elif defined(GLA_CHECK)
#define CHECK_AMP GLA_CHECK
#endif
#ifndef PHM
#define PHM 0xFFF
#endif
__global__ void __launch_bounds__(NWAVES * 64, 2) hybrid_fwd(Args args) {
    extern __shared__ __attribute__((aligned(16))) unsigned char lds[];
    Frame F;
    F.lds = (LAS unsigned char*)lds; F.MISC = (volatile LAS unsigned*)(F.lds + MISC_OFF);
    F.tid = threadIdx.x; F.lane = F.tid & 63; F.wave = __builtin_amdgcn_readfirstlane(F.tid >> 6);
    F.G = gridDim.x; F.blk = blockIdx.x;
    for (int u = F.tid; u < (LDS_BYTES - LDSCTL_OFF) / 4; u += NWAVES * 64) ((LAS unsigned*)(F.lds + LDSCTL_OFF))[u] = 0u;
    __syncthreads();
    const int lo = args.ph_lo, hi = args.ph_hi;
    if (hi - lo > 1 && F.tid == 0) { unsigned* bw = (unsigned*)(args.ws + WS_CTL) + CW_BAR; (void)xb_add(&bw[XB_XCNT(xb_xcc_id())], 1u); }
#define IN(k) (((PHM >> (k)) & 1) && lo <= (k) && (k) < hi)
#ifndef PH_REP
#define PH_REP 0
#endif
#ifndef PH_REPN
#define PH_REPN 2
#endif
#define NREP(k) (((PH_REP >> (k)) & 1) ? PH_REPN : 1)
#define FRESH() KArgs ap = fresh_args(); unsigned char* ws = ap->ws; (void)ws; { int _l; asm volatile("v_mbcnt_lo_u32_b32 %0, -1, 0\n\tv_mbcnt_hi_u32_b32 %0, -1, %0" : "=v"(_l)); F.lane = _l; F.tid = F.wave * 64 + _l; }
#ifndef WGM_UP
#define WGM_UP 8
#endif
#ifndef WGM_DOWN
#define WGM_DOWN 8
#endif
#ifndef DEPH9
#define DEPH9 1
#endif
#ifndef STAG_TICKS
#define STAG_TICKS 0
#endif
#ifndef STAG_MASK
#define STAG_MASK 0
#endif
#define STAGGER_P(k) do { if ((STAG_MASK >> (k)) & 1) STAGGER(); } while (0)
#define STAGGER() do { const unsigned long long t0_ = __builtin_amdgcn_s_memrealtime(); const unsigned long long dl_ = (unsigned long long)xb_xcc_id() * STAG_TICKS; while (__builtin_amdgcn_s_memrealtime() - t0_ < dl_) __builtin_amdgcn_s_sleep(8); } while (0)
#define SEAM(k) do { if (IN(k) && IN((k) + 1)) { XcdBarrier bar; bar.bar = (unsigned*)(ws + WS_CTL) + CW_BAR; bar.x = xb_xcc_id(); bar.st = F.MISC + 8; xcd_barrier(bar, F.wave); } } while (0)
    LAS unsigned char* ring = F.lds;

    if (IN(0)) for (int rep_ = 0; rep_ < NREP(0); ++rep_) { FRESH(); p0_prologue(F, ap); SEAM(0); }
#ifdef EXTRA_SEAMS
    for (int xs_ = 0; xs_ < EXTRA_SEAMS; ++xs_) { FRESH(); SEAM(0); }
#endif
    if (IN(1)) for (int rep_ = 0; rep_ < NREP(1); ++rep_) {
        FRESH();
        { pg8::Gemm g{(const pg8::bf16_t*)(ws + WS_H), (const pg8::bf16_t*)(ws + WS_WIN), M, NB16, D}; pg8::StaticOrder S; S.init(M, NB16, F.G, F.blk);
          pg8::EpiU E{(pg8::bf16_t*)(ws + WS_U), LDU, 0, 1.f, GATE_FP8 != 0};
          STAGGER_P(1);
          pg8::gemm_phase<pg8::EpiU, pg8::StaticOrder, true, true>(ring, g, S, E, F.wave); }
#if GATE_FP8
        { FRESH();
          pg8::Gemm g{(const pg8::bf16_t*)(ws + WS_H8), (const pg8::bf16_t*)(ws + WS_WG8), M, NG8, D / 2};
          pg8::EpiU E{(pg8::bf16_t*)(ws + WS_U), LDU, 44, 1.f / 64.f, false};
          if (F.G == 256) { pg8::LateOrder S; S.init2(M, NG8, F.G, F.blk, 64, 2);
              pg8::gemm_phase<pg8::EpiU, pg8::LateOrder, true, true, true>(ring, g, S, E, F.wave); }
          else { pg8::StaticOrder S; S.init(M, NG8, F.G, F.blk); pg8::gemm_phase<pg8::EpiU, pg8::StaticOrder, true, true, true>(ring, g, S, E, F.wave); } }
#endif
        SEAM(1);
    }
    if (IN(2)) for (int rep_ = 0; rep_ < NREP(2); ++rep_) { FRESH(); p2_im2col(F, ap); SEAM(2); }
    if (IN(3)) for (int rep_ = 0; rep_ < NREP(3); ++rep_) {
        FRESH();
        pg8::Gemm g{(const pg8::bf16_t*)(ws + WS_ACMP), (const pg8::bf16_t*)(ws + WS_W1C), 8192, 256, 4096}; pg8::StaticOrder S; S.init(8192, 256, F.G, F.blk);
        pg8::EpiAct<1> E{(pg8::bf16_t*)(ws + WS_HC), 256};
        pg8::gemm_phase<pg8::EpiAct<1>, pg8::StaticOrder, true, true, false, true>(ring, g, S, E, F.wave);
        VM_WAIT(); __syncthreads();
        { FRESH();
          pg8::Gemm g2{(const pg8::bf16_t*)(ws + WS_HC), (const pg8::bf16_t*)(ws + WS_W2B), 8192, 256, 256}; pg8::StaticOrder S2; S2.init(8192, 256, F.G, F.blk);
          pg8::EpiAct<0> E2{(pg8::bf16_t*)(ws + WS_OC), 256};
          pg8::gemm_phase<pg8::EpiAct<0>, pg8::StaticOrder, true, true>(ring, g2, S2, E2, F.wave); }
#if GLA_IMPL == 2
        if (F.blk >= 32 && F.G > 32) { FRESH(); gla_pre_items(F, ap, F.blk - 32, F.G - 32);
            if (P0_DEFER) p0_prologue(F, ap, false, (F.blk - 32) * NWAVES + F.wave, (F.G - 32) * NWAVES); }
#endif
        SEAM(3);
    }
#if defined(NSA_CHECK)
    if (IN(5)) {
        { FRESH(); const int nG = 64; if (F.blk < nG) gla_chain(F, ap, F.blk); else { LAS float* wl = (LAS float*)F.lds + F.wave * 2048; const int nw = (F.G - nG) * NWAVES; for (int it = (F.blk - nG) * NWAVES + F.wave; it < BATCH * NSA_G * SEQ; it += nw) nsa_item(F, ap, it, wl); }
          XcdBarrier bar; bar.bar = (unsigned*)(ws + WS_CTL) + CW_BAR; bar.x = xb_xcc_id(); bar.st = F.MISC + 8; xcd_barrier(bar, F.wave); }
        { FRESH(); nsa_wg_all(F, ap, F.blk, F.G, WS_R2 + 192 * MiB);
          XcdBarrier bar; bar.bar = (unsigned*)(ws + WS_CTL) + CW_BAR; bar.x = xb_xcc_id(); bar.st = F.MISC + 8; xcd_barrier(bar, F.wave); }
        { FRESH(); const bf16* a = (const bf16*)(ws + WS_ONSA); const bf16* c = (const bf16*)(ws + WS_R2 + 192 * MiB); float num = 0.f, den = 0.f;
          for (size_t i = (size_t)F.blk * 512 + F.tid; i < (size_t)M * 2048; i += (size_t)F.G * 512) { const float x = __uint_as_float((unsigned)a[i] << 16), y = __uint_as_float((unsigned)c[i] << 16); num += (x - y) * (x - y); den += x * x; }
          num = wave_sum(num); den = wave_sum(den); float* cw = (float*)(ws + WS_CTL) + 2048; if (F.lane == 0) { atomicAdd(cw, num); atomicAdd(cw + 64, den); }
          SEAM(5); } }
#elif defined(GLA_CHECK)
    if (IN(5)) {
        { FRESH(); if (F.blk < 64) gla_chain(F, ap, F.blk); else if (F.blk < 128) gla_chain_mfma(F, ap, F.blk - 64, WS_R2 + 192 * MiB); else nsa_wg_all(F, ap, F.blk - 128, F.G - 128, WS_ONSA);
          XcdBarrier bar; bar.bar = (unsigned*)(ws + WS_CTL) + CW_BAR; bar.x = xb_xcc_id(); bar.st = F.MISC + 8; xcd_barrier(bar, F.wave); }
        { FRESH(); const bf16* a = (const bf16*)(ws + WS_OGLA); const bf16* c = (const bf16*)(ws + WS_R2 + 192 * MiB); float num = 0.f, den = 0.f;
          for (size_t i = (size_t)F.blk * 512 + F.tid; i < (size_t)M * 2048; i += (size_t)F.G * 512) { const float x = __uint_as_float((unsigned)a[i] << 16), y = __uint_as_float((unsigned)c[i] << 16); num += (x - y) * (x - y); den += x * x; }
          num = wave_sum(num); den = wave_sum(den); float* cw = (float*)(ws + WS_CTL) + 2048; if (F.lane == 0) { atomicAdd(cw, num); atomicAdd(cw + 64, den); }
          SEAM(5); } }
#else
    if (IN(5)) for (int rep_ = 0; rep_ < NREP(5); ++rep_) { FRESH(); p5_mixers(F, ap, rep_); SEAM(5); }
#endif
    if (IN(6)) for (int rep_ = 0; rep_ < NREP(6); ++rep_) {
        { FRESH();
          pg8::Gemm g{(const pg8::bf16_t*)(ws + WS_OGLA), (const pg8::bf16_t*)(ws + WS_WGLA), M, D, 2048, (const pg8::bf16_t*)(ws + WS_ONSA), (const pg8::bf16_t*)(ws + WS_WNSA)};
          pg8::ChainOrder S; S.init(M, D, F.G, F.blk);
          pg8::EpiMixC E{(pg8::bf16_t*)(ws + WS_MIX), D, (const pg8::bf16_t*)(ws + WS_U) + U_MG, (const pg8::bf16_t*)(ws + WS_U) + U_MN, LDU};
          STAGGER_P(6);
          pg8::gemm_phase<pg8::EpiMixC, pg8::ChainOrder, true, true>(ring, g, S, E, F.wave);
          SEAM(6); }
    }
    if (IN(7)) for (int rep_ = 0; rep_ < NREP(7); ++rep_) {
        FRESH();
        pg8::Gemm g{(const pg8::bf16_t*)(ws + WS_MIX), (const pg8::bf16_t*)(ws + WS_WOUT), M, D, D}; pg8::StaticOrder S; S.init(M, D, F.G, F.blk);
        pg8::EpiResB<false> E{ap->in[0], (pg8::bf16_t*)(ws + WS_H2), D, (float*)(ws + WS_RS)};
        STAGGER_P(7);
        pg8::gemm_phase<pg8::EpiResB<false>, pg8::StaticOrder, true, true>(ring, g, S, E, F.wave);
        SEAM(7);
    }
    if (IN(8)) for (int rep_ = 0; rep_ < NREP(8); ++rep_) {
        FRESH();
        const int gw = F.blk * NWAVES + F.wave, NGW = F.G * NWAVES; LAS float* scr = (LAS float*)(F.lds + F.wave * 16384);
        bf16* H2 = (bf16*)(ws + WS_H2); bf16* WdT = (bf16*)(ws + WS_WDOWN); const float* x1 = ap->out;
#if !DEPH9
        { const float* Wd = ap->in[18]; const int lane_ = F.lane;
          auto dec = [&](int r) -> TD { TD d; const int nblk = D / 32; int kb, nb; TR_MAP(r, nblk, kb, nb); d.W = Wd; d.WT = (unsigned char*)WdT; d.K = FF; d.ldw = D; d.drow = 32 * nb; d.k0 = 64 * kb; d.scol = 32 * nb + (lane_ & 31); d.f8 = 0; d.rs = nullptr; return d; };
          transpose_stream(F, dec, (FF / 64) * (D / 32), scr, gw, NGW); }
#endif
        { const float* RS = (const float*)(ws + WS_RS); float* RS2 = (float*)(ws + WS_RS2);
          for (int m = gw; m < M; m += NGW) { const float t = wave_sum(RS[(size_t)m * 64 + F.lane]); if (F.lane == 0) RS2[m] = 1.f / (t * (1.f / D) + NORM_EPS); } }
        SEAM(8);
    }
    if (IN(9)) for (int rep_ = 0; rep_ < NREP(9); ++rep_) {
        FRESH();
        pg8::Gemm g{(const pg8::bf16_t*)(ws + WS_H2), (const pg8::bf16_t*)(ws + WS_WUP), M, FF, D}; pg8::StaticOrder S; S.init(M, FF, F.G, F.blk, WGM_UP);
        pg8::EpiRelu2R E{(pg8::bf16_t*)(ws + WS_U), FF, (const float*)(ws + WS_RS2)};
        STAGGER_P(9);
#if DEPH9
        const bool grpA = (F.G % 8 == 0) ? ((F.blk & 7) < 4) : true; const int nhalf = (F.G % 8 == 0) ? 2 : 1;
        const int gidx = (F.G % 8 == 0) ? ((F.blk >> 3) * 4 + (F.blk & 3)) : F.blk, gcnt = (F.G % 8 == 0) ? F.G / 2 : F.G;
        const int NIT9 = (FF / 64) * (D / 32);
#define DEPH9_COPY(lo_, hi_) do { FRESH(); const float* Wd = ap->in[18]; bf16* WdT = (bf16*)(ws + WS_WDOWN); const int lane_ = F.lane; LAS float* scr = (LAS float*)(F.lds + F.wave * 16384); const int lo9 = (lo_); \
          auto dec = [&](int r0) -> TD { TD d; const int r = r0 + lo9; const int nblk = D / 32; int kb, nb; TR_MAP(r, nblk, kb, nb); d.W = Wd; d.WT = (unsigned char*)WdT; d.K = FF; d.ldw = D; d.drow = 32 * nb; d.k0 = 64 * kb; d.scol = 32 * nb + (lane_ & 31); d.f8 = 0; d.rs = nullptr; return d; }; \
          transpose_stream(F, dec, (hi_) - (lo_), scr, gidx * NWAVES + F.wave, gcnt * NWAVES); LDS_WAIT(); __syncthreads(); } while (0)
        if (grpA) DEPH9_COPY(0, NIT9 / nhalf);
#endif
        pg8::gemm_phase<pg8::EpiRelu2R, pg8::StaticOrder, true, true>(ring, g, S, E, F.wave);
#if DEPH9
        if (!grpA) { VM_WAIT(); __syncthreads(); DEPH9_COPY(NIT9 / 2, NIT9); }
#endif
        SEAM(9);
    }
    if (IN(10)) {
        FRESH();
        pg8::Gemm g{(const pg8::bf16_t*)(ws + WS_U), (const pg8::bf16_t*)(ws + WS_WDOWN), M, D, FF}; pg8::StaticOrder S; S.init(M, D, F.G, F.blk, WGM_DOWN);
        pg8::EpiResB<true> E{nullptr, (pg8::bf16_t*)(ws + WS_H2), D, (float*)(ws + WS_RS)};
        STAGGER_P(10);
        pg8::gemm_phase<pg8::EpiResB<true>, pg8::StaticOrder, true, true>(ring, g, S, E, F.wave);
        SEAM(10);
    }
    if (IN(11)) {
        FRESH();
        const int gw = F.blk * NWAVES + F.wave, NGW = F.G * NWAVES; float* xo = ap->out;
        { const bf16* X2 = (const bf16*)(ws + WS_H2); const float* RS = (const float*)(ws + WS_RS); const float* gf = ap->in[19];
          f32x4 gq[8][2]; { const GAS f32x4* gr = (const GAS f32x4*)gf + 2 * F.lane;
#pragma unroll
            for (int j = 0; j < 8; ++j) { gq[j][0] = gr[128 * j]; gq[j][1] = gr[128 * j + 1]; } }
          v4u wv[8]; float rsv = 0.f;
          if (gw < M) { const GAS v4u* xr = (const GAS v4u*)(X2 + (size_t)gw * D) + F.lane; rsv = RS[(size_t)gw * 64 + F.lane];
#pragma unroll
            for (int j = 0; j < 8; ++j) wv[j] = xr[64 * j]; }
          for (int m = gw; m < M; m += NGW) { v4u wn[8]; float rsn = 0.f; const bool has = m + NGW < M;
              if (has) { const GAS v4u* xr = (const GAS v4u*)(X2 + (size_t)(m + NGW) * D) + F.lane; rsn = RS[(size_t)(m + NGW) * 64 + F.lane];
#pragma unroll
                  for (int j = 0; j < 8; ++j) wn[j] = xr[64 * j]; }
              const float rstd = 1.f / sqrtf(wave_sum(rsv) * (1.f / D) + NORM_EPS);
              GAS f32x4* orow = (GAS f32x4*)(xo + (size_t)m * D) + 2 * F.lane;
#pragma unroll
              for (int j = 0; j < 8; ++j) { const v4u w = wv[j]; const f32x4 g0 = gq[j][0], g1 = gq[j][1];
                  orow[128 * j] = (f32x4){bfl(w.x) * rstd * g0.x, bfh(w.x) * rstd * g0.y, bfl(w.y) * rstd * g0.z, bfh(w.y) * rstd * g0.w};
                  orow[128 * j + 1] = (f32x4){bfl(w.z) * rstd * g1.x, bfh(w.z) * rstd * g1.y, bfl(w.w) * rstd * g1.z, bfh(w.w) * rstd * g1.w}; }
              if (has) { rsv = rsn;
#pragma unroll
                  for (int j = 0; j < 8; ++j) wv[j] = wn[j]; } } }
#if defined(NSA_CHECK) || defined(GLA_CHECK)
        { const float* cw = (const float*)(ws + WS_CTL) + 2048; const float e = sqrtf(cw[0] / cw[64]); const float sc = 1.f + CHECK_AMP * e;
          for (int m = gw; m < M; m += NGW) { GAS f32x4* xr = (GAS f32x4*)(xo + (size_t)m * D) + F.lane; for (int j = 0; j < 16; ++j) xr[64 * j] = xr[64 * j] * sc; } }
#endif
    }
#undef IN
#undef SEAM
#undef FRESH
}

extern "C" void kernel_launch(void* const* d_in, const int* in_sizes, int n_in, void* d_out, int out_size, void* d_ws, size_t ws_size, hipStream_t stream) {
    static int grid = 0;
    if (grid == 0) {
        if (n_in != 20 || in_sizes[0] != M * D || out_size != M * D || ws_size < WS_END) { fprintf(stderr, "kernel_launch: unexpected shapes (n_in %d, in0 %d, out %d, ws %zu); nothing launched\n", n_in, n_in > 0 ? in_sizes[0] : -1, out_size, ws_size); grid = -1; return; }
        int dev = 0, cus = 0, per_cu = 0;
        if (hipGetDevice(&dev) != hipSuccess || hipDeviceGetAttribute(&cus, hipDeviceAttributeMultiprocessorCount, dev) != hipSuccess) { grid = -1; return; }
        if (hipFuncSetAttribute((const void*)hybrid_fwd, hipFuncAttributeMaxDynamicSharedMemorySize, LDS_BYTES) != hipSuccess) { fprintf(stderr, "kernel_launch: hipFuncSetAttribute failed\n"); grid = -1; return; }
        if (hipOccupancyMaxActiveBlocksPerMultiprocessor(&per_cu, (const void*)hybrid_fwd, NWAVES * 64, LDS_BYTES) != hipSuccess || per_cu < 1) { fprintf(stderr, "kernel_launch: occupancy query says %d blocks per CU\n", per_cu); }
        (void)hipGetLastError();
        grid = cus;
    }
    if (grid < 0) return;
    if (hipMemsetAsync((char*)d_ws + WS_CTL, 0, CTL_ZERO_BYTES, stream) != hipSuccess) return;
    Args a{};
    for (int i = 0; i < 20; ++i) a.in[i] = (const float*)d_in[i];
    a.out = (float*)d_out; a.ws = (unsigned char*)d_ws;
    if (N_LAUNCHES == 1) { a.ph_lo = 0; a.ph_hi = NPHASE; hipLaunchKernelGGL(hybrid_fwd, dim3(grid), dim3(NWAVES * 64), LDS_BYTES, stream, a); }
    else for (int p = 0; p < NPHASE; ++p) { a.ph_lo = p; a.ph_hi = p + 1; hipLaunchKernelGGL(hybrid_fwd, dim3(grid), dim3(NWAVES * 64), LDS_BYTES, stream, a); }
}
```
